# Optimizing an MI355X kernel written in HIP

```python
import math
import jax, jax.numpy as jnp
from jax import lax
import numpy as np

D_MODEL = 2048
BATCH = 4
SEQ = 2048
DEPTH = 2

PLE_DIM = 256
W_CONF = 512
W_GLA = 512
W_DIL = 512
W_SC = 512
CONF_KERNEL = 31
GLA_HEADS = 4
GLA_DV = W_GLA // GLA_HEADS
GLA_DK = GLA_DV // 2
GLA_RANK = 16
GLA_TAU = 16.0
GLA_CHUNK = 32
DIL_HEADS = 8
DIL_HD = W_DIL // DIL_HEADS
DIL_BRANCHES = ((128, 1), (512, 4), (2048, 16))
DIL_BLOCK = 128
REL_BUCKETS = 32
REL_MAX_DIST = 2048
SC_KERNEL = 3
N_GROUPS = 4
EXPERTS_PER_GROUP = 8
N_EXPERTS = N_GROUPS * EXPERTS_PER_GROUP
TOP_K = 2
D_EXPERT = 256
DN_ALPHA = (2 * DEPTH) ** 0.25
DN_BETA = (8 * DEPTH) ** -0.25
LN_EPS = 1e-5
RMS_EPS = 1e-6
IN_SIZES = (2 * W_CONF,
            GLA_HEADS * GLA_DK, GLA_HEADS * GLA_DK, W_GLA, GLA_RANK, W_GLA,
            W_DIL, W_DIL, W_DIL,
            W_SC, W_SC, W_SC)
D_IN = 2 * W_CONF + 2 * GLA_HEADS * GLA_DK + 2 * W_GLA + GLA_RANK + 3 * W_DIL + 3 * W_SC

kernel_name = 'hybrid_parallel_mixers_hmoe_deepnorm'


def layer_norm(x, g, b):
    xf = x.astype(jnp.float32)
    mu = jnp.mean(xf, axis=-1, keepdims=True)
    var = jnp.mean(jnp.square(xf - mu), axis=-1, keepdims=True)
    return ((xf - mu) * lax.rsqrt(var + LN_EPS)).astype(x.dtype) * g + b


def causal_dwconv(x, w):
    K, C = w.shape
    return lax.conv_general_dilated(x, w[:, None, :], window_strides=(1,), padding=[(K - 1, 0)],
                                    dimension_numbers=('NWC', 'WIO', 'NWC'), feature_group_count=C)


def conformer_conv(u, dw_w, dw_b, ln_g, ln_b):
    a, gate = jnp.split(u, 2, axis=-1)
    h = a * jax.nn.sigmoid(gate)
    h = causal_dwconv(h, dw_w) + dw_b
    h = layer_norm(h, ln_g, ln_b)
    return jax.nn.silu(h)


def gla_mixer(q, k, v, g_low, r, w_g2, b_g2, norm_g):
    Bsz, S, _ = q.shape
    H, dk, dv, C = GLA_HEADS, GLA_DK, GLA_DV, GLA_CHUNK
    n = S // C
    f32 = jnp.float32
    log_a = jax.nn.log_sigmoid((g_low @ w_g2 + b_g2).astype(f32)) / GLA_TAU

    def chunked(t, d):
        return t.astype(f32).reshape(Bsz, n, C, H, d).transpose(0, 3, 1, 2, 4)

    qc = chunked(q, dk) * (dk ** -0.5)
    kc = chunked(k, dk)
    vc = chunked(v, dv)
    b = jnp.cumsum(chunked(log_a, dk), axis=3)
    causal = jnp.tril(jnp.ones((C, C), dtype=bool))
    rel = jnp.where(causal[:, :, None], b[:, :, :, :, None, :] - b[:, :, :, None, :, :], -jnp.inf)
    scores = jnp.sum(qc[:, :, :, :, None, :] * kc[:, :, :, None, :, :] * jnp.exp(rel), axis=-1)
    o_intra = jnp.einsum('bhnij,bhnjv->bhniv', scores, vc)
    b_last = b[:, :, :, -1:, :]
    upd = jnp.einsum('bhnjk,bhnjv->bhnkv', kc * jnp.exp(b_last - b), vc)
    decay = jnp.exp(b_last[:, :, :, 0, :])

    def step(state, inp):
        dec, u = inp
        return state * dec[..., None] + u, state

    s0 = jnp.zeros((Bsz, H, dk, dv), f32)
    _, s_prev = lax.scan(step, s0, (jnp.moveaxis(decay, 2, 0), jnp.moveaxis(upd, 2, 0)))
    s_prev = jnp.moveaxis(s_prev, 0, 2)
    o_inter = jnp.einsum('bhnik,bhnkv->bhniv', qc * jnp.exp(b), s_prev)
    o = (o_intra + o_inter).transpose(0, 2, 3, 1, 4).reshape(Bsz, S, H, dv)
    o = o * lax.rsqrt(jnp.mean(o * o, axis=-1, keepdims=True) + RMS_EPS)
    o = (o.astype(v.dtype) * norm_g).reshape(Bsz, S, H * dv)
    return o * jax.nn.silu(r)


def t5_bucket(dist):
    max_exact = REL_BUCKETS // 2
    large = max_exact + (jnp.log(jnp.maximum(dist, 1).astype(jnp.float32) / max_exact)
                         / math.log(REL_MAX_DIST / max_exact) * (REL_BUCKETS - max_exact)).astype(jnp.int32)
    large = jnp.minimum(large, REL_BUCKETS - 1)
    return jnp.where(dist < max_exact, dist, large)


def dilated_branch(q, k, v, rel_bias, window, dil):
    Bsz, S, H, Dh = q.shape
    L = S // dil
    nb = -(-L // DIL_BLOCK)
    Lp = nb * DIL_BLOCK
    span = window // dil
    f32 = jnp.float32

    def by_stride(t):
        t = t.reshape(Bsz, L, dil, H, Dh).transpose(0, 2, 3, 1, 4)
        t = jnp.pad(t, ((0, 0), (0, 0), (0, 0), (0, Lp - L), (0, 0)))
        return t.reshape(Bsz, dil, H, nb, DIL_BLOCK, Dh)

    def band(t):
        prev = jnp.pad(t, ((0, 0), (0, 0), (0, 0), (1, 0), (0, 0), (0, 0)))[:, :, :, :-1]
        return jnp.concatenate([prev, t], axis=4)

    qs = by_stride(q)
    kb = band(by_stride(k))
    vb = band(by_stride(v))
    qi = jnp.arange(DIL_BLOCK)[:, None]
    kj = jnp.arange(2 * DIL_BLOCK)[None, :]
    steps = qi + DIL_BLOCK - kj
    valid = ((steps >= 0) & (steps <= span))[None] & ((jnp.arange(nb)[:, None, None] > 0) | (kj >= DIL_BLOCK)[None])
    bias = rel_bias[t5_bucket(jnp.maximum(steps, 0) * dil)].transpose(2, 0, 1).astype(f32)
    s = jnp.einsum('brhnqe,brhnke->brhnqk', qs, kb).astype(f32) * (Dh ** -0.5) + bias[None, None, :, None]
    s = jnp.where(valid[None, None, None], s, -jnp.inf)
    m = jnp.max(s, axis=-1, keepdims=True)
    pexp = jnp.exp(s - m)
    l = jnp.sum(pexp, axis=-1, keepdims=True)
    o = jnp.einsum('brhnqk,brhnke->brhnqe', pexp, vb.astype(f32)) / l
    lse = (m + jnp.log(l))[..., 0]
    o = o.reshape(Bsz, dil, H, Lp, Dh)[:, :, :, :L].transpose(0, 3, 1, 2, 4).reshape(Bsz, S, H, Dh)
    lse = lse.reshape(Bsz, dil, H, Lp)[:, :, :, :L].transpose(0, 3, 1, 2).reshape(Bsz, S, H)
    return o, lse


def dilated_mixer(q, k, v, rel_bias):
    Bsz, S, _ = q.shape
    q = q.reshape(Bsz, S, DIL_HEADS, DIL_HD)
    k = k.reshape(Bsz, S, DIL_HEADS, DIL_HD)
    v = v.reshape(Bsz, S, DIL_HEADS, DIL_HD)
    outs, lses = [], []
    for window, dil in DIL_BRANCHES:
        o, lse = dilated_branch(q, k, v, rel_bias, window, dil)
        outs.append(o)
        lses.append(lse)
    w = jax.nn.softmax(jnp.stack(lses, axis=0), axis=0)
    o = jnp.sum(w[..., None] * jnp.stack(outs, axis=0), axis=0)
    return o.reshape(Bsz, S, W_DIL).astype(v.dtype)


def short_gated_conv(b_gate, c_gate, h, conv_w):
    return b_gate * causal_dwconv(c_gate * h, conv_w)


def hier_moe(x, rg_w, rg_b, re_w, re_b, w_gate, w_up, w_down):
    Bsz, S, D = x.shape
    t = x.reshape(-1, D)
    f32 = jnp.float32
    g_prob = jax.nn.softmax((t @ rg_w + rg_b).astype(f32), axis=-1)
    g_top, g_idx = lax.top_k(g_prob, 1)
    e_logits = (t @ re_w + re_b).astype(f32).reshape(-1, N_GROUPS, EXPERTS_PER_GROUP)
    e_logits = jnp.take_along_axis(e_logits, g_idx[:, :, None], axis=1)[:, 0]
    e_top, e_idx = lax.top_k(jax.nn.softmax(e_logits, axis=-1), TOP_K)
    gate = g_top * (e_top / jnp.sum(e_top, axis=-1, keepdims=True))
    expert = g_idx * EXPERTS_PER_GROUP + e_idx
    combine = jnp.sum(jax.nn.one_hot(expert, N_EXPERTS, dtype=f32) * gate[..., None], axis=1)
    h = jax.nn.silu(jnp.einsum('td,edf->tef', t, w_gate)) * jnp.einsum('td,edf->tef', t, w_up)
    h = h * combine.astype(h.dtype)[:, :, None]
    y = jnp.einsum('tef,efd->td', h, w_down)
    return y.reshape(Bsz, S, D)


def setup_inputs(seed: int = 0) -> dict:
    key = jax.random.key(seed)
    ks = iter(jax.random.split(key, 32))

    def nrm(shape, scale):
        return jax.random.normal(next(ks), shape, jnp.float32) * scale

    L = DEPTH
    return {
        'x': nrm((BATCH, SEQ, D_MODEL), 1.0),
        'p': nrm((DEPTH, BATCH, SEQ, PLE_DIM), 1.0),
        'w_in': nrm((L, D_MODEL, D_IN), D_MODEL ** -0.5),
        'conf_dw_w': nrm((L, CONF_KERNEL, W_CONF), CONF_KERNEL ** -0.5),
        'conf_dw_b': nrm((L, W_CONF), 0.02),
        'conf_ln_g': 1.0 + nrm((L, W_CONF), 0.02),
        'conf_ln_b': nrm((L, W_CONF), 0.02),
        'gla_w_g2': nrm((L, GLA_RANK, GLA_HEADS * GLA_DK), GLA_RANK ** -0.5),
        'gla_b_g2': nrm((L, GLA_HEADS * GLA_DK), 0.1),
        'gla_norm_g': 1.0 + nrm((L, GLA_DV), 0.02),
        'sc_conv_w': nrm((L, SC_KERNEL, W_SC), SC_KERNEL ** -0.5),
        'mix_scale': 1.0 + nrm((L, D_MODEL), 0.02),
        'w_out': nrm((L, D_MODEL, D_MODEL), DN_BETA * D_MODEL ** -0.5),
        'rel_bias': nrm((REL_BUCKETS, DIL_HEADS), 0.5),
        'ln1_g': 1.0 + nrm((L, D_MODEL), 0.02),
        'ln1_b': nrm((L, D_MODEL), 0.02),
        'router_g_w': nrm((L, D_MODEL, N_GROUPS), D_MODEL ** -0.5),
        'router_g_b': nrm((L, N_GROUPS), 0.01),
        'router_e_w': nrm((L, D_MODEL, N_EXPERTS), D_MODEL ** -0.5),
        'router_e_b': nrm((L, N_EXPERTS), 0.01),
        'exp_w_gate': nrm((L, N_EXPERTS, D_MODEL, D_EXPERT), D_MODEL ** -0.5),
        'exp_w_up': nrm((L, N_EXPERTS, D_MODEL, D_EXPERT), D_MODEL ** -0.5),
        'exp_w_down': nrm((L, N_EXPERTS, D_EXPERT, D_MODEL), DN_BETA * D_EXPERT ** -0.5),
        'ple_w_gate': nrm((L, D_MODEL, D_MODEL), D_MODEL ** -0.5),
        'ple_b_gate': nrm((L, D_MODEL), 0.02),
        'ple_w_proj': nrm((L, PLE_DIM, D_MODEL), DN_BETA * PLE_DIM ** -0.5),
        'ln2_g': 1.0 + nrm((L, D_MODEL), 0.02),
        'ln2_b': nrm((L, D_MODEL), 0.02),
    }


def reference(x, p, w_in, conf_dw_w, conf_dw_b, conf_ln_g, conf_ln_b, gla_w_g2, gla_b_g2, gla_norm_g,
              sc_conv_w, mix_scale, w_out, rel_bias, ln1_g, ln1_b, router_g_w, router_g_b, router_e_w,
              router_e_b, exp_w_gate, exp_w_up, exp_w_down, ple_w_gate, ple_b_gate, ple_w_proj, ln2_g, ln2_b):
    split_idx = np.cumsum(IN_SIZES)[:-1].tolist()
    for i in range(DEPTH):
        u = x @ w_in[i]
        a_u, gq, gk, gv, g_low, g_r, cq, ck, cv, sb, sc, sh = jnp.split(u, split_idx, axis=-1)
        y_a = conformer_conv(a_u, conf_dw_w[i], conf_dw_b[i], conf_ln_g[i], conf_ln_b[i])
        y_b = gla_mixer(gq, gk, gv, g_low, g_r, gla_w_g2[i], gla_b_g2[i], gla_norm_g[i])
        y_c = dilated_mixer(cq, ck, cv, rel_bias)
        y_d = short_gated_conv(sb, sc, sh, sc_conv_w[i])
        mix = jnp.concatenate([y_a, y_b, y_c, y_d], axis=-1) * mix_scale[i]
        x = layer_norm(DN_ALPHA * x + mix @ w_out[i], ln1_g[i], ln1_b[i])
        ffn = hier_moe(x, router_g_w[i], router_g_b[i], router_e_w[i], router_e_b[i],
                       exp_w_gate[i], exp_w_up[i], exp_w_down[i])
        ple = jax.nn.sigmoid(x @ ple_w_gate[i] + ple_b_gate[i]) * (p[i] @ ple_w_proj[i])
        x = layer_norm(DN_ALPHA * x + ffn + ple, ln2_g[i], ln2_b[i])
    return x
```

```cpp
#include <hip/hip_runtime.h>
#include <cstdio>
#include <cstdint>

#ifndef LAUNCH_PER_PHASE
#define LAUNCH_PER_PHASE 1
#endif

#define LAS __attribute__((address_space(3)))
#define GAS __attribute__((address_space(1)))
typedef unsigned short bf16_t;
typedef short bf16x8 __attribute__((ext_vector_type(8)));
typedef float f32x4 __attribute__((ext_vector_type(4)));
typedef float f32x2 __attribute__((ext_vector_type(2)));
typedef unsigned u32x4 __attribute__((ext_vector_type(4)));
typedef unsigned u32x2 __attribute__((ext_vector_type(2)));

constexpr int NL = 2, NBATCH = 4, SEQ = 2048, DM = 2048, MT = NBATCH * SEQ;
constexpr int DIN = 5648, DINP = 5888, PLE = 256, NEXP = 32, DEXP = 256;
constexpr int UA_VAL = 0, UA_GATE = 512, UG_Q = 1024, UG_K = 1280, UG_V = 1536, UG_R = 2048, UC_Q = 2560, UC_K = 3072, UC_V = 3584, US_B = 4096, US_C = 4608, US_H = 5120, UG_LOW = 5632;
constexpr float DN_ALPHA = 1.41421356237309515f, LN_EPS = 1e-5f, RMS_EPS = 1e-6f;
constexpr int MAXSLOT = 24576;

constexpr size_t MiB = 1u << 20;
constexpr size_t WS_CTL = 0, CTL_ZERO_BYTES = 1 * MiB;
constexpr size_t WS_BTAB = 1 * MiB;
constexpr size_t WS_WRT = 1 * MiB + 64 * 1024;
constexpr size_t WS_LTOK = 2 * MiB;
constexpr size_t WS_LGATE = 3 * MiB;
constexpr size_t WS_TINFO = 4 * MiB;
constexpr size_t WS_WIN = 8 * MiB;
constexpr size_t WS_WOUT = 54 * MiB;
constexpr size_t WS_WGU = 70 * MiB;
constexpr size_t WS_WD = 198 * MiB;
constexpr size_t WS_WPG = 262 * MiB;
constexpr size_t WS_WPP = 278 * MiB;
constexpr size_t WS_XB = 280 * MiB;
constexpr size_t WS_PB = 312 * MiB;
constexpr size_t WS_U = 320 * MiB;
constexpr size_t WS_Y = 320 * MiB;
constexpr size_t WS_MIX = 416 * MiB;
constexpr size_t WS_PRE = 448 * MiB;
constexpr size_t WS_GU = 448 * MiB;
constexpr size_t WS_GO = 480 * MiB;
constexpr size_t WS_GQ = 496 * MiB;
constexpr size_t WS_GD = 504 * MiB;
constexpr size_t WS_PP = 512 * MiB;
constexpr size_t WS_H = 544 * MiB;
constexpr size_t WS_END = 556 * MiB;
static_assert(WS_U + (size_t)MT * DINP * 2 <= WS_MIX && WS_Y + (size_t)MAXSLOT * 2048 * 2 <= WS_MIX + 32 * MiB, "ws map");
constexpr int CW_BAR = 4096;
constexpr int CW_CNT = 16384;

constexpr int LDS_STAGE = 131072;
constexpr int LDS_TOFF = LDS_STAGE;
constexpr int LDS_BARW = LDS_STAGE + 512;
constexpr int LDS_BYTES = LDS_STAGE + 1024;

__device__ __forceinline__ float bf2f(unsigned b) { return __uint_as_float(b << 16); }
__device__ __forceinline__ unsigned f2bf(float f) { unsigned u = __float_as_uint(f); return (u + 0x7fffu + ((u >> 16) & 1u)) >> 16; }
__device__ __forceinline__ unsigned pk2(float lo, float hi) { return f2bf(lo) | (f2bf(hi) << 16); }
__device__ __forceinline__ float bflo(unsigned w) { return __uint_as_float(w << 16); }
__device__ __forceinline__ float bfhi(unsigned w) { return __uint_as_float(w & 0xffff0000u); }
__device__ __forceinline__ float wave_sum(float v) {
#pragma unroll
    for (int o = 1; o < 64; o <<= 1) v += __shfl_xor(v, o);
    return v;
}
__device__ __forceinline__ float wave_max(float v) {
#pragma unroll
    for (int o = 1; o < 64; o <<= 1) v = fmaxf(v, __shfl_xor(v, o));
    return v;
}
__device__ __forceinline__ float sigmoidf_(float x) { return 1.0f / (1.0f + __expf(-x)); }
__device__ __forceinline__ float siluf_(float x) { return x / (1.0f + __expf(-x)); }
#define LDS_WAIT() asm volatile("s_waitcnt lgkmcnt(0)" ::: "memory")

namespace pg8 {
constexpr int BM = 256, BK = 64, HALF = 128, HTB = HALF * BK * 2, STAGE_BYTES = 8 * HTB, NXCD = 8, WGM = 8;
__host__ __device__ __forceinline__ int lds_byte(int r, int c) { const int st = (r >> 4) * 2 + (c >> 5), rr = r & 15, cc = c & 31, ob = rr * 64 + cc * 2; return st * 1024 + (ob ^ (((ob >> 9) & 1) << 5)); }
__host__ __device__ __forceinline__ void stage_rc(int b, int& R, int& C) { const int st = b / 1024, sb = b % 1024, swz = sb ^ (((sb >> 9) & 1) << 5); R = (st >> 1) * 16 + swz / 64; C = (st & 1) * 32 + (swz % 64) / 2; }
__host__ __device__ __forceinline__ int perm32(int rho) { const int n = rho >> 4, i = rho & 15; return 8 * (i >> 2) + 4 * n + (i & 3); }

struct Unit { int pm, pn, e, r; };

struct DenseSched {
    static constexpr bool GATHER = false;
    const bf16_t* A; const bf16_t* Bt; int lda, ldb, nM, nN, nwg, G, c;
    __device__ void init(const bf16_t* A_, const bf16_t* Bt_, int lda_, int ldb_, int M, int N, int G_, int c_) { A = A_; Bt = Bt_; lda = lda_; ldb = ldb_; nM = M / BM; nN = N / BM; nwg = nM * nN; G = G_; c = c_; }
    __device__ __forceinline__ bool next(int i, Unit& u) const {
        const long L = (long)i * G + c; if (L >= nwg) return false;
        int wgid = (int)L; { const int q = nwg / NXCD, r = nwg % NXCD, xcd = wgid % NXCD, off = wgid / NXCD; wgid = (xcd < r ? xcd * (q + 1) : r * (q + 1) + (xcd - r) * q) + off; }
        const int nig = WGM * nN, gid = wgid / nig, fm = gid * WGM, gsz = (nM - fm) < WGM ? (nM - fm) : WGM;
        u.pm = fm + ((wgid % nig) % gsz); u.pn = (wgid % nig) / gsz; u.e = 0; u.r = 0; return true;
    }
    __device__ __forceinline__ const char* a_base(const Unit& u) const { return (const char*)A + (size_t)u.pm * BM * lda * 2; }
    __device__ __forceinline__ const char* b_base(const Unit& u) const { return (const char*)Bt + (size_t)u.pn * BM * ldb * 2; }
    __device__ __forceinline__ void a_offs(const Unit&, const int (&R)[2], const int (&C)[2], unsigned (&vo)[2][2]) const { }
};
template <bool GATHER_> struct MoeSched {
    static constexpr bool GATHER = GATHER_;
    const bf16_t* A; const bf16_t* Bt; int lda, ldb, nN, G, c; size_t bexp;
    const LAS int* toff; const unsigned* cnt; const int* ltok;
    __device__ __forceinline__ bool next(int i, Unit& u) const {
        const int L = i * G + c; const int total = __builtin_amdgcn_readfirstlane(toff[32]) * nN; if (L >= total) return false;
        const int j = L / nN; u.pn = L - j * nN; int e = 0;
#pragma unroll 1
        for (int k = 1; k < 32; ++k) e = (__builtin_amdgcn_readfirstlane(toff[k]) <= j) ? k : e;
        u.e = e; u.r = j - __builtin_amdgcn_readfirstlane(toff[e]); u.pm = j; return true;
    }
    __device__ __forceinline__ const char* a_base(const Unit& u) const { return GATHER ? (const char*)A : (const char*)A + (size_t)u.pm * BM * lda * 2; }
    __device__ __forceinline__ const char* b_base(const Unit& u) const { return (const char*)Bt + (size_t)u.e * bexp + (size_t)u.pn * BM * ldb * 2; }
    __device__ __forceinline__ void a_offs(const Unit& u, const int (&R)[2], const int (&C)[2], unsigned (&vo)[2][2]) const {
        if constexpr (GATHER) {
        const int n = __builtin_amdgcn_readfirstlane((int)cnt[u.e * 64]);
#pragma unroll
        for (int h = 0; h < 2; ++h)
#pragma unroll
            for (int i = 0; i < 2; ++i) {
                const int sr = u.r * BM + h * HALF + R[i]; const int row = (sr < n) ? ltok[u.e * MT + sr] : 0;
                vo[h][i] = (unsigned)(row * lda + C[i]) * 2u;
            }
        }
    }
};

__device__ __forceinline__ unsigned cvt_pk_bf16(float lo, float hi) { unsigned r; asm volatile("v_cvt_pk_bf16_f32 %0, %1, %2" : "=v"(r) : "v"(lo), "v"(hi)); return r; }

struct EpiBf16 {
    static constexpr bool PERM = true;
    bf16_t* O; int ldc;
    __device__ __forceinline__ void operator()(const f32x4 (&acc)[2][2][4][2], const Unit& u, int wr, int wc, int fr, int fq) const {
        const int row0 = u.pm * BM + wr * 64 + fr, col0 = u.pn * BM + wc * 32 + 8 * fq;
#pragma unroll
        for (int ai = 0; ai < 2; ++ai)
#pragma unroll
            for (int m = 0; m < 4; ++m) { bf16_t* rowp = O + (size_t)(row0 + ai * HALF + m * 16) * ldc + col0;
#pragma unroll
                for (int bj = 0; bj < 2; ++bj) { const f32x4 v0 = acc[ai][bj][m][0], v1 = acc[ai][bj][m][1];
                    u32x4 w; w.x = cvt_pk_bf16(v0[0], v0[1]); w.y = cvt_pk_bf16(v0[2], v0[3]); w.z = cvt_pk_bf16(v1[0], v1[1]); w.w = cvt_pk_bf16(v1[2], v1[3]);
                    *(u32x4*)(rowp + bj * HALF) = w; } }
    }
};
struct EpiRes {
    static constexpr bool PERM = false;
    float* C; const float* res; int ldc; float alpha;
    __device__ __forceinline__ void operator()(const f32x4 (&acc)[2][2][4][2], const Unit& u, int wr, int wc, int fr, int fq) const {
        const int row0 = u.pm * BM + wr * 64 + fr, col0 = u.pn * BM + wc * 32 + 4 * fq;
#pragma unroll
        for (int ai = 0; ai < 2; ++ai)
#pragma unroll
            for (int m = 0; m < 4; ++m) { const size_t off = (size_t)(row0 + ai * HALF + m * 16) * ldc + col0;
#pragma unroll
                for (int bj = 0; bj < 2; ++bj)
#pragma unroll
                    for (int n = 0; n < 2; ++n) { const f32x4 rv = *(const f32x4*)(res + off + bj * HALF + n * 16); *(f32x4*)(C + off + bj * HALF + n * 16) = rv * alpha + acc[ai][bj][m][n]; }
                asm volatile("" ::: "memory"); }
    }
};
struct EpiPle {
    static constexpr bool PERM = false;
    float* C; const float* x1; const bf16_t* pp; const float* bias; int ldc; float alpha;
    __device__ __forceinline__ void operator()(const f32x4 (&acc)[2][2][4][2], const Unit& u, int wr, int wc, int fr, int fq) const {
        const int row0 = u.pm * BM + wr * 64 + fr, col0 = u.pn * BM + wc * 32 + 4 * fq;
        f32x4 bv[2][2];
#pragma unroll
        for (int bj = 0; bj < 2; ++bj)
#pragma unroll
            for (int n = 0; n < 2; ++n) bv[bj][n] = *(const f32x4*)(bias + col0 + bj * HALF + n * 16);
#pragma unroll
        for (int ai = 0; ai < 2; ++ai)
#pragma unroll
            for (int m = 0; m < 4; ++m) { const size_t off = (size_t)(row0 + ai * HALF + m * 16) * ldc + col0;
#pragma unroll
                for (int bj = 0; bj < 2; ++bj)
#pragma unroll
                    for (int n = 0; n < 2; ++n) { const size_t o = off + bj * HALF + n * 16; const f32x4 xv = *(const f32x4*)(x1 + o); const u32x2 pw = *(const u32x2*)(pp + o);
                        const f32x4 a = acc[ai][bj][m][n] + bv[bj][n]; f32x4 r;
                        r[0] = xv[0] * alpha + sigmoidf_(a[0]) * bflo(pw.x); r[1] = xv[1] * alpha + sigmoidf_(a[1]) * bfhi(pw.x);
                        r[2] = xv[2] * alpha + sigmoidf_(a[2]) * bflo(pw.y); r[3] = xv[3] * alpha + sigmoidf_(a[3]) * bfhi(pw.y);
                        *(f32x4*)(C + o) = r; }
                asm volatile("" ::: "memory"); }
    }
};
struct EpiMoe1 {
    static constexpr bool PERM = true;
    bf16_t* H; const float* lgate; const unsigned* cnt;
    __device__ __forceinline__ void operator()(const f32x4 (&acc)[2][2][4][2], const Unit& u, int wr, int wc, int fr, int fq) const {
        const int n_e = __builtin_amdgcn_readfirstlane((int)cnt[u.e * 64]);
        const int col0 = u.pn * HALF + wc * 32 + 8 * fq;
#pragma unroll
        for (int ai = 0; ai < 2; ++ai)
#pragma unroll
            for (int m = 0; m < 4; ++m) { const int rt = ai * HALF + wr * 64 + m * 16 + fr; const int sr = u.r * BM + rt;
                const float gw = (sr < n_e) ? lgate[u.e * MT + sr] : 0.f;
                const f32x4 g0 = acc[ai][0][m][0], g1 = acc[ai][0][m][1], u0 = acc[ai][1][m][0], u1 = acc[ai][1][m][1];
                float o[8];
#pragma unroll
                for (int j = 0; j < 4; ++j) { o[j] = siluf_(g0[j]) * u0[j] * gw; o[4 + j] = siluf_(g1[j]) * u1[j] * gw; }
                u32x4 w; w.x = cvt_pk_bf16(o[0], o[1]); w.y = cvt_pk_bf16(o[2], o[3]); w.z = cvt_pk_bf16(o[4], o[5]); w.w = cvt_pk_bf16(o[6], o[7]);
                *(u32x4*)(H + (size_t)(u.pm * BM + rt) * DEXP + col0) = w; }
    }
};

template <class Epi, class Sched>
__device__ __forceinline__ void gemm_phase(LAS unsigned char* lds, const int K, const Sched& S, const Epi& E) {
    constexpr bool GA = Sched::GATHER;
    int tid = threadIdx.x; asm volatile("" : "+v"(tid));
    const int wid = __builtin_amdgcn_readfirstlane(tid >> 6), lane = tid & 63, wr = wid >> 2, wc = wid & 3, fr = lane & 15, fq = lane >> 4;
    const int nt = K / BK, ldb = S.ldb, lda = S.lda;
    int Rr[2], Cc[2]; unsigned voffB[2], voffA[2];
#pragma unroll
    for (int i = 0; i < 2; ++i) { int R, C; stage_rc(tid * 16 + i * 8192, R, C); Rr[i] = R; Cc[i] = C; const int Rb = Epi::PERM ? ((R & ~31) + perm32(R & 31)) : R; voffB[i] = (unsigned)(Rb * ldb + C) * 2u; voffA[i] = (unsigned)(R * lda + C) * 2u; }
    const size_t kstep = (size_t)(BK * 2);
    const size_t hstep = (size_t)HALF * ldb * 2;
    const size_t ahstep = GA ? 0 : (size_t)HALF * lda * 2;
    const unsigned ldsw = (unsigned)wid * 1024u;
    const int aoff = lds_byte(wr * 64 + fr, fq * 8), boff = lds_byte(wc * 32 + fr, fq * 8);
#define PG8_SA(b, h) (((b) * 2 + (h)) * HTB)
#define PG8_SB(b, h) ((4 + (b) * 2 + (h)) * HTB)
#define PG8_STAGE(bufoff, gbase, voff) do { _Pragma("unroll") for (int _i = 0; _i < 2; ++_i) \
        __builtin_amdgcn_global_load_lds((const unsigned*)((const char*)(gbase) + (voff)[_i]), (LAS unsigned*)(lds + (bufoff) + ldsw + _i * 8192), 16, 0, 0); } while (0)
#define PG8_STAGE_A(bufoff, gbase, h) do { if constexpr (GA) PG8_STAGE(bufoff, gbase, voA[h]); else PG8_STAGE(bufoff, (gbase) + (h) * ahstep, voffA); } while (0)
#define PG8_STAGE_A2(bufoff, gbase, h) do { if constexpr (GA) { unsigned _v[2] = {last ? voN[h][0] : voA[h][0], last ? voN[h][1] : voA[h][1]}; PG8_STAGE(bufoff, gbase, _v); } else PG8_STAGE(bufoff, (gbase) + (h) * ahstep, voffA); } while (0)
#define PG8_LDA(dst, b, h) do { _Pragma("unroll") for (int m = 0; m < 4; ++m) _Pragma("unroll") for (int k = 0; k < 2; ++k) dst[m][k] = *(const LAS bf16x8*)(lds + PG8_SA(b, h) + aoff + m * 2048 + k * 1024); } while (0)
#define PG8_LDB(dst, b, h) do { _Pragma("unroll") for (int n = 0; n < 2; ++n) _Pragma("unroll") for (int k = 0; k < 2; ++k) dst[n][k] = *(const LAS bf16x8*)(lds + PG8_SB(b, h) + boff + n * 2048 + k * 1024); } while (0)
#define PG8_MMA(ai, bj, At, Bt) do { __builtin_amdgcn_s_setprio(1); _Pragma("unroll") for (int m = 0; m < 4; ++m) _Pragma("unroll") for (int n = 0; n < 2; ++n) _Pragma("unroll") for (int k = 0; k < 2; ++k) \
        acc[ai][bj][m][n] = __builtin_amdgcn_mfma_f32_16x16x32_bf16(Bt[n][k], At[m][k], acc[ai][bj][m][n], 0, 0, 0); __builtin_amdgcn_s_setprio(0); } while (0)
#define PG8_WAIT_V(n) asm volatile("s_waitcnt vmcnt(" #n ")" ::: "memory")
#define PG8_WAIT_L(n) asm volatile("s_waitcnt lgkmcnt(" #n ")" ::: "memory")
#define PG8_BAR __builtin_amdgcn_s_barrier()
#define PG8_SCHED __builtin_amdgcn_sched_barrier(0)
    Unit cur, nxt; int ui = 0;
    if (!S.next(0, cur)) return;
    f32x4 acc[2][2][4][2];
#pragma unroll
    for (int a = 0; a < 2; ++a)
#pragma unroll
        for (int b = 0; b < 2; ++b)
#pragma unroll
            for (int m = 0; m < 4; ++m)
#pragma unroll
                for (int n = 0; n < 2; ++n) acc[a][b][m][n] = (f32x4){0.f, 0.f, 0.f, 0.f};
    bf16x8 At[4][2], B0[2][2], B1[2][2];
    const char* cA = S.a_base(cur); const char* cB = S.b_base(cur);
    unsigned voA[2][2], voN[2][2];
    if constexpr (GA) S.a_offs(cur, Rr, Cc, voA);
    PG8_STAGE(PG8_SB(0, 0), cB, voffB); PG8_STAGE(PG8_SB(0, 1), cB + hstep, voffB); PG8_STAGE_A(PG8_SA(0, 0), cA, 0); PG8_STAGE_A(PG8_SA(0, 1), cA, 1);
    if (wr == 1) PG8_BAR;
    PG8_WAIT_V(2); PG8_BAR;
    PG8_STAGE(PG8_SB(1, 0), cB + kstep, voffB); PG8_STAGE_A(PG8_SA(1, 0), cA + kstep, 0); PG8_STAGE(PG8_SB(1, 1), cB + hstep + kstep, voffB);
    PG8_WAIT_V(6); PG8_BAR;
    for (;;) {
        const bool has_next = S.next(ui + 1, nxt);
        const char* nA = has_next ? S.a_base(nxt) : cA; const char* nB = has_next ? S.b_base(nxt) : cB;
        if constexpr (GA) {
            if (has_next) S.a_offs(nxt, Rr, Cc, voN);
            else {
#pragma unroll
                for (int h = 0; h < 2; ++h)
#pragma unroll
                    for (int i = 0; i < 2; ++i) voN[h][i] = voA[h][i]; } }
#pragma unroll 1
        for (int t = 0; t < nt; t += 2) {
            const bool last = (t == nt - 2);
            const char* a1 = cA + (size_t)(t + 1) * kstep;
            const char* a2 = last ? nA : cA + (size_t)(t + 2) * kstep; const char* b2 = last ? nB : cB + (size_t)(t + 2) * kstep;
            const char* a3 = a2 + kstep; const char* b3 = b2 + kstep;
            PG8_LDB(B0, 0, 0); PG8_LDB(B1, 0, 1); PG8_SCHED; PG8_LDA(At, 0, 0); PG8_STAGE_A(PG8_SA(1, 1), a1, 1);
            PG8_WAIT_V(8); PG8_WAIT_L(0); PG8_BAR; PG8_MMA(0, 0, At, B0); PG8_MMA(0, 1, At, B1); PG8_BAR; PG8_SCHED;
            PG8_LDA(At, 0, 1); PG8_STAGE(PG8_SB(0, 0), b2, voffB); PG8_STAGE(PG8_SB(0, 1), b2 + hstep, voffB); PG8_STAGE_A2(PG8_SA(0, 0), a2, 0);
            PG8_WAIT_V(8); PG8_WAIT_L(0); PG8_BAR; PG8_MMA(1, 0, At, B0); PG8_MMA(1, 1, At, B1); PG8_BAR; PG8_SCHED;
            PG8_LDB(B0, 1, 0); PG8_LDB(B1, 1, 1); PG8_SCHED; PG8_LDA(At, 1, 0); PG8_STAGE_A2(PG8_SA(0, 1), a2, 1);
            PG8_WAIT_V(8); PG8_WAIT_L(0); PG8_BAR; PG8_MMA(0, 0, At, B0); PG8_MMA(0, 1, At, B1); PG8_BAR; PG8_SCHED;
            PG8_LDA(At, 1, 1); PG8_STAGE(PG8_SB(1, 0), b3, voffB); PG8_STAGE(PG8_SB(1, 1), b3 + hstep, voffB); PG8_STAGE_A2(PG8_SA(1, 0), a3, 0);
            PG8_WAIT_V(8); PG8_WAIT_L(0); PG8_BAR; PG8_MMA(1, 0, At, B0); PG8_MMA(1, 1, At, B1); PG8_BAR; PG8_SCHED;
        }
        if (wr == 0) PG8_BAR;
        E(acc, cur, wr, wc, fr, fq);
        if (!has_next) break;
#pragma unroll
        for (int a = 0; a < 2; ++a)
#pragma unroll
            for (int b = 0; b < 2; ++b)
#pragma unroll
                for (int m = 0; m < 4; ++m)
#pragma unroll
                    for (int n = 0; n < 2; ++n) acc[a][b][m][n] = (f32x4){0.f, 0.f, 0.f, 0.f};
        cur = nxt; cA = nA; cB = nB; ++ui;
        if constexpr (GA) {
#pragma unroll
            for (int h = 0; h < 2; ++h)
#pragma unroll
                for (int i = 0; i < 2; ++i) voA[h][i] = voN[h][i]; }
        if (wr == 1) PG8_BAR;
    }
    PG8_WAIT_V(0);
    PG8_BAR;
#undef PG8_SA
#undef PG8_SB
#undef PG8_STAGE
#undef PG8_STAGE_A
#undef PG8_STAGE_A2
#undef PG8_LDA
#undef PG8_LDB
#undef PG8_MMA
#undef PG8_WAIT_V
#undef PG8_WAIT_L
#undef PG8_BAR
#undef PG8_SCHED
}
}

#define XB_TMO      128
#define XB_XCNT(j)  (256  + 64 * (j))
#define XB_XSUB(j)  (1280 + 64 * (j))
#define XB_XGEN(j)  (2304 + 64 * (j))
#define XB_TOP      3328
#define XB_TOPGEN   3392
#define XCD_BAR_WORDS 3456
#define XB_SPIN_CAP (1u << 18)
__device__ __forceinline__ unsigned xb_ld(unsigned* p)              { return __hip_atomic_load(p, __ATOMIC_RELAXED, __HIP_MEMORY_SCOPE_AGENT); }
__device__ __forceinline__ unsigned xb_add(unsigned* p, unsigned v) { return __hip_atomic_fetch_add(p, v, __ATOMIC_RELAXED, __HIP_MEMORY_SCOPE_AGENT); }
__device__ __forceinline__ unsigned xb_xcc_id() { return (unsigned)__builtin_amdgcn_s_getreg((3 << 11) | 20) & 0xFu; }
#define XB_SPIN(cond, bar) do { unsigned _sp = 0; while (cond) { __builtin_amdgcn_s_sleep(1); \
    if ((++_sp & 255u) == 0u) { if (xb_ld(&(bar)[XB_TMO])) break; if (_sp > XB_SPIN_CAP) { atomicAdd(&(bar)[XB_TMO], 1u); break; } } } } while (0)
struct XcdBarrier { unsigned* bar; unsigned x; volatile LAS unsigned* st; };
__device__ __forceinline__ XcdBarrier xcd_barrier_post(unsigned* bar, volatile LAS unsigned* st) {
    XcdBarrier b; b.bar = bar; b.x = xb_xcc_id(); b.st = st;
    if (threadIdx.x == 0) (void)xb_add(&bar[XB_XCNT(b.x)], 1u);
    return b;
}
__device__ __forceinline__ void xcd_barrier_complete(unsigned* bar, unsigned x, unsigned& nloc, unsigned& nx) {
    const unsigned G = gridDim.x * gridDim.y * gridDim.z;
    unsigned sum, cnt, mine, sp = 0u;
    for (;;) {
        sum = 0u; cnt = 0u; mine = 0u;
#pragma unroll
        for (unsigned j = 0; j < 16; ++j) { const unsigned c = xb_ld(&bar[XB_XCNT(j)]); sum += c; cnt += (c > 0u) ? 1u : 0u; mine = (j == x) ? c : mine; }
        if (sum == G) break;
        __builtin_amdgcn_s_sleep(1);
        if ((++sp & 255u) == 0u) { if (xb_ld(&bar[XB_TMO])) break; if (sp > XB_SPIN_CAP) { atomicAdd(&bar[XB_TMO], 1u); break; } }
    }
    nloc = mine > 0u ? mine : 1u; nx = cnt > 0u ? cnt : 1u;
}
__device__ __forceinline__ void xcd_barrier(const XcdBarrier& b) {
    asm volatile("s_waitcnt vmcnt(0)" ::: "memory");
    __syncthreads();
    if (threadIdx.x == 0) {
        unsigned* bar = b.bar;
        __builtin_amdgcn_s_waitcnt(0);
        unsigned nloc = b.st[0], nx = b.st[1];
        if (nloc == 0u) { xcd_barrier_complete(bar, b.x, nloc, nx); b.st[0] = nloc; b.st[1] = nx; }
        const unsigned old = xb_add(&bar[XB_XSUB(b.x)], 1u);
        const unsigned gen = old / nloc;
        if (old + 1u == (gen + 1u) * nloc) {
            __builtin_amdgcn_fence(__ATOMIC_RELEASE, "agent");
            asm volatile("s_waitcnt vmcnt(0)" ::: "memory");
            const unsigned og = xb_add(&bar[XB_TOP], 1u);
            const unsigned tg = og / nx;
            if (og + 1u == (tg + 1u) * nx) xb_add(&bar[XB_TOPGEN], 1u);
            else XB_SPIN(xb_ld(&bar[XB_TOPGEN]) == tg, bar);
            __builtin_amdgcn_fence(__ATOMIC_ACQUIRE, "agent");
            xb_add(&bar[XB_XGEN(b.x)], 1u);
            asm volatile("s_waitcnt vmcnt(0)" ::: "memory");
        } else {
            XB_SPIN(xb_ld(&bar[XB_XGEN(b.x)]) == gen, bar);
            __builtin_amdgcn_fence(__ATOMIC_ACQUIRE, "agent");
            asm volatile("s_waitcnt vmcnt(0)" ::: "memory");
        }
    }
    __syncthreads();
}

struct Args { const float* in[28]; float* out; unsigned char* ws; int ph_lo, ph_hi; };

struct Frame {
    LAS unsigned char* lds; unsigned char* ws; unsigned* ctl;
    int tid, lane, wave, G, bx;
    __device__ __forceinline__ Frame fresh() const { Frame f = *this; int t = threadIdx.x; asm volatile("" : "+v"(t)); f.tid = t; f.lane = t & 63; return f; }
};

__device__ __forceinline__ int dmap(int type, int n) {
    if (type == 1) return n < 2048 ? n : (n < 2064 ? n - 2048 + UG_LOW : n - 16);
    if (type == 2) return (n >> 7) * 256 + (n & 127);
    if (type == 3) return (n >> 7) * 256 + 128 + (n & 127);
    return n;
}
__device__ __forceinline__ void transpose_item(const float* W, int ldw, int ncols, int k0, int n0, const float* kscale, bf16_t* WT, int ldt, int type, LAS float* scr, int lane) {
    const int nn = n0 + (lane & 31); const bool okc = nn < ncols;
#pragma unroll 8
    for (int i = 0; i < 32; ++i) { const int kk = 2 * i + (lane >> 5); float v = okc ? W[(size_t)(k0 + kk) * ldw + nn] : 0.f; if (kscale) v *= kscale[k0 + kk]; scr[kk * 33 + (lane & 31)] = v; }
    LDS_WAIT(); asm volatile("" ::: "memory");
    const int c = lane & 7;
#pragma unroll
    for (int j = 0; j < 4; ++j) { const int n = (lane >> 3) + 8 * j; const LAS float* s = scr + (8 * c) * 33 + n;
        u32x4 o; o.x = pk2(s[0 * 33], s[1 * 33]); o.y = pk2(s[2 * 33], s[3 * 33]); o.z = pk2(s[4 * 33], s[5 * 33]); o.w = pk2(s[6 * 33], s[7 * 33]);
        if (n0 + n < ncols) *(u32x4*)(WT + (size_t)dmap(type, n0 + n) * ldt + k0 + 8 * c) = o; }
    LDS_WAIT(); asm volatile("" ::: "memory");
}
__device__ __forceinline__ int t5_bucket(int d) {
    if (d < 16) return d;
    const float v = logf((float)d / 16.0f) / 4.852030263919617f * 16.0f;
    int b = 16 + (int)v; return b < 31 ? b : 31;
}
__device__ __forceinline__ void phase_prologue(const Frame& F, const Args& a) {
    LAS float* scr = (LAS float*)(F.lds + F.wave * 16384);
    const int gw = F.bx * 8 + F.wave, NGW = F.G * 8;
    constexpr int I_IN = 32 * 177, I_OUT = 32 * 64, I_G = 32 * 256, I_U = 32 * 256, I_D = 32 * 256, I_PG = 32 * 64, I_PP = 4 * 64, I_L = I_IN + I_OUT + I_G + I_U + I_D + I_PG + I_PP;
    bf16_t* WIN = (bf16_t*)(F.ws + WS_WIN); bf16_t* WOUT = (bf16_t*)(F.ws + WS_WOUT); bf16_t* WGU = (bf16_t*)(F.ws + WS_WGU); bf16_t* WD = (bf16_t*)(F.ws + WS_WD);
    bf16_t* WPG = (bf16_t*)(F.ws + WS_WPG); bf16_t* WPP = (bf16_t*)(F.ws + WS_WPP);
    for (int it = gw; it < NL * I_L; it += NGW) {
        const int l = it / I_L; int r = it - l * I_L;
        if (r < I_IN) { const int kb = r / 177, nb = r - kb * 177; transpose_item(a.in[2] + (size_t)l * DM * DIN, DIN, DIN, kb * 64, nb * 32, nullptr, WIN + (size_t)l * DINP * DM, DM, 1, scr, F.lane); continue; } r -= I_IN;
        if (r < I_OUT) { const int kb = r >> 6, nb = r & 63; transpose_item(a.in[12] + (size_t)l * DM * DM, DM, DM, kb * 64, nb * 32, a.in[11] + l * DM, WOUT + (size_t)l * DM * DM, DM, 0, scr, F.lane); continue; } r -= I_OUT;
        if (r < I_G) { const int e = r >> 8, q = r & 255, kb = q >> 3, nb = q & 7; transpose_item(a.in[20] + (size_t)(l * NEXP + e) * DM * DEXP, DEXP, DEXP, kb * 64, nb * 32, nullptr, WGU + (size_t)(l * NEXP + e) * 512 * DM, DM, 2, scr, F.lane); continue; } r -= I_G;
        if (r < I_U) { const int e = r >> 8, q = r & 255, kb = q >> 3, nb = q & 7; transpose_item(a.in[21] + (size_t)(l * NEXP + e) * DM * DEXP, DEXP, DEXP, kb * 64, nb * 32, nullptr, WGU + (size_t)(l * NEXP + e) * 512 * DM, DM, 3, scr, F.lane); continue; } r -= I_U;
        if (r < I_D) { const int e = r >> 8, q = r & 255, kb = q >> 6, nb = q & 63; transpose_item(a.in[22] + (size_t)(l * NEXP + e) * DEXP * DM, DM, DM, kb * 64, nb * 32, nullptr, WD + (size_t)(l * NEXP + e) * DM * DEXP, DEXP, 0, scr, F.lane); continue; } r -= I_D;
        if (r < I_PG) { const int kb = r >> 6, nb = r & 63; transpose_item(a.in[23] + (size_t)l * DM * DM, DM, DM, kb * 64, nb * 32, nullptr, WPG + (size_t)l * DM * DM, DM, 0, scr, F.lane); continue; } r -= I_PG;
        { const int kb = r >> 6, nb = r & 63; transpose_item(a.in[25] + (size_t)l * PLE * DM, DM, DM, kb * 64, nb * 32, nullptr, WPP + (size_t)l * DM * PLE, PLE, 0, scr, F.lane); }
    }
    const size_t gt = (size_t)F.bx * 512 + F.tid, NT = (size_t)F.G * 512;
    for (size_t i = gt; i < (size_t)NL * (DINP - DIN) * DM / 8; i += NT) { const size_t l = i / ((DINP - DIN) * DM / 8), r = i % ((DINP - DIN) * DM / 8);
        *(u32x4*)(WIN + (l * DINP + DIN) * DM + r * 8) = (u32x4){0u, 0u, 0u, 0u}; }
    { const float* x = a.in[0]; bf16_t* XB = (bf16_t*)(F.ws + WS_XB);
      for (size_t i = gt; i < (size_t)MT * DM / 8; i += NT) { const f32x4 v0 = *(const f32x4*)(x + i * 8), v1 = *(const f32x4*)(x + i * 8 + 4);
          *(u32x4*)(XB + i * 8) = (u32x4){pk2(v0[0], v0[1]), pk2(v0[2], v0[3]), pk2(v1[0], v1[1]), pk2(v1[2], v1[3])}; } }
    { const float* p = a.in[1]; bf16_t* PB = (bf16_t*)(F.ws + WS_PB);
      for (size_t i = gt; i < (size_t)NL * MT * PLE / 8; i += NT) { const f32x4 v0 = *(const f32x4*)(p + i * 8), v1 = *(const f32x4*)(p + i * 8 + 4);
          *(u32x4*)(PB + i * 8) = (u32x4){pk2(v0[0], v0[1]), pk2(v0[2], v0[3]), pk2(v1[0], v1[1]), pk2(v1[2], v1[3])}; } }
    { float* bt = (float*)(F.ws + WS_BTAB); const float* rb = a.in[13];
      for (size_t i = gt; i < 3 * 129 * 8; i += NT) { const int h = (int)(i & 7), j = (int)((i >> 3) % 129), br = (int)((i >> 3) / 129); const int dil = br == 0 ? 1 : (br == 1 ? 4 : 16);
          bt[i] = rb[t5_bucket(j * dil) * 8 + h]; } }
    { float* wrt = (float*)(F.ws + WS_WRT);
      for (size_t i = gt; i < (size_t)NL * 36 * DM; i += NT) { const int c = (int)(i % DM), col = (int)((i / DM) % 36), l = (int)(i / (36 * DM));
          wrt[i] = col < 4 ? a.in[16][((size_t)l * DM + c) * 4 + col] : a.in[18][((size_t)l * DM + c) * 32 + (col - 4)]; } }
}

__device__ __forceinline__ void conv_unit(const Frame& F, const Args& a, int l, int unit) {
    const bf16_t* U = (const bf16_t*)(F.ws + WS_U); bf16_t* MIX = (bf16_t*)(F.ws + WS_MIX);
    LAS float* hb = (LAS float*)F.lds;
    const int t0 = unit * 32, tl0 = t0 & (SEQ - 1), tb = t0 - tl0;
    const int tid = F.tid;
    __syncthreads();
#pragma unroll 1
    for (int i = 0; i < 8; ++i) { const int id = tid + 512 * i; if (id < 62 * 64) { const int row = id >> 6, ch = (id & 63) * 8; const int tl = tl0 - 30 + row;
        float o[8];
        if (tl >= 0) { const bf16_t* up = U + (size_t)(tb + tl) * DINP; const u32x4 av = *(const u32x4*)(up + UA_VAL + ch), gv = *(const u32x4*)(up + UA_GATE + ch);
            const unsigned aw[4] = {av.x, av.y, av.z, av.w}, gw[4] = {gv.x, gv.y, gv.z, gv.w};
#pragma unroll
            for (int j = 0; j < 4; ++j) { o[2 * j] = bflo(aw[j]) * sigmoidf_(bflo(gw[j])); o[2 * j + 1] = bfhi(aw[j]) * sigmoidf_(bfhi(gw[j])); } }
        else {
#pragma unroll
            for (int j = 0; j < 8; ++j) o[j] = 0.f; }
        *(LAS f32x4*)(hb + row * 512 + ch) = (f32x4){o[0], o[1], o[2], o[3]}; *(LAS f32x4*)(hb + row * 512 + ch + 4) = (f32x4){o[4], o[5], o[6], o[7]}; } }
    __syncthreads();
    float yv[32];
    { const int c = tid; const float* w = a.in[3] + (size_t)l * 31 * 512; const float bias = a.in[4][l * 512 + c];
      float wv[31];
#pragma unroll
      for (int j = 0; j < 31; ++j) wv[j] = w[j * 512 + c];
      float hv[62];
#pragma unroll
      for (int r = 0; r < 62; ++r) hv[r] = hb[r * 512 + c];
#pragma unroll
      for (int t = 0; t < 32; ++t) { float s = bias;
#pragma unroll
          for (int j = 0; j < 31; ++j) s += wv[j] * hv[t + j];
          yv[t] = s; } }
    __syncthreads();
#pragma unroll
    for (int t = 0; t < 32; ++t) hb[t * 512 + tid] = yv[t];
    __syncthreads();
    { const float* lg = a.in[5] + l * 512; const float* lb = a.in[6] + l * 512;
#pragma unroll 1
      for (int i = 0; i < 4; ++i) { const int t = F.wave + 8 * i;
          const f32x4 v0 = *(const LAS f32x4*)(hb + t * 512 + 4 * F.lane), v1 = *(const LAS f32x4*)(hb + t * 512 + 256 + 4 * F.lane);
          const float mean = wave_sum((v0[0] + v0[1]) + (v0[2] + v0[3]) + (v1[0] + v1[1]) + (v1[2] + v1[3])) * (1.f / 512.f);
          const f32x4 d0 = v0 - mean, d1 = v1 - mean;
          const float var = wave_sum((d0[0] * d0[0] + d0[1] * d0[1]) + (d0[2] * d0[2] + d0[3] * d0[3]) + (d1[0] * d1[0] + d1[1] * d1[1]) + (d1[2] * d1[2] + d1[3] * d1[3])) * (1.f / 512.f);
          const float rstd = 1.0f / sqrtf(var + LN_EPS);
          const f32x4 g0 = *(const f32x4*)(lg + 4 * F.lane), g1 = *(const f32x4*)(lg + 256 + 4 * F.lane), b0 = *(const f32x4*)(lb + 4 * F.lane), b1 = *(const f32x4*)(lb + 256 + 4 * F.lane);
          float o0[4], o1[4];
#pragma unroll
          for (int j = 0; j < 4; ++j) { o0[j] = siluf_(d0[j] * rstd * g0[j] + b0[j]); o1[j] = siluf_(d1[j] * rstd * g1[j] + b1[j]); }
          bf16_t* mp = MIX + (size_t)(t0 + t) * DM;
          *(u32x2*)(mp + 4 * F.lane) = (u32x2){pk2(o0[0], o0[1]), pk2(o0[2], o0[3])}; *(u32x2*)(mp + 256 + 4 * F.lane) = (u32x2){pk2(o1[0], o1[1]), pk2(o1[2], o1[3])}; } }
    { const int c = tid; const float* w = a.in[10] + (size_t)l * 3 * 512; const float w0 = w[c], w1 = w[512 + c], w2 = w[1024 + c];
      float p2 = 0.f, p1 = 0.f;
      if (tl0 >= 2) { const bf16_t* up = U + (size_t)(t0 - 2) * DINP; p2 = bf2f(up[US_C + c]) * bf2f(up[US_H + c]); }
      if (tl0 >= 1) { const bf16_t* up = U + (size_t)(t0 - 1) * DINP; p1 = bf2f(up[US_C + c]) * bf2f(up[US_H + c]); }
#pragma unroll 4
      for (int t = 0; t < 32; ++t) { const bf16_t* up = U + (size_t)(t0 + t) * DINP; const float p0 = bf2f(up[US_C + c]) * bf2f(up[US_H + c]);
          const float y = bf2f(up[US_B + c]) * (w0 * p2 + w1 * p1 + w2 * p0);
          MIX[(size_t)(t0 + t) * DM + 1536 + c] = (bf16_t)f2bf(y); p2 = p1; p1 = p0; } }
}

__device__ __forceinline__ void gla_a_unit(const Frame& F, const Args& a, int l, int unit) {
    const bf16_t* U = (const bf16_t*)(F.ws + WS_U);
    float* GU = (float*)(F.ws + WS_GU); float* GO = (float*)(F.ws + WS_GO); float* GQ = (float*)(F.ws + WS_GQ); float* GD = (float*)(F.ws + WS_GD);
    const int n = unit & 63, h = (unit >> 6) & 3, b = unit >> 8, bh = b * 4 + h;
    const int t0 = b * SEQ + n * 32, tid = F.tid;
    LAS float* L = (LAS float*)F.lds;
    LAS float* qt = L; LAS float* kr = L + 2048; LAS float* kt = L + 4096; LAS float* kh = L + 6144; LAS float* vv = L + 8192; LAS float* bc = L + 12288; LAS float* gl = L + 14336; LAS float* wg = L + 14848; LAS float* sc = L + 15872;
    const int i = tid >> 4, k4 = (tid & 15) * 4, v8 = (tid & 15) * 8;
    __syncthreads();
    { const bf16_t* up = U + (size_t)(t0 + i) * DINP;
      const u32x2 qw = *(const u32x2*)(up + UG_Q + h * 64 + k4), kw = *(const u32x2*)(up + UG_K + h * 64 + k4); const u32x4 vw = *(const u32x4*)(up + UG_V + h * 128 + v8);
      *(LAS f32x4*)(qt + i * 64 + k4) = (f32x4){bflo(qw.x), bfhi(qw.x), bflo(qw.y), bfhi(qw.y)};
      *(LAS f32x4*)(kr + i * 64 + k4) = (f32x4){bflo(kw.x), bfhi(kw.x), bflo(kw.y), bfhi(kw.y)};
      *(LAS f32x4*)(vv + i * 128 + v8) = (f32x4){bflo(vw.x), bfhi(vw.x), bflo(vw.y), bfhi(vw.y)}; *(LAS f32x4*)(vv + i * 128 + v8 + 4) = (f32x4){bflo(vw.z), bfhi(vw.z), bflo(vw.w), bfhi(vw.w)};
      gl[i * 16 + (tid & 15)] = bf2f(up[UG_LOW + (tid & 15)]);
      const float* w2 = a.in[7] + (size_t)l * 16 * 256;
      wg[tid] = w2[(tid >> 6) * 256 + h * 64 + (tid & 63)]; wg[512 + tid] = w2[(8 + (tid >> 6)) * 256 + h * 64 + (tid & 63)]; }
    __syncthreads();
    { const f32x4 bg = *(const f32x4*)(a.in[8] + l * 256 + h * 64 + k4); f32x4 z = bg;
#pragma unroll
      for (int r = 0; r < 16; ++r) { const float g = gl[i * 16 + r]; const f32x4 w = *(const LAS f32x4*)(wg + r * 64 + k4); z = z + w * g; }
      f32x4 la;
#pragma unroll
      for (int j = 0; j < 4; ++j) la[j] = (fminf(z[j], 0.f) - log1pf(expf(-fabsf(z[j])))) * (1.0f / 16.0f);
      *(LAS f32x4*)(bc + i * 64 + k4) = la; }
    __syncthreads();
    if (tid < 64) { float run = 0.f;
#pragma unroll
        for (int r = 0; r < 32; ++r) { run += bc[r * 64 + tid]; bc[r * 64 + tid] = run; } }
    __syncthreads();
    { const f32x4 bv = *(const LAS f32x4*)(bc + i * 64 + k4), bl = *(const LAS f32x4*)(bc + 31 * 64 + k4), q = *(const LAS f32x4*)(qt + i * 64 + k4), k = *(const LAS f32x4*)(kr + i * 64 + k4);
      f32x4 qo, ko, ho;
#pragma unroll
      for (int j = 0; j < 4; ++j) { qo[j] = q[j] * expf(bv[j]) * 0.125f; ko[j] = k[j] * expf(-bv[j]); ho[j] = k[j] * expf(bl[j] - bv[j]); }
      *(LAS f32x4*)(qt + i * 64 + k4) = qo; *(LAS f32x4*)(kt + i * 64 + k4) = ko; *(LAS f32x4*)(kh + i * 64 + k4) = ho;
      *(f32x4*)(GQ + (size_t)(t0 + i) * 256 + h * 64 + k4) = qo;
      if (i == 31) { f32x4 d;
#pragma unroll
          for (int j = 0; j < 4; ++j) d[j] = expf(bl[j]);
          *(f32x4*)(GD + ((size_t)bh * 64 + n) * 64 + k4) = d; } }
    __syncthreads();
    { const int j0 = (tid & 15) * 2; float s0 = 0.f, s1 = 0.f;
#pragma unroll
      for (int k = 0; k < 64; k += 4) { const f32x4 q = *(const LAS f32x4*)(qt + i * 64 + k), ka = *(const LAS f32x4*)(kt + j0 * 64 + k), kb = *(const LAS f32x4*)(kt + (j0 + 1) * 64 + k);
          s0 += (q[0] * ka[0] + q[1] * ka[1]) + (q[2] * ka[2] + q[3] * ka[3]); s1 += (q[0] * kb[0] + q[1] * kb[1]) + (q[2] * kb[2] + q[3] * kb[3]); }
      sc[i * 33 + j0] = (j0 <= i) ? s0 : 0.f; sc[i * 33 + j0 + 1] = (j0 + 1 <= i) ? s1 : 0.f; }
    { const int kk = (tid >> 5) * 4, v0 = (tid & 31) * 4; f32x4 u0 = {0.f, 0.f, 0.f, 0.f}, u1 = u0, u2 = u0, u3 = u0;
#pragma unroll 8
      for (int j = 0; j < 32; ++j) { const f32x4 kv = *(const LAS f32x4*)(kh + j * 64 + kk), vx = *(const LAS f32x4*)(vv + j * 128 + v0);
          u0 = u0 + vx * kv[0]; u1 = u1 + vx * kv[1]; u2 = u2 + vx * kv[2]; u3 = u3 + vx * kv[3]; }
      float* gp = GU + (((size_t)bh * 64 + n) * 64 + kk) * 128 + v0;
      *(f32x4*)(gp) = u0; *(f32x4*)(gp + 128) = u1; *(f32x4*)(gp + 256) = u2; *(f32x4*)(gp + 384) = u3; }
    __syncthreads();
    { f32x4 o0 = {0.f, 0.f, 0.f, 0.f}, o1 = o0;
#pragma unroll 8
      for (int j = 0; j < 32; ++j) { const float s = sc[i * 33 + j]; const f32x4 va = *(const LAS f32x4*)(vv + j * 128 + v8), vb = *(const LAS f32x4*)(vv + j * 128 + v8 + 4); o0 = o0 + va * s; o1 = o1 + vb * s; }
      float* gp = GO + (size_t)(t0 + i) * 512 + h * 128 + v8; *(f32x4*)gp = o0; *(f32x4*)(gp + 4) = o1; }
}
__device__ __forceinline__ void gla_scan(const Frame& F) {
    float* GU = (float*)(F.ws + WS_GU); const float* GD = (const float*)(F.ws + WS_GD);
    for (int g = F.bx * 512 + F.tid; g < 16 * 8192; g += F.G * 512) { const int bh = g >> 13, kv = g & 8191, k = kv >> 7;
        float* p = GU + (size_t)bh * 64 * 8192 + kv; const float* d = GD + (size_t)bh * 64 * 64 + k; float S = 0.f;
#pragma unroll 8
        for (int n = 0; n < 64; ++n) { const float u = p[(size_t)n * 8192]; const float dc = d[n * 64]; p[(size_t)n * 8192] = S; S = S * dc + u; } }
}
__device__ __forceinline__ void gla_c_unit(const Frame& F, const Args& a, int l, int unit) {
    const bf16_t* U = (const bf16_t*)(F.ws + WS_U); bf16_t* MIX = (bf16_t*)(F.ws + WS_MIX);
    const float* GU = (const float*)(F.ws + WS_GU); const float* GO = (const float*)(F.ws + WS_GO); const float* GQ = (const float*)(F.ws + WS_GQ);
    const int n = unit & 63, h = (unit >> 6) & 3, b = unit >> 8, bh = b * 4 + h;
    const int t0 = b * SEQ + n * 32, tid = F.tid;
    LAS float* qt = (LAS float*)F.lds; LAS float* Ss = qt + 2048;
    const int i = tid >> 4, k4 = (tid & 15) * 4, v8 = (tid & 15) * 8;
    __syncthreads();
    *(LAS f32x4*)(qt + i * 64 + k4) = *(const f32x4*)(GQ + (size_t)(t0 + i) * 256 + h * 64 + k4);
    { const float* sp = GU + ((size_t)bh * 64 + n) * 8192;
#pragma unroll
      for (int j = 0; j < 4; ++j) *(LAS f32x4*)(Ss + (tid + 512 * j) * 4) = *(const f32x4*)(sp + (tid + 512 * j) * 4); }
    __syncthreads();
    const float* gp = GO + (size_t)(t0 + i) * 512 + h * 128 + v8;
    f32x4 o0 = *(const f32x4*)gp, o1 = *(const f32x4*)(gp + 4);
#pragma unroll 8
    for (int k = 0; k < 64; ++k) { const float q = qt[i * 64 + k]; const f32x4 sa = *(const LAS f32x4*)(Ss + k * 128 + v8), sb = *(const LAS f32x4*)(Ss + k * 128 + v8 + 4); o0 = o0 + sa * q; o1 = o1 + sb * q; }
    float ss = (o0[0] * o0[0] + o0[1] * o0[1]) + (o0[2] * o0[2] + o0[3] * o0[3]) + (o1[0] * o1[0] + o1[1] * o1[1]) + (o1[2] * o1[2] + o1[3] * o1[3]);
    ss += __shfl_xor(ss, 1); ss += __shfl_xor(ss, 2); ss += __shfl_xor(ss, 4); ss += __shfl_xor(ss, 8);
    const float rms = 1.0f / sqrtf(ss * (1.f / 128.f) + RMS_EPS);
    const float* ng = a.in[9] + l * 128 + v8; const f32x4 n0 = *(const f32x4*)ng, n1 = *(const f32x4*)(ng + 4);
    const u32x4 rw = *(const u32x4*)(U + (size_t)(t0 + i) * DINP + UG_R + h * 128 + v8);
    const float r[8] = {bflo(rw.x), bfhi(rw.x), bflo(rw.y), bfhi(rw.y), bflo(rw.z), bfhi(rw.z), bflo(rw.w), bfhi(rw.w)};
    float o[8];
#pragma unroll
    for (int j = 0; j < 4; ++j) { o[j] = o0[j] * rms * n0[j] * siluf_(r[j]); o[4 + j] = o1[j] * rms * n1[j] * siluf_(r[4 + j]); }
    *(u32x4*)(MIX + (size_t)(t0 + i) * DM + 512 + h * 128 + v8) = (u32x4){pk2(o[0], o[1]), pk2(o[2], o[3]), pk2(o[4], o[5]), pk2(o[6], o[7])};
}

__device__ __forceinline__ void attn_simple(const Frame& F, int t, int h, LAS float* pl) {
    const bf16_t* U = (const bf16_t*)(F.ws + WS_U); bf16_t* MIX = (bf16_t*)(F.ws + WS_MIX); const float* btab = (const float*)(F.ws + WS_BTAB);
    const int lane = F.lane, tl = t & (SEQ - 1), tb = t - tl;
    float q[64];
    { const u32x4* qp = (const u32x4*)(U + (size_t)t * DINP + UC_Q + h * 64);
#pragma unroll
      for (int c = 0; c < 8; ++c) { const u32x4 w = qp[c]; q[8 * c] = bflo(w.x); q[8 * c + 1] = bfhi(w.x); q[8 * c + 2] = bflo(w.y); q[8 * c + 3] = bfhi(w.y); q[8 * c + 4] = bflo(w.z); q[8 * c + 5] = bfhi(w.z); q[8 * c + 6] = bflo(w.w); q[8 * c + 7] = bfhi(w.w); } }
    float s[7]; float m = -INFINITY;
#pragma unroll
    for (int r = 0; r < 7; ++r) { const int idx = lane + 64 * r; const int br = idx / 129, j = idx - br * 129; const int dil = br == 0 ? 1 : (br == 1 ? 4 : 16); const int kl = tl - j * dil;
        float sv = -INFINITY;
        if (idx < 387 && kl >= 0) { const u32x4* kp = (const u32x4*)(U + (size_t)(tb + kl) * DINP + UC_K + h * 64); float d = 0.f;
#pragma unroll
            for (int c = 0; c < 8; ++c) { const u32x4 w = kp[c];
                d += (q[8 * c] * bflo(w.x) + q[8 * c + 1] * bfhi(w.x)) + (q[8 * c + 2] * bflo(w.y) + q[8 * c + 3] * bfhi(w.y)) + (q[8 * c + 4] * bflo(w.z) + q[8 * c + 5] * bfhi(w.z)) + (q[8 * c + 6] * bflo(w.w) + q[8 * c + 7] * bfhi(w.w)); }
            sv = d * 0.125f + btab[(br * 129 + j) * 8 + h]; }
        s[r] = sv; m = fmaxf(m, sv); }
    m = wave_max(m);
    float lsum = 0.f;
#pragma unroll
    for (int r = 0; r < 7; ++r) { const float p = (s[r] == -INFINITY) ? 0.f : __expf(s[r] - m); lsum += p; pl[lane + 64 * r] = p; }
    lsum = wave_sum(lsum);
    LDS_WAIT();
    const int kq = lane >> 4, dl = lane & 15;
    float o0 = 0.f, o1 = 0.f, o2 = 0.f, o3 = 0.f;
#pragma unroll 4
    for (int it = 0; it < 97; ++it) { const int idx = 4 * it + kq; const float p = pl[idx]; const int br = idx / 129, j = idx - br * 129; const int dil = br == 0 ? 1 : (br == 1 ? 4 : 16); const int kl = tl - j * dil;
        if (idx < 387 && kl >= 0) { const u32x2 w = *(const u32x2*)(U + (size_t)(tb + kl) * DINP + UC_V + h * 64 + 4 * dl); o0 += p * bflo(w.x); o1 += p * bfhi(w.x); o2 += p * bflo(w.y); o3 += p * bfhi(w.y); } }
    o0 += __shfl_xor(o0, 16); o1 += __shfl_xor(o1, 16); o2 += __shfl_xor(o2, 16); o3 += __shfl_xor(o3, 16);
    o0 += __shfl_xor(o0, 32); o1 += __shfl_xor(o1, 32); o2 += __shfl_xor(o2, 32); o3 += __shfl_xor(o3, 32);
    const float inv = 1.0f / lsum;
    if (kq == 0) *(u32x2*)(MIX + (size_t)t * DM + 1024 + h * 64 + 4 * dl) = (u32x2){pk2(o0 * inv, o1 * inv), pk2(o2 * inv, o3 * inv)};
    LDS_WAIT();
}

__device__ __forceinline__ void ln1_unit(const Frame& F, const Args& a, int l, int unit, float* X1F) {
    const float* PRE = (const float*)(F.ws + WS_PRE); bf16_t* XB = (bf16_t*)(F.ws + WS_XB); const float* wrt = (const float*)(F.ws + WS_WRT) + (size_t)l * 36 * DM;
    int* ltok = (int*)(F.ws + WS_LTOK); float* lgate = (float*)(F.ws + WS_LGATE); int* tinfo = (int*)(F.ws + WS_TINFO); unsigned* cnt = F.ctl + CW_CNT + l * 32 * 64;
    LAS float* xs = (LAS float*)F.lds + F.wave * 2048;
    LAS float* Wl = (LAS float*)F.lds + 8 * 2048;
    const int lane = F.lane, row = unit * 8 + F.wave;
    const float* g = a.in[14] + (size_t)l * DM; const float* bb = a.in[15] + (size_t)l * DM;
    { const float* pr = PRE + (size_t)row * DM; f32x4 v[8]; float s = 0.f;
#pragma unroll
      for (int j = 0; j < 8; ++j) { v[j] = *(const f32x4*)(pr + 256 * j + 4 * lane); s += (v[j][0] + v[j][1]) + (v[j][2] + v[j][3]); }
      const float mean = wave_sum(s) * (1.f / DM); float q = 0.f;
#pragma unroll
      for (int j = 0; j < 8; ++j) { v[j] = v[j] - mean; q += (v[j][0] * v[j][0] + v[j][1] * v[j][1]) + (v[j][2] * v[j][2] + v[j][3] * v[j][3]); }
      const float rstd = 1.0f / sqrtf(wave_sum(q) * (1.f / DM) + LN_EPS);
#pragma unroll
      for (int j = 0; j < 8; ++j) { const f32x4 gv = *(const f32x4*)(g + 256 * j + 4 * lane), bv = *(const f32x4*)(bb + 256 * j + 4 * lane); const f32x4 y = v[j] * rstd * gv + bv;
          *(f32x4*)(X1F + (size_t)row * DM + 256 * j + 4 * lane) = y; *(u32x2*)(XB + (size_t)row * DM + 256 * j + 4 * lane) = (u32x2){pk2(y[0], y[1]), pk2(y[2], y[3])};
          *(LAS f32x4*)(xs + 256 * j + 4 * lane) = y; } }
    float acc[36];
#pragma unroll
    for (int c = 0; c < 36; ++c) acc[c] = 0.f;
#pragma unroll 1
    for (int j = 0; j < 8; ++j) {
        __syncthreads();
#pragma unroll 1
        for (int i = F.tid; i < 36 * 64; i += 512) { const int col = i >> 6, c4 = (i & 63) * 4; *(LAS f32x4*)(Wl + col * 256 + c4) = *(const f32x4*)(wrt + (size_t)col * DM + 256 * j + c4); }
        __syncthreads();
        const f32x4 xv = *(const LAS f32x4*)(xs + 256 * j + 4 * lane);
#pragma unroll
        for (int c = 0; c < 36; ++c) { const f32x4 w = *(const LAS f32x4*)(Wl + c * 256 + 4 * lane); acc[c] += (xv[0] * w[0] + xv[1] * w[1]) + (xv[2] * w[2] + xv[3] * w[3]); }
    }
#pragma unroll
    for (int c = 0; c < 36; ++c) acc[c] = wave_sum(acc[c]);
    const float* gb = a.in[17] + l * 4; const float* eb = a.in[19] + l * 32;
    {
        float gl[4];
#pragma unroll
        for (int c = 0; c < 4; ++c) gl[c] = acc[c] + gb[c];
        int gi = 0; float gm = gl[0];
#pragma unroll
        for (int c = 1; c < 4; ++c) if (gl[c] > gm) { gm = gl[c]; gi = c; }
        float gs = 0.f;
#pragma unroll
        for (int c = 0; c < 4; ++c) gs += expf(gl[c] - gm);
        const float gtop = 1.0f / gs;
        float ev[8];
#pragma unroll
        for (int c = 0; c < 8; ++c) { const float v0 = acc[4 + c] + eb[c], v1 = acc[12 + c] + eb[8 + c], v2 = acc[20 + c] + eb[16 + c], v3 = acc[28 + c] + eb[24 + c]; ev[c] = gi == 0 ? v0 : (gi == 1 ? v1 : (gi == 2 ? v2 : v3)); }
        int i1 = 0; float m1 = ev[0];
#pragma unroll
        for (int c = 1; c < 8; ++c) if (ev[c] > m1) { m1 = ev[c]; i1 = c; }
        int i2 = -1; float m2 = -INFINITY;
#pragma unroll
        for (int c = 0; c < 8; ++c) if (c != i1 && ev[c] > m2) { m2 = ev[c]; i2 = c; }
        const float p2 = expf(m2 - m1), den = 1.0f + p2;
        const float w1 = gtop / den, w2 = gtop * p2 / den;
        if (lane == 0) { const int tok = row; const int e1 = gi * 8 + i1, e2 = gi * 8 + i2;
            const unsigned s1 = __hip_atomic_fetch_add(cnt + e1 * 64, 1u, __ATOMIC_RELAXED, __HIP_MEMORY_SCOPE_AGENT), s2 = __hip_atomic_fetch_add(cnt + e2 * 64, 1u, __ATOMIC_RELAXED, __HIP_MEMORY_SCOPE_AGENT);
            ltok[e1 * MT + s1] = tok; lgate[e1 * MT + s1] = w1; ltok[e2 * MT + s2] = tok; lgate[e2 * MT + s2] = w2;
            tinfo[tok * 2] = e1 * MT + (int)s1; tinfo[tok * 2 + 1] = e2 * MT + (int)s2; }
    }
}
__device__ __forceinline__ void moe_tables(const Frame& F, int l) {
    LAS int* toff = (LAS int*)(F.lds + LDS_TOFF); const unsigned* cnt = F.ctl + CW_CNT + l * 32 * 64;
    __syncthreads();
    if (F.tid == 0) { int run = 0; for (int e = 0; e < 32; ++e) { toff[e] = run; run += ((int)cnt[e * 64] + 255) >> 8; } toff[32] = run; }
    __syncthreads();
}
__device__ __forceinline__ void ln2_rows(const Frame& F, const Args& a, int l, float* OUT, bool write_xb) {
    const float* PRE = (const float*)(F.ws + WS_PRE); const bf16_t* Y = (const bf16_t*)(F.ws + WS_Y); bf16_t* XB = (bf16_t*)(F.ws + WS_XB); const int* tinfo = (const int*)(F.ws + WS_TINFO);
    const LAS int* toff = (const LAS int*)(F.lds + LDS_TOFF);
    const float* g = a.in[26] + (size_t)l * DM; const float* bb = a.in[27] + (size_t)l * DM; const int lane = F.lane;
    for (int row = F.bx * 8 + F.wave; row < MT; row += F.G * 8) {
        const int i0 = tinfo[row * 2], i1 = tinfo[row * 2 + 1];
        const size_t s0 = (size_t)toff[i0 >> 13] * 256 + (i0 & 8191), s1 = (size_t)toff[i1 >> 13] * 256 + (i1 & 8191);
        const float* pr = PRE + (size_t)row * DM; const bf16_t* y0 = Y + s0 * DM; const bf16_t* y1 = Y + s1 * DM;
        f32x4 v[8]; float s = 0.f;
#pragma unroll
        for (int j = 0; j < 8; ++j) { const f32x4 p = *(const f32x4*)(pr + 256 * j + 4 * lane); const u32x2 a0 = *(const u32x2*)(y0 + 256 * j + 4 * lane), a1 = *(const u32x2*)(y1 + 256 * j + 4 * lane);
            v[j][0] = p[0] + (bflo(a0.x) + bflo(a1.x)); v[j][1] = p[1] + (bfhi(a0.x) + bfhi(a1.x)); v[j][2] = p[2] + (bflo(a0.y) + bflo(a1.y)); v[j][3] = p[3] + (bfhi(a0.y) + bfhi(a1.y));
            s += (v[j][0] + v[j][1]) + (v[j][2] + v[j][3]); }
        const float mean = wave_sum(s) * (1.f / DM); float q = 0.f;
#pragma unroll
        for (int j = 0; j < 8; ++j) { v[j] = v[j] - mean; q += (v[j][0] * v[j][0] + v[j][1] * v[j][1]) + (v[j][2] * v[j][2] + v[j][3] * v[j][3]); }
        const float rstd = 1.0f / sqrtf(wave_sum(q) * (1.f / DM) + LN_EPS);
#pragma unroll
        for (int j = 0; j < 8; ++j) { const f32x4 gv = *(const f32x4*)(g + 256 * j + 4 * lane), bv = *(const f32x4*)(bb + 256 * j + 4 * lane); const f32x4 y = v[j] * rstd * gv + bv;
            *(f32x4*)(OUT + (size_t)row * DM + 256 * j + 4 * lane) = y; if (write_xb) *(u32x2*)(XB + (size_t)row * DM + 256 * j + 4 * lane) = (u32x2){pk2(y[0], y[1]), pk2(y[2], y[3])}; }
    }
}

constexpr int PH_PER_LAYER = 9, N_PHASES = 1 + NL * PH_PER_LAYER;
__global__ void __launch_bounds__(512, 2) mega(Args args) {
    extern __shared__ __attribute__((aligned(16))) unsigned char lds_raw[];
    Frame F; F.lds = (LAS unsigned char*)lds_raw; F.ws = args.ws; F.ctl = (unsigned*)(args.ws + WS_CTL);
    F.tid = threadIdx.x; F.lane = F.tid & 63; F.wave = __builtin_amdgcn_readfirstlane(F.tid >> 6); F.G = gridDim.x; F.bx = blockIdx.x;
    if (F.tid < 4) ((LAS unsigned*)(F.lds + LDS_BARW))[F.tid] = 0u;
    __syncthreads();
#if LAUNCH_PER_PHASE
#define GRID_BAR() do { } while (0)
#else
    XcdBarrier bar = xcd_barrier_post(F.ctl + CW_BAR, (volatile LAS unsigned*)(F.lds + LDS_BARW));
#define GRID_BAR() xcd_barrier(bar)
#endif
    const int lo = args.ph_lo, hi = args.ph_hi;
#define IN(k) (lo <= (k) && (k) < hi)
#define SEAM(k) do { if (IN(k) && IN((k) + 1)) GRID_BAR(); } while (0)
    bf16_t* XB = (bf16_t*)(F.ws + WS_XB); bf16_t* Ub = (bf16_t*)(F.ws + WS_U); bf16_t* MIXb = (bf16_t*)(F.ws + WS_MIX); float* PRE = (float*)(F.ws + WS_PRE);
    bf16_t* PPb = (bf16_t*)(F.ws + WS_PP); bf16_t* Hb = (bf16_t*)(F.ws + WS_H); bf16_t* Yb = (bf16_t*)(F.ws + WS_Y);
    float* X1F = args.out;

    if (IN(0)) { const Frame f = F.fresh(); phase_prologue(f, args); }
    SEAM(0);
#pragma unroll 1
    for (int l = 0; l < NL; ++l) {
        const int pb = 1 + l * PH_PER_LAYER;
        const float* XRES = (l == 0) ? args.in[0] : (const float*)args.out;
        if (IN(pb + 0)) { pg8::DenseSched S; S.init(XB, (const bf16_t*)(F.ws + WS_WIN) + (size_t)l * DINP * DM, DM, DM, MT, DINP, F.G, F.bx);
            pg8::EpiBf16 E{Ub, DINP}; pg8::gemm_phase(F.lds, DM, S, E); }
        SEAM(pb + 0);
        if (IN(pb + 1)) { { const Frame f = F.fresh(); for (int u = F.bx; u < 256; u += F.G) conv_unit(f, args, l, u); }
            { const Frame f = F.fresh(); for (int u = F.bx; u < 1024; u += F.G) gla_a_unit(f, args, l, u); } __syncthreads(); }
        SEAM(pb + 1);
        if (IN(pb + 2)) { { const Frame f = F.fresh(); gla_scan(f); }
            const Frame f = F.fresh(); LAS float* pl = (LAS float*)F.lds + F.wave * 448;
            for (int u = F.bx; u < 1024; u += F.G) { const int h = u & 7, tb = (u >> 3) * 64;
#pragma unroll 1
                for (int i = 0; i < 8; ++i) attn_simple(f, tb + F.wave + 8 * i, h, pl); } }
        SEAM(pb + 2);
        if (IN(pb + 3)) { const Frame f = F.fresh(); for (int u = F.bx; u < 1024; u += F.G) gla_c_unit(f, args, l, u); __syncthreads(); }
        SEAM(pb + 3);
        if (IN(pb + 4)) { { pg8::DenseSched S; S.init(MIXb, (const bf16_t*)(F.ws + WS_WOUT) + (size_t)l * DM * DM, DM, DM, MT, DM, F.G, F.bx);
              pg8::EpiRes E{PRE, XRES, DM, DN_ALPHA}; pg8::gemm_phase(F.lds, DM, S, E); }
            { pg8::DenseSched S; S.init((const bf16_t*)(F.ws + WS_PB) + (size_t)l * MT * PLE, (const bf16_t*)(F.ws + WS_WPP) + (size_t)l * DM * PLE, PLE, PLE, MT, DM, F.G, F.bx);
              pg8::EpiBf16 E{PPb, DM}; pg8::gemm_phase(F.lds, PLE, S, E); } }
        SEAM(pb + 4);
        if (IN(pb + 5)) { const Frame f = F.fresh(); for (int u = F.bx; u < MT / 8; u += F.G) ln1_unit(f, args, l, u, X1F); __syncthreads(); }
        SEAM(pb + 5);
        if (IN(pb + 6)) { { pg8::DenseSched S; S.init(XB, (const bf16_t*)(F.ws + WS_WPG) + (size_t)l * DM * DM, DM, DM, MT, DM, F.G, F.bx);
              pg8::EpiPle E{PRE, X1F, PPb, args.in[24] + (size_t)l * DM, DM, DN_ALPHA}; pg8::gemm_phase(F.lds, DM, S, E); }
            moe_tables(F, l);
            { pg8::MoeSched<true> S; S.A = XB; S.Bt = (const bf16_t*)(F.ws + WS_WGU) + (size_t)l * NEXP * 512 * DM; S.lda = DM; S.ldb = DM; S.nN = 2; S.G = F.G; S.c = F.bx; S.bexp = (size_t)512 * DM * 2;
              S.toff = (const LAS int*)(F.lds + LDS_TOFF); S.cnt = F.ctl + CW_CNT + l * 32 * 64; S.ltok = (const int*)(F.ws + WS_LTOK);
              pg8::EpiMoe1 E{Hb, (const float*)(F.ws + WS_LGATE), F.ctl + CW_CNT + l * 32 * 64}; pg8::gemm_phase(F.lds, DM, S, E); } }
        SEAM(pb + 6);
        if (IN(pb + 7)) { moe_tables(F, l);
            pg8::MoeSched<false> S; S.A = Hb; S.Bt = (const bf16_t*)(F.ws + WS_WD) + (size_t)l * NEXP * DM * DEXP; S.lda = DEXP; S.ldb = DEXP; S.nN = 8; S.G = F.G; S.c = F.bx; S.bexp = (size_t)DM * DEXP * 2;
            S.toff = (const LAS int*)(F.lds + LDS_TOFF); S.cnt = F.ctl + CW_CNT + l * 32 * 64; S.ltok = (const int*)(F.ws + WS_LTOK);
            pg8::EpiBf16 E{Yb, DM}; pg8::gemm_phase(F.lds, DEXP, S, E); }
        SEAM(pb + 7);
        if (IN(pb + 8)) { const Frame f = F.fresh(); moe_tables(f, l); ln2_rows(f, args, l, args.out, l + 1 < NL); }
        SEAM(pb + 8);
    }
#undef IN
#undef SEAM
}

extern "C" void kernel_launch(void* const* d_in, const int* in_sizes, int n_in, void* d_out, int out_size, void* d_ws, size_t ws_size, hipStream_t stream) {
    static int grid = 0;
    if (grid == 0) {
        if (n_in != 28 || out_size != MT * DM || ws_size < WS_END) { fprintf(stderr, "kernel_launch: unexpected shapes (n_in %d, out %d, ws %zu); nothing launched\n", n_in, out_size, ws_size); grid = -1; return; }
        int dev = 0, cus = 0, per_cu = 0;
        if (hipGetDevice(&dev) != hipSuccess || hipDeviceGetAttribute(&cus, hipDeviceAttributeMultiprocessorCount, dev) != hipSuccess) { grid = -1; return; }
        if (hipFuncSetAttribute((const void*)mega, hipFuncAttributeMaxDynamicSharedMemorySize, LDS_BYTES) != hipSuccess) { fprintf(stderr, "kernel_launch: hipFuncSetAttribute failed\n"); grid = -1; return; }
        if (hipOccupancyMaxActiveBlocksPerMultiprocessor(&per_cu, (const void*)mega, 512, LDS_BYTES) != hipSuccess || per_cu < 1) { fprintf(stderr, "kernel_launch: occupancy query says %d\n", per_cu); }
        (void)hipGetLastError();
        grid = cus;
    }
    if (grid < 0) return;
    (void)hipMemsetAsync((char*)d_ws + WS_CTL, 0, CTL_ZERO_BYTES, stream);
    Args a{};
    for (int i = 0; i < 28; ++i) a.in[i] = (const float*)d_in[i];
    a.out = (float*)d_out; a.ws = (unsigned char*)d_ws;
#if LAUNCH_PER_PHASE
    for (int p = 0; p < N_PHASES; ++p) { a.ph_lo = p; a.ph_hi = p + 1; hipLaunchKernelGGL(mega, dim3(grid), dim3(512), LDS_BYTES, stream, a); }
#else
    a.ph_lo = 0; a.ph_hi = N_PHASES; hipLaunchKernelGGL(mega, dim3(grid), dim3(512), LDS_BYTES, stream, a);
#endif
}
```

```cpp
#include <hip/hip_runtime.h>
#include <cstdio>
#include <cstdint>

#ifndef LAUNCH_PER_PHASE
#define LAUNCH_PER_PHASE 0
#endif

#define LAS __attribute__((address_space(3)))
#define GAS __attribute__((address_space(1)))
typedef unsigned short bf16_t;
typedef short bf16x8 __attribute__((ext_vector_type(8)));
typedef float f32x4 __attribute__((ext_vector_type(4)));
typedef float f32x2 __attribute__((ext_vector_type(2)));
typedef unsigned u32x4 __attribute__((ext_vector_type(4)));
typedef unsigned u32x2 __attribute__((ext_vector_type(2)));

constexpr int NL = 2, NBATCH = 4, SEQ = 2048, DM = 2048, MT = NBATCH * SEQ;
constexpr int DIN = 5648, DINP = 5888, PLE = 256, NEXP = 32, DEXP = 256;
constexpr int UA_VAL = 0, UA_GATE = 512, UG_Q = 1024, UG_K = 1280, UG_V = 1536, UG_R = 2048, UC_Q = 2560, UC_K = 3072, UC_V = 3584, US_B = 4096, US_C = 4608, US_H = 5120, UG_LOW = 5632;
constexpr float DN_ALPHA = 1.41421356237309515f, LN_EPS = 1e-5f, RMS_EPS = 1e-6f;
constexpr int MAXSLOT = 24576;

constexpr size_t MiB = 1u << 20;
constexpr size_t WS_CTL = 0, CTL_ZERO_BYTES = 1 * MiB;
constexpr size_t WS_BTAB = 1 * MiB;
constexpr size_t WS_WRT = 1 * MiB + 64 * 1024;
constexpr size_t WS_LTOK = 2 * MiB;
constexpr size_t WS_LGATE = 3 * MiB;
constexpr size_t WS_TINFO = 4 * MiB;
constexpr size_t WS_WIN = 8 * MiB;
constexpr size_t WS_WOUT = 54 * MiB;
constexpr size_t WS_WGU = 70 * MiB;
constexpr size_t WS_WD = 198 * MiB;
constexpr size_t WS_WPG = 262 * MiB;
constexpr size_t WS_WPP = 278 * MiB;
constexpr size_t WS_XB = 280 * MiB;
constexpr size_t WS_PB = 312 * MiB;
constexpr size_t WS_U = 320 * MiB;
constexpr size_t WS_Y = 320 * MiB;
constexpr size_t WS_MIX = 416 * MiB;
constexpr size_t WS_PRE = 448 * MiB;
constexpr size_t WS_GU = 448 * MiB;
constexpr size_t WS_GO = 480 * MiB;
constexpr size_t WS_GQ = 496 * MiB;
constexpr size_t WS_GD = 504 * MiB;
constexpr size_t WS_PP = 512 * MiB;
constexpr size_t WS_H = 544 * MiB;
constexpr size_t WS_END = 556 * MiB;
static_assert(WS_U + (size_t)MT * DINP * 2 <= WS_MIX && WS_Y + (size_t)MAXSLOT * 2048 * 2 <= WS_MIX + 32 * MiB, "ws map");
constexpr int CW_BAR = 4096;
constexpr int CW_CNT = 16384;

constexpr int LDS_STAGE = 131072;
constexpr int LDS_TOFF = LDS_STAGE;
constexpr int LDS_BARW = LDS_STAGE + 512;
constexpr int LDS_BYTES = LDS_STAGE + 1024;

__device__ __forceinline__ float bf2f(unsigned b) { return __uint_as_float(b << 16); }
__device__ __forceinline__ unsigned f2bf(float f) { unsigned u = __float_as_uint(f); return (u + 0x7fffu + ((u >> 16) & 1u)) >> 16; }
__device__ __forceinline__ unsigned pk2(float lo, float hi) { return f2bf(lo) | (f2bf(hi) << 16); }
__device__ __forceinline__ float bflo(unsigned w) { return __uint_as_float(w << 16); }
__device__ __forceinline__ float bfhi(unsigned w) { return __uint_as_float(w & 0xffff0000u); }
__device__ __forceinline__ float wave_sum(float v) {
#pragma unroll
    for (int o = 1; o < 64; o <<= 1) v += __shfl_xor(v, o);
    return v;
}
__device__ __forceinline__ float wave_max(float v) {
#pragma unroll
    for (int o = 1; o < 64; o <<= 1) v = fmaxf(v, __shfl_xor(v, o));
    return v;
}
__device__ __forceinline__ float sigmoidf_(float x) { return 1.0f / (1.0f + __expf(-x)); }
__device__ __forceinline__ float siluf_(float x) { return x / (1.0f + __expf(-x)); }
#define LDS_WAIT() asm volatile("s_waitcnt lgkmcnt(0)" ::: "memory")

namespace pg8 {
constexpr int BM = 256, BK = 64, HALF = 128, HTB = HALF * BK * 2, STAGE_BYTES = 8 * HTB, NXCD = 8, WGM = 8;
__host__ __device__ __forceinline__ int lds_byte(int r, int c) { const int st = (r >> 4) * 2 + (c >> 5), rr = r & 15, cc = c & 31, ob = rr * 64 + cc * 2; return st * 1024 + (ob ^ (((ob >> 9) & 1) << 5)); }
__host__ __device__ __forceinline__ void stage_rc(int b, int& R, int& C) { const int st = b / 1024, sb = b % 1024, swz = sb ^ (((sb >> 9) & 1) << 5); R = (st >> 1) * 16 + swz / 64; C = (st & 1) * 32 + (swz % 64) / 2; }
__host__ __device__ __forceinline__ int perm32(int rho) { const int n = rho >> 4, i = rho & 15; return 8 * (i >> 2) + 4 * n + (i & 3); }

struct Unit { int pm, pn, e, r; };

struct DenseSched {
    static constexpr bool GATHER = false;
    const bf16_t* A; const bf16_t* Bt; int lda, ldb, nM, nN, nwg, G, c;
    __device__ void init(const bf16_t* A_, const bf16_t* Bt_, int lda_, int ldb_, int M, int N, int G_, int c_) { A = A_; Bt = Bt_; lda = lda_; ldb = ldb_; nM = M / BM; nN = N / BM; nwg = nM * nN; G = G_; c = c_; }
    __device__ __forceinline__ bool next(int i, Unit& u) const {
        const long L = (long)i * G + c; if (L >= nwg) return false;
        int wgid = (int)L; { const int q = nwg / NXCD, r = nwg % NXCD, xcd = wgid % NXCD, off = wgid / NXCD; wgid = (xcd < r ? xcd * (q + 1) : r * (q + 1) + (xcd - r) * q) + off; }
        const int nig = WGM * nN, gid = wgid / nig, fm = gid * WGM, gsz = (nM - fm) < WGM ? (nM - fm) : WGM;
        u.pm = fm + ((wgid % nig) % gsz); u.pn = (wgid % nig) / gsz; u.e = 0; u.r = 0; return true;
    }
    __device__ __forceinline__ const char* a_base(const Unit& u) const { return (const char*)A + (size_t)u.pm * BM * lda * 2; }
    __device__ __forceinline__ const char* b_base(const Unit& u) const { return (const char*)Bt + (size_t)u.pn * BM * ldb * 2; }
    __device__ __forceinline__ void a_offs(const Unit&, const int (&R)[2], const int (&C)[2], unsigned (&vo)[2][2]) const { }
};
template <bool GATHER_> struct MoeSched {
    static constexpr bool GATHER = GATHER_;
    const bf16_t* A; const bf16_t* Bt; int lda, ldb, nN, G, c; size_t bexp;
    const LAS int* toff; const unsigned* cnt; const int* ltok;
    __device__ __forceinline__ bool next(int i, Unit& u) const {
        const int L = i * G + c; const int total = __builtin_amdgcn_readfirstlane(toff[32]) * nN; if (L >= total) return false;
        const int j = L / nN; u.pn = L - j * nN; int e = 0;
#pragma unroll 1
        for (int k = 1; k < 32; ++k) e = (__builtin_amdgcn_readfirstlane(toff[k]) <= j) ? k : e;
        u.e = e; u.r = j - __builtin_amdgcn_readfirstlane(toff[e]); u.pm = j; return true;
    }
    __device__ __forceinline__ const char* a_base(const Unit& u) const { return GATHER ? (const char*)A : (const char*)A + (size_t)u.pm * BM * lda * 2; }
    __device__ __forceinline__ const char* b_base(const Unit& u) const { return (const char*)Bt + (size_t)u.e * bexp + (size_t)u.pn * BM * ldb * 2; }
    __device__ __forceinline__ void a_offs(const Unit& u, const int (&R)[2], const int (&C)[2], unsigned (&vo)[2][2]) const {
        if constexpr (GATHER) {
        const int n = __builtin_amdgcn_readfirstlane((int)cnt[u.e * 64]);
#pragma unroll
        for (int h = 0; h < 2; ++h)
#pragma unroll
            for (int i = 0; i < 2; ++i) {
                const int sr = u.r * BM + h * HALF + R[i]; const int row = (sr < n) ? ltok[u.e * MT + sr] : 0;
                vo[h][i] = (unsigned)(row * lda + C[i]) * 2u;
            }
        }
    }
};

__device__ __forceinline__ unsigned cvt_pk_bf16(float lo, float hi) { unsigned r; asm volatile("v_cvt_pk_bf16_f32 %0, %1, %2" : "=v"(r) : "v"(lo), "v"(hi)); return r; }

struct EpiBf16 {
    static constexpr bool PERM = true;
    bf16_t* O; int ldc;
    __device__ __forceinline__ void operator()(const f32x4 (&acc)[2][2][4][2], const Unit& u, int wr, int wc, int fr, int fq) const {
        const int row0 = u.pm * BM + wr * 64 + fr, col0 = u.pn * BM + wc * 32 + 8 * fq;
#pragma unroll
        for (int ai = 0; ai < 2; ++ai)
#pragma unroll
            for (int m = 0; m < 4; ++m) { bf16_t* rowp = O + (size_t)(row0 + ai * HALF + m * 16) * ldc + col0;
#pragma unroll
                for (int bj = 0; bj < 2; ++bj) { const f32x4 v0 = acc[ai][bj][m][0], v1 = acc[ai][bj][m][1];
                    u32x4 w; w.x = cvt_pk_bf16(v0[0], v0[1]); w.y = cvt_pk_bf16(v0[2], v0[3]); w.z = cvt_pk_bf16(v1[0], v1[1]); w.w = cvt_pk_bf16(v1[2], v1[3]);
                    *(u32x4*)(rowp + bj * HALF) = w; } }
    }
};
struct EpiRes {
    static constexpr bool PERM = false;
    float* C; const float* res; int ldc; float alpha;
    __device__ __forceinline__ void operator()(const f32x4 (&acc)[2][2][4][2], const Unit& u, int wr, int wc, int fr, int fq) const {
        const int row0 = u.pm * BM + wr * 64 + fr, col0 = u.pn * BM + wc * 32 + 4 * fq;
#pragma unroll
        for (int ai = 0; ai < 2; ++ai)
#pragma unroll
            for (int m = 0; m < 4; ++m) { const size_t off = (size_t)(row0 + ai * HALF + m * 16) * ldc + col0;
#pragma unroll
                for (int bj = 0; bj < 2; ++bj)
#pragma unroll
                    for (int n = 0; n < 2; ++n) { const f32x4 rv = *(const f32x4*)(res + off + bj * HALF + n * 16); *(f32x4*)(C + off + bj * HALF + n * 16) = rv * alpha + acc[ai][bj][m][n]; }
                asm volatile("" ::: "memory"); }
    }
};
struct EpiPle {
    static constexpr bool PERM = false;
    float* C; const float* x1; const bf16_t* pp; const float* bias; int ldc; float alpha;
    __device__ __forceinline__ void operator()(const f32x4 (&acc)[2][2][4][2], const Unit& u, int wr, int wc, int fr, int fq) const {
        const int row0 = u.pm * BM + wr * 64 + fr, col0 = u.pn * BM + wc * 32 + 4 * fq;
        f32x4 bv[2][2];
#pragma unroll
        for (int bj = 0; bj < 2; ++bj)
#pragma unroll
            for (int n = 0; n < 2; ++n) bv[bj][n] = *(const f32x4*)(bias + col0 + bj * HALF + n * 16);
#pragma unroll
        for (int ai = 0; ai < 2; ++ai)
#pragma unroll
            for (int m = 0; m < 4; ++m) { const size_t off = (size_t)(row0 + ai * HALF + m * 16) * ldc + col0;
#pragma unroll
                for (int bj = 0; bj < 2; ++bj)
#pragma unroll
                    for (int n = 0; n < 2; ++n) { const size_t o = off + bj * HALF + n * 16; const f32x4 xv = *(const f32x4*)(x1 + o); const u32x2 pw = *(const u32x2*)(pp + o);
                        const f32x4 a = acc[ai][bj][m][n] + bv[bj][n]; f32x4 r;
                        r[0] = xv[0] * alpha + sigmoidf_(a[0]) * bflo(pw.x); r[1] = xv[1] * alpha + sigmoidf_(a[1]) * bfhi(pw.x);
                        r[2] = xv[2] * alpha + sigmoidf_(a[2]) * bflo(pw.y); r[3] = xv[3] * alpha + sigmoidf_(a[3]) * bfhi(pw.y);
                        *(f32x4*)(C + o) = r; }
                asm volatile("" ::: "memory"); }
    }
};
struct EpiMoe1 {
    static constexpr bool PERM = true;
    bf16_t* H; const float* lgate; const unsigned* cnt;
    __device__ __forceinline__ void operator()(const f32x4 (&acc)[2][2][4][2], const Unit& u, int wr, int wc, int fr, int fq) const {
        const int n_e = __builtin_amdgcn_readfirstlane((int)cnt[u.e * 64]);
        const int col0 = u.pn * HALF + wc * 32 + 8 * fq;
#pragma unroll
        for (int ai = 0; ai < 2; ++ai)
#pragma unroll
            for (int m = 0; m < 4; ++m) { const int rt = ai * HALF + wr * 64 + m * 16 + fr; const int sr = u.r * BM + rt;
                const float gw = (sr < n_e) ? lgate[u.e * MT + sr] : 0.f;
                const f32x4 g0 = acc[ai][0][m][0], g1 = acc[ai][0][m][1], u0 = acc[ai][1][m][0], u1 = acc[ai][1][m][1];
                float o[8];
#pragma unroll
                for (int j = 0; j < 4; ++j) { o[j] = siluf_(g0[j]) * u0[j] * gw; o[4 + j] = siluf_(g1[j]) * u1[j] * gw; }
                u32x4 w; w.x = cvt_pk_bf16(o[0], o[1]); w.y = cvt_pk_bf16(o[2], o[3]); w.z = cvt_pk_bf16(o[4], o[5]); w.w = cvt_pk_bf16(o[6], o[7]);
                *(u32x4*)(H + (size_t)(u.pm * BM + rt) * DEXP + col0) = w; }
    }
};

template <class Epi, class Sched>
__device__ __forceinline__ void gemm_phase(LAS unsigned char* lds, const int K, const Sched& S, const Epi& E) {
    constexpr bool GA = Sched::GATHER;
    int tid = threadIdx.x; asm volatile("" : "+v"(tid));
    const int wid = __builtin_amdgcn_readfirstlane(tid >> 6), lane = tid & 63, wr = wid >> 2, wc = wid & 3, fr = lane & 15, fq = lane >> 4;
    const int nt = K / BK, ldb = S.ldb, lda = S.lda;
    int Rr[2], Cc[2]; unsigned voffB[2], voffA[2];
#pragma unroll
    for (int i = 0; i < 2; ++i) { int R, C; stage_rc(tid * 16 + i * 8192, R, C); Rr[i] = R; Cc[i] = C; const int Rb = Epi::PERM ? ((R & ~31) + perm32(R & 31)) : R; voffB[i] = (unsigned)(Rb * ldb + C) * 2u; voffA[i] = (unsigned)(R * lda + C) * 2u; }
    const size_t kstep = (size_t)(BK * 2);
    const size_t hstep = (size_t)HALF * ldb * 2;
    const size_t ahstep = GA ? 0 : (size_t)HALF * lda * 2;
    const unsigned ldsw = (unsigned)wid * 1024u;
    const int aoff = lds_byte(wr * 64 + fr, fq * 8), boff = lds_byte(wc * 32 + fr, fq * 8);
#define PG8_SA(b, h) (((b) * 2 + (h)) * HTB)
#define PG8_SB(b, h) ((4 + (b) * 2 + (h)) * HTB)
#define PG8_STAGE(bufoff, gbase, voff) do { _Pragma("unroll") for (int _i = 0; _i < 2; ++_i) \
        __builtin_amdgcn_global_load_lds((const unsigned*)((const char*)(gbase) + (voff)[_i]), (LAS unsigned*)(lds + (bufoff) + ldsw + _i * 8192), 16, 0, 0); } while (0)
#define PG8_STAGE_A(bufoff, gbase, h) do { if constexpr (GA) PG8_STAGE(bufoff, gbase, voA[h]); else PG8_STAGE(bufoff, (gbase) + (h) * ahstep, voffA); } while (0)
#define PG8_STAGE_A2(bufoff, gbase, h) do { if constexpr (GA) { unsigned _v[2] = {last ? voN[h][0] : voA[h][0], last ? voN[h][1] : voA[h][1]}; PG8_STAGE(bufoff, gbase, _v); } else PG8_STAGE(bufoff, (gbase) + (h) * ahstep, voffA); } while (0)
#define PG8_LDA(dst, b, h) do { _Pragma("unroll") for (int m = 0; m < 4; ++m) _Pragma("unroll") for (int k = 0; k < 2; ++k) dst[m][k] = *(const LAS bf16x8*)(lds + PG8_SA(b, h) + aoff + m * 2048 + k * 1024); } while (0)
#define PG8_LDB(dst, b, h) do { _Pragma("unroll") for (int n = 0; n < 2; ++n) _Pragma("unroll") for (int k = 0; k < 2; ++k) dst[n][k] = *(const LAS bf16x8*)(lds + PG8_SB(b, h) + boff + n * 2048 + k * 1024); } while (0)
#define PG8_MMA(ai, bj, At, Bt) do { __builtin_amdgcn_s_setprio(1); _Pragma("unroll") for (int m = 0; m < 4; ++m) _Pragma("unroll") for (int n = 0; n < 2; ++n) _Pragma("unroll") for (int k = 0; k < 2; ++k) \
        acc[ai][bj][m][n] = __builtin_amdgcn_mfma_f32_16x16x32_bf16(Bt[n][k], At[m][k], acc[ai][bj][m][n], 0, 0, 0); __builtin_amdgcn_s_setprio(0); } while (0)
#define PG8_WAIT_V(n) asm volatile("s_waitcnt vmcnt(" #n ")" ::: "memory")
#define PG8_WAIT_L(n) asm volatile("s_waitcnt lgkmcnt(" #n ")" ::: "memory")
#define PG8_BAR __builtin_amdgcn_s_barrier()
#define PG8_SCHED __builtin_amdgcn_sched_barrier(0)
    Unit cur, nxt; int ui = 0;
    if (!S.next(0, cur)) return;
    f32x4 acc[2][2][4][2];
#pragma unroll
    for (int a = 0; a < 2; ++a)
#pragma unroll
        for (int b = 0; b < 2; ++b)
#pragma unroll
            for (int m = 0; m < 4; ++m)
#pragma unroll
                for (int n = 0; n < 2; ++n) acc[a][b][m][n] = (f32x4){0.f, 0.f, 0.f, 0.f};
    bf16x8 At[4][2], B0[2][2], B1[2][2];
    const char* cA = S.a_base(cur); const char* cB = S.b_base(cur);
    unsigned voA[2][2], voN[2][2];
    if constexpr (GA) S.a_offs(cur, Rr, Cc, voA);
    PG8_STAGE(PG8_SB(0, 0), cB, voffB); PG8_STAGE(PG8_SB(0, 1), cB + hstep, voffB); PG8_STAGE_A(PG8_SA(0, 0), cA, 0); PG8_STAGE_A(PG8_SA(0, 1), cA, 1);
    if (wr == 1) PG8_BAR;
    PG8_WAIT_V(2); PG8_BAR;
    PG8_STAGE(PG8_SB(1, 0), cB + kstep, voffB); PG8_STAGE_A(PG8_SA(1, 0), cA + kstep, 0); PG8_STAGE(PG8_SB(1, 1), cB + hstep + kstep, voffB);
    PG8_WAIT_V(6); PG8_BAR;
    for (;;) {
        const bool has_next = S.next(ui + 1, nxt);
        const char* nA = has_next ? S.a_base(nxt) : cA; const char* nB = has_next ? S.b_base(nxt) : cB;
        if constexpr (GA) {
            if (has_next) S.a_offs(nxt, Rr, Cc, voN);
            else {
#pragma unroll
                for (int h = 0; h < 2; ++h)
#pragma unroll
                    for (int i = 0; i < 2; ++i) voN[h][i] = voA[h][i]; } }
#pragma unroll 1
        for (int t = 0; t < nt; t += 2) {
            const bool last = (t == nt - 2);
            const char* a1 = cA + (size_t)(t + 1) * kstep;
            const char* a2 = last ? nA : cA + (size_t)(t + 2) * kstep; const char* b2 = last ? nB : cB + (size_t)(t + 2) * kstep;
            const char* a3 = a2 + kstep; const char* b3 = b2 + kstep;
            PG8_LDB(B0, 0, 0); PG8_LDB(B1, 0, 1); PG8_SCHED; PG8_LDA(At, 0, 0); PG8_STAGE_A(PG8_SA(1, 1), a1, 1);
            PG8_WAIT_V(8); PG8_WAIT_L(0); PG8_BAR; PG8_MMA(0, 0, At, B0); PG8_MMA(0, 1, At, B1); PG8_BAR; PG8_SCHED;
            PG8_LDA(At, 0, 1); PG8_STAGE(PG8_SB(0, 0), b2, voffB); PG8_STAGE(PG8_SB(0, 1), b2 + hstep, voffB); PG8_STAGE_A2(PG8_SA(0, 0), a2, 0);
            PG8_WAIT_V(8); PG8_WAIT_L(0); PG8_BAR; PG8_MMA(1, 0, At, B0); PG8_MMA(1, 1, At, B1); PG8_BAR; PG8_SCHED;
            PG8_LDB(B0, 1, 0); PG8_LDB(B1, 1, 1); PG8_SCHED; PG8_LDA(At, 1, 0); PG8_STAGE_A2(PG8_SA(0, 1), a2, 1);
            PG8_WAIT_V(8); PG8_WAIT_L(0); PG8_BAR; PG8_MMA(0, 0, At, B0); PG8_MMA(0, 1, At, B1); PG8_BAR; PG8_SCHED;
            PG8_LDA(At, 1, 1); PG8_STAGE(PG8_SB(1, 0), b3, voffB); PG8_STAGE(PG8_SB(1, 1), b3 + hstep, voffB); PG8_STAGE_A2(PG8_SA(1, 0), a3, 0);
            PG8_WAIT_V(8); PG8_WAIT_L(0); PG8_BAR; PG8_MMA(1, 0, At, B0); PG8_MMA(1, 1, At, B1); PG8_BAR; PG8_SCHED;
        }
        if (wr == 0) PG8_BAR;
        E(acc, cur, wr, wc, fr, fq);
        if (!has_next) break;
#pragma unroll
        for (int a = 0; a < 2; ++a)
#pragma unroll
            for (int b = 0; b < 2; ++b)
#pragma unroll
                for (int m = 0; m < 4; ++m)
#pragma unroll
                    for (int n = 0; n < 2; ++n) acc[a][b][m][n] = (f32x4){0.f, 0.f, 0.f, 0.f};
        cur = nxt; cA = nA; cB = nB; ++ui;
        if constexpr (GA) {
#pragma unroll
            for (int h = 0; h < 2; ++h)
#pragma unroll
                for (int i = 0; i < 2; ++i) voA[h][i] = voN[h][i]; }
        if (wr == 1) PG8_BAR;
    }
    PG8_WAIT_V(0);
    PG8_BAR;
#undef PG8_SA
#undef PG8_SB
#undef PG8_STAGE
#undef PG8_STAGE_A
#undef PG8_STAGE_A2
#undef PG8_LDA
#undef PG8_LDB
#undef PG8_MMA
#undef PG8_WAIT_V
#undef PG8_WAIT_L
#undef PG8_BAR
#undef PG8_SCHED
}
}

#define XB_TMO      128
#define XB_XCNT(j)  (256  + 64 * (j))
#define XB_XSUB(j)  (1280 + 64 * (j))
#define XB_XGEN(j)  (2304 + 64 * (j))
#define XB_TOP      3328
#define XB_TOPGEN   3392
#define XCD_BAR_WORDS 3456
#define XB_SPIN_CAP (1u << 18)
__device__ __forceinline__ unsigned xb_ld(unsigned* p)              { return __hip_atomic_load(p, __ATOMIC_RELAXED, __HIP_MEMORY_SCOPE_AGENT); }
__device__ __forceinline__ unsigned xb_add(unsigned* p, unsigned v) { return __hip_atomic_fetch_add(p, v, __ATOMIC_RELAXED, __HIP_MEMORY_SCOPE_AGENT); }
__device__ __forceinline__ unsigned xb_xcc_id() { return (unsigned)__builtin_amdgcn_s_getreg((3 << 11) | 20) & 0xFu; }
#define XB_SPIN(cond, bar) do { unsigned _sp = 0; while (cond) { __builtin_amdgcn_s_sleep(1); \
    if ((++_sp & 255u) == 0u) { if (xb_ld(&(bar)[XB_TMO])) break; if (_sp > XB_SPIN_CAP) { atomicAdd(&(bar)[XB_TMO], 1u); break; } } } } while (0)
struct XcdBarrier { unsigned* bar; unsigned x; volatile LAS unsigned* st; };
__device__ __forceinline__ XcdBarrier xcd_barrier_post(unsigned* bar, volatile LAS unsigned* st) {
    XcdBarrier b; b.bar = bar; b.x = xb_xcc_id(); b.st = st;
    if (threadIdx.x == 0) (void)xb_add(&bar[XB_XCNT(b.x)], 1u);
    return b;
}
__device__ __forceinline__ void xcd_barrier_complete(unsigned* bar, unsigned x, unsigned& nloc, unsigned& nx) {
    const unsigned G = gridDim.x * gridDim.y * gridDim.z;
    unsigned sum, cnt, mine, sp = 0u;
    for (;;) {
        sum = 0u; cnt = 0u; mine = 0u;
#pragma unroll
        for (unsigned j = 0; j < 16; ++j) { const unsigned c = xb_ld(&bar[XB_XCNT(j)]); sum += c; cnt += (c > 0u) ? 1u : 0u; mine = (j == x) ? c : mine; }
        if (sum == G) break;
        __builtin_amdgcn_s_sleep(1);
        if ((++sp & 255u) == 0u) { if (xb_ld(&bar[XB_TMO])) break; if (sp > XB_SPIN_CAP) { atomicAdd(&bar[XB_TMO], 1u); break; } }
    }
    nloc = mine > 0u ? mine : 1u; nx = cnt > 0u ? cnt : 1u;
}
__device__ __forceinline__ void xcd_barrier(const XcdBarrier& b) {
    asm volatile("s_waitcnt vmcnt(0)" ::: "memory");
    __syncthreads();
    if (threadIdx.x == 0) {
        unsigned* bar = b.bar;
        __builtin_amdgcn_s_waitcnt(0);
        unsigned nloc = b.st[0], nx = b.st[1];
        if (nloc == 0u) { xcd_barrier_complete(bar, b.x, nloc, nx); b.st[0] = nloc; b.st[1] = nx; }
        const unsigned old = xb_add(&bar[XB_XSUB(b.x)], 1u);
        const unsigned gen = old / nloc;
        if (old + 1u == (gen + 1u) * nloc) {
            __builtin_amdgcn_fence(__ATOMIC_RELEASE, "agent");
            asm volatile("s_waitcnt vmcnt(0)" ::: "memory");
            const unsigned og = xb_add(&bar[XB_TOP], 1u);
            const unsigned tg = og / nx;
            if (og + 1u == (tg + 1u) * nx) xb_add(&bar[XB_TOPGEN], 1u);
            else XB_SPIN(xb_ld(&bar[XB_TOPGEN]) == tg, bar);
            __builtin_amdgcn_fence(__ATOMIC_ACQUIRE, "agent");
            xb_add(&bar[XB_XGEN(b.x)], 1u);
            asm volatile("s_waitcnt vmcnt(0)" ::: "memory");
        } else {
            XB_SPIN(xb_ld(&bar[XB_XGEN(b.x)]) == gen, bar);
            __builtin_amdgcn_fence(__ATOMIC_ACQUIRE, "agent");
            asm volatile("s_waitcnt vmcnt(0)" ::: "memory");
        }
    }
    __syncthreads();
}

struct Args { const float* in[28]; float* out; unsigned char* ws; int ph_lo, ph_hi; };

struct Frame {
    LAS unsigned char* lds; unsigned char* ws; unsigned* ctl;
    int tid, lane, wave, G, bx;
    __device__ __forceinline__ Frame fresh() const { Frame f = *this; int t = threadIdx.x; asm volatile("" : "+v"(t)); f.tid = t; f.lane = t & 63; return f; }
};

__device__ __forceinline__ int dmap(int type, int n) {
    if (type == 1) return n < 2048 ? n : (n < 2064 ? n - 2048 + UG_LOW : n - 16);
    if (type == 2) return (n >> 7) * 256 + (n & 127);
    if (type == 3) return (n >> 7) * 256 + 128 + (n & 127);
    return n;
}
__device__ __forceinline__ void transpose_item(const float* W, int ldw, int ncols, int k0, int n0, const float* kscale, bf16_t* WT, int ldt, int type, LAS float* scr, int lane) {
    const int nn = n0 + (lane & 31); const bool okc = nn < ncols;
#pragma unroll 8
    for (int i = 0; i < 32; ++i) { const int kk = 2 * i + (lane >> 5); float v = okc ? W[(size_t)(k0 + kk) * ldw + nn] : 0.f; if (kscale) v *= kscale[k0 + kk]; scr[kk * 33 + (lane & 31)] = v; }
    LDS_WAIT(); asm volatile("" ::: "memory");
    const int c = lane & 7;
#pragma unroll
    for (int j = 0; j < 4; ++j) { const int n = (lane >> 3) + 8 * j; const LAS float* s = scr + (8 * c) * 33 + n;
        u32x4 o; o.x = pk2(s[0 * 33], s[1 * 33]); o.y = pk2(s[2 * 33], s[3 * 33]); o.z = pk2(s[4 * 33], s[5 * 33]); o.w = pk2(s[6 * 33], s[7 * 33]);
        if (n0 + n < ncols) *(u32x4*)(WT + (size_t)dmap(type, n0 + n) * ldt + k0 + 8 * c) = o; }
    LDS_WAIT(); asm volatile("" ::: "memory");
}
__device__ __forceinline__ int t5_bucket(int d) {
    if (d < 16) return d;
    const float v = logf((float)d / 16.0f) / 4.852030263919617f * 16.0f;
    int b = 16 + (int)v; return b < 31 ? b : 31;
}
__device__ __forceinline__ void phase_prologue(const Frame& F, const Args& a) {
    LAS float* scr = (LAS float*)(F.lds + F.wave * 16384);
    const int gw = F.bx * 8 + F.wave, NGW = F.G * 8;
    constexpr int I_IN = 32 * 177, I_OUT = 32 * 64, I_G = 32 * 256, I_U = 32 * 256, I_D = 32 * 256, I_PG = 32 * 64, I_PP = 4 * 64, I_L = I_IN + I_OUT + I_G + I_U + I_D + I_PG + I_PP;
    bf16_t* WIN = (bf16_t*)(F.ws + WS_WIN); bf16_t* WOUT = (bf16_t*)(F.ws + WS_WOUT); bf16_t* WGU = (bf16_t*)(F.ws + WS_WGU); bf16_t* WD = (bf16_t*)(F.ws + WS_WD);
    bf16_t* WPG = (bf16_t*)(F.ws + WS_WPG); bf16_t* WPP = (bf16_t*)(F.ws + WS_WPP);
    for (int it = gw; it < NL * I_L; it += NGW) {
        const int l = it / I_L; int r = it - l * I_L;
        if (r < I_IN) { const int kb = r / 177, nb = r - kb * 177; transpose_item(a.in[2] + (size_t)l * DM * DIN, DIN, DIN, kb * 64, nb * 32, nullptr, WIN + (size_t)l * DINP * DM, DM, 1, scr, F.lane); continue; } r -= I_IN;
        if (r < I_OUT) { const int kb = r >> 6, nb = r & 63; transpose_item(a.in[12] + (size_t)l * DM * DM, DM, DM, kb * 64, nb * 32, a.in[11] + l * DM, WOUT + (size_t)l * DM * DM, DM, 0, scr, F.lane); continue; } r -= I_OUT;
        if (r < I_G) { const int e = r >> 8, q = r & 255, kb = q >> 3, nb = q & 7; transpose_item(a.in[20] + (size_t)(l * NEXP + e) * DM * DEXP, DEXP, DEXP, kb * 64, nb * 32, nullptr, WGU + (size_t)(l * NEXP + e) * 512 * DM, DM, 2, scr, F.lane); continue; } r -= I_G;
        if (r < I_U) { const int e = r >> 8, q = r & 255, kb = q >> 3, nb = q & 7; transpose_item(a.in[21] + (size_t)(l * NEXP + e) * DM * DEXP, DEXP, DEXP, kb * 64, nb * 32, nullptr, WGU + (size_t)(l * NEXP + e) * 512 * DM, DM, 3, scr, F.lane); continue; } r -= I_U;
        if (r < I_D) { const int e = r >> 8, q = r & 255, kb = q >> 6, nb = q & 63; transpose_item(a.in[22] + (size_t)(l * NEXP + e) * DEXP * DM, DM, DM, kb * 64, nb * 32, nullptr, WD + (size_t)(l * NEXP + e) * DM * DEXP, DEXP, 0, scr, F.lane); continue; } r -= I_D;
        if (r < I_PG) { const int kb = r >> 6, nb = r & 63; transpose_item(a.in[23] + (size_t)l * DM * DM, DM, DM, kb * 64, nb * 32, nullptr, WPG + (size_t)l * DM * DM, DM, 0, scr, F.lane); continue; } r -= I_PG;
        { const int kb = r >> 6, nb = r & 63; transpose_item(a.in[25] + (size_t)l * PLE * DM, DM, DM, kb * 64, nb * 32, nullptr, WPP + (size_t)l * DM * PLE, PLE, 0, scr, F.lane); }
    }
    const size_t gt = (size_t)F.bx * 512 + F.tid, NT = (size_t)F.G * 512;
    for (size_t i = gt; i < (size_t)NL * (DINP - DIN) * DM / 8; i += NT) { const size_t l = i / ((DINP - DIN) * DM / 8), r = i % ((DINP - DIN) * DM / 8);
        *(u32x4*)(WIN + (l * DINP + DIN) * DM + r * 8) = (u32x4){0u, 0u, 0u, 0u}; }
    { const float* x = a.in[0]; bf16_t* XB = (bf16_t*)(F.ws + WS_XB);
      for (size_t i = gt; i < (size_t)MT * DM / 8; i += NT) { const f32x4 v0 = *(const f32x4*)(x + i * 8), v1 = *(const f32x4*)(x + i * 8 + 4);
          *(u32x4*)(XB + i * 8) = (u32x4){pk2(v0[0], v0[1]), pk2(v0[2], v0[3]), pk2(v1[0], v1[1]), pk2(v1[2], v1[3])}; } }
    { const float* p = a.in[1]; bf16_t* PB = (bf16_t*)(F.ws + WS_PB);
      for (size_t i = gt; i < (size_t)NL * MT * PLE / 8; i += NT) { const f32x4 v0 = *(const f32x4*)(p + i * 8), v1 = *(const f32x4*)(p + i * 8 + 4);
          *(u32x4*)(PB + i * 8) = (u32x4){pk2(v0[0], v0[1]), pk2(v0[2], v0[3]), pk2(v1[0], v1[1]), pk2(v1[2], v1[3])}; } }
    { float* bt = (float*)(F.ws + WS_BTAB); const float* rb = a.in[13];
      for (size_t i = gt; i < 3 * 129 * 8; i += NT) { const int h = (int)(i & 7), j = (int)((i >> 3) % 129), br = (int)((i >> 3) / 129); const int dil = br == 0 ? 1 : (br == 1 ? 4 : 16);
          bt[i] = rb[t5_bucket(j * dil) * 8 + h]; } }
    { float* wrt = (float*)(F.ws + WS_WRT);
      for (size_t i = gt; i < (size_t)NL * 36 * DM; i += NT) { const int c = (int)(i % DM), col = (int)((i / DM) % 36), l = (int)(i / (36 * DM));
          wrt[i] = col < 4 ? a.in[16][((size_t)l * DM + c) * 4 + col] : a.in[18][((size_t)l * DM + c) * 32 + (col - 4)]; } }
}

__device__ __forceinline__ void conv_unit(const Frame& F, const Args& a, int l, int unit) {
    const bf16_t* U = (const bf16_t*)(F.ws + WS_U); bf16_t* MIX = (bf16_t*)(F.ws + WS_MIX);
    LAS float* hb = (LAS float*)F.lds;
    const int t0 = unit * 32, tl0 = t0 & (SEQ - 1), tb = t0 - tl0;
    const int tid = F.tid;
    __syncthreads();
#pragma unroll 1
    for (int i = 0; i < 8; ++i) { const int id = tid + 512 * i; if (id < 62 * 64) { const int row = id >> 6, ch = (id & 63) * 8; const int tl = tl0 - 30 + row;
        float o[8];
        if (tl >= 0) { const bf16_t* up = U + (size_t)(tb + tl) * DINP; const u32x4 av = *(const u32x4*)(up + UA_VAL + ch), gv = *(const u32x4*)(up + UA_GATE + ch);
            const unsigned aw[4] = {av.x, av.y, av.z, av.w}, gw[4] = {gv.x, gv.y, gv.z, gv.w};
#pragma unroll
            for (int j = 0; j < 4; ++j) { o[2 * j] = bflo(aw[j]) * sigmoidf_(bflo(gw[j])); o[2 * j + 1] = bfhi(aw[j]) * sigmoidf_(bfhi(gw[j])); } }
        else {
#pragma unroll
            for (int j = 0; j < 8; ++j) o[j] = 0.f; }
        *(LAS f32x4*)(hb + row * 512 + ch) = (f32x4){o[0], o[1], o[2], o[3]}; *(LAS f32x4*)(hb + row * 512 + ch + 4) = (f32x4){o[4], o[5], o[6], o[7]}; } }
    __syncthreads();
    float yv[32];
    { const int c = tid; const float* w = a.in[3] + (size_t)l * 31 * 512; const float bias = a.in[4][l * 512 + c];
      float wv[31];
#pragma unroll
      for (int j = 0; j < 31; ++j) wv[j] = w[j * 512 + c];
      float hv[62];
#pragma unroll
      for (int r = 0; r < 62; ++r) hv[r] = hb[r * 512 + c];
#pragma unroll
      for (int t = 0; t < 32; ++t) { float s = bias;
#pragma unroll
          for (int j = 0; j < 31; ++j) s += wv[j] * hv[t + j];
          yv[t] = s; } }
    __syncthreads();
#pragma unroll
    for (int t = 0; t < 32; ++t) hb[t * 512 + tid] = yv[t];
    __syncthreads();
    { const float* lg = a.in[5] + l * 512; const float* lb = a.in[6] + l * 512;
#pragma unroll 1
      for (int i = 0; i < 4; ++i) { const int t = F.wave + 8 * i;
          const f32x4 v0 = *(const LAS f32x4*)(hb + t * 512 + 4 * F.lane), v1 = *(const LAS f32x4*)(hb + t * 512 + 256 + 4 * F.lane);
          const float mean = wave_sum((v0[0] + v0[1]) + (v0[2] + v0[3]) + (v1[0] + v1[1]) + (v1[2] + v1[3])) * (1.f / 512.f);
          const f32x4 d0 = v0 - mean, d1 = v1 - mean;
          const float var = wave_sum((d0[0] * d0[0] + d0[1] * d0[1]) + (d0[2] * d0[2] + d0[3] * d0[3]) + (d1[0] * d1[0] + d1[1] * d1[1]) + (d1[2] * d1[2] + d1[3] * d1[3])) * (1.f / 512.f);
          const float rstd = 1.0f / sqrtf(var + LN_EPS);
          const f32x4 g0 = *(const f32x4*)(lg + 4 * F.lane), g1 = *(const f32x4*)(lg + 256 + 4 * F.lane), b0 = *(const f32x4*)(lb + 4 * F.lane), b1 = *(const f32x4*)(lb + 256 + 4 * F.lane);
          float o0[4], o1[4];
#pragma unroll
          for (int j = 0; j < 4; ++j) { o0[j] = siluf_(d0[j] * rstd * g0[j] + b0[j]); o1[j] = siluf_(d1[j] * rstd * g1[j] + b1[j]); }
          bf16_t* mp = MIX + (size_t)(t0 + t) * DM;
          *(u32x2*)(mp + 4 * F.lane) = (u32x2){pk2(o0[0], o0[1]), pk2(o0[2], o0[3])}; *(u32x2*)(mp + 256 + 4 * F.lane) = (u32x2){pk2(o1[0], o1[1]), pk2(o1[2], o1[3])}; } }
    { const int c = tid; const float* w = a.in[10] + (size_t)l * 3 * 512; const float w0 = w[c], w1 = w[512 + c], w2 = w[1024 + c];
      float p2 = 0.f, p1 = 0.f;
      if (tl0 >= 2) { const bf16_t* up = U + (size_t)(t0 - 2) * DINP; p2 = bf2f(up[US_C + c]) * bf2f(up[US_H + c]); }
      if (tl0 >= 1) { const bf16_t* up = U + (size_t)(t0 - 1) * DINP; p1 = bf2f(up[US_C + c]) * bf2f(up[US_H + c]); }
#pragma unroll 4
      for (int t = 0; t < 32; ++t) { const bf16_t* up = U + (size_t)(t0 + t) * DINP; const float p0 = bf2f(up[US_C + c]) * bf2f(up[US_H + c]);
          const float y = bf2f(up[US_B + c]) * (w0 * p2 + w1 * p1 + w2 * p0);
          MIX[(size_t)(t0 + t) * DM + 1536 + c] = (bf16_t)f2bf(y); p2 = p1; p1 = p0; } }
}

__device__ __forceinline__ void gla_a_unit(const Frame& F, const Args& a, int l, int unit) {
    const bf16_t* U = (const bf16_t*)(F.ws + WS_U);
    float* GU = (float*)(F.ws + WS_GU); float* GO = (float*)(F.ws + WS_GO); float* GQ = (float*)(F.ws + WS_GQ); float* GD = (float*)(F.ws + WS_GD);
    const int n = unit & 63, h = (unit >> 6) & 3, b = unit >> 8, bh = b * 4 + h;
    const int t0 = b * SEQ + n * 32, tid = F.tid;
    LAS float* L = (LAS float*)F.lds;
    LAS float* qt = L; LAS float* kr = L + 2048; LAS float* kt = L + 4096; LAS float* kh = L + 6144; LAS float* vv = L + 8192; LAS float* bc = L + 12288; LAS float* gl = L + 14336; LAS float* wg = L + 14848; LAS float* sc = L + 15872;
    const int i = tid >> 4, k4 = (tid & 15) * 4, v8 = (tid & 15) * 8;
    __syncthreads();
    { const bf16_t* up = U + (size_t)(t0 + i) * DINP;
      const u32x2 qw = *(const u32x2*)(up + UG_Q + h * 64 + k4), kw = *(const u32x2*)(up + UG_K + h * 64 + k4); const u32x4 vw = *(const u32x4*)(up + UG_V + h * 128 + v8);
      *(LAS f32x4*)(qt + i * 64 + k4) = (f32x4){bflo(qw.x), bfhi(qw.x), bflo(qw.y), bfhi(qw.y)};
      *(LAS f32x4*)(kr + i * 64 + k4) = (f32x4){bflo(kw.x), bfhi(kw.x), bflo(kw.y), bfhi(kw.y)};
      *(LAS f32x4*)(vv + i * 128 + v8) = (f32x4){bflo(vw.x), bfhi(vw.x), bflo(vw.y), bfhi(vw.y)}; *(LAS f32x4*)(vv + i * 128 + v8 + 4) = (f32x4){bflo(vw.z), bfhi(vw.z), bflo(vw.w), bfhi(vw.w)};
      gl[i * 16 + (tid & 15)] = bf2f(up[UG_LOW + (tid & 15)]);
      const float* w2 = a.in[7] + (size_t)l * 16 * 256;
      wg[tid] = w2[(tid >> 6) * 256 + h * 64 + (tid & 63)]; wg[512 + tid] = w2[(8 + (tid >> 6)) * 256 + h * 64 + (tid & 63)]; }
    __syncthreads();
    { const f32x4 bg = *(const f32x4*)(a.in[8] + l * 256 + h * 64 + k4); f32x4 z = bg;
#pragma unroll
      for (int r = 0; r < 16; ++r) { const float g = gl[i * 16 + r]; const f32x4 w = *(const LAS f32x4*)(wg + r * 64 + k4); z = z + w * g; }
      f32x4 la;
#pragma unroll
      for (int j = 0; j < 4; ++j) la[j] = (fminf(z[j], 0.f) - log1pf(expf(-fabsf(z[j])))) * (1.0f / 16.0f);
      *(LAS f32x4*)(bc + i * 64 + k4) = la; }
    __syncthreads();
    if (tid < 64) { float run = 0.f;
#pragma unroll
        for (int r = 0; r < 32; ++r) { run += bc[r * 64 + tid]; bc[r * 64 + tid] = run; } }
    __syncthreads();
    { const f32x4 bv = *(const LAS f32x4*)(bc + i * 64 + k4), bl = *(const LAS f32x4*)(bc + 31 * 64 + k4), q = *(const LAS f32x4*)(qt + i * 64 + k4), k = *(const LAS f32x4*)(kr + i * 64 + k4);
      f32x4 qo, ko, ho;
#pragma unroll
      for (int j = 0; j < 4; ++j) { qo[j] = q[j] * expf(bv[j]) * 0.125f; ko[j] = k[j] * expf(-bv[j]); ho[j] = k[j] * expf(bl[j] - bv[j]); }
      *(LAS f32x4*)(qt + i * 64 + k4) = qo; *(LAS f32x4*)(kt + i * 64 + k4) = ko; *(LAS f32x4*)(kh + i * 64 + k4) = ho;
      *(f32x4*)(GQ + (size_t)(t0 + i) * 256 + h * 64 + k4) = qo;
      if (i == 31) { f32x4 d;
#pragma unroll
          for (int j = 0; j < 4; ++j) d[j] = expf(bl[j]);
          *(f32x4*)(GD + ((size_t)bh * 64 + n) * 64 + k4) = d; } }
    __syncthreads();
    { const int j0 = (tid & 15) * 2; float s0 = 0.f, s1 = 0.f;
#pragma unroll
      for (int k = 0; k < 64; k += 4) { const f32x4 q = *(const LAS f32x4*)(qt + i * 64 + k), ka = *(const LAS f32x4*)(kt + j0 * 64 + k), kb = *(const LAS f32x4*)(kt + (j0 + 1) * 64 + k);
          s0 += (q[0] * ka[0] + q[1] * ka[1]) + (q[2] * ka[2] + q[3] * ka[3]); s1 += (q[0] * kb[0] + q[1] * kb[1]) + (q[2] * kb[2] + q[3] * kb[3]); }
      sc[i * 33 + j0] = (j0 <= i) ? s0 : 0.f; sc[i * 33 + j0 + 1] = (j0 + 1 <= i) ? s1 : 0.f; }
    { const int kk = (tid >> 5) * 4, v0 = (tid & 31) * 4; f32x4 u0 = {0.f, 0.f, 0.f, 0.f}, u1 = u0, u2 = u0, u3 = u0;
#pragma unroll 8
      for (int j = 0; j < 32; ++j) { const f32x4 kv = *(const LAS f32x4*)(kh + j * 64 + kk), vx = *(const LAS f32x4*)(vv + j * 128 + v0);
          u0 = u0 + vx * kv[0]; u1 = u1 + vx * kv[1]; u2 = u2 + vx * kv[2]; u3 = u3 + vx * kv[3]; }
      float* gp = GU + (((size_t)bh * 64 + n) * 64 + kk) * 128 + v0;
      *(f32x4*)(gp) = u0; *(f32x4*)(gp + 128) = u1; *(f32x4*)(gp + 256) = u2; *(f32x4*)(gp + 384) = u3; }
    __syncthreads();
    { f32x4 o0 = {0.f, 0.f, 0.f, 0.f}, o1 = o0;
#pragma unroll 8
      for (int j = 0; j < 32; ++j) { const float s = sc[i * 33 + j]; const f32x4 va = *(const LAS f32x4*)(vv + j * 128 + v8), vb = *(const LAS f32x4*)(vv + j * 128 + v8 + 4); o0 = o0 + va * s; o1 = o1 + vb * s; }
      float* gp = GO + (size_t)(t0 + i) * 512 + h * 128 + v8; *(f32x4*)gp = o0; *(f32x4*)(gp + 4) = o1; }
}
__device__ __forceinline__ void gla_scan(const Frame& F) {
    float* GU = (float*)(F.ws + WS_GU); const float* GD = (const float*)(F.ws + WS_GD);
    for (int g = F.bx * 512 + F.tid; g < 16 * 8192; g += F.G * 512) { const int bh = g >> 13, kv = g & 8191, k = kv >> 7;
        float* p = GU + (size_t)bh * 64 * 8192 + kv; const float* d = GD + (size_t)bh * 64 * 64 + k; float S = 0.f;
#pragma unroll 8
        for (int n = 0; n < 64; ++n) { const float u = p[(size_t)n * 8192]; const float dc = d[n * 64]; p[(size_t)n * 8192] = S; S = S * dc + u; } }
}
__device__ __forceinline__ void gla_c_unit(const Frame& F, const Args& a, int l, int unit) {
    const bf16_t* U = (const bf16_t*)(F.ws + WS_U); bf16_t* MIX = (bf16_t*)(F.ws + WS_MIX);
    const float* GU = (const float*)(F.ws + WS_GU); const float* GO = (const float*)(F.ws + WS_GO); const float* GQ = (const float*)(F.ws + WS_GQ);
    const int n = unit & 63, h = (unit >> 6) & 3, b = unit >> 8, bh = b * 4 + h;
    const int t0 = b * SEQ + n * 32, tid = F.tid;
    LAS float* qt = (LAS float*)F.lds; LAS float* Ss = qt + 2048;
    const int i = tid >> 4, k4 = (tid & 15) * 4, v8 = (tid & 15) * 8;
    __syncthreads();
    *(LAS f32x4*)(qt + i * 64 + k4) = *(const f32x4*)(GQ + (size_t)(t0 + i) * 256 + h * 64 + k4);
    { const float* sp = GU + ((size_t)bh * 64 + n) * 8192;
#pragma unroll
      for (int j = 0; j < 4; ++j) *(LAS f32x4*)(Ss + (tid + 512 * j) * 4) = *(const f32x4*)(sp + (tid + 512 * j) * 4); }
    __syncthreads();
    const float* gp = GO + (size_t)(t0 + i) * 512 + h * 128 + v8;
    f32x4 o0 = *(const f32x4*)gp, o1 = *(const f32x4*)(gp + 4);
#pragma unroll 8
    for (int k = 0; k < 64; ++k) { const float q = qt[i * 64 + k]; const f32x4 sa = *(const LAS f32x4*)(Ss + k * 128 + v8), sb = *(const LAS f32x4*)(Ss + k * 128 + v8 + 4); o0 = o0 + sa * q; o1 = o1 + sb * q; }
    float ss = (o0[0] * o0[0] + o0[1] * o0[1]) + (o0[2] * o0[2] + o0[3] * o0[3]) + (o1[0] * o1[0] + o1[1] * o1[1]) + (o1[2] * o1[2] + o1[3] * o1[3]);
    ss += __shfl_xor(ss, 1); ss += __shfl_xor(ss, 2); ss += __shfl_xor(ss, 4); ss += __shfl_xor(ss, 8);
    const float rms = 1.0f / sqrtf(ss * (1.f / 128.f) + RMS_EPS);
    const float* ng = a.in[9] + l * 128 + v8; const f32x4 n0 = *(const f32x4*)ng, n1 = *(const f32x4*)(ng + 4);
    const u32x4 rw = *(const u32x4*)(U + (size_t)(t0 + i) * DINP + UG_R + h * 128 + v8);
    const float r[8] = {bflo(rw.x), bfhi(rw.x), bflo(rw.y), bfhi(rw.y), bflo(rw.z), bfhi(rw.z), bflo(rw.w), bfhi(rw.w)};
    float o[8];
#pragma unroll
    for (int j = 0; j < 4; ++j) { o[j] = o0[j] * rms * n0[j] * siluf_(r[j]); o[4 + j] = o1[j] * rms * n1[j] * siluf_(r[4 + j]); }
    *(u32x4*)(MIX + (size_t)(t0 + i) * DM + 512 + h * 128 + v8) = (u32x4){pk2(o[0], o[1]), pk2(o[2], o[3]), pk2(o[4], o[5]), pk2(o[6], o[7])};
}

__device__ __forceinline__ void attn_simple(const Frame& F, int t, int h, LAS float* pl) {
    const bf16_t* U = (const bf16_t*)(F.ws + WS_U); bf16_t* MIX = (bf16_t*)(F.ws + WS_MIX); const float* btab = (const float*)(F.ws + WS_BTAB);
    const int lane = F.lane, tl = t & (SEQ - 1), tb = t - tl;
    float q[64];
    { const u32x4* qp = (const u32x4*)(U + (size_t)t * DINP + UC_Q + h * 64);
#pragma unroll
      for (int c = 0; c < 8; ++c) { const u32x4 w = qp[c]; q[8 * c] = bflo(w.x); q[8 * c + 1] = bfhi(w.x); q[8 * c + 2] = bflo(w.y); q[8 * c + 3] = bfhi(w.y); q[8 * c + 4] = bflo(w.z); q[8 * c + 5] = bfhi(w.z); q[8 * c + 6] = bflo(w.w); q[8 * c + 7] = bfhi(w.w); } }
    float s[7]; float m = -INFINITY;
#pragma unroll
    for (int r = 0; r < 7; ++r) { const int idx = lane + 64 * r; const int br = idx / 129, j = idx - br * 129; const int dil = br == 0 ? 1 : (br == 1 ? 4 : 16); const int kl = tl - j * dil;
        float sv = -INFINITY;
        if (idx < 387 && kl >= 0) { const u32x4* kp = (const u32x4*)(U + (size_t)(tb + kl) * DINP + UC_K + h * 64); float d = 0.f;
#pragma unroll
            for (int c = 0; c < 8; ++c) { const u32x4 w = kp[c];
                d += (q[8 * c] * bflo(w.x) + q[8 * c + 1] * bfhi(w.x)) + (q[8 * c + 2] * bflo(w.y) + q[8 * c + 3] * bfhi(w.y)) + (q[8 * c + 4] * bflo(w.z) + q[8 * c + 5] * bfhi(w.z)) + (q[8 * c + 6] * bflo(w.w) + q[8 * c + 7] * bfhi(w.w)); }
            sv = d * 0.125f + btab[(br * 129 + j) * 8 + h]; }
        s[r] = sv; m = fmaxf(m, sv); }
    m = wave_max(m);
    float lsum = 0.f;
#pragma unroll
    for (int r = 0; r < 7; ++r) { const float p = (s[r] == -INFINITY) ? 0.f : __expf(s[r] - m); lsum += p; pl[lane + 64 * r] = p; }
    lsum = wave_sum(lsum);
    LDS_WAIT();
    const int kq = lane >> 4, dl = lane & 15;
    float o0 = 0.f, o1 = 0.f, o2 = 0.f, o3 = 0.f;
#pragma unroll 4
    for (int it = 0; it < 97; ++it) { const int idx = 4 * it + kq; const float p = pl[idx]; const int br = idx / 129, j = idx - br * 129; const int dil = br == 0 ? 1 : (br == 1 ? 4 : 16); const int kl = tl - j * dil;
        if (idx < 387 && kl >= 0) { const u32x2 w = *(const u32x2*)(U + (size_t)(tb + kl) * DINP + UC_V + h * 64 + 4 * dl); o0 += p * bflo(w.x); o1 += p * bfhi(w.x); o2 += p * bflo(w.y); o3 += p * bfhi(w.y); } }
    o0 += __shfl_xor(o0, 16); o1 += __shfl_xor(o1, 16); o2 += __shfl_xor(o2, 16); o3 += __shfl_xor(o3, 16);
    o0 += __shfl_xor(o0, 32); o1 += __shfl_xor(o1, 32); o2 += __shfl_xor(o2, 32); o3 += __shfl_xor(o3, 32);
    const float inv = 1.0f / lsum;
    if (kq == 0) *(u32x2*)(MIX + (size_t)t * DM + 1024 + h * 64 + 4 * dl) = (u32x2){pk2(o0 * inv, o1 * inv), pk2(o2 * inv, o3 * inv)};
    LDS_WAIT();
}

__device__ __forceinline__ void ln1_unit(const Frame& F, const Args& a, int l, int unit, float* X1F) {
    const float* PRE = (const float*)(F.ws + WS_PRE); bf16_t* XB = (bf16_t*)(F.ws + WS_XB); const float* wrt = (const float*)(F.ws + WS_WRT) + (size_t)l * 36 * DM;
    int* ltok = (int*)(F.ws + WS_LTOK); float* lgate = (float*)(F.ws + WS_LGATE); int* tinfo = (int*)(F.ws + WS_TINFO); unsigned* cnt = F.ctl + CW_CNT + l * 32 * 64;
    LAS float* xs = (LAS float*)F.lds + F.wave * 2048;
    LAS float* Wl = (LAS float*)F.lds + 8 * 2048;
    const int lane = F.lane, row = unit * 8 + F.wave;
    const float* g = a.in[14] + (size_t)l * DM; const float* bb = a.in[15] + (size_t)l * DM;
    { const float* pr = PRE + (size_t)row * DM; f32x4 v[8]; float s = 0.f;
#pragma unroll
      for (int j = 0; j < 8; ++j) { v[j] = *(const f32x4*)(pr + 256 * j + 4 * lane); s += (v[j][0] + v[j][1]) + (v[j][2] + v[j][3]); }
      const float mean = wave_sum(s) * (1.f / DM); float q = 0.f;
#pragma unroll
      for (int j = 0; j < 8; ++j) { v[j] = v[j] - mean; q += (v[j][0] * v[j][0] + v[j][1] * v[j][1]) + (v[j][2] * v[j][2] + v[j][3] * v[j][3]); }
      const float rstd = 1.0f / sqrtf(wave_sum(q) * (1.f / DM) + LN_EPS);
#pragma unroll
      for (int j = 0; j < 8; ++j) { const f32x4 gv = *(const f32x4*)(g + 256 * j + 4 * lane), bv = *(const f32x4*)(bb + 256 * j + 4 * lane); const f32x4 y = v[j] * rstd * gv + bv;
          *(f32x4*)(X1F + (size_t)row * DM + 256 * j + 4 * lane) = y; *(u32x2*)(XB + (size_t)row * DM + 256 * j + 4 * lane) = (u32x2){pk2(y[0], y[1]), pk2(y[2], y[3])};
          *(LAS f32x4*)(xs + 256 * j + 4 * lane) = y; } }
    float acc[36];
#pragma unroll
    for (int c = 0; c < 36; ++c) acc[c] = 0.f;
#pragma unroll 1
    for (int j = 0; j < 8; ++j) {
        __syncthreads();
#pragma unroll 1
        for (int i = F.tid; i < 36 * 64; i += 512) { const int col = i >> 6, c4 = (i & 63) * 4; *(LAS f32x4*)(Wl + col * 256 + c4) = *(const f32x4*)(wrt + (size_t)col * DM + 256 * j + c4); }
        __syncthreads();
        const f32x4 xv = *(const LAS f32x4*)(xs + 256 * j + 4 * lane);
#pragma unroll
        for (int c = 0; c < 36; ++c) { const f32x4 w = *(const LAS f32x4*)(Wl + c * 256 + 4 * lane); acc[c] += (xv[0] * w[0] + xv[1] * w[1]) + (xv[2] * w[2] + xv[3] * w[3]); }
    }
#pragma unroll
    for (int c = 0; c < 36; ++c) acc[c] = wave_sum(acc[c]);
    const float* gb = a.in[17] + l * 4; const float* eb = a.in[19] + l * 32;
    {
        float gl[4];
#pragma unroll
        for (int c = 0; c < 4; ++c) gl[c] = acc[c] + gb[c];
        int gi = 0; float gm = gl[0];
#pragma unroll
        for (int c = 1; c < 4; ++c) if (gl[c] > gm) { gm = gl[c]; gi = c; }
        float gs = 0.f;
#pragma unroll
        for (int c = 0; c < 4; ++c) gs += expf(gl[c] - gm);
        const float gtop = 1.0f / gs;
        float ev[8];
#pragma unroll
        for (int c = 0; c < 8; ++c) { const float v0 = acc[4 + c] + eb[c], v1 = acc[12 + c] + eb[8 + c], v2 = acc[20 + c] + eb[16 + c], v3 = acc[28 + c] + eb[24 + c]; ev[c] = gi == 0 ? v0 : (gi == 1 ? v1 : (gi == 2 ? v2 : v3)); }
        int i1 = 0; float m1 = ev[0];
#pragma unroll
        for (int c = 1; c < 8; ++c) if (ev[c] > m1) { m1 = ev[c]; i1 = c; }
        int i2 = -1; float m2 = -INFINITY;
#pragma unroll
        for (int c = 0; c < 8; ++c) if (c != i1 && ev[c] > m2) { m2 = ev[c]; i2 = c; }
        const float p2 = expf(m2 - m1), den = 1.0f + p2;
        const float w1 = gtop / den, w2 = gtop * p2 / den;
        if (lane == 0) { const int tok = row; const int e1 = gi * 8 + i1, e2 = gi * 8 + i2;
            const unsigned s1 = __hip_atomic_fetch_add(cnt + e1 * 64, 1u, __ATOMIC_RELAXED, __HIP_MEMORY_SCOPE_AGENT), s2 = __hip_atomic_fetch_add(cnt + e2 * 64, 1u, __ATOMIC_RELAXED, __HIP_MEMORY_SCOPE_AGENT);
            ltok[e1 * MT + s1] = tok; lgate[e1 * MT + s1] = w1; ltok[e2 * MT + s2] = tok; lgate[e2 * MT + s2] = w2;
            tinfo[tok * 2] = e1 * MT + (int)s1; tinfo[tok * 2 + 1] = e2 * MT + (int)s2; }
    }
}
__device__ __forceinline__ void moe_tables(const Frame& F, int l) {
    LAS int* toff = (LAS int*)(F.lds + LDS_TOFF); const unsigned* cnt = F.ctl + CW_CNT + l * 32 * 64;
    __syncthreads();
    if (F.tid == 0) { int run = 0; for (int e = 0; e < 32; ++e) { toff[e] = run; run += ((int)cnt[e * 64] + 255) >> 8; } toff[32] = run; }
    __syncthreads();
}
__device__ __forceinline__ void ln2_rows(const Frame& F, const Args& a, int l, float* OUT, bool write_xb) {
    const float* PRE = (const float*)(F.ws + WS_PRE); const bf16_t* Y = (const bf16_t*)(F.ws + WS_Y); bf16_t* XB = (bf16_t*)(F.ws + WS_XB); const int* tinfo = (const int*)(F.ws + WS_TINFO);
    const LAS int* toff = (const LAS int*)(F.lds + LDS_TOFF);
    const float* g = a.in[26] + (size_t)l * DM; const float* bb = a.in[27] + (size_t)l * DM; const int lane = F.lane;
    for (int row = F.bx * 8 + F.wave; row < MT; row += F.G * 8) {
        const int i0 = tinfo[row * 2], i1 = tinfo[row * 2 + 1];
        const size_t s0 = (size_t)toff[i0 >> 13] * 256 + (i0 & 8191), s1 = (size_t)toff[i1 >> 13] * 256 + (i1 & 8191);
        const float* pr = PRE + (size_t)row * DM; const bf16_t* y0 = Y + s0 * DM; const bf16_t* y1 = Y + s1 * DM;
        f32x4 v[8]; float s = 0.f;
#pragma unroll
        for (int j = 0; j < 8; ++j) { const f32x4 p = *(const f32x4*)(pr + 256 * j + 4 * lane); const u32x2 a0 = *(const u32x2*)(y0 + 256 * j + 4 * lane), a1 = *(const u32x2*)(y1 + 256 * j + 4 * lane);
            v[j][0] = p[0] + (bflo(a0.x) + bflo(a1.x)); v[j][1] = p[1] + (bfhi(a0.x) + bfhi(a1.x)); v[j][2] = p[2] + (bflo(a0.y) + bflo(a1.y)); v[j][3] = p[3] + (bfhi(a0.y) + bfhi(a1.y));
            s += (v[j][0] + v[j][1]) + (v[j][2] + v[j][3]); }
        const float mean = wave_sum(s) * (1.f / DM); float q = 0.f;
#pragma unroll
        for (int j = 0; j < 8; ++j) { v[j] = v[j] - mean; q += (v[j][0] * v[j][0] + v[j][1] * v[j][1]) + (v[j][2] * v[j][2] + v[j][3] * v[j][3]); }
        const float rstd = 1.0f / sqrtf(wave_sum(q) * (1.f / DM) + LN_EPS);
#pragma unroll
        for (int j = 0; j < 8; ++j) { const f32x4 gv = *(const f32x4*)(g + 256 * j + 4 * lane), bv = *(const f32x4*)(bb + 256 * j + 4 * lane); const f32x4 y = v[j] * rstd * gv + bv;
            *(f32x4*)(OUT + (size_t)row * DM + 256 * j + 4 * lane) = y; if (write_xb) *(u32x2*)(XB + (size_t)row * DM + 256 * j + 4 * lane) = (u32x2){pk2(y[0], y[1]), pk2(y[2], y[3])}; }
    }
}

constexpr int PH_PER_LAYER = 9, N_PHASES = 1 + NL * PH_PER_LAYER;
__global__ void __launch_bounds__(512, 2) mega(Args args) {
    extern __shared__ __attribute__((aligned(16))) unsigned char lds_raw[];
    Frame F; F.lds = (LAS unsigned char*)lds_raw; F.ws = args.ws; F.ctl = (unsigned*)(args.ws + WS_CTL);
    F.tid = threadIdx.x; F.lane = F.tid & 63; F.wave = __builtin_amdgcn_readfirstlane(F.tid >> 6); F.G = gridDim.x; F.bx = blockIdx.x;
    if (F.tid < 4) ((LAS unsigned*)(F.lds + LDS_BARW))[F.tid] = 0u;
    __syncthreads();
#if LAUNCH_PER_PHASE
#define GRID_BAR() do { } while (0)
#else
    XcdBarrier bar = xcd_barrier_post(F.ctl + CW_BAR, (volatile LAS unsigned*)(F.lds + LDS_BARW));
#define GRID_BAR() xcd_barrier(bar)
#endif
    const int lo = args.ph_lo, hi = args.ph_hi;
#define IN(k) (lo <= (k) && (k) < hi)
#define SEAM(k) do { if (IN(k) && IN((k) + 1)) GRID_BAR(); } while (0)
    bf16_t* XB = (bf16_t*)(F.ws + WS_XB); bf16_t* Ub = (bf16_t*)(F.ws + WS_U); bf16_t* MIXb = (bf16_t*)(F.ws + WS_MIX); float* PRE = (float*)(F.ws + WS_PRE);
    bf16_t* PPb = (bf16_t*)(F.ws + WS_PP); bf16_t* Hb = (bf16_t*)(F.ws + WS_H); bf16_t* Yb = (bf16_t*)(F.ws + WS_Y);
    float* X1F = args.out;

    if (IN(0)) { const Frame f = F.fresh(); phase_prologue(f, args); }
    SEAM(0);
#pragma unroll 1
    for (int l = 0; l < NL; ++l) {
        const int pb = 1 + l * PH_PER_LAYER;
        const float* XRES = (l == 0) ? args.in[0] : (const float*)args.out;
        if (IN(pb + 0)) { pg8::DenseSched S; S.init(XB, (const bf16_t*)(F.ws + WS_WIN) + (size_t)l * DINP * DM, DM, DM, MT, DINP, F.G, F.bx);
            pg8::EpiBf16 E{Ub, DINP}; pg8::gemm_phase(F.lds, DM, S, E); }
        SEAM(pb + 0);
        if (IN(pb + 1)) { { const Frame f = F.fresh(); for (int u = F.bx; u < 256; u += F.G) conv_unit(f, args, l, u); }
            { const Frame f = F.fresh(); for (int u = F.bx; u < 1024; u += F.G) gla_a_unit(f, args, l, u); } __syncthreads(); }
        SEAM(pb + 1);
        if (IN(pb + 2)) { { const Frame f = F.fresh(); gla_scan(f); }
            const Frame f = F.fresh(); LAS float* pl = (LAS float*)F.lds + F.wave * 448;
            for (int u = F.bx; u < 1024; u += F.G) { const int h = u & 7, tb = (u >> 3) * 64;
#pragma unroll 1
                for (int i = 0; i < 8; ++i) attn_simple(f, tb + F.wave + 8 * i, h, pl); } }
        SEAM(pb + 2);
        if (IN(pb + 3)) { const Frame f = F.fresh(); for (int u = F.bx; u < 1024; u += F.G) gla_c_unit(f, args, l, u); __syncthreads(); }
        SEAM(pb + 3);
        if (IN(pb + 4)) { { pg8::DenseSched S; S.init(MIXb, (const bf16_t*)(F.ws + WS_WOUT) + (size_t)l * DM * DM, DM, DM, MT, DM, F.G, F.bx);
              pg8::EpiRes E{PRE, XRES, DM, DN_ALPHA}; pg8::gemm_phase(F.lds, DM, S, E); }
            { pg8::DenseSched S; S.init((const bf16_t*)(F.ws + WS_PB) + (size_t)l * MT * PLE, (const bf16_t*)(F.ws + WS_WPP) + (size_t)l * DM * PLE, PLE, PLE, MT, DM, F.G, F.bx);
              pg8::EpiBf16 E{PPb, DM}; pg8::gemm_phase(F.lds, PLE, S, E); } }
        SEAM(pb + 4);
        if (IN(pb + 5)) { const Frame f = F.fresh(); for (int u = F.bx; u < MT / 8; u += F.G) ln1_unit(f, args, l, u, X1F); __syncthreads(); }
        SEAM(pb + 5);
        if (IN(pb + 6)) { { pg8::DenseSched S; S.init(XB, (const bf16_t*)(F.ws + WS_WPG) + (size_t)l * DM * DM, DM, DM, MT, DM, F.G, F.bx);
              pg8::EpiPle E{PRE, X1F, PPb, args.in[24] + (size_t)l * DM, DM, DN_ALPHA}; pg8::gemm_phase(F.lds, DM, S, E); }
            moe_tables(F, l);
            { pg8::MoeSched<true> S; S.A = XB; S.Bt = (const bf16_t*)(F.ws + WS_WGU) + (size_t)l * NEXP * 512 * DM; S.lda = DM; S.ldb = DM; S.nN = 2; S.G = F.G; S.c = F.bx; S.bexp = (size_t)512 * DM * 2;
              S.toff = (const LAS int*)(F.lds + LDS_TOFF); S.cnt = F.ctl + CW_CNT + l * 32 * 64; S.ltok = (const int*)(F.ws + WS_LTOK);
              pg8::EpiMoe1 E{Hb, (const float*)(F.ws + WS_LGATE), F.ctl + CW_CNT + l * 32 * 64}; pg8::gemm_phase(F.lds, DM, S, E); } }
        SEAM(pb + 6);
        if (IN(pb + 7)) { moe_tables(F, l);
            pg8::MoeSched<false> S; S.A = Hb; S.Bt = (const bf16_t*)(F.ws + WS_WD) + (size_t)l * NEXP * DM * DEXP; S.lda = DEXP; S.ldb = DEXP; S.nN = 8; S.G = F.G; S.c = F.bx; S.bexp = (size_t)DM * DEXP * 2;
            S.toff = (const LAS int*)(F.lds + LDS_TOFF); S.cnt = F.ctl + CW_CNT + l * 32 * 64; S.ltok = (const int*)(F.ws + WS_LTOK);
            pg8::EpiBf16 E{Yb, DM}; pg8::gemm_phase(F.lds, DEXP, S, E); }
        SEAM(pb + 7);
        if (IN(pb + 8)) { const Frame f = F.fresh(); moe_tables(f, l); ln2_rows(f, args, l, args.out, l + 1 < NL); }
        SEAM(pb + 8);
    }
#undef IN
#undef SEAM
}

extern "C" void kernel_launch(void* const* d_in, const int* in_sizes, int n_in, void* d_out, int out_size, void* d_ws, size_t ws_size, hipStream_t stream) {
    static int grid = 0;
    if (grid == 0) {
        if (n_in != 28 || out_size != MT * DM || ws_size < WS_END) { fprintf(stderr, "kernel_launch: unexpected shapes (n_in %d, out %d, ws %zu); nothing launched\n", n_in, out_size, ws_size); grid = -1; return; }
        int dev = 0, cus = 0, per_cu = 0;
        if (hipGetDevice(&dev) != hipSuccess || hipDeviceGetAttribute(&cus, hipDeviceAttributeMultiprocessorCount, dev) != hipSuccess) { grid = -1; return; }
        if (hipFuncSetAttribute((const void*)mega, hipFuncAttributeMaxDynamicSharedMemorySize, LDS_BYTES) != hipSuccess) { fprintf(stderr, "kernel_launch: hipFuncSetAttribute failed\n"); grid = -1; return; }
        if (hipOccupancyMaxActiveBlocksPerMultiprocessor(&per_cu, (const void*)mega, 512, LDS_BYTES) != hipSuccess || per_cu < 1) { fprintf(stderr, "kernel_launch: occupancy query says %d\n", per_cu); }
        (void)hipGetLastError();
        grid = cus;
    }
    if (grid < 0) return;
    (void)hipMemsetAsync((char*)d_ws + WS_CTL, 0, CTL_ZERO_BYTES, stream);
    Args a{};
    for (int i = 0; i < 28; ++i) a.in[i] = (const float*)d_in[i];
    a.out = (float*)d_out; a.ws = (unsigned char*)d_ws;
#if LAUNCH_PER_PHASE
    for (int p = 0; p < N_PHASES; ++p) { a.ph_lo = p; a.ph_hi = p + 1; hipLaunchKernelGGL(mega, dim3(grid), dim3(512), LDS_BYTES, stream, a); }
#else
    a.ph_lo = 0; a.ph_hi = N_PHASES; hipLaunchKernelGGL(mega, dim3(grid), dim3(512), LDS_BYTES, stream, a);
#endif
}
```

```cpp
#include <hip/hip_runtime.h>
#include <cstdio>
#include <cstdint>

#ifndef REP_MASK
#define REP_MASK 0
#endif
#define REPS(k) (1 + ((REP_MASK >> (k)) & 1))
#ifndef LAUNCH_PER_PHASE
#define LAUNCH_PER_PHASE 0
#endif

#define LAS __attribute__((address_space(3)))
#define GAS __attribute__((address_space(1)))
typedef unsigned short bf16_t;
typedef short bf16x8 __attribute__((ext_vector_type(8)));
typedef float f32x4 __attribute__((ext_vector_type(4)));
typedef float f32x2 __attribute__((ext_vector_type(2)));
typedef unsigned u32x4 __attribute__((ext_vector_type(4)));
typedef unsigned u32x2 __attribute__((ext_vector_type(2)));

constexpr int NL = 2, NBATCH = 4, SEQ = 2048, DM = 2048, MT = NBATCH * SEQ;
constexpr int DIN = 5648, DINP = 5888, PLE = 256, NEXP = 32, DEXP = 256;
constexpr int UA_VAL = 0, UA_GATE = 512, UG_Q = 1024, UG_K = 1280, UG_V = 1536, UG_R = 2048, UC_Q = 2560, UC_K = 3072, UC_V = 3584, US_B = 4096, US_C = 4608, US_H = 5120, UG_LOW = 5632;
constexpr float DN_ALPHA = 1.41421356237309515f, LN_EPS = 1e-5f, RMS_EPS = 1e-6f;
constexpr int MAXSLOT = 24576;

constexpr size_t MiB = 1u << 20;
constexpr size_t WS_CTL = 0, CTL_ZERO_BYTES = 1 * MiB;
constexpr size_t WS_BTAB = 1 * MiB;
constexpr size_t WS_WRT = 1 * MiB + 64 * 1024;
constexpr size_t WS_LTOK = 2 * MiB;
constexpr size_t WS_LGATE = 3 * MiB;
constexpr size_t WS_TINFO = 4 * MiB;
constexpr size_t WS_WIN = 8 * MiB;
constexpr size_t WS_WOUT = 54 * MiB;
constexpr size_t WS_WGU = 70 * MiB;
constexpr size_t WS_WD = 198 * MiB;
constexpr size_t WS_WPG = 262 * MiB;
constexpr size_t WS_WPP = 278 * MiB;
constexpr size_t WS_XB = 280 * MiB;
constexpr size_t WS_PB = 312 * MiB;
constexpr size_t WS_U = 320 * MiB;
constexpr size_t WS_Y = 320 * MiB;
constexpr size_t WS_MIX = 416 * MiB;
constexpr size_t WS_PRE = 448 * MiB;
constexpr size_t WS_GU = 448 * MiB;
constexpr size_t WS_GO = 480 * MiB;
constexpr size_t WS_GQ = 496 * MiB;
constexpr size_t WS_GD = 504 * MiB;
constexpr size_t WS_PP = 512 * MiB;
constexpr size_t WS_AO = 512 * MiB;
constexpr size_t WS_ALSE = 536 * MiB;
constexpr size_t WS_H = 544 * MiB;
constexpr size_t WS_END = 556 * MiB;
static_assert(WS_U + (size_t)MT * DINP * 2 <= WS_MIX && WS_Y + (size_t)MAXSLOT * 2048 * 2 <= WS_MIX + 32 * MiB, "ws map");
constexpr int CW_BAR = 4096;
constexpr int CW_CNT = 16384;

constexpr int LDS_STAGE = 131072;
constexpr int LDS_TOFF = LDS_STAGE;
constexpr int LDS_BARW = LDS_STAGE + 512;
constexpr int LDS_BYTES = LDS_STAGE + 1024;

__device__ __forceinline__ float bf2f(unsigned b) { return __uint_as_float(b << 16); }
__device__ __forceinline__ unsigned f2bf(float f) { unsigned u = __float_as_uint(f); return (u + 0x7fffu + ((u >> 16) & 1u)) >> 16; }
__device__ __forceinline__ unsigned pk2(float lo, float hi) { return f2bf(lo) | (f2bf(hi) << 16); }
__device__ __forceinline__ float bflo(unsigned w) { return __uint_as_float(w << 16); }
__device__ __forceinline__ float bfhi(unsigned w) { return __uint_as_float(w & 0xffff0000u); }
__device__ __forceinline__ float wave_sum(float v) {
#pragma unroll
    for (int o = 1; o < 64; o <<= 1) v += __shfl_xor(v, o);
    return v;
}
__device__ __forceinline__ float wave_max(float v) {
#pragma unroll
    for (int o = 1; o < 64; o <<= 1) v = fmaxf(v, __shfl_xor(v, o));
    return v;
}
__device__ __forceinline__ float sigmoidf_(float x) { return 1.0f / (1.0f + __expf(-x)); }
__device__ __forceinline__ float siluf_(float x) { return x / (1.0f + __expf(-x)); }
#define LDS_WAIT() asm volatile("s_waitcnt lgkmcnt(0)" ::: "memory")

namespace pg8 {
constexpr int BM = 256, BK = 64, HALF = 128, HTB = HALF * BK * 2, STAGE_BYTES = 8 * HTB, NXCD = 8, WGM = 8;
__host__ __device__ __forceinline__ int lds_byte(int r, int c) { const int st = (r >> 4) * 2 + (c >> 5), rr = r & 15, cc = c & 31, ob = rr * 64 + cc * 2; return st * 1024 + (ob ^ (((ob >> 9) & 1) << 5)); }
__host__ __device__ __forceinline__ void stage_rc(int b, int& R, int& C) { const int st = b / 1024, sb = b % 1024, swz = sb ^ (((sb >> 9) & 1) << 5); R = (st >> 1) * 16 + swz / 64; C = (st & 1) * 32 + (swz % 64) / 2; }
__host__ __device__ __forceinline__ int perm32(int rho) { const int n = rho >> 4, i = rho & 15; return 8 * (i >> 2) + 4 * n + (i & 3); }

struct Unit { int pm, pn, e, r; };

struct DenseSched {
    static constexpr bool GATHER = false;
    const bf16_t* A; const bf16_t* Bt; int lda, ldb, nM, nN, nwg, G, c;
    __device__ void init(const bf16_t* A_, const bf16_t* Bt_, int lda_, int ldb_, int M, int N, int G_, int c_) { A = A_; Bt = Bt_; lda = lda_; ldb = ldb_; nM = M / BM; nN = N / BM; nwg = nM * nN; G = G_; c = c_; }
    __device__ __forceinline__ bool next(int i, Unit& u) const {
        const long L = (long)i * G + c; if (L >= nwg) return false;
        int wgid = (int)L; { const int q = nwg / NXCD, r = nwg % NXCD, xcd = wgid % NXCD, off = wgid / NXCD; wgid = (xcd < r ? xcd * (q + 1) : r * (q + 1) + (xcd - r) * q) + off; }
        const int nig = WGM * nN, gid = wgid / nig, fm = gid * WGM, gsz = (nM - fm) < WGM ? (nM - fm) : WGM;
        u.pm = fm + ((wgid % nig) % gsz); u.pn = (wgid % nig) / gsz; u.e = 0; u.r = 0; return true;
    }
    __device__ __forceinline__ const char* a_base(const Unit& u) const { return (const char*)A + (size_t)u.pm * BM * lda * 2; }
    __device__ __forceinline__ const char* b_base(const Unit& u) const { return (const char*)Bt + (size_t)u.pn * BM * ldb * 2; }
    __device__ __forceinline__ void a_offs(const Unit&, const int (&R)[2], const int (&C)[2], unsigned (&vo)[2][2]) const { }
};
template <bool GATHER_> struct MoeSched {
    static constexpr bool GATHER = GATHER_;
    const bf16_t* A; const bf16_t* Bt; int lda, ldb, nN, G, c; size_t bexp;
    const LAS int* toff; const unsigned* cnt; const int* ltok;
    __device__ __forceinline__ bool next(int i, Unit& u) const {
        const int L = i * G + c; const int total = __builtin_amdgcn_readfirstlane(toff[32]) * nN; if (L >= total) return false;
        const int j = L / nN; u.pn = L - j * nN; int e = 0;
#pragma unroll 1
        for (int k = 1; k < 32; ++k) e = (__builtin_amdgcn_readfirstlane(toff[k]) <= j) ? k : e;
        u.e = e; u.r = j - __builtin_amdgcn_readfirstlane(toff[e]); u.pm = j; return true;
    }
    __device__ __forceinline__ const char* a_base(const Unit& u) const { return GATHER ? (const char*)A : (const char*)A + (size_t)u.pm * BM * lda * 2; }
    __device__ __forceinline__ const char* b_base(const Unit& u) const { return (const char*)Bt + (size_t)u.e * bexp + (size_t)u.pn * BM * ldb * 2; }
    __device__ __forceinline__ void a_offs(const Unit& u, const int (&R)[2], const int (&C)[2], unsigned (&vo)[2][2]) const {
        if constexpr (GATHER) {
        const int n = __builtin_amdgcn_readfirstlane((int)cnt[u.e * 64]);
#pragma unroll
        for (int h = 0; h < 2; ++h)
#pragma unroll
            for (int i = 0; i < 2; ++i) {
                const int sr = u.r * BM + h * HALF + R[i]; const int row = (sr < n) ? ltok[u.e * MT + sr] : 0;
                vo[h][i] = (unsigned)(row * lda + C[i]) * 2u;
            }
        }
    }
};

__device__ __forceinline__ unsigned cvt_pk_bf16(float lo, float hi) { unsigned r; asm volatile("v_cvt_pk_bf16_f32 %0, %1, %2" : "=v"(r) : "v"(lo), "v"(hi)); return r; }

struct EpiBf16 {
    static constexpr bool PERM = true;
    bf16_t* O; int ldc;
    __device__ __forceinline__ void operator()(const f32x4 (&acc)[2][2][4][2], const Unit& u, int wr, int wc, int fr, int fq) const {
        const int row0 = u.pm * BM + wr * 64 + fr, col0 = u.pn * BM + wc * 32 + 8 * fq;
#pragma unroll
        for (int ai = 0; ai < 2; ++ai)
#pragma unroll
            for (int m = 0; m < 4; ++m) { bf16_t* rowp = O + (size_t)(row0 + ai * HALF + m * 16) * ldc + col0;
#pragma unroll
                for (int bj = 0; bj < 2; ++bj) { const f32x4 v0 = acc[ai][bj][m][0], v1 = acc[ai][bj][m][1];
                    u32x4 w; w.x = cvt_pk_bf16(v0[0], v0[1]); w.y = cvt_pk_bf16(v0[2], v0[3]); w.z = cvt_pk_bf16(v1[0], v1[1]); w.w = cvt_pk_bf16(v1[2], v1[3]);
                    *(u32x4*)(rowp + bj * HALF) = w; } }
    }
};
struct EpiRes {
    static constexpr bool PERM = false;
    float* C; const float* res; int ldc; float alpha;
    __device__ __forceinline__ void operator()(const f32x4 (&acc)[2][2][4][2], const Unit& u, int wr, int wc, int fr, int fq) const {
        const int row0 = u.pm * BM + wr * 64 + fr, col0 = u.pn * BM + wc * 32 + 4 * fq;
#pragma unroll
        for (int ai = 0; ai < 2; ++ai)
#pragma unroll
            for (int m = 0; m < 4; ++m) { const size_t off = (size_t)(row0 + ai * HALF + m * 16) * ldc + col0;
#pragma unroll
                for (int bj = 0; bj < 2; ++bj)
#pragma unroll
                    for (int n = 0; n < 2; ++n) { const f32x4 rv = *(const f32x4*)(res + off + bj * HALF + n * 16); *(f32x4*)(C + off + bj * HALF + n * 16) = rv * alpha + acc[ai][bj][m][n]; }
                asm volatile("" ::: "memory"); }
    }
};
struct EpiPle {
    static constexpr bool PERM = false;
    float* C; const float* x1; const bf16_t* pp; const float* bias; int ldc; float alpha;
    __device__ __forceinline__ void operator()(const f32x4 (&acc)[2][2][4][2], const Unit& u, int wr, int wc, int fr, int fq) const {
        const int row0 = u.pm * BM + wr * 64 + fr, col0 = u.pn * BM + wc * 32 + 4 * fq;
        f32x4 bv[2][2];
#pragma unroll
        for (int bj = 0; bj < 2; ++bj)
#pragma unroll
            for (int n = 0; n < 2; ++n) bv[bj][n] = *(const f32x4*)(bias + col0 + bj * HALF + n * 16);
#pragma unroll
        for (int ai = 0; ai < 2; ++ai)
#pragma unroll
            for (int m = 0; m < 4; ++m) { const size_t off = (size_t)(row0 + ai * HALF + m * 16) * ldc + col0;
#pragma unroll
                for (int bj = 0; bj < 2; ++bj)
#pragma unroll
                    for (int n = 0; n < 2; ++n) { const size_t o = off + bj * HALF + n * 16; const f32x4 xv = *(const f32x4*)(x1 + o); const u32x2 pw = *(const u32x2*)(pp + o);
                        const f32x4 a = acc[ai][bj][m][n] + bv[bj][n]; f32x4 r;
                        r[0] = xv[0] * alpha + sigmoidf_(a[0]) * bflo(pw.x); r[1] = xv[1] * alpha + sigmoidf_(a[1]) * bfhi(pw.x);
                        r[2] = xv[2] * alpha + sigmoidf_(a[2]) * bflo(pw.y); r[3] = xv[3] * alpha + sigmoidf_(a[3]) * bfhi(pw.y);
                        *(f32x4*)(C + o) = r; }
                asm volatile("" ::: "memory"); }
    }
};
struct EpiMoe1 {
    static constexpr bool PERM = true;
    bf16_t* H; const float* lgate; const unsigned* cnt;
    __device__ __forceinline__ void operator()(const f32x4 (&acc)[2][2][4][2], const Unit& u, int wr, int wc, int fr, int fq) const {
        const int n_e = __builtin_amdgcn_readfirstlane((int)cnt[u.e * 64]);
        const int col0 = u.pn * HALF + wc * 32 + 8 * fq;
#pragma unroll
        for (int ai = 0; ai < 2; ++ai)
#pragma unroll
            for (int m = 0; m < 4; ++m) { const int rt = ai * HALF + wr * 64 + m * 16 + fr; const int sr = u.r * BM + rt;
                const float gw = (sr < n_e) ? lgate[u.e * MT + sr] : 0.f;
                const f32x4 g0 = acc[ai][0][m][0], g1 = acc[ai][0][m][1], u0 = acc[ai][1][m][0], u1 = acc[ai][1][m][1];
                float o[8];
#pragma unroll
                for (int j = 0; j < 4; ++j) { o[j] = siluf_(g0[j]) * u0[j] * gw; o[4 + j] = siluf_(g1[j]) * u1[j] * gw; }
                u32x4 w; w.x = cvt_pk_bf16(o[0], o[1]); w.y = cvt_pk_bf16(o[2], o[3]); w.z = cvt_pk_bf16(o[4], o[5]); w.w = cvt_pk_bf16(o[6], o[7]);
                *(u32x4*)(H + (size_t)(u.pm * BM + rt) * DEXP + col0) = w; }
    }
};

template <class Epi, class Sched>
__device__ __forceinline__ void gemm_phase(LAS unsigned char* lds, const int K, const Sched& S, const Epi& E) {
    constexpr bool GA = Sched::GATHER;
    int tid = threadIdx.x; asm volatile("" : "+v"(tid));
    const int wid = __builtin_amdgcn_readfirstlane(tid >> 6), lane = tid & 63, wr = wid >> 2, wc = wid & 3, fr = lane & 15, fq = lane >> 4;
    const int nt = K / BK, ldb = S.ldb, lda = S.lda;
    int Rr[2], Cc[2]; unsigned voffB[2], voffA[2];
#pragma unroll
    for (int i = 0; i < 2; ++i) { int R, C; stage_rc(tid * 16 + i * 8192, R, C); Rr[i] = R; Cc[i] = C; const int Rb = Epi::PERM ? ((R & ~31) + perm32(R & 31)) : R; voffB[i] = (unsigned)(Rb * ldb + C) * 2u; voffA[i] = (unsigned)(R * lda + C) * 2u; }
    const size_t kstep = (size_t)(BK * 2);
    const size_t hstep = (size_t)HALF * ldb * 2;
    const size_t ahstep = GA ? 0 : (size_t)HALF * lda * 2;
    const unsigned ldsw = (unsigned)wid * 1024u;
    const int aoff = lds_byte(wr * 64 + fr, fq * 8), boff = lds_byte(wc * 32 + fr, fq * 8);
#define PG8_SA(b, h) (((b) * 2 + (h)) * HTB)
#define PG8_SB(b, h) ((4 + (b) * 2 + (h)) * HTB)
#define PG8_STAGE(bufoff, gbase, voff) do { _Pragma("unroll") for (int _i = 0; _i < 2; ++_i) \
        __builtin_amdgcn_global_load_lds((const unsigned*)((const char*)(gbase) + (voff)[_i]), (LAS unsigned*)(lds + (bufoff) + ldsw + _i * 8192), 16, 0, 0); } while (0)
#define PG8_STAGE_A(bufoff, gbase, h) do { if constexpr (GA) PG8_STAGE(bufoff, gbase, voA[h]); else PG8_STAGE(bufoff, (gbase) + (h) * ahstep, voffA); } while (0)
#define PG8_STAGE_A2(bufoff, gbase, h) do { if constexpr (GA) { unsigned _v[2] = {last ? voN[h][0] : voA[h][0], last ? voN[h][1] : voA[h][1]}; PG8_STAGE(bufoff, gbase, _v); } else PG8_STAGE(bufoff, (gbase) + (h) * ahstep, voffA); } while (0)
#define PG8_LDA(dst, b, h) do { _Pragma("unroll") for (int m = 0; m < 4; ++m) _Pragma("unroll") for (int k = 0; k < 2; ++k) dst[m][k] = *(const LAS bf16x8*)(lds + PG8_SA(b, h) + aoff + m * 2048 + k * 1024); } while (0)
#define PG8_LDB(dst, b, h) do { _Pragma("unroll") for (int n = 0; n < 2; ++n) _Pragma("unroll") for (int k = 0; k < 2; ++k) dst[n][k] = *(const LAS bf16x8*)(lds + PG8_SB(b, h) + boff + n * 2048 + k * 1024); } while (0)
#define PG8_MMA(ai, bj, At, Bt) do { __builtin_amdgcn_s_setprio(1); _Pragma("unroll") for (int m = 0; m < 4; ++m) _Pragma("unroll") for (int n = 0; n < 2; ++n) _Pragma("unroll") for (int k = 0; k < 2; ++k) \
        acc[ai][bj][m][n] = __builtin_amdgcn_mfma_f32_16x16x32_bf16(Bt[n][k], At[m][k], acc[ai][bj][m][n], 0, 0, 0); __builtin_amdgcn_s_setprio(0); } while (0)
#define PG8_WAIT_V(n) asm volatile("s_waitcnt vmcnt(" #n ")" ::: "memory")
#define PG8_WAIT_L(n) asm volatile("s_waitcnt lgkmcnt(" #n ")" ::: "memory")
#define PG8_BAR __builtin_amdgcn_s_barrier()
#define PG8_SCHED __builtin_amdgcn_sched_barrier(0)
    Unit cur, nxt; int ui = 0;
    if (!S.next(0, cur)) return;
    f32x4 acc[2][2][4][2];
#pragma unroll
    for (int a = 0; a < 2; ++a)
#pragma unroll
        for (int b = 0; b < 2; ++b)
#pragma unroll
            for (int m = 0; m < 4; ++m)
#pragma unroll
                for (int n = 0; n < 2; ++n) acc[a][b][m][n] = (f32x4){0.f, 0.f, 0.f, 0.f};
    bf16x8 At[4][2], B0[2][2], B1[2][2];
    const char* cA = S.a_base(cur); const char* cB = S.b_base(cur);
    unsigned voA[2][2], voN[2][2];
    if constexpr (GA) S.a_offs(cur, Rr, Cc, voA);
    PG8_STAGE(PG8_SB(0, 0), cB, voffB); PG8_STAGE(PG8_SB(0, 1), cB + hstep, voffB); PG8_STAGE_A(PG8_SA(0, 0), cA, 0); PG8_STAGE_A(PG8_SA(0, 1), cA, 1);
    if (wr == 1) PG8_BAR;
    PG8_WAIT_V(2); PG8_BAR;
    PG8_STAGE(PG8_SB(1, 0), cB + kstep, voffB); PG8_STAGE_A(PG8_SA(1, 0), cA + kstep, 0); PG8_STAGE(PG8_SB(1, 1), cB + hstep + kstep, voffB);
    PG8_WAIT_V(6); PG8_BAR;
    for (;;) {
        const bool has_next = S.next(ui + 1, nxt);
        const char* nA = has_next ? S.a_base(nxt) : cA; const char* nB = has_next ? S.b_base(nxt) : cB;
        if constexpr (GA) {
            if (has_next) S.a_offs(nxt, Rr, Cc, voN);
            else {
#pragma unroll
                for (int h = 0; h < 2; ++h)
#pragma unroll
                    for (int i = 0; i < 2; ++i) voN[h][i] = voA[h][i]; } }
#pragma unroll 1
        for (int t = 0; t < nt; t += 2) {
            const bool last = (t == nt - 2);
            const char* a1 = cA + (size_t)(t + 1) * kstep;
            const char* a2 = last ? nA : cA + (size_t)(t + 2) * kstep; const char* b2 = last ? nB : cB + (size_t)(t + 2) * kstep;
            const char* a3 = a2 + kstep; const char* b3 = b2 + kstep;
            PG8_LDB(B0, 0, 0); PG8_LDB(B1, 0, 1); PG8_SCHED; PG8_LDA(At, 0, 0); PG8_STAGE_A(PG8_SA(1, 1), a1, 1);
            PG8_WAIT_V(8); PG8_WAIT_L(0); PG8_BAR; PG8_MMA(0, 0, At, B0); PG8_MMA(0, 1, At, B1); PG8_BAR; PG8_SCHED;
            PG8_LDA(At, 0, 1); PG8_STAGE(PG8_SB(0, 0), b2, voffB); PG8_STAGE(PG8_SB(0, 1), b2 + hstep, voffB); PG8_STAGE_A2(PG8_SA(0, 0), a2, 0);
            PG8_WAIT_V(8); PG8_WAIT_L(0); PG8_BAR; PG8_MMA(1, 0, At, B0); PG8_MMA(1, 1, At, B1); PG8_BAR; PG8_SCHED;
            PG8_LDB(B0, 1, 0); PG8_LDB(B1, 1, 1); PG8_SCHED; PG8_LDA(At, 1, 0); PG8_STAGE_A2(PG8_SA(0, 1), a2, 1);
            PG8_WAIT_V(8); PG8_WAIT_L(0); PG8_BAR; PG8_MMA(0, 0, At, B0); PG8_MMA(0, 1, At, B1); PG8_BAR; PG8_SCHED;
            PG8_LDA(At, 1, 1); PG8_STAGE(PG8_SB(1, 0), b3, voffB); PG8_STAGE(PG8_SB(1, 1), b3 + hstep, voffB); PG8_STAGE_A2(PG8_SA(1, 0), a3, 0);
            PG8_WAIT_V(8); PG8_WAIT_L(0); PG8_BAR; PG8_MMA(1, 0, At, B0); PG8_MMA(1, 1, At, B1); PG8_BAR; PG8_SCHED;
        }
        if (wr == 0) PG8_BAR;
        E(acc, cur, wr, wc, fr, fq);
        if (!has_next) break;
#pragma unroll
        for (int a = 0; a < 2; ++a)
#pragma unroll
            for (int b = 0; b < 2; ++b)
#pragma unroll
                for (int m = 0; m < 4; ++m)
#pragma unroll
                    for (int n = 0; n < 2; ++n) acc[a][b][m][n] = (f32x4){0.f, 0.f, 0.f, 0.f};
        cur = nxt; cA = nA; cB = nB; ++ui;
        if constexpr (GA) {
#pragma unroll
            for (int h = 0; h < 2; ++h)
#pragma unroll
                for (int i = 0; i < 2; ++i) voA[h][i] = voN[h][i]; }
        if (wr == 1) PG8_BAR;
    }
    PG8_WAIT_V(0);
    PG8_BAR;
#undef PG8_SA
#undef PG8_SB
#undef PG8_STAGE
#undef PG8_STAGE_A
#undef PG8_STAGE_A2
#undef PG8_LDA
#undef PG8_LDB
#undef PG8_MMA
#undef PG8_WAIT_V
#undef PG8_WAIT_L
#undef PG8_BAR
#undef PG8_SCHED
}
}

#define XB_TMO      128
#define XB_XCNT(j)  (256  + 64 * (j))
#define XB_XSUB(j)  (1280 + 64 * (j))
#define XB_XGEN(j)  (2304 + 64 * (j))
#define XB_TOP      3328
#define XB_TOPGEN   3392
#define XCD_BAR_WORDS 3456
#define XB_SPIN_CAP (1u << 18)
__device__ __forceinline__ unsigned xb_ld(unsigned* p)              { return __hip_atomic_load(p, __ATOMIC_RELAXED, __HIP_MEMORY_SCOPE_AGENT); }
__device__ __forceinline__ unsigned xb_add(unsigned* p, unsigned v) { return __hip_atomic_fetch_add(p, v, __ATOMIC_RELAXED, __HIP_MEMORY_SCOPE_AGENT); }
__device__ __forceinline__ unsigned xb_xcc_id() { return (unsigned)__builtin_amdgcn_s_getreg((3 << 11) | 20) & 0xFu; }
#define XB_SPIN(cond, bar) do { unsigned _sp = 0; while (cond) { __builtin_amdgcn_s_sleep(1); \
    if ((++_sp & 255u) == 0u) { if (xb_ld(&(bar)[XB_TMO])) break; if (_sp > XB_SPIN_CAP) { atomicAdd(&(bar)[XB_TMO], 1u); break; } } } } while (0)
struct XcdBarrier { unsigned* bar; unsigned x; volatile LAS unsigned* st; };
__device__ __forceinline__ XcdBarrier xcd_barrier_post(unsigned* bar, volatile LAS unsigned* st) {
    XcdBarrier b; b.bar = bar; b.x = xb_xcc_id(); b.st = st;
    if (threadIdx.x == 0) (void)xb_add(&bar[XB_XCNT(b.x)], 1u);
    return b;
}
__device__ __forceinline__ void xcd_barrier_complete(unsigned* bar, unsigned x, unsigned& nloc, unsigned& nx) {
    const unsigned G = gridDim.x * gridDim.y * gridDim.z;
    unsigned sum, cnt, mine, sp = 0u;
    for (;;) {
        sum = 0u; cnt = 0u; mine = 0u;
#pragma unroll
        for (unsigned j = 0; j < 16; ++j) { const unsigned c = xb_ld(&bar[XB_XCNT(j)]); sum += c; cnt += (c > 0u) ? 1u : 0u; mine = (j == x) ? c : mine; }
        if (sum == G) break;
        __builtin_amdgcn_s_sleep(1);
        if ((++sp & 255u) == 0u) { if (xb_ld(&bar[XB_TMO])) break; if (sp > XB_SPIN_CAP) { atomicAdd(&bar[XB_TMO], 1u); break; } }
    }
    nloc = mine > 0u ? mine : 1u; nx = cnt > 0u ? cnt : 1u;
}
__device__ __forceinline__ void xcd_barrier(const XcdBarrier& b) {
    asm volatile("s_waitcnt vmcnt(0)" ::: "memory");
    __syncthreads();
    if (threadIdx.x == 0) {
        unsigned* bar = b.bar;
        __builtin_amdgcn_s_waitcnt(0);
        unsigned nloc = b.st[0], nx = b.st[1];
        if (nloc == 0u) { xcd_barrier_complete(bar, b.x, nloc, nx); b.st[0] = nloc; b.st[1] = nx; }
        const unsigned old = xb_add(&bar[XB_XSUB(b.x)], 1u);
        const unsigned gen = old / nloc;
        if (old + 1u == (gen + 1u) * nloc) {
            __builtin_amdgcn_fence(__ATOMIC_RELEASE, "agent");
            asm volatile("s_waitcnt vmcnt(0)" ::: "memory");
            const unsigned og = xb_add(&bar[XB_TOP], 1u);
            const unsigned tg = og / nx;
            if (og + 1u == (tg + 1u) * nx) xb_add(&bar[XB_TOPGEN], 1u);
            else XB_SPIN(xb_ld(&bar[XB_TOPGEN]) == tg, bar);
            __builtin_amdgcn_fence(__ATOMIC_ACQUIRE, "agent");
            xb_add(&bar[XB_XGEN(b.x)], 1u);
            asm volatile("s_waitcnt vmcnt(0)" ::: "memory");
        } else {
            XB_SPIN(xb_ld(&bar[XB_XGEN(b.x)]) == gen, bar);
            __builtin_amdgcn_fence(__ATOMIC_ACQUIRE, "agent");
            asm volatile("s_waitcnt vmcnt(0)" ::: "memory");
        }
    }
    __syncthreads();
}

struct Args { const float* in[28]; float* out; unsigned char* ws; int ph_lo, ph_hi; };

struct Frame {
    LAS unsigned char* lds; unsigned char* ws; unsigned* ctl;
    int tid, lane, wave, G, bx;
    __device__ __forceinline__ Frame fresh() const { Frame f = *this; int t = threadIdx.x; asm volatile("" : "+v"(t)); f.tid = t; f.lane = t & 63; return f; }
};

__device__ __forceinline__ int dmap(int type, int n) {
    if (type == 1) return n < 2048 ? n : (n < 2064 ? n - 2048 + UG_LOW : n - 16);
    if (type == 2) return (n >> 7) * 256 + (n & 127);
    if (type == 3) return (n >> 7) * 256 + 128 + (n & 127);
    return n;
}
__device__ __forceinline__ void transpose_item(const float* W, int ldw, int ncols, int k0, int n0, const float* kscale, bf16_t* WT, int ldt, int type, LAS float* scr, int lane) {
    const int nn = n0 + (lane & 31); const bool okc = nn < ncols;
#pragma unroll 8
    for (int i = 0; i < 32; ++i) { const int kk = 2 * i + (lane >> 5); float v = okc ? W[(size_t)(k0 + kk) * ldw + nn] : 0.f; if (kscale) v *= kscale[k0 + kk]; scr[kk * 33 + (lane & 31)] = v; }
    LDS_WAIT(); asm volatile("" ::: "memory");
    const int c = lane & 7;
#pragma unroll
    for (int j = 0; j < 4; ++j) { const int n = (lane >> 3) + 8 * j; const LAS float* s = scr + (8 * c) * 33 + n;
        u32x4 o; o.x = pk2(s[0 * 33], s[1 * 33]); o.y = pk2(s[2 * 33], s[3 * 33]); o.z = pk2(s[4 * 33], s[5 * 33]); o.w = pk2(s[6 * 33], s[7 * 33]);
        if (n0 + n < ncols) *(u32x4*)(WT + (size_t)dmap(type, n0 + n) * ldt + k0 + 8 * c) = o; }
    LDS_WAIT(); asm volatile("" ::: "memory");
}
__device__ __forceinline__ int t5_bucket(int d) {
    if (d < 16) return d;
    const float v = logf((float)d / 16.0f) / 4.852030263919617f * 16.0f;
    int b = 16 + (int)v; return b < 31 ? b : 31;
}
__device__ __forceinline__ void phase_prologue(const Frame& F, const Args& a) {
    LAS float* scr = (LAS float*)(F.lds + F.wave * 16384);
    const int gw = F.bx * 8 + F.wave, NGW = F.G * 8;
    constexpr int I_IN = 32 * 177, I_OUT = 32 * 64, I_G = 32 * 256, I_U = 32 * 256, I_D = 32 * 256, I_PG = 32 * 64, I_PP = 4 * 64, I_L = I_IN + I_OUT + I_G + I_U + I_D + I_PG + I_PP;
    bf16_t* WIN = (bf16_t*)(F.ws + WS_WIN); bf16_t* WOUT = (bf16_t*)(F.ws + WS_WOUT); bf16_t* WGU = (bf16_t*)(F.ws + WS_WGU); bf16_t* WD = (bf16_t*)(F.ws + WS_WD);
    bf16_t* WPG = (bf16_t*)(F.ws + WS_WPG); bf16_t* WPP = (bf16_t*)(F.ws + WS_WPP);
    for (int it = gw; it < NL * I_L; it += NGW) {
        const int l = it / I_L; int r = it - l * I_L;
        if (r < I_IN) { const int kb = r / 177, nb = r - kb * 177; transpose_item(a.in[2] + (size_t)l * DM * DIN, DIN, DIN, kb * 64, nb * 32, nullptr, WIN + (size_t)l * DINP * DM, DM, 1, scr, F.lane); continue; } r -= I_IN;
        if (r < I_OUT) { const int kb = r >> 6, nb = r & 63; transpose_item(a.in[12] + (size_t)l * DM * DM, DM, DM, kb * 64, nb * 32, a.in[11] + l * DM, WOUT + (size_t)l * DM * DM, DM, 0, scr, F.lane); continue; } r -= I_OUT;
        if (r < I_G) { const int e = r >> 8, q = r & 255, kb = q >> 3, nb = q & 7; transpose_item(a.in[20] + (size_t)(l * NEXP + e) * DM * DEXP, DEXP, DEXP, kb * 64, nb * 32, nullptr, WGU + (size_t)(l * NEXP + e) * 512 * DM, DM, 2, scr, F.lane); continue; } r -= I_G;
        if (r < I_U) { const int e = r >> 8, q = r & 255, kb = q >> 3, nb = q & 7; transpose_item(a.in[21] + (size_t)(l * NEXP + e) * DM * DEXP, DEXP, DEXP, kb * 64, nb * 32, nullptr, WGU + (size_t)(l * NEXP + e) * 512 * DM, DM, 3, scr, F.lane); continue; } r -= I_U;
        if (r < I_D) { const int e = r >> 8, q = r & 255, kb = q >> 6, nb = q & 63; transpose_item(a.in[22] + (size_t)(l * NEXP + e) * DEXP * DM, DM, DM, kb * 64, nb * 32, nullptr, WD + (size_t)(l * NEXP + e) * DM * DEXP, DEXP, 0, scr, F.lane); continue; } r -= I_D;
        if (r < I_PG) { const int kb = r >> 6, nb = r & 63; transpose_item(a.in[23] + (size_t)l * DM * DM, DM, DM, kb * 64, nb * 32, nullptr, WPG + (size_t)l * DM * DM, DM, 0, scr, F.lane); continue; } r -= I_PG;
        { const int kb = r >> 6, nb = r & 63; transpose_item(a.in[25] + (size_t)l * PLE * DM, DM, DM, kb * 64, nb * 32, nullptr, WPP + (size_t)l * DM * PLE, PLE, 0, scr, F.lane); }
    }
    const size_t gt = (size_t)F.bx * 512 + F.tid, NT = (size_t)F.G * 512;
    for (size_t i = gt; i < (size_t)NL * (DINP - DIN) * DM / 8; i += NT) { const size_t l = i / ((DINP - DIN) * DM / 8), r = i % ((DINP - DIN) * DM / 8);
        *(u32x4*)(WIN + (l * DINP + DIN) * DM + r * 8) = (u32x4){0u, 0u, 0u, 0u}; }
    { const float* x = a.in[0]; bf16_t* XB = (bf16_t*)(F.ws + WS_XB);
      for (size_t i = gt; i < (size_t)MT * DM / 8; i += NT) { const f32x4 v0 = *(const f32x4*)(x + i * 8), v1 = *(const f32x4*)(x + i * 8 + 4);
          *(u32x4*)(XB + i * 8) = (u32x4){pk2(v0[0], v0[1]), pk2(v0[2], v0[3]), pk2(v1[0], v1[1]), pk2(v1[2], v1[3])}; } }
    { const float* p = a.in[1]; bf16_t* PB = (bf16_t*)(F.ws + WS_PB);
      for (size_t i = gt; i < (size_t)NL * MT * PLE / 8; i += NT) { const f32x4 v0 = *(const f32x4*)(p + i * 8), v1 = *(const f32x4*)(p + i * 8 + 4);
          *(u32x4*)(PB + i * 8) = (u32x4){pk2(v0[0], v0[1]), pk2(v0[2], v0[3]), pk2(v1[0], v1[1]), pk2(v1[2], v1[3])}; } }
    { float* bt = (float*)(F.ws + WS_BTAB); const float* rb = a.in[13];
      for (size_t i = gt; i < 3 * 129 * 8; i += NT) { const int h = (int)(i & 7), j = (int)((i >> 3) % 129), br = (int)((i >> 3) / 129); const int dil = br == 0 ? 1 : (br == 1 ? 4 : 16);
          bt[i] = rb[t5_bucket(j * dil) * 8 + h]; } }
    { float* wrt = (float*)(F.ws + WS_WRT);
      for (size_t i = gt; i < (size_t)NL * 36 * DM; i += NT) { const int c = (int)(i % DM), col = (int)((i / DM) % 36), l = (int)(i / (36 * DM));
          wrt[i] = col < 4 ? a.in[16][((size_t)l * DM + c) * 4 + col] : a.in[18][((size_t)l * DM + c) * 32 + (col - 4)]; } }
}

__device__ __forceinline__ void conv_unit(const Frame& F, const Args& a, int l, int unit) {
    const bf16_t* U = (const bf16_t*)(F.ws + WS_U); bf16_t* MIX = (bf16_t*)(F.ws + WS_MIX);
    LAS float* hb = (LAS float*)F.lds;
    const int t0 = unit * 32, tl0 = t0 & (SEQ - 1), tb = t0 - tl0;
    const int tid = F.tid;
    __syncthreads();
#pragma unroll 1
    for (int i = 0; i < 8; ++i) { const int id = tid + 512 * i; if (id < 62 * 64) { const int row = id >> 6, ch = (id & 63) * 8; const int tl = tl0 - 30 + row;
        float o[8];
        if (tl >= 0) { const bf16_t* up = U + (size_t)(tb + tl) * DINP; const u32x4 av = *(const u32x4*)(up + UA_VAL + ch), gv = *(const u32x4*)(up + UA_GATE + ch);
            const unsigned aw[4] = {av.x, av.y, av.z, av.w}, gw[4] = {gv.x, gv.y, gv.z, gv.w};
#pragma unroll
            for (int j = 0; j < 4; ++j) { o[2 * j] = bflo(aw[j]) * sigmoidf_(bflo(gw[j])); o[2 * j + 1] = bfhi(aw[j]) * sigmoidf_(bfhi(gw[j])); } }
        else {
#pragma unroll
            for (int j = 0; j < 8; ++j) o[j] = 0.f; }
        *(LAS f32x4*)(hb + row * 512 + ch) = (f32x4){o[0], o[1], o[2], o[3]}; *(LAS f32x4*)(hb + row * 512 + ch + 4) = (f32x4){o[4], o[5], o[6], o[7]}; } }
    __syncthreads();
    float yv[32];
    { const int c = tid; const float* w = a.in[3] + (size_t)l * 31 * 512; const float bias = a.in[4][l * 512 + c];
      float wv[31];
#pragma unroll
      for (int j = 0; j < 31; ++j) wv[j] = w[j * 512 + c];
      float hv[62];
#pragma unroll
      for (int r = 0; r < 62; ++r) hv[r] = hb[r * 512 + c];
#pragma unroll
      for (int t = 0; t < 32; ++t) { float s = bias;
#pragma unroll
          for (int j = 0; j < 31; ++j) s += wv[j] * hv[t + j];
          yv[t] = s; } }
    __syncthreads();
#pragma unroll
    for (int t = 0; t < 32; ++t) hb[t * 512 + tid] = yv[t];
    __syncthreads();
    { const float* lg = a.in[5] + l * 512; const float* lb = a.in[6] + l * 512;
#pragma unroll 1
      for (int i = 0; i < 4; ++i) { const int t = F.wave + 8 * i;
          const f32x4 v0 = *(const LAS f32x4*)(hb + t * 512 + 4 * F.lane), v1 = *(const LAS f32x4*)(hb + t * 512 + 256 + 4 * F.lane);
          const float mean = wave_sum((v0[0] + v0[1]) + (v0[2] + v0[3]) + (v1[0] + v1[1]) + (v1[2] + v1[3])) * (1.f / 512.f);
          const f32x4 d0 = v0 - mean, d1 = v1 - mean;
          const float var = wave_sum((d0[0] * d0[0] + d0[1] * d0[1]) + (d0[2] * d0[2] + d0[3] * d0[3]) + (d1[0] * d1[0] + d1[1] * d1[1]) + (d1[2] * d1[2] + d1[3] * d1[3])) * (1.f / 512.f);
          const float rstd = 1.0f / sqrtf(var + LN_EPS);
          const f32x4 g0 = *(const f32x4*)(lg + 4 * F.lane), g1 = *(const f32x4*)(lg + 256 + 4 * F.lane), b0 = *(const f32x4*)(lb + 4 * F.lane), b1 = *(const f32x4*)(lb + 256 + 4 * F.lane);
          float o0[4], o1[4];
#pragma unroll
          for (int j = 0; j < 4; ++j) { o0[j] = siluf_(d0[j] * rstd * g0[j] + b0[j]); o1[j] = siluf_(d1[j] * rstd * g1[j] + b1[j]); }
          bf16_t* mp = MIX + (size_t)(t0 + t) * DM;
          *(u32x2*)(mp + 4 * F.lane) = (u32x2){pk2(o0[0], o0[1]), pk2(o0[2], o0[3])}; *(u32x2*)(mp + 256 + 4 * F.lane) = (u32x2){pk2(o1[0], o1[1]), pk2(o1[2], o1[3])}; } }
    { const int c = tid; const float* w = a.in[10] + (size_t)l * 3 * 512; const float w0 = w[c], w1 = w[512 + c], w2 = w[1024 + c];
      float p2 = 0.f, p1 = 0.f;
      if (tl0 >= 2) { const bf16_t* up = U + (size_t)(t0 - 2) * DINP; p2 = bf2f(up[US_C + c]) * bf2f(up[US_H + c]); }
      if (tl0 >= 1) { const bf16_t* up = U + (size_t)(t0 - 1) * DINP; p1 = bf2f(up[US_C + c]) * bf2f(up[US_H + c]); }
#pragma unroll 4
      for (int t = 0; t < 32; ++t) { const bf16_t* up = U + (size_t)(t0 + t) * DINP; const float p0 = bf2f(up[US_C + c]) * bf2f(up[US_H + c]);
          const float y = bf2f(up[US_B + c]) * (w0 * p2 + w1 * p1 + w2 * p0);
          MIX[(size_t)(t0 + t) * DM + 1536 + c] = (bf16_t)f2bf(y); p2 = p1; p1 = p0; } }
}

__device__ __forceinline__ void gla_a_unit(const Frame& F, const Args& a, int l, int unit) {
    const bf16_t* U = (const bf16_t*)(F.ws + WS_U);
    float* GU = (float*)(F.ws + WS_GU); float* GO = (float*)(F.ws + WS_GO); float* GQ = (float*)(F.ws + WS_GQ); float* GD = (float*)(F.ws + WS_GD);
    const int n = unit & 63, h = (unit >> 6) & 3, b = unit >> 8, bh = b * 4 + h;
    const int t0 = b * SEQ + n * 32, tid = F.tid;
    LAS float* L = (LAS float*)F.lds;
    LAS float* qt = L; LAS float* kr = L + 2048; LAS float* kt = L + 4096; LAS float* kh = L + 6144; LAS float* vv = L + 8192; LAS float* bc = L + 12288; LAS float* gl = L + 14336; LAS float* wg = L + 14848; LAS float* sc = L + 15872;
    const int i = tid >> 4, k4 = (tid & 15) * 4, v8 = (tid & 15) * 8;
    __syncthreads();
    { const bf16_t* up = U + (size_t)(t0 + i) * DINP;
      const u32x2 qw = *(const u32x2*)(up + UG_Q + h * 64 + k4), kw = *(const u32x2*)(up + UG_K + h * 64 + k4); const u32x4 vw = *(const u32x4*)(up + UG_V + h * 128 + v8);
      *(LAS f32x4*)(qt + i * 64 + k4) = (f32x4){bflo(qw.x), bfhi(qw.x), bflo(qw.y), bfhi(qw.y)};
      *(LAS f32x4*)(kr + i * 64 + k4) = (f32x4){bflo(kw.x), bfhi(kw.x), bflo(kw.y), bfhi(kw.y)};
      *(LAS f32x4*)(vv + i * 128 + v8) = (f32x4){bflo(vw.x), bfhi(vw.x), bflo(vw.y), bfhi(vw.y)}; *(LAS f32x4*)(vv + i * 128 + v8 + 4) = (f32x4){bflo(vw.z), bfhi(vw.z), bflo(vw.w), bfhi(vw.w)};
      gl[i * 16 + (tid & 15)] = bf2f(up[UG_LOW + (tid & 15)]);
      const float* w2 = a.in[7] + (size_t)l * 16 * 256;
      wg[tid] = w2[(tid >> 6) * 256 + h * 64 + (tid & 63)]; wg[512 + tid] = w2[(8 + (tid >> 6)) * 256 + h * 64 + (tid & 63)]; }
    __syncthreads();
    { const f32x4 bg = *(const f32x4*)(a.in[8] + l * 256 + h * 64 + k4); f32x4 z = bg;
#pragma unroll
      for (int r = 0; r < 16; ++r) { const float g = gl[i * 16 + r]; const f32x4 w = *(const LAS f32x4*)(wg + r * 64 + k4); z = z + w * g; }
      f32x4 la;
#pragma unroll
      for (int j = 0; j < 4; ++j) la[j] = (fminf(z[j], 0.f) - log1pf(expf(-fabsf(z[j])))) * (1.0f / 16.0f);
      *(LAS f32x4*)(bc + i * 64 + k4) = la; }
    __syncthreads();
    if (tid < 64) { float run = 0.f;
#pragma unroll
        for (int r = 0; r < 32; ++r) { run += bc[r * 64 + tid]; bc[r * 64 + tid] = run; } }
    __syncthreads();
    { const f32x4 bv = *(const LAS f32x4*)(bc + i * 64 + k4), bl = *(const LAS f32x4*)(bc + 31 * 64 + k4), q = *(const LAS f32x4*)(qt + i * 64 + k4), k = *(const LAS f32x4*)(kr + i * 64 + k4);
      f32x4 qo, ko, ho;
#pragma unroll
      for (int j = 0; j < 4; ++j) { qo[j] = q[j] * expf(bv[j]) * 0.125f; ko[j] = k[j] * expf(-bv[j]); ho[j] = k[j] * expf(bl[j] - bv[j]); }
      *(LAS f32x4*)(qt + i * 64 + k4) = qo; *(LAS f32x4*)(kt + i * 64 + k4) = ko; *(LAS f32x4*)(kh + i * 64 + k4) = ho;
      *(f32x4*)(GQ + (size_t)(t0 + i) * 256 + h * 64 + k4) = qo;
      if (i == 31) { f32x4 d;
#pragma unroll
          for (int j = 0; j < 4; ++j) d[j] = expf(bl[j]);
          *(f32x4*)(GD + ((size_t)bh * 64 + n) * 64 + k4) = d; } }
    __syncthreads();
    { const int j0 = (tid & 15) * 2; float s0 = 0.f, s1 = 0.f;
#pragma unroll
      for (int k = 0; k < 64; k += 4) { const f32x4 q = *(const LAS f32x4*)(qt + i * 64 + k), ka = *(const LAS f32x4*)(kt + j0 * 64 + k), kb = *(const LAS f32x4*)(kt + (j0 + 1) * 64 + k);
          s0 += (q[0] * ka[0] + q[1] * ka[1]) + (q[2] * ka[2] + q[3] * ka[3]); s1 += (q[0] * kb[0] + q[1] * kb[1]) + (q[2] * kb[2] + q[3] * kb[3]); }
      sc[i * 33 + j0] = (j0 <= i) ? s0 : 0.f; sc[i * 33 + j0 + 1] = (j0 + 1 <= i) ? s1 : 0.f; }
    { const int kk = (tid >> 5) * 4, v0 = (tid & 31) * 4; f32x4 u0 = {0.f, 0.f, 0.f, 0.f}, u1 = u0, u2 = u0, u3 = u0;
#pragma unroll 8
      for (int j = 0; j < 32; ++j) { const f32x4 kv = *(const LAS f32x4*)(kh + j * 64 + kk), vx = *(const LAS f32x4*)(vv + j * 128 + v0);
          u0 = u0 + vx * kv[0]; u1 = u1 + vx * kv[1]; u2 = u2 + vx * kv[2]; u3 = u3 + vx * kv[3]; }
      float* gp = GU + (((size_t)bh * 64 + n) * 64 + kk) * 128 + v0;
      *(f32x4*)(gp) = u0; *(f32x4*)(gp + 128) = u1; *(f32x4*)(gp + 256) = u2; *(f32x4*)(gp + 384) = u3; }
    __syncthreads();
    { f32x4 o0 = {0.f, 0.f, 0.f, 0.f}, o1 = o0;
#pragma unroll 8
      for (int j = 0; j < 32; ++j) { const float s = sc[i * 33 + j]; const f32x4 va = *(const LAS f32x4*)(vv + j * 128 + v8), vb = *(const LAS f32x4*)(vv + j * 128 + v8 + 4); o0 = o0 + va * s; o1 = o1 + vb * s; }
      float* gp = GO + (size_t)(t0 + i) * 512 + h * 128 + v8; *(f32x4*)gp = o0; *(f32x4*)(gp + 4) = o1; }
}
__device__ __forceinline__ void gla_scan(const Frame& F) {
    float* GU = (float*)(F.ws + WS_GU); const float* GD = (const float*)(F.ws + WS_GD);
    for (int g = F.bx * 512 + F.tid; g < 16 * 8192; g += F.G * 512) { const int bh = g >> 13, kv = g & 8191, k = kv >> 7;
        float* p = GU + (size_t)bh * 64 * 8192 + kv; const float* d = GD + (size_t)bh * 64 * 64 + k; float S = 0.f;
#pragma unroll 8
        for (int n = 0; n < 64; ++n) { const float u = p[(size_t)n * 8192]; const float dc = d[n * 64]; p[(size_t)n * 8192] = S; S = S * dc + u; } }
}
__device__ __forceinline__ void gla_c_unit(const Frame& F, const Args& a, int l, int unit) {
    const bf16_t* U = (const bf16_t*)(F.ws + WS_U); bf16_t* MIX = (bf16_t*)(F.ws + WS_MIX);
    const float* GU = (const float*)(F.ws + WS_GU); const float* GO = (const float*)(F.ws + WS_GO); const float* GQ = (const float*)(F.ws + WS_GQ);
    const int n = unit & 63, h = (unit >> 6) & 3, b = unit >> 8, bh = b * 4 + h;
    const int t0 = b * SEQ + n * 32, tid = F.tid;
    LAS float* qt = (LAS float*)F.lds; LAS float* Ss = qt + 2048;
    const int i = tid >> 4, k4 = (tid & 15) * 4, v8 = (tid & 15) * 8;
    __syncthreads();
    *(LAS f32x4*)(qt + i * 64 + k4) = *(const f32x4*)(GQ + (size_t)(t0 + i) * 256 + h * 64 + k4);
    { const float* sp = GU + ((size_t)bh * 64 + n) * 8192;
#pragma unroll
      for (int j = 0; j < 4; ++j) *(LAS f32x4*)(Ss + (tid + 512 * j) * 4) = *(const f32x4*)(sp + (tid + 512 * j) * 4); }
    __syncthreads();
    const float* gp = GO + (size_t)(t0 + i) * 512 + h * 128 + v8;
    f32x4 o0 = *(const f32x4*)gp, o1 = *(const f32x4*)(gp + 4);
#pragma unroll 8
    for (int k = 0; k < 64; ++k) { const float q = qt[i * 64 + k]; const f32x4 sa = *(const LAS f32x4*)(Ss + k * 128 + v8), sb = *(const LAS f32x4*)(Ss + k * 128 + v8 + 4); o0 = o0 + sa * q; o1 = o1 + sb * q; }
    float ss = (o0[0] * o0[0] + o0[1] * o0[1]) + (o0[2] * o0[2] + o0[3] * o0[3]) + (o1[0] * o1[0] + o1[1] * o1[1]) + (o1[2] * o1[2] + o1[3] * o1[3]);
    ss += __shfl_xor(ss, 1); ss += __shfl_xor(ss, 2); ss += __shfl_xor(ss, 4); ss += __shfl_xor(ss, 8);
    const float rms = 1.0f / sqrtf(ss * (1.f / 128.f) + RMS_EPS);
    const float* ng = a.in[9] + l * 128 + v8; const f32x4 n0 = *(const f32x4*)ng, n1 = *(const f32x4*)(ng + 4);
    const u32x4 rw = *(const u32x4*)(U + (size_t)(t0 + i) * DINP + UG_R + h * 128 + v8);
    const float r[8] = {bflo(rw.x), bfhi(rw.x), bflo(rw.y), bfhi(rw.y), bflo(rw.z), bfhi(rw.z), bflo(rw.w), bfhi(rw.w)};
    float o[8];
#pragma unroll
    for (int j = 0; j < 4; ++j) { o[j] = o0[j] * rms * n0[j] * siluf_(r[j]); o[4 + j] = o1[j] * rms * n1[j] * siluf_(r[4 + j]); }
    *(u32x4*)(MIX + (size_t)(t0 + i) * DM + 512 + h * 128 + v8) = (u32x4){pk2(o[0], o[1]), pk2(o[2], o[3]), pk2(o[4], o[5]), pk2(o[6], o[7])};
}

typedef short s16x4 __attribute__((ext_vector_type(4)));
__device__ __forceinline__ s16x4 vtr(const LAS unsigned char* p) { return __builtin_bit_cast(s16x4, __builtin_amdgcn_ds_read_tr16_b64_v4i16((LAS s16x4*)p)); }
constexpr int AT_VROW = 160, AT_VBUF = 32 * AT_VROW;
__device__ __forceinline__ void attn_job(const Frame& F, int job, LAS unsigned char* vbuf, const LAS float* bt) {
    const bf16_t* U = (const bf16_t*)(F.ws + WS_U); bf16_t* AO = (bf16_t*)(F.ws + WS_AO); float* ALSE = (float*)(F.ws + WS_ALSE);
    const int lane = F.lane, qi = lane & 15, g = lane >> 4;
    const int gidx = job & 127, t2 = job >> 7, br = t2 % 3, bh = t2 / 3, h = bh & 7, b = bh >> 3;
    const int dsh = 2 * br, dil = 1 << dsh, gsh = 7 - dsh, r = gidx >> gsh, gi = gidx & ((1 << gsh) - 1);
    const int q0 = gi * 16, tb = b * SEQ;
    const bf16_t* Ub = U + (size_t)(tb + r) * DINP + h * 64;
    const size_t sstep = (size_t)dil * DINP;
    const bf16_t* qrow = Ub + (size_t)(q0 + qi) * sstep + UC_Q + 8 * g;
    const bf16x8 qf0 = *(const bf16x8*)qrow, qf1 = *(const bf16x8*)(qrow + 32);
    const int klo = (q0 >= 128 ? q0 - 128 : 0) & ~31;
    const int nch = ((q0 + 15 - klo) >> 5) + 1;
    float m_run = -1e30f, l_part = 0.f;
    f32x4 o[4];
#pragma unroll
    for (int d = 0; d < 4; ++d) o[d] = (f32x4){0.f, 0.f, 0.f, 0.f};
    bf16x8 ka0, ka1, kb0, kb1; u32x4 vr[4];
#define AT_LOAD(kc) do { const bf16_t* kp = Ub + (size_t)((kc) + qi) * sstep + UC_K + 8 * g; ka0 = *(const bf16x8*)kp; ka1 = *(const bf16x8*)(kp + 32); kp += 16 * sstep; kb0 = *(const bf16x8*)kp; kb1 = *(const bf16x8*)(kp + 32); \
        const bf16_t* vp = Ub + (size_t)((kc) + (lane >> 3)) * sstep + UC_V + (lane & 7) * 8; _Pragma("unroll") for (int it = 0; it < 4; ++it) vr[it] = *(const u32x4*)(vp + (size_t)(8 * it) * sstep); } while (0)
    AT_LOAD(klo);
#pragma unroll 1
    for (int c = 0; c < nch; ++c) {
        const int kc = klo + 32 * c;
        LAS unsigned char* vb = vbuf + (c & 1) * AT_VBUF;
#pragma unroll
        for (int it = 0; it < 4; ++it) *(LAS u32x4*)(vb + (it * 8 + (lane >> 3)) * AT_VROW + (lane & 7) * 16) = vr[it];
        const bf16x8 ca0 = ka0, ca1 = ka1, cb0 = kb0, cb1 = kb1;
        if (c + 1 < nch) AT_LOAD(kc + 32);
        f32x4 sa = (f32x4){0.f, 0.f, 0.f, 0.f}, sb = sa;
        sa = __builtin_amdgcn_mfma_f32_16x16x32_bf16(ca0, qf0, sa, 0, 0, 0); sa = __builtin_amdgcn_mfma_f32_16x16x32_bf16(ca1, qf1, sa, 0, 0, 0);
        sb = __builtin_amdgcn_mfma_f32_16x16x32_bf16(cb0, qf0, sb, 0, 0, 0); sb = __builtin_amdgcn_mfma_f32_16x16x32_bf16(cb1, qf1, sb, 0, 0, 0);
        const int st0 = (q0 + qi) - (kc + 4 * g);
        float cmax = -1e30f;
#pragma unroll
        for (int rr = 0; rr < 4; ++rr) {
            const int sA = st0 - rr, sB = st0 - rr - 16;
            const int iA = sA < 0 ? 0 : (sA > 128 ? 128 : sA), iB = sB < 0 ? 0 : (sB > 128 ? 128 : sB);
            const float vA = sa[rr] * 0.125f + bt[(br * 129 + iA) * 8 + h], vB = sb[rr] * 0.125f + bt[(br * 129 + iB) * 8 + h];
            sa[rr] = (sA >= 0 && sA <= 128) ? vA : -1e30f; sb[rr] = (sB >= 0 && sB <= 128) ? vB : -1e30f;
            cmax = fmaxf(cmax, fmaxf(sa[rr], sb[rr])); }
        cmax = fmaxf(cmax, __shfl_xor(cmax, 16)); cmax = fmaxf(cmax, __shfl_xor(cmax, 32));
        const float m_new = fmaxf(m_run, cmax), alpha = __expf(m_run - m_new);
        float psum = 0.f;
#pragma unroll
        for (int rr = 0; rr < 4; ++rr) { sa[rr] = __expf(sa[rr] - m_new); sb[rr] = __expf(sb[rr] - m_new); psum += sa[rr] + sb[rr]; }
        l_part = l_part * alpha + psum; m_run = m_new;
#pragma unroll
        for (int d = 0; d < 4; ++d) o[d] = o[d] * alpha;
        const u32x4 pw = (u32x4){pk2(sa[0], sa[1]), pk2(sa[2], sa[3]), pk2(sb[0], sb[1]), pk2(sb[2], sb[3])};
        const bf16x8 pf = __builtin_bit_cast(bf16x8, pw);
        const LAS unsigned char* tp = vb + (4 * g + (qi >> 2)) * AT_VROW + (qi & 3) * 8;
#pragma unroll
        for (int d = 0; d < 4; ++d) { const s16x4 va = vtr(tp + d * 32), vb2 = vtr(tp + 16 * AT_VROW + d * 32);
            const bf16x8 vf = (bf16x8){va[0], va[1], va[2], va[3], vb2[0], vb2[1], vb2[2], vb2[3]};
            o[d] = __builtin_amdgcn_mfma_f32_16x16x32_bf16(vf, pf, o[d], 0, 0, 0); }
    }
#undef AT_LOAD
    float l = l_part; l += __shfl_xor(l, 16); l += __shfl_xor(l, 32);
    const float inv = 1.0f / l;
    const int token = tb + (q0 + qi) * dil + r;
    bf16_t* op = AO + ((size_t)br * MT + token) * 512 + h * 64 + 4 * g;
#pragma unroll
    for (int d = 0; d < 4; ++d) *(u32x2*)(op + d * 16) = (u32x2){pk2(o[d][0] * inv, o[d][1] * inv), pk2(o[d][2] * inv, o[d][3] * inv)};
    if (g == 0) ALSE[((size_t)br * MT + token) * 8 + h] = m_run + logf(l);
}
__device__ __forceinline__ void attn_combine(const Frame& F) {
    const bf16_t* AO = (const bf16_t*)(F.ws + WS_AO); const float* ALSE = (const float*)(F.ws + WS_ALSE); bf16_t* MIX = (bf16_t*)(F.ws + WS_MIX);
    for (int i = F.bx * 512 + F.tid; i < MT * 64; i += F.G * 512) { const int token = i >> 6, c8 = (i & 63) * 8, h = c8 >> 6;
        const float l0 = ALSE[(size_t)token * 8 + h], l1 = ALSE[((size_t)MT + token) * 8 + h], l2 = ALSE[((size_t)2 * MT + token) * 8 + h];
        const float m = fmaxf(l0, fmaxf(l1, l2)); float w0 = __expf(l0 - m), w1 = __expf(l1 - m), w2 = __expf(l2 - m); const float inv = 1.0f / (w0 + w1 + w2); w0 *= inv; w1 *= inv; w2 *= inv;
        const u32x4 a = *(const u32x4*)(AO + (size_t)token * 512 + c8), bq = *(const u32x4*)(AO + ((size_t)MT + token) * 512 + c8), cq = *(const u32x4*)(AO + ((size_t)2 * MT + token) * 512 + c8);
        const unsigned aw[4] = {a.x, a.y, a.z, a.w}, bw[4] = {bq.x, bq.y, bq.z, bq.w}, cw[4] = {cq.x, cq.y, cq.z, cq.w}; unsigned ow[4];
#pragma unroll
        for (int j = 0; j < 4; ++j) ow[j] = pk2(w0 * bflo(aw[j]) + w1 * bflo(bw[j]) + w2 * bflo(cw[j]), w0 * bfhi(aw[j]) + w1 * bfhi(bw[j]) + w2 * bfhi(cw[j]));
        *(u32x4*)(MIX + (size_t)token * DM + 1024 + c8) = (u32x4){ow[0], ow[1], ow[2], ow[3]}; }
}

__device__ __forceinline__ void ln1_unit(const Frame& F, const Args& a, int l, int unit, float* X1F) {
    const float* PRE = (const float*)(F.ws + WS_PRE); bf16_t* XB = (bf16_t*)(F.ws + WS_XB); const float* wrt = (const float*)(F.ws + WS_WRT) + (size_t)l * 36 * DM;
    int* ltok = (int*)(F.ws + WS_LTOK); float* lgate = (float*)(F.ws + WS_LGATE); int* tinfo = (int*)(F.ws + WS_TINFO); unsigned* cnt = F.ctl + CW_CNT + l * 32 * 64;
    LAS float* xs = (LAS float*)F.lds + F.wave * 2048;
    LAS float* Wl = (LAS float*)F.lds + 8 * 2048;
    const int lane = F.lane, row = unit * 8 + F.wave;
    const float* g = a.in[14] + (size_t)l * DM; const float* bb = a.in[15] + (size_t)l * DM;
    { const float* pr = PRE + (size_t)row * DM; f32x4 v[8]; float s = 0.f;
#pragma unroll
      for (int j = 0; j < 8; ++j) { v[j] = *(const f32x4*)(pr + 256 * j + 4 * lane); s += (v[j][0] + v[j][1]) + (v[j][2] + v[j][3]); }
      const float mean = wave_sum(s) * (1.f / DM); float q = 0.f;
#pragma unroll
      for (int j = 0; j < 8; ++j) { v[j] = v[j] - mean; q += (v[j][0] * v[j][0] + v[j][1] * v[j][1]) + (v[j][2] * v[j][2] + v[j][3] * v[j][3]); }
      const float rstd = 1.0f / sqrtf(wave_sum(q) * (1.f / DM) + LN_EPS);
#pragma unroll
      for (int j = 0; j < 8; ++j) { const f32x4 gv = *(const f32x4*)(g + 256 * j + 4 * lane), bv = *(const f32x4*)(bb + 256 * j + 4 * lane); const f32x4 y = v[j] * rstd * gv + bv;
          *(f32x4*)(X1F + (size_t)row * DM + 256 * j + 4 * lane) = y; *(u32x2*)(XB + (size_t)row * DM + 256 * j + 4 * lane) = (u32x2){pk2(y[0], y[1]), pk2(y[2], y[3])};
          *(LAS f32x4*)(xs + 256 * j + 4 * lane) = y; } }
    float acc[36];
#pragma unroll
    for (int c = 0; c < 36; ++c) acc[c] = 0.f;
#pragma unroll 1
    for (int j = 0; j < 8; ++j) {
        __syncthreads();
#pragma unroll 1
        for (int i = F.tid; i < 36 * 64; i += 512) { const int col = i >> 6, c4 = (i & 63) * 4; *(LAS f32x4*)(Wl + col * 256 + c4) = *(const f32x4*)(wrt + (size_t)col * DM + 256 * j + c4); }
        __syncthreads();
        const f32x4 xv = *(const LAS f32x4*)(xs + 256 * j + 4 * lane);
#pragma unroll
        for (int c = 0; c < 36; ++c) { const f32x4 w = *(const LAS f32x4*)(Wl + c * 256 + 4 * lane); acc[c] += (xv[0] * w[0] + xv[1] * w[1]) + (xv[2] * w[2] + xv[3] * w[3]); }
    }
#pragma unroll
    for (int c = 0; c < 36; ++c) acc[c] = wave_sum(acc[c]);
    const float* gb = a.in[17] + l * 4; const float* eb = a.in[19] + l * 32;
    {
        float gl[4];
#pragma unroll
        for (int c = 0; c < 4; ++c) gl[c] = acc[c] + gb[c];
        int gi = 0; float gm = gl[0];
#pragma unroll
        for (int c = 1; c < 4; ++c) if (gl[c] > gm) { gm = gl[c]; gi = c; }
        float gs = 0.f;
#pragma unroll
        for (int c = 0; c < 4; ++c) gs += expf(gl[c] - gm);
        const float gtop = 1.0f / gs;
        float ev[8];
#pragma unroll
        for (int c = 0; c < 8; ++c) { const float v0 = acc[4 + c] + eb[c], v1 = acc[12 + c] + eb[8 + c], v2 = acc[20 + c] + eb[16 + c], v3 = acc[28 + c] + eb[24 + c]; ev[c] = gi == 0 ? v0 : (gi == 1 ? v1 : (gi == 2 ? v2 : v3)); }
        int i1 = 0; float m1 = ev[0];
#pragma unroll
        for (int c = 1; c < 8; ++c) if (ev[c] > m1) { m1 = ev[c]; i1 = c; }
        int i2 = -1; float m2 = -INFINITY;
#pragma unroll
        for (int c = 0; c < 8; ++c) if (c != i1 && ev[c] > m2) { m2 = ev[c]; i2 = c; }
        const float p2 = expf(m2 - m1), den = 1.0f + p2;
        const float w1 = gtop / den, w2 = gtop * p2 / den;
        if (lane == 0) { const int tok = row; const int e1 = gi * 8 + i1, e2 = gi * 8 + i2;
            const unsigned s1 = __hip_atomic_fetch_add(cnt + e1 * 64, 1u, __ATOMIC_RELAXED, __HIP_MEMORY_SCOPE_AGENT), s2 = __hip_atomic_fetch_add(cnt + e2 * 64, 1u, __ATOMIC_RELAXED, __HIP_MEMORY_SCOPE_AGENT);
            ltok[e1 * MT + s1] = tok; lgate[e1 * MT + s1] = w1; ltok[e2 * MT + s2] = tok; lgate[e2 * MT + s2] = w2;
            tinfo[tok * 2] = e1 * MT + (int)s1; tinfo[tok * 2 + 1] = e2 * MT + (int)s2; }
    }
}
__device__ __forceinline__ void moe_tables(const Frame& F, int l) {
    LAS int* toff = (LAS int*)(F.lds + LDS_TOFF); const unsigned* cnt = F.ctl + CW_CNT + l * 32 * 64;
    __syncthreads();
    if (F.tid == 0) { int run = 0; for (int e = 0; e < 32; ++e) { toff[e] = run; run += ((int)cnt[e * 64] + 255) >> 8; } toff[32] = run; }
    __syncthreads();
}
__device__ __forceinline__ void ln2_rows(const Frame& F, const Args& a, int l, float* OUT, bool write_xb) {
    const float* PRE = (const float*)(F.ws + WS_PRE); const bf16_t* Y = (const bf16_t*)(F.ws + WS_Y); bf16_t* XB = (bf16_t*)(F.ws + WS_XB); const int* tinfo = (const int*)(F.ws + WS_TINFO);
    const LAS int* toff = (const LAS int*)(F.lds + LDS_TOFF);
    const float* g = a.in[26] + (size_t)l * DM; const float* bb = a.in[27] + (size_t)l * DM; const int lane = F.lane;
    for (int row = F.bx * 8 + F.wave; row < MT; row += F.G * 8) {
        const int i0 = tinfo[row * 2], i1 = tinfo[row * 2 + 1];
        const size_t s0 = (size_t)toff[i0 >> 13] * 256 + (i0 & 8191), s1 = (size_t)toff[i1 >> 13] * 256 + (i1 & 8191);
        const float* pr = PRE + (size_t)row * DM; const bf16_t* y0 = Y + s0 * DM; const bf16_t* y1 = Y + s1 * DM;
        f32x4 v[8]; float s = 0.f;
#pragma unroll
        for (int j = 0; j < 8; ++j) { const f32x4 p = *(const f32x4*)(pr + 256 * j + 4 * lane); const u32x2 a0 = *(const u32x2*)(y0 + 256 * j + 4 * lane), a1 = *(const u32x2*)(y1 + 256 * j + 4 * lane);
            v[j][0] = p[0] + (bflo(a0.x) + bflo(a1.x)); v[j][1] = p[1] + (bfhi(a0.x) + bfhi(a1.x)); v[j][2] = p[2] + (bflo(a0.y) + bflo(a1.y)); v[j][3] = p[3] + (bfhi(a0.y) + bfhi(a1.y));
            s += (v[j][0] + v[j][1]) + (v[j][2] + v[j][3]); }
        const float mean = wave_sum(s) * (1.f / DM); float q = 0.f;
#pragma unroll
        for (int j = 0; j < 8; ++j) { v[j] = v[j] - mean; q += (v[j][0] * v[j][0] + v[j][1] * v[j][1]) + (v[j][2] * v[j][2] + v[j][3] * v[j][3]); }
        const float rstd = 1.0f / sqrtf(wave_sum(q) * (1.f / DM) + LN_EPS);
#pragma unroll
        for (int j = 0; j < 8; ++j) { const f32x4 gv = *(const f32x4*)(g + 256 * j + 4 * lane), bv = *(const f32x4*)(bb + 256 * j + 4 * lane); const f32x4 y = v[j] * rstd * gv + bv;
            *(f32x4*)(OUT + (size_t)row * DM + 256 * j + 4 * lane) = y; if (write_xb) *(u32x2*)(XB + (size_t)row * DM + 256 * j + 4 * lane) = (u32x2){pk2(y[0], y[1]), pk2(y[2], y[3])}; }
    }
}

constexpr int PH_PER_LAYER = 9, N_PHASES = 1 + NL * PH_PER_LAYER;
__global__ void __launch_bounds__(512, 2) mega(Args args) {
    extern __shared__ __attribute__((aligned(16))) unsigned char lds_raw[];
    Frame F; F.lds = (LAS unsigned char*)lds_raw; F.ws = args.ws; F.ctl = (unsigned*)(args.ws + WS_CTL);
    F.tid = threadIdx.x; F.lane = F.tid & 63; F.wave = __builtin_amdgcn_readfirstlane(F.tid >> 6); F.G = gridDim.x; F.bx = blockIdx.x;
    if (F.tid < 4) ((LAS unsigned*)(F.lds + LDS_BARW))[F.tid] = 0u;
    __syncthreads();
#if LAUNCH_PER_PHASE
#define GRID_BAR() do { } while (0)
#else
    XcdBarrier bar = xcd_barrier_post(F.ctl + CW_BAR, (volatile LAS unsigned*)(F.lds + LDS_BARW));
#define GRID_BAR() xcd_barrier(bar)
#endif
    const int lo = args.ph_lo, hi = args.ph_hi;
#define IN(k) (lo <= (k) && (k) < hi)
#define SEAM(k) do { if (IN(k) && IN((k) + 1)) GRID_BAR(); } while (0)
    bf16_t* XB = (bf16_t*)(F.ws + WS_XB); bf16_t* Ub = (bf16_t*)(F.ws + WS_U); bf16_t* MIXb = (bf16_t*)(F.ws + WS_MIX); float* PRE = (float*)(F.ws + WS_PRE);
    bf16_t* PPb = (bf16_t*)(F.ws + WS_PP); bf16_t* Hb = (bf16_t*)(F.ws + WS_H); bf16_t* Yb = (bf16_t*)(F.ws + WS_Y);
    float* X1F = args.out;

    if (IN(0)) { for (int rep = 0; rep < REPS(9); ++rep) { const Frame f = F.fresh(); phase_prologue(f, args); if (rep + 1 < REPS(9)) GRID_BAR(); } }
    SEAM(0);
#pragma unroll 1
    for (int l = 0; l < NL; ++l) {
        const int pb = 1 + l * PH_PER_LAYER;
        const float* XRES = (l == 0) ? args.in[0] : (const float*)args.out;
        if (IN(pb + 0)) for (int rep = 0; rep < REPS(0); ++rep) { if (rep) GRID_BAR(); pg8::DenseSched S; S.init(XB, (const bf16_t*)(F.ws + WS_WIN) + (size_t)l * DINP * DM, DM, DM, MT, DINP, F.G, F.bx);
            pg8::EpiBf16 E{Ub, DINP}; pg8::gemm_phase(F.lds, DM, S, E); }
        SEAM(pb + 0);
        if (IN(pb + 1)) for (int rep = 0; rep < REPS(1); ++rep) { if (rep) GRID_BAR(); { const Frame f = F.fresh(); for (int u = F.bx; u < 256; u += F.G) conv_unit(f, args, l, u); }
            { const Frame f = F.fresh(); for (int u = F.bx; u < 1024; u += F.G) gla_a_unit(f, args, l, u); } __syncthreads(); }
        SEAM(pb + 1);
        if (IN(pb + 2)) { { const Frame f = F.fresh(); gla_scan(f); }
            const Frame f = F.fresh();
            LAS float* bt = (LAS float*)(F.lds + 8 * 2 * AT_VBUF);
            __syncthreads();
            for (int i = f.tid; i < 3 * 129 * 8; i += 512) bt[i] = ((const float*)(F.ws + WS_BTAB))[i];
            __syncthreads();
            for (int rep = 0; rep < REPS(2); ++rep)
            for (int job = F.bx * 8 + F.wave; job < 32 * 3 * 128; job += F.G * 8) attn_job(f, job, F.lds + F.wave * 2 * AT_VBUF, bt);
            __syncthreads(); }
        SEAM(pb + 2);
        if (IN(pb + 3)) for (int rep = 0; rep < REPS(3); ++rep) { if (rep) GRID_BAR(); { const Frame f = F.fresh(); for (int u = F.bx; u < 1024; u += F.G) gla_c_unit(f, args, l, u); __syncthreads(); } { const Frame f = F.fresh(); attn_combine(f); } }
        SEAM(pb + 3);
        if (IN(pb + 4)) for (int rep = 0; rep < REPS(4); ++rep) { if (rep) GRID_BAR(); { pg8::DenseSched S; S.init(MIXb, (const bf16_t*)(F.ws + WS_WOUT) + (size_t)l * DM * DM, DM, DM, MT, DM, F.G, F.bx);
              pg8::EpiRes E{PRE, XRES, DM, DN_ALPHA}; pg8::gemm_phase(F.lds, DM, S, E); }
            { pg8::DenseSched S; S.init((const bf16_t*)(F.ws + WS_PB) + (size_t)l * MT * PLE, (const bf16_t*)(F.ws + WS_WPP) + (size_t)l * DM * PLE, PLE, PLE, MT, DM, F.G, F.bx);
              pg8::EpiBf16 E{PPb, DM}; pg8::gemm_phase(F.lds, PLE, S, E); } }
        SEAM(pb + 4);
        if (IN(pb + 5)) { const Frame f = F.fresh(); for (int u = F.bx; u < MT / 8; u += F.G) ln1_unit(f, args, l, u, X1F); __syncthreads(); }
        SEAM(pb + 5);
        if (IN(pb + 6)) for (int rep = 0; rep < REPS(6); ++rep) { if (rep) GRID_BAR(); { pg8::DenseSched S; S.init(XB, (const bf16_t*)(F.ws + WS_WPG) + (size_t)l * DM * DM, DM, DM, MT, DM, F.G, F.bx);
              pg8::EpiPle E{PRE, X1F, PPb, args.in[24] + (size_t)l * DM, DM, DN_ALPHA}; pg8::gemm_phase(F.lds, DM, S, E); }
            moe_tables(F, l);
            { pg8::MoeSched<true> S; S.A = XB; S.Bt = (const bf16_t*)(F.ws + WS_WGU) + (size_t)l * NEXP * 512 * DM; S.lda = DM; S.ldb = DM; S.nN = 2; S.G = F.G; S.c = F.bx; S.bexp = (size_t)512 * DM * 2;
              S.toff = (const LAS int*)(F.lds + LDS_TOFF); S.cnt = F.ctl + CW_CNT + l * 32 * 64; S.ltok = (const int*)(F.ws + WS_LTOK);
              pg8::EpiMoe1 E{Hb, (const float*)(F.ws + WS_LGATE), F.ctl + CW_CNT + l * 32 * 64}; pg8::gemm_phase(F.lds, DM, S, E); } }
        SEAM(pb + 6);
        if (IN(pb + 7)) for (int rep = 0; rep < REPS(7); ++rep) { if (rep) GRID_BAR(); moe_tables(F, l);
            pg8::MoeSched<false> S; S.A = Hb; S.Bt = (const bf16_t*)(F.ws + WS_WD) + (size_t)l * NEXP * DM * DEXP; S.lda = DEXP; S.ldb = DEXP; S.nN = 8; S.G = F.G; S.c = F.bx; S.bexp = (size_t)DM * DEXP * 2;
            S.toff = (const LAS int*)(F.lds + LDS_TOFF); S.cnt = F.ctl + CW_CNT + l * 32 * 64; S.ltok = (const int*)(F.ws + WS_LTOK);
            pg8::EpiBf16 E{Yb, DM}; pg8::gemm_phase(F.lds, DEXP, S, E); }
        SEAM(pb + 7);
        if (IN(pb + 8)) for (int rep = 0; rep < REPS(8); ++rep) { if (rep) GRID_BAR(); const Frame f = F.fresh(); moe_tables(f, l); ln2_rows(f, args, l, args.out, l + 1 < NL); }
        SEAM(pb + 8);
    }
#undef IN
#undef SEAM
}

extern "C" void kernel_launch(void* const* d_in, const int* in_sizes, int n_in, void* d_out, int out_size, void* d_ws, size_t ws_size, hipStream_t stream) {
    static int grid = 0;
    if (grid == 0) {
        if (n_in != 28 || out_size != MT * DM || ws_size < WS_END) { fprintf(stderr, "kernel_launch: unexpected shapes (n_in %d, out %d, ws %zu); nothing launched\n", n_in, out_size, ws_size); grid = -1; return; }
        int dev = 0, cus = 0, per_cu = 0;
        if (hipGetDevice(&dev) != hipSuccess || hipDeviceGetAttribute(&cus, hipDeviceAttributeMultiprocessorCount, dev) != hipSuccess) { grid = -1; return; }
        if (hipFuncSetAttribute((const void*)mega, hipFuncAttributeMaxDynamicSharedMemorySize, LDS_BYTES) != hipSuccess) { fprintf(stderr, "kernel_launch: hipFuncSetAttribute failed\n"); grid = -1; return; }
        if (hipOccupancyMaxActiveBlocksPerMultiprocessor(&per_cu, (const void*)mega, 512, LDS_BYTES) != hipSuccess || per_cu < 1) { fprintf(stderr, "kernel_launch: occupancy query says %d\n", per_cu); }
        (void)hipGetLastError();
        grid = cus;
    }
    if (grid < 0) return;
    (void)hipMemsetAsync((char*)d_ws + WS_CTL, 0, CTL_ZERO_BYTES, stream);
    Args a{};
    for (int i = 0; i < 28; ++i) a.in[i] = (const float*)d_in[i];
    a.out = (float*)d_out; a.ws = (unsigned char*)d_ws;
#if LAUNCH_PER_PHASE
    for (int p = 0; p < N_PHASES; ++p) { a.ph_lo = p; a.ph_hi = p + 1; hipLaunchKernelGGL(mega, dim3(grid), dim3(512), LDS_BYTES, stream, a); }
#else
    a.ph_lo = 0; a.ph_hi = N_PHASES; hipLaunchKernelGGL(mega, dim3(grid), dim3(512), LDS_BYTES, stream, a);
#endif
}
```

```cpp
#include <hip/hip_runtime.h>
#include <cstdio>
#include <cstdint>

#ifndef REP_MASK
#define REP_MASK 0
#endif
#define REPS(k) (1 + ((REP_MASK >> (k)) & 1))
#ifndef LAUNCH_PER_PHASE
#define LAUNCH_PER_PHASE 0
#endif

#define LAS __attribute__((address_space(3)))
#define GAS __attribute__((address_space(1)))
typedef unsigned short bf16_t;
typedef short bf16x8 __attribute__((ext_vector_type(8)));
typedef float f32x4 __attribute__((ext_vector_type(4)));
typedef float f32x2 __attribute__((ext_vector_type(2)));
typedef unsigned u32x4 __attribute__((ext_vector_type(4)));
typedef unsigned u32x2 __attribute__((ext_vector_type(2)));

constexpr int NL = 2, NBATCH = 4, SEQ = 2048, DM = 2048, MT = NBATCH * SEQ;
constexpr int DIN = 5648, DINP = 5888, PLE = 256, NEXP = 32, DEXP = 256;
constexpr int UA_VAL = 0, UA_GATE = 512, UG_Q = 1024, UG_K = 1280, UG_V = 1536, UG_R = 2048, UC_Q = 2560, UC_K = 3072, UC_V = 3584, US_B = 4096, US_C = 4608, US_H = 5120, UG_LOW = 5632;
constexpr float DN_ALPHA = 1.41421356237309515f, LN_EPS = 1e-5f, RMS_EPS = 1e-6f;
constexpr int MAXSLOT = 24576;

constexpr size_t MiB = 1u << 20;
constexpr size_t WS_CTL = 0, CTL_ZERO_BYTES = 1 * MiB;
constexpr size_t WS_BTAB = 1 * MiB;
constexpr size_t WS_WRT = 1 * MiB + 64 * 1024;
constexpr size_t WS_LTOK = 2 * MiB;
constexpr size_t WS_LGATE = 3 * MiB;
constexpr size_t WS_TINFO = 4 * MiB;
constexpr size_t WS_WIN = 8 * MiB;
constexpr size_t WS_WOUT = 54 * MiB;
constexpr size_t WS_WGU = 70 * MiB;
constexpr size_t WS_WD = 198 * MiB;
constexpr size_t WS_WPG = 262 * MiB;
constexpr size_t WS_WPP = 278 * MiB;
constexpr size_t WS_XB = 280 * MiB;
constexpr size_t WS_PB = 312 * MiB;
constexpr size_t WS_U = 320 * MiB;
constexpr size_t WS_Y = 320 * MiB;
constexpr size_t WS_MIX = 416 * MiB;
constexpr size_t WS_PRE = 448 * MiB;
constexpr size_t WS_GU = 448 * MiB;
constexpr size_t WS_GO = 480 * MiB;
constexpr size_t WS_GQ = 496 * MiB;
constexpr size_t WS_GD = 504 * MiB;
constexpr size_t WS_PP = 512 * MiB;
constexpr size_t WS_AO = 512 * MiB;
constexpr size_t WS_ALSE = 536 * MiB;
constexpr size_t WS_H = 544 * MiB;
constexpr size_t WS_END = 556 * MiB;
static_assert(WS_U + (size_t)MT * DINP * 2 <= WS_MIX && WS_Y + (size_t)MAXSLOT * 2048 * 2 <= WS_MIX + 32 * MiB, "ws map");
constexpr int CW_BAR = 4096;
constexpr int CW_CNT = 16384;

constexpr int LDS_STAGE = 135168;
constexpr int LDS_TOFF = LDS_STAGE;
constexpr int LDS_BARW = LDS_STAGE + 512;
constexpr int LDS_BYTES = LDS_STAGE + 1024;

__device__ __forceinline__ float bf2f(unsigned b) { return __uint_as_float(b << 16); }
__device__ __forceinline__ unsigned f2bf(float f) { unsigned u = __float_as_uint(f); return (u + 0x7fffu + ((u >> 16) & 1u)) >> 16; }
__device__ __forceinline__ unsigned pk2(float lo, float hi) { return f2bf(lo) | (f2bf(hi) << 16); }
__device__ __forceinline__ float bflo(unsigned w) { return __uint_as_float(w << 16); }
__device__ __forceinline__ float bfhi(unsigned w) { return __uint_as_float(w & 0xffff0000u); }
__device__ __forceinline__ float wave_sum(float v) {
#pragma unroll
    for (int o = 1; o < 64; o <<= 1) v += __shfl_xor(v, o);
    return v;
}
__device__ __forceinline__ float wave_max(float v) {
#pragma unroll
    for (int o = 1; o < 64; o <<= 1) v = fmaxf(v, __shfl_xor(v, o));
    return v;
}
__device__ __forceinline__ float sigmoidf_(float x) { return 1.0f / (1.0f + __expf(-x)); }
__device__ __forceinline__ float siluf_(float x) { return x / (1.0f + __expf(-x)); }
#define LDS_WAIT() asm volatile("s_waitcnt lgkmcnt(0)" ::: "memory")

namespace pg8 {
constexpr int BM = 256, BK = 64, HALF = 128, HTB = HALF * BK * 2, STAGE_BYTES = 8 * HTB, NXCD = 8, WGM = 8;
__host__ __device__ __forceinline__ int lds_byte(int r, int c) { const int st = (r >> 4) * 2 + (c >> 5), rr = r & 15, cc = c & 31, ob = rr * 64 + cc * 2; return st * 1024 + (ob ^ (((ob >> 9) & 1) << 5)); }
__host__ __device__ __forceinline__ void stage_rc(int b, int& R, int& C) { const int st = b / 1024, sb = b % 1024, swz = sb ^ (((sb >> 9) & 1) << 5); R = (st >> 1) * 16 + swz / 64; C = (st & 1) * 32 + (swz % 64) / 2; }
__host__ __device__ __forceinline__ int perm32(int rho) { const int n = rho >> 4, i = rho & 15; return 8 * (i >> 2) + 4 * n + (i & 3); }

struct Unit { int pm, pn, e, r; };

struct DenseSched {
    static constexpr bool GATHER = false;
    const bf16_t* A; const bf16_t* Bt; int lda, ldb, nM, nN, nwg, G, c;
    __device__ void init(const bf16_t* A_, const bf16_t* Bt_, int lda_, int ldb_, int M, int N, int G_, int c_) { A = A_; Bt = Bt_; lda = lda_; ldb = ldb_; nM = M / BM; nN = N / BM; nwg = nM * nN; G = G_; c = c_; }
    __device__ __forceinline__ bool next(int i, Unit& u) const {
        const long L = (long)i * G + c; if (L >= nwg) return false;
        int wgid = (int)L; { const int q = nwg / NXCD, r = nwg % NXCD, xcd = wgid % NXCD, off = wgid / NXCD; wgid = (xcd < r ? xcd * (q + 1) : r * (q + 1) + (xcd - r) * q) + off; }
        const int nig = WGM * nN, gid = wgid / nig, fm = gid * WGM, gsz = (nM - fm) < WGM ? (nM - fm) : WGM;
        u.pm = fm + ((wgid % nig) % gsz); u.pn = (wgid % nig) / gsz; u.e = 0; u.r = 0; return true;
    }
    __device__ __forceinline__ const char* a_base(const Unit& u) const { return (const char*)A + (size_t)u.pm * BM * lda * 2; }
    __device__ __forceinline__ const char* b_base(const Unit& u) const { return (const char*)Bt + (size_t)u.pn * BM * ldb * 2; }
    __device__ __forceinline__ void a_offs(const Unit&, const int (&R)[2], const int (&C)[2], unsigned (&vo)[2][2]) const { }
};
template <bool GATHER_> struct MoeSched {
    static constexpr bool GATHER = GATHER_;
    const bf16_t* A; const bf16_t* Bt; int lda, ldb, nN, G, c; size_t bexp;
    const LAS int* toff; const unsigned* cnt; const int* ltok;
    __device__ __forceinline__ bool next(int i, Unit& u) const {
        const int L = i * G + c; const int total = __builtin_amdgcn_readfirstlane(toff[32]) * nN; if (L >= total) return false;
        const int j = L / nN; u.pn = L - j * nN; int e = 0;
#pragma unroll 1
        for (int k = 1; k < 32; ++k) e = (__builtin_amdgcn_readfirstlane(toff[k]) <= j) ? k : e;
        u.e = e; u.r = j - __builtin_amdgcn_readfirstlane(toff[e]); u.pm = j; return true;
    }
    __device__ __forceinline__ const char* a_base(const Unit& u) const { return GATHER ? (const char*)A : (const char*)A + (size_t)u.pm * BM * lda * 2; }
    __device__ __forceinline__ const char* b_base(const Unit& u) const { return (const char*)Bt + (size_t)u.e * bexp + (size_t)u.pn * BM * ldb * 2; }
    __device__ __forceinline__ void a_offs(const Unit& u, const int (&R)[2], const int (&C)[2], unsigned (&vo)[2][2]) const {
        if constexpr (GATHER) {
        const int n = __builtin_amdgcn_readfirstlane((int)cnt[u.e * 64]);
#pragma unroll
        for (int h = 0; h < 2; ++h)
#pragma unroll
            for (int i = 0; i < 2; ++i) {
                const int sr = u.r * BM + h * HALF + R[i]; const int row = (sr < n) ? ltok[u.e * MT + sr] : 0;
                vo[h][i] = (unsigned)(row * lda + C[i]) * 2u;
            }
        }
    }
};

__device__ __forceinline__ unsigned cvt_pk_bf16(float lo, float hi) { unsigned r; asm volatile("v_cvt_pk_bf16_f32 %0, %1, %2" : "=v"(r) : "v"(lo), "v"(hi)); return r; }

struct EpiBf16 {
    static constexpr bool PERM = true;
    bf16_t* O; int ldc;
    __device__ __forceinline__ void operator()(const f32x4 (&acc)[2][2][4][2], const Unit& u, int wr, int wc, int fr, int fq) const {
        const int row0 = u.pm * BM + wr * 64 + fr, col0 = u.pn * BM + wc * 32 + 8 * fq;
#pragma unroll
        for (int ai = 0; ai < 2; ++ai)
#pragma unroll
            for (int m = 0; m < 4; ++m) { bf16_t* rowp = O + (size_t)(row0 + ai * HALF + m * 16) * ldc + col0;
#pragma unroll
                for (int bj = 0; bj < 2; ++bj) { const f32x4 v0 = acc[ai][bj][m][0], v1 = acc[ai][bj][m][1];
                    u32x4 w; w.x = cvt_pk_bf16(v0[0], v0[1]); w.y = cvt_pk_bf16(v0[2], v0[3]); w.z = cvt_pk_bf16(v1[0], v1[1]); w.w = cvt_pk_bf16(v1[2], v1[3]);
                    *(u32x4*)(rowp + bj * HALF) = w; } }
    }
};
struct EpiRes {
    static constexpr bool PERM = false;
    float* C; const float* res; int ldc; float alpha;
    __device__ __forceinline__ void operator()(const f32x4 (&acc)[2][2][4][2], const Unit& u, int wr, int wc, int fr, int fq) const {
        const int row0 = u.pm * BM + wr * 64 + fr, col0 = u.pn * BM + wc * 32 + 4 * fq;
#pragma unroll
        for (int ai = 0; ai < 2; ++ai)
#pragma unroll
            for (int m = 0; m < 4; ++m) { const size_t off = (size_t)(row0 + ai * HALF + m * 16) * ldc + col0;
#pragma unroll
                for (int bj = 0; bj < 2; ++bj)
#pragma unroll
                    for (int n = 0; n < 2; ++n) { const f32x4 rv = *(const f32x4*)(res + off + bj * HALF + n * 16); *(f32x4*)(C + off + bj * HALF + n * 16) = rv * alpha + acc[ai][bj][m][n]; }
                asm volatile("" ::: "memory"); }
    }
};
struct EpiPle {
    static constexpr bool PERM = false;
    float* C; const float* x1; const bf16_t* pp; const float* bias; int ldc; float alpha;
    __device__ __forceinline__ void operator()(const f32x4 (&acc)[2][2][4][2], const Unit& u, int wr, int wc, int fr, int fq) const {
        const int row0 = u.pm * BM + wr * 64 + fr, col0 = u.pn * BM + wc * 32 + 4 * fq;
        f32x4 bv[2][2];
#pragma unroll
        for (int bj = 0; bj < 2; ++bj)
#pragma unroll
            for (int n = 0; n < 2; ++n) bv[bj][n] = *(const f32x4*)(bias + col0 + bj * HALF + n * 16);
#pragma unroll
        for (int ai = 0; ai < 2; ++ai)
#pragma unroll
            for (int m = 0; m < 4; ++m) { const size_t off = (size_t)(row0 + ai * HALF + m * 16) * ldc + col0;
#pragma unroll
                for (int bj = 0; bj < 2; ++bj)
#pragma unroll
                    for (int n = 0; n < 2; ++n) { const size_t o = off + bj * HALF + n * 16; const f32x4 xv = *(const f32x4*)(x1 + o); const u32x2 pw = *(const u32x2*)(pp + o);
                        const f32x4 a = acc[ai][bj][m][n] + bv[bj][n]; f32x4 r;
                        r[0] = xv[0] * alpha + sigmoidf_(a[0]) * bflo(pw.x); r[1] = xv[1] * alpha + sigmoidf_(a[1]) * bfhi(pw.x);
                        r[2] = xv[2] * alpha + sigmoidf_(a[2]) * bflo(pw.y); r[3] = xv[3] * alpha + sigmoidf_(a[3]) * bfhi(pw.y);
                        *(f32x4*)(C + o) = r; }
                asm volatile("" ::: "memory"); }
    }
};
struct EpiMoe1 {
    static constexpr bool PERM = true;
    bf16_t* H; const float* lgate; const unsigned* cnt;
    __device__ __forceinline__ void operator()(const f32x4 (&acc)[2][2][4][2], const Unit& u, int wr, int wc, int fr, int fq) const {
        const int n_e = __builtin_amdgcn_readfirstlane((int)cnt[u.e * 64]);
        const int col0 = u.pn * HALF + wc * 32 + 8 * fq;
#pragma unroll
        for (int ai = 0; ai < 2; ++ai)
#pragma unroll
            for (int m = 0; m < 4; ++m) { const int rt = ai * HALF + wr * 64 + m * 16 + fr; const int sr = u.r * BM + rt;
                const float gw = (sr < n_e) ? lgate[u.e * MT + sr] : 0.f;
                const f32x4 g0 = acc[ai][0][m][0], g1 = acc[ai][0][m][1], u0 = acc[ai][1][m][0], u1 = acc[ai][1][m][1];
                float o[8];
#pragma unroll
                for (int j = 0; j < 4; ++j) { o[j] = siluf_(g0[j]) * u0[j] * gw; o[4 + j] = siluf_(g1[j]) * u1[j] * gw; }
                u32x4 w; w.x = cvt_pk_bf16(o[0], o[1]); w.y = cvt_pk_bf16(o[2], o[3]); w.z = cvt_pk_bf16(o[4], o[5]); w.w = cvt_pk_bf16(o[6], o[7]);
                *(u32x4*)(H + (size_t)(u.pm * BM + rt) * DEXP + col0) = w; }
    }
};

template <class Epi, class Sched>
__device__ __forceinline__ void gemm_phase(LAS unsigned char* lds, const int K, const Sched& S, const Epi& E) {
    constexpr bool GA = Sched::GATHER;
    int tid = threadIdx.x; asm volatile("" : "+v"(tid));
    const int wid = __builtin_amdgcn_readfirstlane(tid >> 6), lane = tid & 63, wr = wid >> 2, wc = wid & 3, fr = lane & 15, fq = lane >> 4;
    const int nt = K / BK, ldb = S.ldb, lda = S.lda;
    int Rr[2], Cc[2]; unsigned voffB[2], voffA[2];
#pragma unroll
    for (int i = 0; i < 2; ++i) { int R, C; stage_rc(tid * 16 + i * 8192, R, C); Rr[i] = R; Cc[i] = C; const int Rb = Epi::PERM ? ((R & ~31) + perm32(R & 31)) : R; voffB[i] = (unsigned)(Rb * ldb + C) * 2u; voffA[i] = (unsigned)(R * lda + C) * 2u; }
    const size_t kstep = (size_t)(BK * 2);
    const size_t hstep = (size_t)HALF * ldb * 2;
    const size_t ahstep = GA ? 0 : (size_t)HALF * lda * 2;
    const unsigned ldsw = (unsigned)wid * 1024u;
    const int aoff = lds_byte(wr * 64 + fr, fq * 8), boff = lds_byte(wc * 32 + fr, fq * 8);
#define PG8_SA(b, h) (((b) * 2 + (h)) * HTB)
#define PG8_SB(b, h) ((4 + (b) * 2 + (h)) * HTB)
#define PG8_STAGE(bufoff, gbase, voff) do { _Pragma("unroll") for (int _i = 0; _i < 2; ++_i) \
        __builtin_amdgcn_global_load_lds((const unsigned*)((const char*)(gbase) + (voff)[_i]), (LAS unsigned*)(lds + (bufoff) + ldsw + _i * 8192), 16, 0, 0); } while (0)
#define PG8_STAGE_A(bufoff, gbase, h) do { if constexpr (GA) PG8_STAGE(bufoff, gbase, voA[h]); else PG8_STAGE(bufoff, (gbase) + (h) * ahstep, voffA); } while (0)
#define PG8_STAGE_A2(bufoff, gbase, h) do { if constexpr (GA) { unsigned _v[2] = {last ? voN[h][0] : voA[h][0], last ? voN[h][1] : voA[h][1]}; PG8_STAGE(bufoff, gbase, _v); } else PG8_STAGE(bufoff, (gbase) + (h) * ahstep, voffA); } while (0)
#define PG8_LDA(dst, b, h) do { _Pragma("unroll") for (int m = 0; m < 4; ++m) _Pragma("unroll") for (int k = 0; k < 2; ++k) dst[m][k] = *(const LAS bf16x8*)(lds + PG8_SA(b, h) + aoff + m * 2048 + k * 1024); } while (0)
#define PG8_LDB(dst, b, h) do { _Pragma("unroll") for (int n = 0; n < 2; ++n) _Pragma("unroll") for (int k = 0; k < 2; ++k) dst[n][k] = *(const LAS bf16x8*)(lds + PG8_SB(b, h) + boff + n * 2048 + k * 1024); } while (0)
#define PG8_MMA(ai, bj, At, Bt) do { __builtin_amdgcn_s_setprio(1); _Pragma("unroll") for (int m = 0; m < 4; ++m) _Pragma("unroll") for (int n = 0; n < 2; ++n) _Pragma("unroll") for (int k = 0; k < 2; ++k) \
        acc[ai][bj][m][n] = __builtin_amdgcn_mfma_f32_16x16x32_bf16(Bt[n][k], At[m][k], acc[ai][bj][m][n], 0, 0, 0); __builtin_amdgcn_s_setprio(0); } while (0)
#define PG8_WAIT_V(n) asm volatile("s_waitcnt vmcnt(" #n ")" ::: "memory")
#define PG8_WAIT_L(n) asm volatile("s_waitcnt lgkmcnt(" #n ")" ::: "memory")
#define PG8_BAR __builtin_amdgcn_s_barrier()
#define PG8_SCHED __builtin_amdgcn_sched_barrier(0)
    Unit cur, nxt; int ui = 0;
    if (!S.next(0, cur)) return;
    f32x4 acc[2][2][4][2];
#pragma unroll
    for (int a = 0; a < 2; ++a)
#pragma unroll
        for (int b = 0; b < 2; ++b)
#pragma unroll
            for (int m = 0; m < 4; ++m)
#pragma unroll
                for (int n = 0; n < 2; ++n) acc[a][b][m][n] = (f32x4){0.f, 0.f, 0.f, 0.f};
    bf16x8 At[4][2], B0[2][2], B1[2][2];
    const char* cA = S.a_base(cur); const char* cB = S.b_base(cur);
    unsigned voA[2][2], voN[2][2];
    if constexpr (GA) S.a_offs(cur, Rr, Cc, voA);
    PG8_STAGE(PG8_SB(0, 0), cB, voffB); PG8_STAGE(PG8_SB(0, 1), cB + hstep, voffB); PG8_STAGE_A(PG8_SA(0, 0), cA, 0); PG8_STAGE_A(PG8_SA(0, 1), cA, 1);
    if (wr == 1) PG8_BAR;
    PG8_WAIT_V(2); PG8_BAR;
    PG8_STAGE(PG8_SB(1, 0), cB + kstep, voffB); PG8_STAGE_A(PG8_SA(1, 0), cA + kstep, 0); PG8_STAGE(PG8_SB(1, 1), cB + hstep + kstep, voffB);
    PG8_WAIT_V(6); PG8_BAR;
    for (;;) {
        const bool has_next = S.next(ui + 1, nxt);
        const char* nA = has_next ? S.a_base(nxt) : cA; const char* nB = has_next ? S.b_base(nxt) : cB;
        if constexpr (GA) {
            if (has_next) S.a_offs(nxt, Rr, Cc, voN);
            else {
#pragma unroll
                for (int h = 0; h < 2; ++h)
#pragma unroll
                    for (int i = 0; i < 2; ++i) voN[h][i] = voA[h][i]; } }
#pragma unroll 1
        for (int t = 0; t < nt; t += 2) {
            const bool last = (t == nt - 2);
            const char* a1 = cA + (size_t)(t + 1) * kstep;
            const char* a2 = last ? nA : cA + (size_t)(t + 2) * kstep; const char* b2 = last ? nB : cB + (size_t)(t + 2) * kstep;
            const char* a3 = a2 + kstep; const char* b3 = b2 + kstep;
            PG8_LDB(B0, 0, 0); PG8_LDB(B1, 0, 1); PG8_SCHED; PG8_LDA(At, 0, 0); PG8_STAGE_A(PG8_SA(1, 1), a1, 1);
            PG8_WAIT_V(8); PG8_WAIT_L(0); PG8_BAR; PG8_MMA(0, 0, At, B0); PG8_MMA(0, 1, At, B1); PG8_BAR; PG8_SCHED;
            PG8_LDA(At, 0, 1); PG8_STAGE(PG8_SB(0, 0), b2, voffB); PG8_STAGE(PG8_SB(0, 1), b2 + hstep, voffB); PG8_STAGE_A2(PG8_SA(0, 0), a2, 0);
            PG8_WAIT_V(8); PG8_WAIT_L(0); PG8_BAR; PG8_MMA(1, 0, At, B0); PG8_MMA(1, 1, At, B1); PG8_BAR; PG8_SCHED;
            PG8_LDB(B0, 1, 0); PG8_LDB(B1, 1, 1); PG8_SCHED; PG8_LDA(At, 1, 0); PG8_STAGE_A2(PG8_SA(0, 1), a2, 1);
            PG8_WAIT_V(8); PG8_WAIT_L(0); PG8_BAR; PG8_MMA(0, 0, At, B0); PG8_MMA(0, 1, At, B1); PG8_BAR; PG8_SCHED;
            PG8_LDA(At, 1, 1); PG8_STAGE(PG8_SB(1, 0), b3, voffB); PG8_STAGE(PG8_SB(1, 1), b3 + hstep, voffB); PG8_STAGE_A2(PG8_SA(1, 0), a3, 0);
            PG8_WAIT_V(8); PG8_WAIT_L(0); PG8_BAR; PG8_MMA(1, 0, At, B0); PG8_MMA(1, 1, At, B1); PG8_BAR; PG8_SCHED;
        }
        if (wr == 0) PG8_BAR;
        E(acc, cur, wr, wc, fr, fq);
        if (!has_next) break;
#pragma unroll
        for (int a = 0; a < 2; ++a)
#pragma unroll
            for (int b = 0; b < 2; ++b)
#pragma unroll
                for (int m = 0; m < 4; ++m)
#pragma unroll
                    for (int n = 0; n < 2; ++n) acc[a][b][m][n] = (f32x4){0.f, 0.f, 0.f, 0.f};
        cur = nxt; cA = nA; cB = nB; ++ui;
        if constexpr (GA) {
#pragma unroll
            for (int h = 0; h < 2; ++h)
#pragma unroll
                for (int i = 0; i < 2; ++i) voA[h][i] = voN[h][i]; }
        if (wr == 1) PG8_BAR;
    }
    PG8_WAIT_V(0);
    PG8_BAR;
#undef PG8_SA
#undef PG8_SB
#undef PG8_STAGE
#undef PG8_STAGE_A
#undef PG8_STAGE_A2
#undef PG8_LDA
#undef PG8_LDB
#undef PG8_MMA
#undef PG8_WAIT_V
#undef PG8_WAIT_L
#undef PG8_BAR
#undef PG8_SCHED
}
}

#define XB_TMO      128
#define XB_XCNT(j)  (256  + 64 * (j))
#define XB_XSUB(j)  (1280 + 64 * (j))
#define XB_XGEN(j)  (2304 + 64 * (j))
#define XB_TOP      3328
#define XB_TOPGEN   3392
#define XCD_BAR_WORDS 3456
#define XB_SPIN_CAP (1u << 18)
__device__ __forceinline__ unsigned xb_ld(unsigned* p)              { return __hip_atomic_load(p, __ATOMIC_RELAXED, __HIP_MEMORY_SCOPE_AGENT); }
__device__ __forceinline__ unsigned xb_add(unsigned* p, unsigned v) { return __hip_atomic_fetch_add(p, v, __ATOMIC_RELAXED, __HIP_MEMORY_SCOPE_AGENT); }
__device__ __forceinline__ unsigned xb_xcc_id() { return (unsigned)__builtin_amdgcn_s_getreg((3 << 11) | 20) & 0xFu; }
#define XB_SPIN(cond, bar) do { unsigned _sp = 0; while (cond) { __builtin_amdgcn_s_sleep(1); \
    if ((++_sp & 255u) == 0u) { if (xb_ld(&(bar)[XB_TMO])) break; if (_sp > XB_SPIN_CAP) { atomicAdd(&(bar)[XB_TMO], 1u); break; } } } } while (0)
struct XcdBarrier { unsigned* bar; unsigned x; volatile LAS unsigned* st; };
__device__ __forceinline__ XcdBarrier xcd_barrier_post(unsigned* bar, volatile LAS unsigned* st) {
    XcdBarrier b; b.bar = bar; b.x = xb_xcc_id(); b.st = st;
    if (threadIdx.x == 0) (void)xb_add(&bar[XB_XCNT(b.x)], 1u);
    return b;
}
__device__ __forceinline__ void xcd_barrier_complete(unsigned* bar, unsigned x, unsigned& nloc, unsigned& nx) {
    const unsigned G = gridDim.x * gridDim.y * gridDim.z;
    unsigned sum, cnt, mine, sp = 0u;
    for (;;) {
        sum = 0u; cnt = 0u; mine = 0u;
#pragma unroll
        for (unsigned j = 0; j < 16; ++j) { const unsigned c = xb_ld(&bar[XB_XCNT(j)]); sum += c; cnt += (c > 0u) ? 1u : 0u; mine = (j == x) ? c : mine; }
        if (sum == G) break;
        __builtin_amdgcn_s_sleep(1);
        if ((++sp & 255u) == 0u) { if (xb_ld(&bar[XB_TMO])) break; if (sp > XB_SPIN_CAP) { atomicAdd(&bar[XB_TMO], 1u); break; } }
    }
    nloc = mine > 0u ? mine : 1u; nx = cnt > 0u ? cnt : 1u;
}
__device__ __forceinline__ void xcd_barrier(const XcdBarrier& b) {
    asm volatile("s_waitcnt vmcnt(0)" ::: "memory");
    __syncthreads();
    if (threadIdx.x == 0) {
        unsigned* bar = b.bar;
        __builtin_amdgcn_s_waitcnt(0);
        unsigned nloc = b.st[0], nx = b.st[1];
        if (nloc == 0u) { xcd_barrier_complete(bar, b.x, nloc, nx); b.st[0] = nloc; b.st[1] = nx; }
        const unsigned old = xb_add(&bar[XB_XSUB(b.x)], 1u);
        const unsigned gen = old / nloc;
        if (old + 1u == (gen + 1u) * nloc) {
            __builtin_amdgcn_fence(__ATOMIC_RELEASE, "agent");
            asm volatile("s_waitcnt vmcnt(0)" ::: "memory");
            const unsigned og = xb_add(&bar[XB_TOP], 1u);
            const unsigned tg = og / nx;
            if (og + 1u == (tg + 1u) * nx) xb_add(&bar[XB_TOPGEN], 1u);
            else XB_SPIN(xb_ld(&bar[XB_TOPGEN]) == tg, bar);
            __builtin_amdgcn_fence(__ATOMIC_ACQUIRE, "agent");
            xb_add(&bar[XB_XGEN(b.x)], 1u);
            asm volatile("s_waitcnt vmcnt(0)" ::: "memory");
        } else {
            XB_SPIN(xb_ld(&bar[XB_XGEN(b.x)]) == gen, bar);
            __builtin_amdgcn_fence(__ATOMIC_ACQUIRE, "agent");
            asm volatile("s_waitcnt vmcnt(0)" ::: "memory");
        }
    }
    __syncthreads();
}

struct Args { const float* in[28]; float* out; unsigned char* ws; int ph_lo, ph_hi; };

struct Frame {
    LAS unsigned char* lds; unsigned char* ws; unsigned* ctl;
    int tid, lane, wave, G, bx;
    __device__ __forceinline__ Frame fresh() const { Frame f = *this; int t = threadIdx.x; asm volatile("" : "+v"(t)); f.tid = t; f.lane = t & 63; return f; }
};

__device__ __forceinline__ int dmap(int type, int n) {
    if (type == 1) return n < 2048 ? n : (n < 2064 ? n - 2048 + UG_LOW : n - 16);
    if (type == 2) return (n >> 7) * 256 + (n & 127);
    if (type == 3) return (n >> 7) * 256 + 128 + (n & 127);
    return n;
}
__device__ __forceinline__ void transpose_item(const float* W, int ldw, int ncols, int k0, int n0, const float* kscale, bf16_t* WT, int ldt, int type, LAS float* scr, int lane) {
    const int n4 = (lane & 15) * 4, kr = lane >> 4; const bool okc = (n0 + n4) < ncols;
    f32x4 v[16];
#pragma unroll
    for (int i = 0; i < 16; ++i) v[i] = okc ? __builtin_nontemporal_load((const f32x4*)(W + (size_t)(k0 + 4 * i + kr) * ldw + n0 + n4)) : (f32x4){0.f, 0.f, 0.f, 0.f};
    if (kscale) {
#pragma unroll
        for (int i = 0; i < 16; ++i) v[i] = v[i] * kscale[k0 + 4 * i + kr]; }
#pragma unroll
    for (int i = 0; i < 16; ++i) { LAS float* s = scr + (4 * i + kr) * 65 + n4; s[0] = v[i][0]; s[1] = v[i][1]; s[2] = v[i][2]; s[3] = v[i][3]; }
    LDS_WAIT(); asm volatile("" ::: "memory");
    const int c = lane & 7;
#pragma unroll
    for (int j = 0; j < 8; ++j) { const int n = (lane >> 3) + 8 * j; const LAS float* s = scr + (8 * c) * 65 + n;
        u32x4 o; o.x = pk2(s[0 * 65], s[1 * 65]); o.y = pk2(s[2 * 65], s[3 * 65]); o.z = pk2(s[4 * 65], s[5 * 65]); o.w = pk2(s[6 * 65], s[7 * 65]);
        if (n0 + n < ncols) *(u32x4*)(WT + (size_t)dmap(type, n0 + n) * ldt + k0 + 8 * c) = o; }
    LDS_WAIT(); asm volatile("" ::: "memory");
}
__device__ __forceinline__ int t5_bucket(int d) {
    if (d < 16) return d;
    const float v = logf((float)d / 16.0f) / 4.852030263919617f * 16.0f;
    int b = 16 + (int)v; return b < 31 ? b : 31;
}
constexpr int I_IN = 32 * 89, I_OUT = 32 * 32, I_PP = 4 * 32, I_PG = 32 * 32, I_G = 32 * 128, I_U = 32 * 128, I_D = 32 * 128;
constexpr int IO_OUT = I_IN, IO_PP = IO_OUT + I_OUT, IO_PG = IO_PP + I_PP, IO_G = IO_PG + I_PG, IO_U = IO_G + I_G, IO_D = IO_U + I_U, I_L = IO_D + I_D;
__device__ __forceinline__ void conv_items(const Frame& F, const Args& a, const int l, const int lo, const int hi, const int gw, const int NGW) {
    LAS float* scr = (LAS float*)(F.lds + F.wave * 16640);
    bf16_t* WIN = (bf16_t*)(F.ws + WS_WIN); bf16_t* WOUT = (bf16_t*)(F.ws + WS_WOUT); bf16_t* WGU = (bf16_t*)(F.ws + WS_WGU); bf16_t* WD = (bf16_t*)(F.ws + WS_WD);
    bf16_t* WPG = (bf16_t*)(F.ws + WS_WPG); bf16_t* WPP = (bf16_t*)(F.ws + WS_WPP);
    for (int it = lo + gw; it < hi; it += NGW) {
        int r = it;
        if (r < IO_OUT) { const int kb = r / 89, nb = r - kb * 89; transpose_item(a.in[2] + (size_t)l * DM * DIN, DIN, DIN, kb * 64, nb * 64, nullptr, WIN + (size_t)l * DINP * DM, DM, 1, scr, F.lane); continue; }
        if (r < IO_PP) { r -= IO_OUT; const int kb = r >> 5, nb = r & 31; transpose_item(a.in[12] + (size_t)l * DM * DM, DM, DM, kb * 64, nb * 64, a.in[11] + l * DM, WOUT + (size_t)l * DM * DM, DM, 0, scr, F.lane); continue; }
        if (r < IO_PG) { r -= IO_PP; const int kb = r >> 5, nb = r & 31; transpose_item(a.in[25] + (size_t)l * PLE * DM, DM, DM, kb * 64, nb * 64, nullptr, WPP + (size_t)l * DM * PLE, PLE, 0, scr, F.lane); continue; }
        if (r < IO_G) { r -= IO_PG; const int kb = r >> 5, nb = r & 31; transpose_item(a.in[23] + (size_t)l * DM * DM, DM, DM, kb * 64, nb * 64, nullptr, WPG + (size_t)l * DM * DM, DM, 0, scr, F.lane); continue; }
        if (r < IO_U) { r -= IO_G; const int e = r >> 7, q = r & 127, kb = q >> 2, nb = q & 3; transpose_item(a.in[20] + (size_t)(l * NEXP + e) * DM * DEXP, DEXP, DEXP, kb * 64, nb * 64, nullptr, WGU + (size_t)(l * NEXP + e) * 512 * DM, DM, 2, scr, F.lane); continue; }
        if (r < IO_D) { r -= IO_U; const int e = r >> 7, q = r & 127, kb = q >> 2, nb = q & 3; transpose_item(a.in[21] + (size_t)(l * NEXP + e) * DM * DEXP, DEXP, DEXP, kb * 64, nb * 64, nullptr, WGU + (size_t)(l * NEXP + e) * 512 * DM, DM, 3, scr, F.lane); continue; }
        { r -= IO_D; const int e = r >> 7, q = r & 127, kb = q >> 5, nb = q & 31; transpose_item(a.in[22] + (size_t)(l * NEXP + e) * DEXP * DM, DM, DM, kb * 64, nb * 64, nullptr, WD + (size_t)(l * NEXP + e) * DM * DEXP, DEXP, 0, scr, F.lane); }
    }
}
__device__ __forceinline__ void conv_all(const Frame& F, const Args& a, const int l, const int lo, const int hi) { __syncthreads(); conv_items(F, a, l, lo, hi, F.bx * 8 + F.wave, F.G * 8); __syncthreads(); }
__device__ __forceinline__ void phase_prologue(const Frame& F, const Args& a) {
    bf16_t* WIN = (bf16_t*)(F.ws + WS_WIN);
    conv_all(F, a, 0, 0, I_L);
    const size_t gt = (size_t)F.bx * 512 + F.tid, NT = (size_t)F.G * 512;
    for (size_t i = gt; i < (size_t)NL * (DINP - DIN) * DM / 8; i += NT) { const size_t l = i / ((DINP - DIN) * DM / 8), r = i % ((DINP - DIN) * DM / 8);
        *(u32x4*)(WIN + (l * DINP + DIN) * DM + r * 8) = (u32x4){0u, 0u, 0u, 0u}; }
    { const float* x = a.in[0]; bf16_t* XB = (bf16_t*)(F.ws + WS_XB);
      for (size_t i = gt; i < (size_t)MT * DM / 8; i += NT) { const f32x4 v0 = *(const f32x4*)(x + i * 8), v1 = *(const f32x4*)(x + i * 8 + 4);
          *(u32x4*)(XB + i * 8) = (u32x4){pk2(v0[0], v0[1]), pk2(v0[2], v0[3]), pk2(v1[0], v1[1]), pk2(v1[2], v1[3])}; } }
    { const float* p = a.in[1]; bf16_t* PB = (bf16_t*)(F.ws + WS_PB);
      for (size_t i = gt; i < (size_t)NL * MT * PLE / 8; i += NT) { const f32x4 v0 = *(const f32x4*)(p + i * 8), v1 = *(const f32x4*)(p + i * 8 + 4);
          *(u32x4*)(PB + i * 8) = (u32x4){pk2(v0[0], v0[1]), pk2(v0[2], v0[3]), pk2(v1[0], v1[1]), pk2(v1[2], v1[3])}; } }
    { float* bt = (float*)(F.ws + WS_BTAB); const float* rb = a.in[13];
      for (size_t i = gt; i < 3 * 129 * 8; i += NT) { const int h = (int)(i & 7), j = (int)((i >> 3) % 129), br = (int)((i >> 3) / 129); const int dil = br == 0 ? 1 : (br == 1 ? 4 : 16);
          bt[i] = rb[t5_bucket(j * dil) * 8 + h]; } }
    { float* wrt = (float*)(F.ws + WS_WRT);
      for (size_t i = gt; i < (size_t)NL * 36 * DM; i += NT) { const int c = (int)(i % DM), col = (int)((i / DM) % 36), l = (int)(i / (36 * DM));
          wrt[i] = col < 4 ? a.in[16][((size_t)l * DM + c) * 4 + col] : a.in[18][((size_t)l * DM + c) * 32 + (col - 4)]; } }
}

__device__ __forceinline__ void conv_unit(const Frame& F, const Args& a, int l, int unit) {
    const bf16_t* U = (const bf16_t*)(F.ws + WS_U); bf16_t* MIX = (bf16_t*)(F.ws + WS_MIX);
    LAS float* hb = (LAS float*)F.lds;
    const int t0 = unit * 32, tl0 = t0 & (SEQ - 1), tb = t0 - tl0;
    const int tid = F.tid;
    __syncthreads();
#pragma unroll 1
    for (int i = 0; i < 8; ++i) { const int id = tid + 512 * i; if (id < 62 * 64) { const int row = id >> 6, ch = (id & 63) * 8; const int tl = tl0 - 30 + row;
        float o[8];
        if (tl >= 0) { const bf16_t* up = U + (size_t)(tb + tl) * DINP; const u32x4 av = *(const u32x4*)(up + UA_VAL + ch), gv = *(const u32x4*)(up + UA_GATE + ch);
            const unsigned aw[4] = {av.x, av.y, av.z, av.w}, gw[4] = {gv.x, gv.y, gv.z, gv.w};
#pragma unroll
            for (int j = 0; j < 4; ++j) { o[2 * j] = bflo(aw[j]) * sigmoidf_(bflo(gw[j])); o[2 * j + 1] = bfhi(aw[j]) * sigmoidf_(bfhi(gw[j])); } }
        else {
#pragma unroll
            for (int j = 0; j < 8; ++j) o[j] = 0.f; }
        *(LAS f32x4*)(hb + row * 512 + ch) = (f32x4){o[0], o[1], o[2], o[3]}; *(LAS f32x4*)(hb + row * 512 + ch + 4) = (f32x4){o[4], o[5], o[6], o[7]}; } }
    __syncthreads();
    float yv[32];
    { const int c = tid; const float* w = a.in[3] + (size_t)l * 31 * 512; const float bias = a.in[4][l * 512 + c];
      float wv[31];
#pragma unroll
      for (int j = 0; j < 31; ++j) wv[j] = w[j * 512 + c];
      float hv[62];
#pragma unroll
      for (int r = 0; r < 62; ++r) hv[r] = hb[r * 512 + c];
#pragma unroll
      for (int t = 0; t < 32; ++t) { float s = bias;
#pragma unroll
          for (int j = 0; j < 31; ++j) s += wv[j] * hv[t + j];
          yv[t] = s; } }
    __syncthreads();
#pragma unroll
    for (int t = 0; t < 32; ++t) hb[t * 512 + tid] = yv[t];
    __syncthreads();
    { const float* lg = a.in[5] + l * 512; const float* lb = a.in[6] + l * 512;
#pragma unroll 1
      for (int i = 0; i < 4; ++i) { const int t = F.wave + 8 * i;
          const f32x4 v0 = *(const LAS f32x4*)(hb + t * 512 + 4 * F.lane), v1 = *(const LAS f32x4*)(hb + t * 512 + 256 + 4 * F.lane);
          const float mean = wave_sum((v0[0] + v0[1]) + (v0[2] + v0[3]) + (v1[0] + v1[1]) + (v1[2] + v1[3])) * (1.f / 512.f);
          const f32x4 d0 = v0 - mean, d1 = v1 - mean;
          const float var = wave_sum((d0[0] * d0[0] + d0[1] * d0[1]) + (d0[2] * d0[2] + d0[3] * d0[3]) + (d1[0] * d1[0] + d1[1] * d1[1]) + (d1[2] * d1[2] + d1[3] * d1[3])) * (1.f / 512.f);
          const float rstd = 1.0f / sqrtf(var + LN_EPS);
          const f32x4 g0 = *(const f32x4*)(lg + 4 * F.lane), g1 = *(const f32x4*)(lg + 256 + 4 * F.lane), b0 = *(const f32x4*)(lb + 4 * F.lane), b1 = *(const f32x4*)(lb + 256 + 4 * F.lane);
          float o0[4], o1[4];
#pragma unroll
          for (int j = 0; j < 4; ++j) { o0[j] = siluf_(d0[j] * rstd * g0[j] + b0[j]); o1[j] = siluf_(d1[j] * rstd * g1[j] + b1[j]); }
          bf16_t* mp = MIX + (size_t)(t0 + t) * DM;
          *(u32x2*)(mp + 4 * F.lane) = (u32x2){pk2(o0[0], o0[1]), pk2(o0[2], o0[3])}; *(u32x2*)(mp + 256 + 4 * F.lane) = (u32x2){pk2(o1[0], o1[1]), pk2(o1[2], o1[3])}; } }
    { const int c = tid; const float* w = a.in[10] + (size_t)l * 3 * 512; const float w0 = w[c], w1 = w[512 + c], w2 = w[1024 + c];
      float p2 = 0.f, p1 = 0.f;
      if (tl0 >= 2) { const bf16_t* up = U + (size_t)(t0 - 2) * DINP; p2 = bf2f(up[US_C + c]) * bf2f(up[US_H + c]); }
      if (tl0 >= 1) { const bf16_t* up = U + (size_t)(t0 - 1) * DINP; p1 = bf2f(up[US_C + c]) * bf2f(up[US_H + c]); }
#pragma unroll 4
      for (int t = 0; t < 32; ++t) { const bf16_t* up = U + (size_t)(t0 + t) * DINP; const float p0 = bf2f(up[US_C + c]) * bf2f(up[US_H + c]);
          const float y = bf2f(up[US_B + c]) * (w0 * p2 + w1 * p1 + w2 * p0);
          MIX[(size_t)(t0 + t) * DM + 1536 + c] = (bf16_t)f2bf(y); p2 = p1; p1 = p0; } }
}

__device__ __forceinline__ void gla_a_unit(const Frame& F, const Args& a, int l, int unit) {
    const bf16_t* U = (const bf16_t*)(F.ws + WS_U);
    float* GU = (float*)(F.ws + WS_GU); float* GO = (float*)(F.ws + WS_GO); float* GQ = (float*)(F.ws + WS_GQ); float* GD = (float*)(F.ws + WS_GD);
    const int n = unit & 63, h = (unit >> 6) & 3, b = unit >> 8, bh = b * 4 + h;
    const int t0 = b * SEQ + n * 32, tid = F.tid;
    LAS float* L = (LAS float*)F.lds;
    LAS float* qt = L; LAS float* kr = L + 2048; LAS float* kt = L + 4096; LAS float* kh = L + 6144; LAS float* vv = L + 8192; LAS float* bc = L + 12288; LAS float* gl = L + 14336; LAS float* wg = L + 14848; LAS float* sc = L + 15872;
    const int i = tid >> 4, k4 = (tid & 15) * 4, v8 = (tid & 15) * 8;
    __syncthreads();
    { const bf16_t* up = U + (size_t)(t0 + i) * DINP;
      const u32x2 qw = *(const u32x2*)(up + UG_Q + h * 64 + k4), kw = *(const u32x2*)(up + UG_K + h * 64 + k4); const u32x4 vw = *(const u32x4*)(up + UG_V + h * 128 + v8);
      *(LAS f32x4*)(qt + i * 64 + k4) = (f32x4){bflo(qw.x), bfhi(qw.x), bflo(qw.y), bfhi(qw.y)};
      *(LAS f32x4*)(kr + i * 64 + k4) = (f32x4){bflo(kw.x), bfhi(kw.x), bflo(kw.y), bfhi(kw.y)};
      *(LAS f32x4*)(vv + i * 128 + v8) = (f32x4){bflo(vw.x), bfhi(vw.x), bflo(vw.y), bfhi(vw.y)}; *(LAS f32x4*)(vv + i * 128 + v8 + 4) = (f32x4){bflo(vw.z), bfhi(vw.z), bflo(vw.w), bfhi(vw.w)};
      gl[i * 16 + (tid & 15)] = bf2f(up[UG_LOW + (tid & 15)]);
      const float* w2 = a.in[7] + (size_t)l * 16 * 256;
      wg[tid] = w2[(tid >> 6) * 256 + h * 64 + (tid & 63)]; wg[512 + tid] = w2[(8 + (tid >> 6)) * 256 + h * 64 + (tid & 63)]; }
    __syncthreads();
    { const f32x4 bg = *(const f32x4*)(a.in[8] + l * 256 + h * 64 + k4); f32x4 z = bg;
#pragma unroll
      for (int r = 0; r < 16; ++r) { const float g = gl[i * 16 + r]; const f32x4 w = *(const LAS f32x4*)(wg + r * 64 + k4); z = z + w * g; }
      f32x4 la;
#pragma unroll
      for (int j = 0; j < 4; ++j) la[j] = (fminf(z[j], 0.f) - log1pf(expf(-fabsf(z[j])))) * (1.0f / 16.0f);
      *(LAS f32x4*)(bc + i * 64 + k4) = la; }
    __syncthreads();
    f32x4 bv = {0.f, 0.f, 0.f, 0.f}, bl = bv;
#pragma unroll 8
    for (int r = 0; r < 32; ++r) { const f32x4 x = *(const LAS f32x4*)(bc + r * 64 + k4); bl = bl + x; if (r <= i) bv = bv + x; }
    { const f32x4  q = *(const LAS f32x4*)(qt + i * 64 + k4), k = *(const LAS f32x4*)(kr + i * 64 + k4);
      f32x4 qo, ko, ho;
#pragma unroll
      for (int j = 0; j < 4; ++j) { qo[j] = q[j] * expf(bv[j]) * 0.125f; ko[j] = k[j] * expf(-bv[j]); ho[j] = k[j] * expf(bl[j] - bv[j]); }
      *(LAS f32x4*)(qt + i * 64 + k4) = qo; *(LAS f32x4*)(kt + i * 64 + k4) = ko; *(LAS f32x4*)(kh + i * 64 + k4) = ho;
      *(f32x4*)(GQ + (size_t)(t0 + i) * 256 + h * 64 + k4) = qo;
      if (i == 31) { f32x4 d;
#pragma unroll
          for (int j = 0; j < 4; ++j) d[j] = expf(bl[j]);
          *(f32x4*)(GD + ((size_t)bh * 64 + n) * 64 + k4) = d; } }
    __syncthreads();
    { const int j0 = (tid & 15) * 2; float s0 = 0.f, s1 = 0.f;
#pragma unroll
      for (int k = 0; k < 64; k += 4) { const f32x4 q = *(const LAS f32x4*)(qt + i * 64 + k), ka = *(const LAS f32x4*)(kt + j0 * 64 + k), kb = *(const LAS f32x4*)(kt + (j0 + 1) * 64 + k);
          s0 += (q[0] * ka[0] + q[1] * ka[1]) + (q[2] * ka[2] + q[3] * ka[3]); s1 += (q[0] * kb[0] + q[1] * kb[1]) + (q[2] * kb[2] + q[3] * kb[3]); }
      sc[i * 33 + j0] = (j0 <= i) ? s0 : 0.f; sc[i * 33 + j0 + 1] = (j0 + 1 <= i) ? s1 : 0.f; }
    { const int kk = (tid >> 5) * 4, v0 = (tid & 31) * 4; f32x4 u0 = {0.f, 0.f, 0.f, 0.f}, u1 = u0, u2 = u0, u3 = u0;
#pragma unroll 8
      for (int j = 0; j < 32; ++j) { const f32x4 kv = *(const LAS f32x4*)(kh + j * 64 + kk), vx = *(const LAS f32x4*)(vv + j * 128 + v0);
          u0 = u0 + vx * kv[0]; u1 = u1 + vx * kv[1]; u2 = u2 + vx * kv[2]; u3 = u3 + vx * kv[3]; }
      float* gp = GU + (((size_t)bh * 64 + n) * 64 + kk) * 128 + v0;
      *(f32x4*)(gp) = u0; *(f32x4*)(gp + 128) = u1; *(f32x4*)(gp + 256) = u2; *(f32x4*)(gp + 384) = u3; }
    __syncthreads();
    { f32x4 o0 = {0.f, 0.f, 0.f, 0.f}, o1 = o0;
#pragma unroll 8
      for (int j = 0; j < 32; ++j) { const float s = sc[i * 33 + j]; const f32x4 va = *(const LAS f32x4*)(vv + j * 128 + v8), vb = *(const LAS f32x4*)(vv + j * 128 + v8 + 4); o0 = o0 + va * s; o1 = o1 + vb * s; }
      float* gp = GO + (size_t)(t0 + i) * 512 + h * 128 + v8; *(f32x4*)gp = o0; *(f32x4*)(gp + 4) = o1; }
}
__device__ __forceinline__ void gla_scan(const Frame& F) {
    float* GU = (float*)(F.ws + WS_GU); const float* GD = (const float*)(F.ws + WS_GD);
    for (int g = F.bx * 512 + F.tid; g < 16 * 8192; g += F.G * 512) { const int bh = g >> 13, kv = g & 8191, k = kv >> 7;
        float* p = GU + (size_t)bh * 64 * 8192 + kv; const float* d = GD + (size_t)bh * 64 * 64 + k; float S = 0.f;
#pragma unroll 8
        for (int n = 0; n < 64; ++n) { const float u = p[(size_t)n * 8192]; const float dc = d[n * 64]; p[(size_t)n * 8192] = S; S = S * dc + u; } }
}
__device__ __forceinline__ void gla_c_unit(const Frame& F, const Args& a, int l, int unit) {
    const bf16_t* U = (const bf16_t*)(F.ws + WS_U); bf16_t* MIX = (bf16_t*)(F.ws + WS_MIX);
    const float* GU = (const float*)(F.ws + WS_GU); const float* GO = (const float*)(F.ws + WS_GO); const float* GQ = (const float*)(F.ws + WS_GQ);
    const int n = unit & 63, h = (unit >> 6) & 3, b = unit >> 8, bh = b * 4 + h;
    const int t0 = b * SEQ + n * 32, tid = F.tid;
    LAS float* qt = (LAS float*)F.lds; LAS float* Ss = qt + 2048;
    const int i = tid >> 4, k4 = (tid & 15) * 4, v8 = (tid & 15) * 8;
    __syncthreads();
    *(LAS f32x4*)(qt + i * 64 + k4) = *(const f32x4*)(GQ + (size_t)(t0 + i) * 256 + h * 64 + k4);
    { const float* sp = GU + ((size_t)bh * 64 + n) * 8192;
#pragma unroll
      for (int j = 0; j < 4; ++j) *(LAS f32x4*)(Ss + (tid + 512 * j) * 4) = *(const f32x4*)(sp + (tid + 512 * j) * 4); }
    __syncthreads();
    const float* gp = GO + (size_t)(t0 + i) * 512 + h * 128 + v8;
    f32x4 o0 = *(const f32x4*)gp, o1 = *(const f32x4*)(gp + 4);
#pragma unroll 8
    for (int k = 0; k < 64; ++k) { const float q = qt[i * 64 + k]; const f32x4 sa = *(const LAS f32x4*)(Ss + k * 128 + v8), sb = *(const LAS f32x4*)(Ss + k * 128 + v8 + 4); o0 = o0 + sa * q; o1 = o1 + sb * q; }
    float ss = (o0[0] * o0[0] + o0[1] * o0[1]) + (o0[2] * o0[2] + o0[3] * o0[3]) + (o1[0] * o1[0] + o1[1] * o1[1]) + (o1[2] * o1[2] + o1[3] * o1[3]);
    ss += __shfl_xor(ss, 1); ss += __shfl_xor(ss, 2); ss += __shfl_xor(ss, 4); ss += __shfl_xor(ss, 8);
    const float rms = 1.0f / sqrtf(ss * (1.f / 128.f) + RMS_EPS);
    const float* ng = a.in[9] + l * 128 + v8; const f32x4 n0 = *(const f32x4*)ng, n1 = *(const f32x4*)(ng + 4);
    const u32x4 rw = *(const u32x4*)(U + (size_t)(t0 + i) * DINP + UG_R + h * 128 + v8);
    const float r[8] = {bflo(rw.x), bfhi(rw.x), bflo(rw.y), bfhi(rw.y), bflo(rw.z), bfhi(rw.z), bflo(rw.w), bfhi(rw.w)};
    float o[8];
#pragma unroll
    for (int j = 0; j < 4; ++j) { o[j] = o0[j] * rms * n0[j] * siluf_(r[j]); o[4 + j] = o1[j] * rms * n1[j] * siluf_(r[4 + j]); }
    *(u32x4*)(MIX + (size_t)(t0 + i) * DM + 512 + h * 128 + v8) = (u32x4){pk2(o[0], o[1]), pk2(o[2], o[3]), pk2(o[4], o[5]), pk2(o[6], o[7])};
}

typedef short s16x4 __attribute__((ext_vector_type(4)));
__device__ __forceinline__ s16x4 vtr(const LAS unsigned char* p) { return __builtin_bit_cast(s16x4, __builtin_amdgcn_ds_read_tr16_b64_v4i16((LAS s16x4*)p)); }
constexpr int AT_VROW = 160, AT_VBUF = 32 * AT_VROW;
__device__ __forceinline__ void attn_job(const Frame& F, int job, LAS unsigned char* vbuf, const LAS float* bt) {
    const bf16_t* U = (const bf16_t*)(F.ws + WS_U); bf16_t* AO = (bf16_t*)(F.ws + WS_AO); float* ALSE = (float*)(F.ws + WS_ALSE);
    const int lane = F.lane, qi = lane & 15, g = lane >> 4;
    const int gidx = job & 127, t2 = job >> 7, br = t2 % 3, bh = t2 / 3, h = bh & 7, b = bh >> 3;
    const int dsh = 2 * br, dil = 1 << dsh, gsh = 7 - dsh, r = gidx >> gsh, gi = gidx & ((1 << gsh) - 1);
    const int q0 = gi * 16, tb = b * SEQ;
    const bf16_t* Ub = U + (size_t)(tb + r) * DINP + h * 64;
    const size_t sstep = (size_t)dil * DINP;
    const bf16_t* qrow = Ub + (size_t)(q0 + qi) * sstep + UC_Q + 8 * g;
    const bf16x8 qf0 = *(const bf16x8*)qrow, qf1 = *(const bf16x8*)(qrow + 32);
    const int klo = (q0 >= 128 ? q0 - 128 : 0) & ~31;
    const int nch = ((q0 + 15 - klo) >> 5) + 1;
    float m_run = -1e30f, l_part = 0.f;
    f32x4 o[4];
#pragma unroll
    for (int d = 0; d < 4; ++d) o[d] = (f32x4){0.f, 0.f, 0.f, 0.f};
    bf16x8 ka0, ka1, kb0, kb1; u32x4 vr[4];
#define AT_LOAD(kc) do { const bf16_t* kp = Ub + (size_t)((kc) + qi) * sstep + UC_K + 8 * g; ka0 = *(const bf16x8*)kp; ka1 = *(const bf16x8*)(kp + 32); kp += 16 * sstep; kb0 = *(const bf16x8*)kp; kb1 = *(const bf16x8*)(kp + 32); \
        const bf16_t* vp = Ub + (size_t)((kc) + (lane >> 3)) * sstep + UC_V + (lane & 7) * 8; _Pragma("unroll") for (int it = 0; it < 4; ++it) vr[it] = *(const u32x4*)(vp + (size_t)(8 * it) * sstep); } while (0)
    AT_LOAD(klo);
#pragma unroll 1
    for (int c = 0; c < nch; ++c) {
        const int kc = klo + 32 * c;
        LAS unsigned char* vb = vbuf + (c & 1) * AT_VBUF;
#pragma unroll
        for (int it = 0; it < 4; ++it) *(LAS u32x4*)(vb + (it * 8 + (lane >> 3)) * AT_VROW + (lane & 7) * 16) = vr[it];
        const bf16x8 ca0 = ka0, ca1 = ka1, cb0 = kb0, cb1 = kb1;
        if (c + 1 < nch) AT_LOAD(kc + 32);
        f32x4 sa = (f32x4){0.f, 0.f, 0.f, 0.f}, sb = sa;
        sa = __builtin_amdgcn_mfma_f32_16x16x32_bf16(ca0, qf0, sa, 0, 0, 0); sa = __builtin_amdgcn_mfma_f32_16x16x32_bf16(ca1, qf1, sa, 0, 0, 0);
        sb = __builtin_amdgcn_mfma_f32_16x16x32_bf16(cb0, qf0, sb, 0, 0, 0); sb = __builtin_amdgcn_mfma_f32_16x16x32_bf16(cb1, qf1, sb, 0, 0, 0);
        const int st0 = (q0 + qi) - (kc + 4 * g);
        float cmax = -1e30f;
#pragma unroll
        for (int rr = 0; rr < 4; ++rr) {
            const int sA = st0 - rr, sB = st0 - rr - 16;
            const int iA = sA < 0 ? 0 : (sA > 128 ? 128 : sA), iB = sB < 0 ? 0 : (sB > 128 ? 128 : sB);
            const float vA = sa[rr] * 0.125f + bt[(br * 129 + iA) * 8 + h], vB = sb[rr] * 0.125f + bt[(br * 129 + iB) * 8 + h];
            sa[rr] = (sA >= 0 && sA <= 128) ? vA : -1e30f; sb[rr] = (sB >= 0 && sB <= 128) ? vB : -1e30f;
            cmax = fmaxf(cmax, fmaxf(sa[rr], sb[rr])); }
        cmax = fmaxf(cmax, __shfl_xor(cmax, 16)); cmax = fmaxf(cmax, __shfl_xor(cmax, 32));
        const float m_new = fmaxf(m_run, cmax), alpha = __expf(m_run - m_new);
        float psum = 0.f;
#pragma unroll
        for (int rr = 0; rr < 4; ++rr) { sa[rr] = __expf(sa[rr] - m_new); sb[rr] = __expf(sb[rr] - m_new); psum += sa[rr] + sb[rr]; }
        l_part = l_part * alpha + psum; m_run = m_new;
#pragma unroll
        for (int d = 0; d < 4; ++d) o[d] = o[d] * alpha;
        const u32x4 pw = (u32x4){pk2(sa[0], sa[1]), pk2(sa[2], sa[3]), pk2(sb[0], sb[1]), pk2(sb[2], sb[3])};
        const bf16x8 pf = __builtin_bit_cast(bf16x8, pw);
        const LAS unsigned char* tp = vb + (4 * g + (qi >> 2)) * AT_VROW + (qi & 3) * 8;
#pragma unroll
        for (int d = 0; d < 4; ++d) { const s16x4 va = vtr(tp + d * 32), vb2 = vtr(tp + 16 * AT_VROW + d * 32);
            const bf16x8 vf = (bf16x8){va[0], va[1], va[2], va[3], vb2[0], vb2[1], vb2[2], vb2[3]};
            o[d] = __builtin_amdgcn_mfma_f32_16x16x32_bf16(vf, pf, o[d], 0, 0, 0); }
    }
#undef AT_LOAD
    float l = l_part; l += __shfl_xor(l, 16); l += __shfl_xor(l, 32);
    const float inv = 1.0f / l;
    const int token = tb + (q0 + qi) * dil + r;
    bf16_t* op = AO + ((size_t)br * MT + token) * 512 + h * 64 + 4 * g;
#pragma unroll
    for (int d = 0; d < 4; ++d) *(u32x2*)(op + d * 16) = (u32x2){pk2(o[d][0] * inv, o[d][1] * inv), pk2(o[d][2] * inv, o[d][3] * inv)};
    if (g == 0) ALSE[((size_t)br * MT + token) * 8 + h] = m_run + logf(l);
}
__device__ __forceinline__ void attn_combine(const Frame& F) {
    const bf16_t* AO = (const bf16_t*)(F.ws + WS_AO); const float* ALSE = (const float*)(F.ws + WS_ALSE); bf16_t* MIX = (bf16_t*)(F.ws + WS_MIX);
    for (int i = F.bx * 512 + F.tid; i < MT * 64; i += F.G * 512) { const int token = i >> 6, c8 = (i & 63) * 8, h = c8 >> 6;
        const float l0 = ALSE[(size_t)token * 8 + h], l1 = ALSE[((size_t)MT + token) * 8 + h], l2 = ALSE[((size_t)2 * MT + token) * 8 + h];
        const float m = fmaxf(l0, fmaxf(l1, l2)); float w0 = __expf(l0 - m), w1 = __expf(l1 - m), w2 = __expf(l2 - m); const float inv = 1.0f / (w0 + w1 + w2); w0 *= inv; w1 *= inv; w2 *= inv;
        const u32x4 a = *(const u32x4*)(AO + (size_t)token * 512 + c8), bq = *(const u32x4*)(AO + ((size_t)MT + token) * 512 + c8), cq = *(const u32x4*)(AO + ((size_t)2 * MT + token) * 512 + c8);
        const unsigned aw[4] = {a.x, a.y, a.z, a.w}, bw[4] = {bq.x, bq.y, bq.z, bq.w}, cw[4] = {cq.x, cq.y, cq.z, cq.w}; unsigned ow[4];
#pragma unroll
        for (int j = 0; j < 4; ++j) ow[j] = pk2(w0 * bflo(aw[j]) + w1 * bflo(bw[j]) + w2 * bflo(cw[j]), w0 * bfhi(aw[j]) + w1 * bfhi(bw[j]) + w2 * bfhi(cw[j]));
        *(u32x4*)(MIX + (size_t)token * DM + 1024 + c8) = (u32x4){ow[0], ow[1], ow[2], ow[3]}; }
}

__device__ __forceinline__ void ln1_unit(const Frame& F, const Args& a, int l, int unit, float* X1F, bool commit) {
    const float* PRE = (const float*)(F.ws + WS_PRE); bf16_t* XB = (bf16_t*)(F.ws + WS_XB); const float* wrt = (const float*)(F.ws + WS_WRT) + (size_t)l * 36 * DM;
    int* ltok = (int*)(F.ws + WS_LTOK); float* lgate = (float*)(F.ws + WS_LGATE); int* tinfo = (int*)(F.ws + WS_TINFO); unsigned* cnt = F.ctl + CW_CNT + l * 32 * 64;
    LAS float* Wl = (LAS float*)F.lds;
    const int lane = F.lane, tid = F.tid, row0 = unit * 16 + F.wave * 2;
    const float* g = a.in[14] + (size_t)l * DM; const float* bb = a.in[15] + (size_t)l * DM;
    f32x4 wreg[5];
#pragma unroll
    for (int i = 0; i < 5; ++i) { const int idx = tid + 512 * i; if (idx < 36 * 64) wreg[i] = *(const f32x4*)(wrt + (size_t)(idx >> 6) * DM + (idx & 63) * 4); }
#pragma unroll 1
    for (int r = 0; r < 2; ++r) { const int row = row0 + r; const float* pr = PRE + (size_t)row * DM; f32x4 v[8]; float s = 0.f;
#pragma unroll
      for (int j = 0; j < 8; ++j) { v[j] = *(const f32x4*)(pr + 256 * j + 4 * lane); s += (v[j][0] + v[j][1]) + (v[j][2] + v[j][3]); }
      const float mean = wave_sum(s) * (1.f / DM); float q = 0.f;
#pragma unroll
      for (int j = 0; j < 8; ++j) { v[j] = v[j] - mean; q += (v[j][0] * v[j][0] + v[j][1] * v[j][1]) + (v[j][2] * v[j][2] + v[j][3] * v[j][3]); }
      const float rstd = 1.0f / sqrtf(wave_sum(q) * (1.f / DM) + LN_EPS);
#pragma unroll
      for (int j = 0; j < 8; ++j) { const f32x4 gv = *(const f32x4*)(g + 256 * j + 4 * lane), bv = *(const f32x4*)(bb + 256 * j + 4 * lane); const f32x4 y = v[j] * rstd * gv + bv;
          *(f32x4*)(X1F + (size_t)row * DM + 256 * j + 4 * lane) = y; *(u32x2*)(XB + (size_t)row * DM + 256 * j + 4 * lane) = (u32x2){pk2(y[0], y[1]), pk2(y[2], y[3])}; } }
    asm volatile("s_waitcnt vmcnt(0)" ::: "memory");
    float acc[2][36];
#pragma unroll
    for (int r = 0; r < 2; ++r)
#pragma unroll
        for (int c = 0; c < 36; ++c) acc[r][c] = 0.f;
    __syncthreads();
#pragma unroll 1
    for (int j = 0; j < 8; ++j) {
        LAS float* Wb = Wl + (j & 1) * (36 * 256);
#pragma unroll
        for (int i = 0; i < 5; ++i) { const int idx = tid + 512 * i; if (idx < 36 * 64) *(LAS f32x4*)(Wb + (idx >> 6) * 256 + (idx & 63) * 4) = wreg[i]; }
        __syncthreads();
        if (j < 7) {
#pragma unroll
            for (int i = 0; i < 5; ++i) { const int idx = tid + 512 * i; if (idx < 36 * 64) wreg[i] = *(const f32x4*)(wrt + (size_t)(idx >> 6) * DM + 256 * (j + 1) + (idx & 63) * 4); } }
        f32x4 xv[2];
#pragma unroll
        for (int r = 0; r < 2; ++r) xv[r] = *(const f32x4*)(X1F + (size_t)(row0 + r) * DM + 256 * j + 4 * lane);
#pragma unroll
        for (int c = 0; c < 36; ++c) { const f32x4 w = *(const LAS f32x4*)(Wb + c * 256 + 4 * lane);
#pragma unroll
            for (int r = 0; r < 2; ++r) acc[r][c] += (xv[r][0] * w[0] + xv[r][1] * w[1]) + (xv[r][2] * w[2] + xv[r][3] * w[3]); }
    }
    const float* gb = a.in[17] + l * 4; const float* eb = a.in[19] + l * 32;
#pragma unroll
    for (int r = 0; r < 2; ++r) {
#pragma unroll
        for (int c = 0; c < 36; ++c) acc[r][c] = wave_sum(acc[r][c]);
        float gl[4];
#pragma unroll
        for (int c = 0; c < 4; ++c) gl[c] = acc[r][c] + gb[c];
        int gi = 0; float gm = gl[0];
#pragma unroll
        for (int c = 1; c < 4; ++c) if (gl[c] > gm) { gm = gl[c]; gi = c; }
        float gs = 0.f;
#pragma unroll
        for (int c = 0; c < 4; ++c) gs += expf(gl[c] - gm);
        const float gtop = 1.0f / gs;
        float ev[8];
#pragma unroll
        for (int c = 0; c < 8; ++c) { const float v0 = acc[r][4 + c] + eb[c], v1 = acc[r][12 + c] + eb[8 + c], v2 = acc[r][20 + c] + eb[16 + c], v3 = acc[r][28 + c] + eb[24 + c]; ev[c] = gi == 0 ? v0 : (gi == 1 ? v1 : (gi == 2 ? v2 : v3)); }
        int i1 = 0; float m1 = ev[0];
#pragma unroll
        for (int c = 1; c < 8; ++c) if (ev[c] > m1) { m1 = ev[c]; i1 = c; }
        int i2 = -1; float m2 = -INFINITY;
#pragma unroll
        for (int c = 0; c < 8; ++c) if (c != i1 && ev[c] > m2) { m2 = ev[c]; i2 = c; }
        const float p2 = expf(m2 - m1), den = 1.0f + p2;
        const float w1 = gtop / den, w2 = gtop * p2 / den;
        if (lane == 0 && commit) { const int tok = row0 + r; const int e1 = gi * 8 + i1, e2 = gi * 8 + i2;
            const unsigned s1 = __hip_atomic_fetch_add(cnt + e1 * 64, 1u, __ATOMIC_RELAXED, __HIP_MEMORY_SCOPE_AGENT), s2 = __hip_atomic_fetch_add(cnt + e2 * 64, 1u, __ATOMIC_RELAXED, __HIP_MEMORY_SCOPE_AGENT);
            ltok[e1 * MT + s1] = tok; lgate[e1 * MT + s1] = w1; ltok[e2 * MT + s2] = tok; lgate[e2 * MT + s2] = w2;
            tinfo[tok * 2] = e1 * MT + (int)s1; tinfo[tok * 2 + 1] = e2 * MT + (int)s2; }
    }
}
__device__ __forceinline__ void moe_tables(const Frame& F, int l) {
    LAS int* toff = (LAS int*)(F.lds + LDS_TOFF); const unsigned* cnt = F.ctl + CW_CNT + l * 32 * 64;
    __syncthreads();
    if (F.tid == 0) { int run = 0; for (int e = 0; e < 32; ++e) { toff[e] = run; run += ((int)cnt[e * 64] + 255) >> 8; } toff[32] = run; }
    __syncthreads();
}
__device__ __forceinline__ void ln2_rows(const Frame& F, const Args& a, int l, float* OUT, bool write_xb) {
    const float* PRE = (const float*)(F.ws + WS_PRE); const bf16_t* Y = (const bf16_t*)(F.ws + WS_Y); bf16_t* XB = (bf16_t*)(F.ws + WS_XB); const int* tinfo = (const int*)(F.ws + WS_TINFO);
    const LAS int* toff = (const LAS int*)(F.lds + LDS_TOFF);
    const float* g = a.in[26] + (size_t)l * DM; const float* bb = a.in[27] + (size_t)l * DM; const int lane = F.lane;
    for (int row = F.bx * 8 + F.wave; row < MT; row += F.G * 8) {
        const int i0 = tinfo[row * 2], i1 = tinfo[row * 2 + 1];
        const size_t s0 = (size_t)toff[i0 >> 13] * 256 + (i0 & 8191), s1 = (size_t)toff[i1 >> 13] * 256 + (i1 & 8191);
        const float* pr = PRE + (size_t)row * DM; const bf16_t* y0 = Y + s0 * DM; const bf16_t* y1 = Y + s1 * DM;
        f32x4 v[8]; float s = 0.f;
#pragma unroll
        for (int j = 0; j < 8; ++j) { const f32x4 p = *(const f32x4*)(pr + 256 * j + 4 * lane); const u32x2 a0 = *(const u32x2*)(y0 + 256 * j + 4 * lane), a1 = *(const u32x2*)(y1 + 256 * j + 4 * lane);
            v[j][0] = p[0] + (bflo(a0.x) + bflo(a1.x)); v[j][1] = p[1] + (bfhi(a0.x) + bfhi(a1.x)); v[j][2] = p[2] + (bflo(a0.y) + bflo(a1.y)); v[j][3] = p[3] + (bfhi(a0.y) + bfhi(a1.y));
            s += (v[j][0] + v[j][1]) + (v[j][2] + v[j][3]); }
        const float mean = wave_sum(s) * (1.f / DM); float q = 0.f;
#pragma unroll
        for (int j = 0; j < 8; ++j) { v[j] = v[j] - mean; q += (v[j][0] * v[j][0] + v[j][1] * v[j][1]) + (v[j][2] * v[j][2] + v[j][3] * v[j][3]); }
        const float rstd = 1.0f / sqrtf(wave_sum(q) * (1.f / DM) + LN_EPS);
#pragma unroll
        for (int j = 0; j < 8; ++j) { const f32x4 gv = *(const f32x4*)(g + 256 * j + 4 * lane), bv = *(const f32x4*)(bb + 256 * j + 4 * lane); const f32x4 y = v[j] * rstd * gv + bv;
            *(f32x4*)(OUT + (size_t)row * DM + 256 * j + 4 * lane) = y; if (write_xb) *(u32x2*)(XB + (size_t)row * DM + 256 * j + 4 * lane) = (u32x2){pk2(y[0], y[1]), pk2(y[2], y[3])}; }
    }
}

constexpr int PH_PER_LAYER = 9, N_PHASES = 1 + NL * PH_PER_LAYER;
__global__ void __launch_bounds__(512, 2) mega(Args args) {
    extern __shared__ __attribute__((aligned(16))) unsigned char lds_raw[];
    Frame F; F.lds = (LAS unsigned char*)lds_raw; F.ws = args.ws; F.ctl = (unsigned*)(args.ws + WS_CTL);
    F.tid = threadIdx.x; F.lane = F.tid & 63; F.wave = __builtin_amdgcn_readfirstlane(F.tid >> 6); F.G = gridDim.x; F.bx = blockIdx.x;
    if (F.tid < 4) ((LAS unsigned*)(F.lds + LDS_BARW))[F.tid] = 0u;
    __syncthreads();
#if LAUNCH_PER_PHASE
#define GRID_BAR() do { } while (0)
#else
    XcdBarrier bar = xcd_barrier_post(F.ctl + CW_BAR, (volatile LAS unsigned*)(F.lds + LDS_BARW));
#define GRID_BAR() xcd_barrier(bar)
#endif
    const int lo = args.ph_lo, hi = args.ph_hi;
#define IN(k) (lo <= (k) && (k) < hi)
#define SEAM(k) do { if (IN(k) && IN((k) + 1)) GRID_BAR(); } while (0)
    bf16_t* XB = (bf16_t*)(F.ws + WS_XB); bf16_t* Ub = (bf16_t*)(F.ws + WS_U); bf16_t* MIXb = (bf16_t*)(F.ws + WS_MIX); float* PRE = (float*)(F.ws + WS_PRE);
    bf16_t* PPb = (bf16_t*)(F.ws + WS_PP); bf16_t* Hb = (bf16_t*)(F.ws + WS_H); bf16_t* Yb = (bf16_t*)(F.ws + WS_Y);
    float* X1F = args.out;

    if (IN(0)) { for (int rep = 0; rep < REPS(9); ++rep) { const Frame f = F.fresh(); phase_prologue(f, args); if (rep + 1 < REPS(9)) GRID_BAR(); } }
    SEAM(0);
#pragma unroll 1
    for (int l = 0; l < NL; ++l) {
        const int pb = 1 + l * PH_PER_LAYER;
        const float* XRES = (l == 0) ? args.in[0] : (const float*)args.out;
        if (IN(pb + 0)) for (int rep = 0; rep < REPS(0); ++rep) { if (rep) GRID_BAR(); pg8::DenseSched S; S.init(XB, (const bf16_t*)(F.ws + WS_WIN) + (size_t)l * DINP * DM, DM, DM, MT, DINP, F.G, F.bx);
            pg8::EpiBf16 E{Ub, DINP}; pg8::gemm_phase(F.lds, DM, S, E); }
        SEAM(pb + 0);
        if (IN(pb + 1)) for (int rep = 0; rep < REPS(1); ++rep) { if (rep) GRID_BAR(); { const Frame f = F.fresh(); for (int u = F.bx; u < 256; u += F.G) conv_unit(f, args, l, u); }
            { const Frame f = F.fresh(); for (int u = F.bx; u < 1024; u += F.G) gla_a_unit(f, args, l, u); } __syncthreads();
            }
        SEAM(pb + 1);
        if (IN(pb + 2)) { { const Frame f = F.fresh(); gla_scan(f); }
            const Frame f = F.fresh();
            LAS float* bt = (LAS float*)(F.lds + 8 * 2 * AT_VBUF);
            __syncthreads();
            for (int i = f.tid; i < 3 * 129 * 8; i += 512) bt[i] = ((const float*)(F.ws + WS_BTAB))[i];
            __syncthreads();
            for (int rep = 0; rep < REPS(2); ++rep)
            for (int job = F.bx * 8 + F.wave; job < 32 * 3 * 128; job += F.G * 8) attn_job(f, job, F.lds + F.wave * 2 * AT_VBUF, bt);
            __syncthreads();
            }
        SEAM(pb + 2);
        if (IN(pb + 3)) for (int rep = 0; rep < REPS(3); ++rep) { if (rep) GRID_BAR(); { const Frame f = F.fresh(); for (int u = F.bx; u < 1024; u += F.G) gla_c_unit(f, args, l, u); __syncthreads(); } { const Frame f = F.fresh(); attn_combine(f); }
            }
        SEAM(pb + 3);
        if (IN(pb + 4)) for (int rep = 0; rep < REPS(4); ++rep) { if (rep) GRID_BAR(); { pg8::DenseSched S; S.init(MIXb, (const bf16_t*)(F.ws + WS_WOUT) + (size_t)l * DM * DM, DM, DM, MT, DM, F.G, F.bx);
              pg8::EpiRes E{PRE, XRES, DM, DN_ALPHA}; pg8::gemm_phase(F.lds, DM, S, E); }
            { pg8::DenseSched S; S.init((const bf16_t*)(F.ws + WS_PB) + (size_t)l * MT * PLE, (const bf16_t*)(F.ws + WS_WPP) + (size_t)l * DM * PLE, PLE, PLE, MT, DM, F.G, F.bx);
              pg8::EpiBf16 E{PPb, DM}; pg8::gemm_phase(F.lds, PLE, S, E); } }
        SEAM(pb + 4);
        if (IN(pb + 5)) for (int rep = 0; rep < REPS(5); ++rep) { if (rep) GRID_BAR(); const Frame f = F.fresh(); for (int u = F.bx; u < MT / 16; u += F.G) ln1_unit(f, args, l, u, X1F, rep + 1 == REPS(5)); __syncthreads();
            }
        SEAM(pb + 5);
        if (IN(pb + 6)) for (int rep = 0; rep < REPS(6); ++rep) { if (rep) GRID_BAR(); { pg8::DenseSched S; S.init(XB, (const bf16_t*)(F.ws + WS_WPG) + (size_t)l * DM * DM, DM, DM, MT, DM, F.G, F.bx);
              pg8::EpiPle E{PRE, X1F, PPb, args.in[24] + (size_t)l * DM, DM, DN_ALPHA}; pg8::gemm_phase(F.lds, DM, S, E); }
            moe_tables(F, l);
            { pg8::MoeSched<true> S; S.A = XB; S.Bt = (const bf16_t*)(F.ws + WS_WGU) + (size_t)l * NEXP * 512 * DM; S.lda = DM; S.ldb = DM; S.nN = 2; S.G = F.G; S.c = F.bx; S.bexp = (size_t)512 * DM * 2;
              S.toff = (const LAS int*)(F.lds + LDS_TOFF); S.cnt = F.ctl + CW_CNT + l * 32 * 64; S.ltok = (const int*)(F.ws + WS_LTOK);
              pg8::EpiMoe1 E{Hb, (const float*)(F.ws + WS_LGATE), F.ctl + CW_CNT + l * 32 * 64}; pg8::gemm_phase(F.lds, DM, S, E); } }
        SEAM(pb + 6);
        if (IN(pb + 7)) for (int rep = 0; rep < REPS(7); ++rep) { if (rep) GRID_BAR(); moe_tables(F, l);
            pg8::MoeSched<false> S; S.A = Hb; S.Bt = (const bf16_t*)(F.ws + WS_WD) + (size_t)l * NEXP * DM * DEXP; S.lda = DEXP; S.ldb = DEXP; S.nN = 8; S.G = F.G; S.c = F.bx; S.bexp = (size_t)DM * DEXP * 2;
            S.toff = (const LAS int*)(F.lds + LDS_TOFF); S.cnt = F.ctl + CW_CNT + l * 32 * 64; S.ltok = (const int*)(F.ws + WS_LTOK);
            pg8::EpiBf16 E{Yb, DM}; pg8::gemm_phase(F.lds, DEXP, S, E); }
        SEAM(pb + 7);
        if (IN(pb + 8)) { for (int rep = 0; rep < REPS(8); ++rep) { if (rep) GRID_BAR(); const Frame f = F.fresh(); moe_tables(f, l); ln2_rows(f, args, l, args.out, l + 1 < NL); }
            if (l + 1 < NL) { const Frame f = F.fresh(); conv_all(f, args, l + 1, 0, I_L); } }
        SEAM(pb + 8);
    }
#undef IN
#undef SEAM
}

extern "C" void kernel_launch(void* const* d_in, const int* in_sizes, int n_in, void* d_out, int out_size, void* d_ws, size_t ws_size, hipStream_t stream) {
    static int grid = 0;
    if (grid == 0) {
        if (n_in != 28 || out_size != MT * DM || ws_size < WS_END) { fprintf(stderr, "kernel_launch: unexpected shapes (n_in %d, out %d, ws %zu); nothing launched\n", n_in, out_size, ws_size); grid = -1; return; }
        int dev = 0, cus = 0, per_cu = 0;
        if (hipGetDevice(&dev) != hipSuccess || hipDeviceGetAttribute(&cus, hipDeviceAttributeMultiprocessorCount, dev) != hipSuccess) { grid = -1; return; }
        if (hipFuncSetAttribute((const void*)mega, hipFuncAttributeMaxDynamicSharedMemorySize, LDS_BYTES) != hipSuccess) { fprintf(stderr, "kernel_launch: hipFuncSetAttribute failed\n"); grid = -1; return; }
        if (hipOccupancyMaxActiveBlocksPerMultiprocessor(&per_cu, (const void*)mega, 512, LDS_BYTES) != hipSuccess || per_cu < 1) { fprintf(stderr, "kernel_launch: occupancy query says %d\n", per_cu); }
        (void)hipGetLastError();
        grid = cus;
    }
    if (grid < 0) return;
    (void)hipMemsetAsync((char*)d_ws + WS_CTL, 0, CTL_ZERO_BYTES, stream);
    Args a{};
    for (int i = 0; i < 28; ++i) a.in[i] = (const float*)d_in[i];
    a.out = (float*)d_out; a.ws = (unsigned char*)d_ws;
#if LAUNCH_PER_PHASE
    for (int p = 0; p < N_PHASES; ++p) { a.ph_lo = p; a.ph_hi = p + 1; hipLaunchKernelGGL(mega, dim3(grid), dim3(512), LDS_BYTES, stream, a); }
#else
    a.ph_lo = 0; a.ph_hi = N_PHASES; hipLaunchKernelGGL(mega, dim3(grid), dim3(512), LDS_BYTES, stream, a);
#endif
}
```

```cpp
#include <hip/hip_runtime.h>
#include <cstdio>
#include <cstdint>

#ifndef REP_MASK
#define REP_MASK 0
#endif
#define REPS(k) (1 + ((REP_MASK >> (k)) & 1))
#ifndef LAUNCH_PER_PHASE
#define LAUNCH_PER_PHASE 0
#endif

#define LAS __attribute__((address_space(3)))
#define GAS __attribute__((address_space(1)))
typedef unsigned short bf16_t;
typedef short bf16x8 __attribute__((ext_vector_type(8)));
typedef float f32x4 __attribute__((ext_vector_type(4)));
typedef float f32x2 __attribute__((ext_vector_type(2)));
typedef unsigned u32x4 __attribute__((ext_vector_type(4)));
typedef unsigned u32x2 __attribute__((ext_vector_type(2)));

constexpr int NL = 2, NBATCH = 4, SEQ = 2048, DM = 2048, MT = NBATCH * SEQ;
constexpr int DIN = 5648, DINP = 5888, PLE = 256, NEXP = 32, DEXP = 256;
constexpr int UA_VAL = 0, UA_GATE = 512, UG_Q = 1024, UG_K = 1280, UG_V = 1536, UG_R = 2048, UC_Q = 2560, UC_K = 3072, UC_V = 3584, US_B = 4096, US_C = 4608, US_H = 5120, UG_LOW = 5632;
constexpr float DN_ALPHA = 1.41421356237309515f, LN_EPS = 1e-5f, RMS_EPS = 1e-6f;
constexpr int MAXSLOT = 24576;

constexpr size_t MiB = 1u << 20;
constexpr size_t WS_CTL = 0, CTL_ZERO_BYTES = 1 * MiB;
constexpr size_t WS_BTAB = 1 * MiB;
constexpr size_t WS_WRT = 1 * MiB + 64 * 1024;
constexpr size_t WS_LTOK = 2 * MiB;
constexpr size_t WS_LGATE = 3 * MiB;
constexpr size_t WS_TINFO = 4 * MiB;
constexpr size_t WS_WIN = 8 * MiB;
constexpr size_t WS_WOUT = 54 * MiB;
constexpr size_t WS_WGU = 70 * MiB;
constexpr size_t WS_WD = 198 * MiB;
constexpr size_t WS_WPG = 262 * MiB;
constexpr size_t WS_WPP = 278 * MiB;
constexpr size_t WS_XB = 280 * MiB;
constexpr size_t WS_PB = 312 * MiB;
constexpr size_t WS_U = 320 * MiB;
constexpr size_t WS_Y = 320 * MiB;
constexpr size_t WS_MIX = 416 * MiB;
constexpr size_t WS_PRE = 448 * MiB;
constexpr size_t WS_GU = 448 * MiB;
constexpr size_t WS_GO = 480 * MiB;
constexpr size_t WS_GQ = 496 * MiB;
constexpr size_t WS_GD = 504 * MiB;
constexpr size_t WS_PP = 512 * MiB;
constexpr size_t WS_AO = 556 * MiB;
constexpr size_t WS_ALSE = 580 * MiB;
constexpr size_t WS_H = 544 * MiB;
constexpr size_t WS_END = 581 * MiB;
static_assert(WS_U + (size_t)MT * DINP * 2 <= WS_MIX && WS_Y + (size_t)MAXSLOT * 2048 * 2 <= WS_MIX + 32 * MiB, "ws map");
constexpr int CW_BAR = 4096;
constexpr int CW_CNT = 16384;

constexpr int LDS_STAGE = 135168;
constexpr int LDS_TOFF = LDS_STAGE;
constexpr int LDS_BARW = LDS_STAGE + 512;
constexpr int LDS_BYTES = LDS_STAGE + 1024;

__device__ __forceinline__ float bf2f(unsigned b) { return __uint_as_float(b << 16); }
__device__ __forceinline__ unsigned f2bf(float f) { unsigned u = __float_as_uint(f); return (u + 0x7fffu + ((u >> 16) & 1u)) >> 16; }
__device__ __forceinline__ unsigned pk2(float lo, float hi) { return f2bf(lo) | (f2bf(hi) << 16); }
__device__ __forceinline__ float bflo(unsigned w) { return __uint_as_float(w << 16); }
__device__ __forceinline__ float bfhi(unsigned w) { return __uint_as_float(w & 0xffff0000u); }
__device__ __forceinline__ float wave_sum(float v) {
#pragma unroll
    for (int o = 1; o < 64; o <<= 1) v += __shfl_xor(v, o);
    return v;
}
__device__ __forceinline__ float wave_max(float v) {
#pragma unroll
    for (int o = 1; o < 64; o <<= 1) v = fmaxf(v, __shfl_xor(v, o));
    return v;
}
__device__ __forceinline__ float sigmoidf_(float x) { return 1.0f / (1.0f + __expf(-x)); }
__device__ __forceinline__ float siluf_(float x) { return x / (1.0f + __expf(-x)); }
#define LDS_WAIT() asm volatile("s_waitcnt lgkmcnt(0)" ::: "memory")

namespace pg8 {
constexpr int BM = 256, BK = 64, HALF = 128, HTB = HALF * BK * 2, STAGE_BYTES = 8 * HTB, NXCD = 8, WGM = 8;
__host__ __device__ __forceinline__ int lds_byte(int r, int c) { const int st = (r >> 4) * 2 + (c >> 5), rr = r & 15, cc = c & 31, ob = rr * 64 + cc * 2; return st * 1024 + (ob ^ (((ob >> 9) & 1) << 5)); }
__host__ __device__ __forceinline__ void stage_rc(int b, int& R, int& C) { const int st = b / 1024, sb = b % 1024, swz = sb ^ (((sb >> 9) & 1) << 5); R = (st >> 1) * 16 + swz / 64; C = (st & 1) * 32 + (swz % 64) / 2; }
__host__ __device__ __forceinline__ int perm32(int rho) { const int n = rho >> 4, i = rho & 15; return 8 * (i >> 2) + 4 * n + (i & 3); }

struct Unit { int pm, pn, e, r; };

struct DenseSched {
    static constexpr bool GATHER = false;
    const bf16_t* A; const bf16_t* Bt; int lda, ldb, nM, nN, nwg, G, c;
    __device__ void init(const bf16_t* A_, const bf16_t* Bt_, int lda_, int ldb_, int M, int N, int G_, int c_) { A = A_; Bt = Bt_; lda = lda_; ldb = ldb_; nM = M / BM; nN = N / BM; nwg = nM * nN; G = G_; c = c_; }
    __device__ __forceinline__ bool next(int i, Unit& u) const {
        const long L = (long)i * G + c; if (L >= nwg) return false;
        int wgid = (int)L; { const int q = nwg / NXCD, r = nwg % NXCD, xcd = wgid % NXCD, off = wgid / NXCD; wgid = (xcd < r ? xcd * (q + 1) : r * (q + 1) + (xcd - r) * q) + off; }
        const int nig = WGM * nN, gid = wgid / nig, fm = gid * WGM, gsz = (nM - fm) < WGM ? (nM - fm) : WGM;
        u.pm = fm + ((wgid % nig) % gsz); u.pn = (wgid % nig) / gsz; u.e = 0; u.r = 0; return true;
    }
    __device__ __forceinline__ const char* a_base(const Unit& u) const { return (const char*)A + (size_t)u.pm * BM * lda * 2; }
    __device__ __forceinline__ const char* b_base(const Unit& u) const { return (const char*)Bt + (size_t)u.pn * BM * ldb * 2; }
    __device__ __forceinline__ void a_offs(const Unit&, const int (&R)[2], const int (&C)[2], unsigned (&vo)[2][2]) const { }
};
template <bool GATHER_> struct MoeSched {
    static constexpr bool GATHER = GATHER_;
    const bf16_t* A; const bf16_t* Bt; int lda, ldb, nN, G, c; size_t bexp;
    const LAS int* toff; const unsigned* cnt; const int* ltok;
    __device__ __forceinline__ bool next(int i, Unit& u) const {
        const int L = i * G + c; const int total = __builtin_amdgcn_readfirstlane(toff[32]) * nN; if (L >= total) return false;
        const int j = L / nN; u.pn = L - j * nN; int e = 0;
#pragma unroll 1
        for (int k = 1; k < 32; ++k) e = (__builtin_amdgcn_readfirstlane(toff[k]) <= j) ? k : e;
        u.e = e; u.r = j - __builtin_amdgcn_readfirstlane(toff[e]); u.pm = j; return true;
    }
    __device__ __forceinline__ const char* a_base(const Unit& u) const { return GATHER ? (const char*)A : (const char*)A + (size_t)u.pm * BM * lda * 2; }
    __device__ __forceinline__ const char* b_base(const Unit& u) const { return (const char*)Bt + (size_t)u.e * bexp + (size_t)u.pn * BM * ldb * 2; }
    __device__ __forceinline__ void a_offs(const Unit& u, const int (&R)[2], const int (&C)[2], unsigned (&vo)[2][2]) const {
        if constexpr (GATHER) {
        const int n = __builtin_amdgcn_readfirstlane((int)cnt[u.e * 64]);
#pragma unroll
        for (int h = 0; h < 2; ++h)
#pragma unroll
            for (int i = 0; i < 2; ++i) {
                const int sr = u.r * BM + h * HALF + R[i]; const int row = (sr < n) ? ltok[u.e * MT + sr] : 0;
                vo[h][i] = (unsigned)(row * lda + C[i]) * 2u;
            }
        }
    }
};

__device__ __forceinline__ unsigned cvt_pk_bf16(float lo, float hi) { unsigned r; asm volatile("v_cvt_pk_bf16_f32 %0, %1, %2" : "=v"(r) : "v"(lo), "v"(hi)); return r; }

struct EpiBf16 {
    static constexpr bool PERM = true;
    bf16_t* O; int ldc;
    __device__ __forceinline__ void operator()(const f32x4 (&acc)[2][2][4][2], const Unit& u, int wr, int wc, int fr, int fq) const {
        const int row0 = u.pm * BM + wr * 64 + fr, col0 = u.pn * BM + wc * 32 + 8 * fq;
#pragma unroll
        for (int ai = 0; ai < 2; ++ai)
#pragma unroll
            for (int m = 0; m < 4; ++m) { bf16_t* rowp = O + (size_t)(row0 + ai * HALF + m * 16) * ldc + col0;
#pragma unroll
                for (int bj = 0; bj < 2; ++bj) { const f32x4 v0 = acc[ai][bj][m][0], v1 = acc[ai][bj][m][1];
                    u32x4 w; w.x = cvt_pk_bf16(v0[0], v0[1]); w.y = cvt_pk_bf16(v0[2], v0[3]); w.z = cvt_pk_bf16(v1[0], v1[1]); w.w = cvt_pk_bf16(v1[2], v1[3]);
                    *(u32x4*)(rowp + bj * HALF) = w; } }
    }
};
struct EpiRes {
    static constexpr bool PERM = true;
    bf16_t* C; const bf16_t* res; int ldc; float alpha;
    __device__ __forceinline__ void operator()(const f32x4 (&acc)[2][2][4][2], const Unit& u, int wr, int wc, int fr, int fq) const {
        const int row0 = u.pm * BM + wr * 64 + fr, col0 = u.pn * BM + wc * 32 + 8 * fq;
#pragma unroll
        for (int ai = 0; ai < 2; ++ai)
#pragma unroll
            for (int m = 0; m < 4; ++m) { const size_t off = (size_t)(row0 + ai * HALF + m * 16) * ldc + col0;
#pragma unroll
                for (int bj = 0; bj < 2; ++bj) { const u32x4 rv = *(const u32x4*)(res + off + bj * HALF); const f32x4 v0 = acc[ai][bj][m][0], v1 = acc[ai][bj][m][1];
                    u32x4 w; w.x = cvt_pk_bf16(bflo(rv.x) * alpha + v0[0], bfhi(rv.x) * alpha + v0[1]); w.y = cvt_pk_bf16(bflo(rv.y) * alpha + v0[2], bfhi(rv.y) * alpha + v0[3]);
                    w.z = cvt_pk_bf16(bflo(rv.z) * alpha + v1[0], bfhi(rv.z) * alpha + v1[1]); w.w = cvt_pk_bf16(bflo(rv.w) * alpha + v1[2], bfhi(rv.w) * alpha + v1[3]);
                    *(u32x4*)(C + off + bj * HALF) = w; }
                asm volatile("" ::: "memory"); }
    }
};
struct EpiPle {
    static constexpr bool PERM = true;
    bf16_t* C; const bf16_t* x1; const bf16_t* pp; const float* bias; int ldc; float alpha;
    __device__ __forceinline__ void operator()(const f32x4 (&acc)[2][2][4][2], const Unit& u, int wr, int wc, int fr, int fq) const {
        const int row0 = u.pm * BM + wr * 64 + fr, col0 = u.pn * BM + wc * 32 + 8 * fq;
        f32x4 bv[2][2];
#pragma unroll
        for (int bj = 0; bj < 2; ++bj)
#pragma unroll
            for (int n = 0; n < 2; ++n) bv[bj][n] = *(const f32x4*)(bias + col0 + bj * HALF + 4 * n);
#pragma unroll
        for (int ai = 0; ai < 2; ++ai)
#pragma unroll
            for (int m = 0; m < 4; ++m) { const size_t off = (size_t)(row0 + ai * HALF + m * 16) * ldc + col0;
#pragma unroll
                for (int bj = 0; bj < 2; ++bj) { const size_t o = off + bj * HALF; const u32x4 xv = *(const u32x4*)(x1 + o), pw = *(const u32x4*)(pp + o);
                    const f32x4 a0 = acc[ai][bj][m][0] + bv[bj][0], a1 = acc[ai][bj][m][1] + bv[bj][1];
                    u32x4 w;
                    w.x = cvt_pk_bf16(bflo(xv.x) * alpha + sigmoidf_(a0[0]) * bflo(pw.x), bfhi(xv.x) * alpha + sigmoidf_(a0[1]) * bfhi(pw.x));
                    w.y = cvt_pk_bf16(bflo(xv.y) * alpha + sigmoidf_(a0[2]) * bflo(pw.y), bfhi(xv.y) * alpha + sigmoidf_(a0[3]) * bfhi(pw.y));
                    w.z = cvt_pk_bf16(bflo(xv.z) * alpha + sigmoidf_(a1[0]) * bflo(pw.z), bfhi(xv.z) * alpha + sigmoidf_(a1[1]) * bfhi(pw.z));
                    w.w = cvt_pk_bf16(bflo(xv.w) * alpha + sigmoidf_(a1[2]) * bflo(pw.w), bfhi(xv.w) * alpha + sigmoidf_(a1[3]) * bfhi(pw.w));
                    *(u32x4*)(C + o) = w; }
                asm volatile("" ::: "memory"); }
    }
};
struct EpiMoe1 {
    static constexpr bool PERM = true;
    bf16_t* H; const float* lgate; const unsigned* cnt;
    __device__ __forceinline__ void operator()(const f32x4 (&acc)[2][2][4][2], const Unit& u, int wr, int wc, int fr, int fq) const {
        const int n_e = __builtin_amdgcn_readfirstlane((int)cnt[u.e * 64]);
        const int col0 = u.pn * HALF + wc * 32 + 8 * fq;
#pragma unroll
        for (int ai = 0; ai < 2; ++ai)
#pragma unroll
            for (int m = 0; m < 4; ++m) { const int rt = ai * HALF + wr * 64 + m * 16 + fr; const int sr = u.r * BM + rt;
                const float gw = (sr < n_e) ? lgate[u.e * MT + sr] : 0.f;
                const f32x4 g0 = acc[ai][0][m][0], g1 = acc[ai][0][m][1], u0 = acc[ai][1][m][0], u1 = acc[ai][1][m][1];
                float o[8];
#pragma unroll
                for (int j = 0; j < 4; ++j) { o[j] = siluf_(g0[j]) * u0[j] * gw; o[4 + j] = siluf_(g1[j]) * u1[j] * gw; }
                u32x4 w; w.x = cvt_pk_bf16(o[0], o[1]); w.y = cvt_pk_bf16(o[2], o[3]); w.z = cvt_pk_bf16(o[4], o[5]); w.w = cvt_pk_bf16(o[6], o[7]);
                *(u32x4*)(H + (size_t)(u.pm * BM + rt) * DEXP + col0) = w; }
    }
};

template <class Epi, class Sched>
__device__ __forceinline__ void gemm_phase(LAS unsigned char* lds, const int K, const Sched& S, const Epi& E) {
    constexpr bool GA = Sched::GATHER;
    int tid = threadIdx.x; asm volatile("" : "+v"(tid));
    const int wid = __builtin_amdgcn_readfirstlane(tid >> 6), lane = tid & 63, wr = wid >> 2, wc = wid & 3, fr = lane & 15, fq = lane >> 4;
    const int nt = K / BK, ldb = S.ldb, lda = S.lda;
    int Rr[2], Cc[2]; unsigned voffB[2], voffA[2];
#pragma unroll
    for (int i = 0; i < 2; ++i) { int R, C; stage_rc(tid * 16 + i * 8192, R, C); Rr[i] = R; Cc[i] = C; const int Rb = Epi::PERM ? ((R & ~31) + perm32(R & 31)) : R; voffB[i] = (unsigned)(Rb * ldb + C) * 2u; voffA[i] = (unsigned)(R * lda + C) * 2u; }
    const size_t kstep = (size_t)(BK * 2);
    const size_t hstep = (size_t)HALF * ldb * 2;
    const size_t ahstep = GA ? 0 : (size_t)HALF * lda * 2;
    const unsigned ldsw = (unsigned)wid * 1024u;
    const int aoff = lds_byte(wr * 64 + fr, fq * 8), boff = lds_byte(wc * 32 + fr, fq * 8);
#define PG8_SA(b, h) (((b) * 2 + (h)) * HTB)
#define PG8_SB(b, h) ((4 + (b) * 2 + (h)) * HTB)
#define PG8_STAGE(bufoff, gbase, voff) do { _Pragma("unroll") for (int _i = 0; _i < 2; ++_i) \
        __builtin_amdgcn_global_load_lds((const unsigned*)((const char*)(gbase) + (voff)[_i]), (LAS unsigned*)(lds + (bufoff) + ldsw + _i * 8192), 16, 0, 0); } while (0)
#define PG8_STAGE_A(bufoff, gbase, h) do { if constexpr (GA) PG8_STAGE(bufoff, gbase, voA[h]); else PG8_STAGE(bufoff, (gbase) + (h) * ahstep, voffA); } while (0)
#define PG8_STAGE_A2(bufoff, gbase, h) do { if constexpr (GA) { unsigned _v[2] = {last ? voN[h][0] : voA[h][0], last ? voN[h][1] : voA[h][1]}; PG8_STAGE(bufoff, gbase, _v); } else PG8_STAGE(bufoff, (gbase) + (h) * ahstep, voffA); } while (0)
#define PG8_LDA(dst, b, h) do { _Pragma("unroll") for (int m = 0; m < 4; ++m) _Pragma("unroll") for (int k = 0; k < 2; ++k) dst[m][k] = *(const LAS bf16x8*)(lds + PG8_SA(b, h) + aoff + m * 2048 + k * 1024); } while (0)
#define PG8_LDB(dst, b, h) do { _Pragma("unroll") for (int n = 0; n < 2; ++n) _Pragma("unroll") for (int k = 0; k < 2; ++k) dst[n][k] = *(const LAS bf16x8*)(lds + PG8_SB(b, h) + boff + n * 2048 + k * 1024); } while (0)
#define PG8_MMA(ai, bj, At, Bt) do { __builtin_amdgcn_s_setprio(1); _Pragma("unroll") for (int m = 0; m < 4; ++m) _Pragma("unroll") for (int n = 0; n < 2; ++n) _Pragma("unroll") for (int k = 0; k < 2; ++k) \
        acc[ai][bj][m][n] = __builtin_amdgcn_mfma_f32_16x16x32_bf16(Bt[n][k], At[m][k], acc[ai][bj][m][n], 0, 0, 0); __builtin_amdgcn_s_setprio(0); } while (0)
#define PG8_WAIT_V(n) asm volatile("s_waitcnt vmcnt(" #n ")" ::: "memory")
#define PG8_WAIT_L(n) asm volatile("s_waitcnt lgkmcnt(" #n ")" ::: "memory")
#define PG8_BAR __builtin_amdgcn_s_barrier()
#define PG8_SCHED __builtin_amdgcn_sched_barrier(0)
    Unit cur, nxt; int ui = 0;
    if (!S.next(0, cur)) return;
    f32x4 acc[2][2][4][2];
#pragma unroll
    for (int a = 0; a < 2; ++a)
#pragma unroll
        for (int b = 0; b < 2; ++b)
#pragma unroll
            for (int m = 0; m < 4; ++m)
#pragma unroll
                for (int n = 0; n < 2; ++n) acc[a][b][m][n] = (f32x4){0.f, 0.f, 0.f, 0.f};
    bf16x8 At[4][2], B0[2][2], B1[2][2];
    const char* cA = S.a_base(cur); const char* cB = S.b_base(cur);
    unsigned voA[2][2], voN[2][2];
    if constexpr (GA) S.a_offs(cur, Rr, Cc, voA);
    PG8_STAGE(PG8_SB(0, 0), cB, voffB); PG8_STAGE(PG8_SB(0, 1), cB + hstep, voffB); PG8_STAGE_A(PG8_SA(0, 0), cA, 0); PG8_STAGE_A(PG8_SA(0, 1), cA, 1);
    if (wr == 1) PG8_BAR;
    PG8_WAIT_V(2); PG8_BAR;
    PG8_STAGE(PG8_SB(1, 0), cB + kstep, voffB); PG8_STAGE_A(PG8_SA(1, 0), cA + kstep, 0); PG8_STAGE(PG8_SB(1, 1), cB + hstep + kstep, voffB);
    PG8_WAIT_V(6); PG8_BAR;
    for (;;) {
        const bool has_next = S.next(ui + 1, nxt);
        const char* nA = has_next ? S.a_base(nxt) : cA; const char* nB = has_next ? S.b_base(nxt) : cB;
        if constexpr (GA) {
            if (has_next) S.a_offs(nxt, Rr, Cc, voN);
            else {
#pragma unroll
                for (int h = 0; h < 2; ++h)
#pragma unroll
                    for (int i = 0; i < 2; ++i) voN[h][i] = voA[h][i]; } }
#pragma unroll 1
        for (int t = 0; t < nt; t += 2) {
            const bool last = (t == nt - 2);
            const char* a1 = cA + (size_t)(t + 1) * kstep;
            const char* a2 = last ? nA : cA + (size_t)(t + 2) * kstep; const char* b2 = last ? nB : cB + (size_t)(t + 2) * kstep;
            const char* a3 = a2 + kstep; const char* b3 = b2 + kstep;
            PG8_LDB(B0, 0, 0); PG8_LDB(B1, 0, 1); PG8_SCHED; PG8_LDA(At, 0, 0); PG8_STAGE_A(PG8_SA(1, 1), a1, 1);
            PG8_WAIT_V(8); PG8_WAIT_L(0); PG8_BAR; PG8_MMA(0, 0, At, B0); PG8_MMA(0, 1, At, B1); PG8_BAR; PG8_SCHED;
            PG8_LDA(At, 0, 1); PG8_STAGE(PG8_SB(0, 0), b2, voffB); PG8_STAGE(PG8_SB(0, 1), b2 + hstep, voffB); PG8_STAGE_A2(PG8_SA(0, 0), a2, 0);
            PG8_WAIT_V(8); PG8_WAIT_L(0); PG8_BAR; PG8_MMA(1, 0, At, B0); PG8_MMA(1, 1, At, B1); PG8_BAR; PG8_SCHED;
            PG8_LDB(B0, 1, 0); PG8_LDB(B1, 1, 1); PG8_SCHED; PG8_LDA(At, 1, 0); PG8_STAGE_A2(PG8_SA(0, 1), a2, 1);
            PG8_WAIT_V(8); PG8_WAIT_L(0); PG8_BAR; PG8_MMA(0, 0, At, B0); PG8_MMA(0, 1, At, B1); PG8_BAR; PG8_SCHED;
            PG8_LDA(At, 1, 1); PG8_STAGE(PG8_SB(1, 0), b3, voffB); PG8_STAGE(PG8_SB(1, 1), b3 + hstep, voffB); PG8_STAGE_A2(PG8_SA(1, 0), a3, 0);
            PG8_WAIT_V(8); PG8_WAIT_L(0); PG8_BAR; PG8_MMA(1, 0, At, B0); PG8_MMA(1, 1, At, B1); PG8_BAR; PG8_SCHED;
        }
        if (wr == 0) PG8_BAR;
        E(acc, cur, wr, wc, fr, fq);
        if (!has_next) break;
#pragma unroll
        for (int a = 0; a < 2; ++a)
#pragma unroll
            for (int b = 0; b < 2; ++b)
#pragma unroll
                for (int m = 0; m < 4; ++m)
#pragma unroll
                    for (int n = 0; n < 2; ++n) acc[a][b][m][n] = (f32x4){0.f, 0.f, 0.f, 0.f};
        cur = nxt; cA = nA; cB = nB; ++ui;
        if constexpr (GA) {
#pragma unroll
            for (int h = 0; h < 2; ++h)
#pragma unroll
                for (int i = 0; i < 2; ++i) voA[h][i] = voN[h][i]; }
        if (wr == 1) PG8_BAR;
    }
    PG8_WAIT_V(0);
    PG8_BAR;
#undef PG8_SA
#undef PG8_SB
#undef PG8_STAGE
#undef PG8_STAGE_A
#undef PG8_STAGE_A2
#undef PG8_LDA
#undef PG8_LDB
#undef PG8_MMA
#undef PG8_WAIT_V
#undef PG8_WAIT_L
#undef PG8_BAR
#undef PG8_SCHED
}
}

#define XB_TMO      128
#define XB_XCNT(j)  (256  + 64 * (j))
#define XB_XSUB(j)  (1280 + 64 * (j))
#define XB_XGEN(j)  (2304 + 64 * (j))
#define XB_TOP      3328
#define XB_TOPGEN   3392
#define XCD_BAR_WORDS 3456
#define XB_SPIN_CAP (1u << 18)
__device__ __forceinline__ unsigned xb_ld(unsigned* p)              { return __hip_atomic_load(p, __ATOMIC_RELAXED, __HIP_MEMORY_SCOPE_AGENT); }
__device__ __forceinline__ unsigned xb_add(unsigned* p, unsigned v) { return __hip_atomic_fetch_add(p, v, __ATOMIC_RELAXED, __HIP_MEMORY_SCOPE_AGENT); }
__device__ __forceinline__ unsigned xb_xcc_id() { return (unsigned)__builtin_amdgcn_s_getreg((3 << 11) | 20) & 0xFu; }
#define XB_SPIN(cond, bar) do { unsigned _sp = 0; while (cond) { __builtin_amdgcn_s_sleep(1); \
    if ((++_sp & 255u) == 0u) { if (xb_ld(&(bar)[XB_TMO])) break; if (_sp > XB_SPIN_CAP) { atomicAdd(&(bar)[XB_TMO], 1u); break; } } } } while (0)
struct XcdBarrier { unsigned* bar; unsigned x; volatile LAS unsigned* st; };
__device__ __forceinline__ XcdBarrier xcd_barrier_post(unsigned* bar, volatile LAS unsigned* st) {
    XcdBarrier b; b.bar = bar; b.x = xb_xcc_id(); b.st = st;
    if (threadIdx.x == 0) (void)xb_add(&bar[XB_XCNT(b.x)], 1u);
    return b;
}
__device__ __forceinline__ void xcd_barrier_complete(unsigned* bar, unsigned x, unsigned& nloc, unsigned& nx) {
    const unsigned G = gridDim.x * gridDim.y * gridDim.z;
    unsigned sum, cnt, mine, sp = 0u;
    for (;;) {
        sum = 0u; cnt = 0u; mine = 0u;
#pragma unroll
        for (unsigned j = 0; j < 16; ++j) { const unsigned c = xb_ld(&bar[XB_XCNT(j)]); sum += c; cnt += (c > 0u) ? 1u : 0u; mine = (j == x) ? c : mine; }
        if (sum == G) break;
        __builtin_amdgcn_s_sleep(1);
        if ((++sp & 255u) == 0u) { if (xb_ld(&bar[XB_TMO])) break; if (sp > XB_SPIN_CAP) { atomicAdd(&bar[XB_TMO], 1u); break; } }
    }
    nloc = mine > 0u ? mine : 1u; nx = cnt > 0u ? cnt : 1u;
}
__device__ __forceinline__ void xcd_barrier(const XcdBarrier& b) {
    asm volatile("s_waitcnt vmcnt(0)" ::: "memory");
    __syncthreads();
    if (threadIdx.x == 0) {
        unsigned* bar = b.bar;
        __builtin_amdgcn_s_waitcnt(0);
        unsigned nloc = b.st[0], nx = b.st[1];
        if (nloc == 0u) { xcd_barrier_complete(bar, b.x, nloc, nx); b.st[0] = nloc; b.st[1] = nx; }
        const unsigned old = xb_add(&bar[XB_XSUB(b.x)], 1u);
        const unsigned gen = old / nloc;
        if (old + 1u == (gen + 1u) * nloc) {
            __builtin_amdgcn_fence(__ATOMIC_RELEASE, "agent");
            asm volatile("s_waitcnt vmcnt(0)" ::: "memory");
            const unsigned og = xb_add(&bar[XB_TOP], 1u);
            const unsigned tg = og / nx;
            if (og + 1u == (tg + 1u) * nx) xb_add(&bar[XB_TOPGEN], 1u);
            else XB_SPIN(xb_ld(&bar[XB_TOPGEN]) == tg, bar);
            __builtin_amdgcn_fence(__ATOMIC_ACQUIRE, "agent");
            xb_add(&bar[XB_XGEN(b.x)], 1u);
            asm volatile("s_waitcnt vmcnt(0)" ::: "memory");
        } else {
            XB_SPIN(xb_ld(&bar[XB_XGEN(b.x)]) == gen, bar);
            __builtin_amdgcn_fence(__ATOMIC_ACQUIRE, "agent");
            asm volatile("s_waitcnt vmcnt(0)" ::: "memory");
        }
    }
    __syncthreads();
}

struct Args { const float* in[28]; float* out; unsigned char* ws; int ph_lo, ph_hi; };

struct Frame {
    LAS unsigned char* lds; unsigned char* ws; unsigned* ctl;
    int tid, lane, wave, G, bx;
    __device__ __forceinline__ Frame fresh() const { Frame f = *this; int t = threadIdx.x; asm volatile("" : "+v"(t)); f.tid = t; f.lane = t & 63; return f; }
};

__device__ __forceinline__ int dmap(int type, int n) {
    if (type == 1) return n < 2048 ? n : (n < 2064 ? n - 2048 + UG_LOW : n - 16);
    if (type == 2) return (n >> 7) * 256 + (n & 127);
    if (type == 3) return (n >> 7) * 256 + 128 + (n & 127);
    return n;
}
__device__ __forceinline__ void transpose_item(const float* W, int ldw, int ncols, int k0, int n0, const float* kscale, bf16_t* WT, int ldt, int type, LAS float* scr, int lane) {
    const int n4 = (lane & 15) * 4, kr = lane >> 4; const bool okc = (n0 + n4) < ncols;
    f32x4 v[16];
#pragma unroll
    for (int i = 0; i < 16; ++i) v[i] = okc ? __builtin_nontemporal_load((const f32x4*)(W + (size_t)(k0 + 4 * i + kr) * ldw + n0 + n4)) : (f32x4){0.f, 0.f, 0.f, 0.f};
    if (kscale) {
#pragma unroll
        for (int i = 0; i < 16; ++i) v[i] = v[i] * kscale[k0 + 4 * i + kr]; }
#pragma unroll
    for (int i = 0; i < 16; ++i) { LAS float* s = scr + (4 * i + kr) * 65 + n4; s[0] = v[i][0]; s[1] = v[i][1]; s[2] = v[i][2]; s[3] = v[i][3]; }
    LDS_WAIT(); asm volatile("" ::: "memory");
    const int c = lane & 7;
#pragma unroll
    for (int j = 0; j < 8; ++j) { const int n = (lane >> 3) + 8 * j; const LAS float* s = scr + (8 * c) * 65 + n;
        u32x4 o; o.x = pk2(s[0 * 65], s[1 * 65]); o.y = pk2(s[2 * 65], s[3 * 65]); o.z = pk2(s[4 * 65], s[5 * 65]); o.w = pk2(s[6 * 65], s[7 * 65]);
        if (n0 + n < ncols) *(u32x4*)(WT + (size_t)dmap(type, n0 + n) * ldt + k0 + 8 * c) = o; }
    LDS_WAIT(); asm volatile("" ::: "memory");
}
__device__ __forceinline__ int t5_bucket(int d) {
    if (d < 16) return d;
    const float v = logf((float)d / 16.0f) / 4.852030263919617f * 16.0f;
    int b = 16 + (int)v; return b < 31 ? b : 31;
}
constexpr int I_IN = 32 * 89, I_OUT = 32 * 32, I_PP = 4 * 32, I_PG = 32 * 32, I_G = 32 * 128, I_U = 32 * 128, I_D = 32 * 128;
constexpr int IO_OUT = I_IN, IO_PP = IO_OUT + I_OUT, IO_PG = IO_PP + I_PP, IO_G = IO_PG + I_PG, IO_U = IO_G + I_G, IO_D = IO_U + I_U, I_L = IO_D + I_D;
__device__ __forceinline__ void conv_items(const Frame& F, const Args& a, const int l, const int lo, const int hi, const int gw, const int NGW) {
    LAS float* scr = (LAS float*)(F.lds + F.wave * 16640);
    bf16_t* WIN = (bf16_t*)(F.ws + WS_WIN); bf16_t* WOUT = (bf16_t*)(F.ws + WS_WOUT); bf16_t* WGU = (bf16_t*)(F.ws + WS_WGU); bf16_t* WD = (bf16_t*)(F.ws + WS_WD);
    bf16_t* WPG = (bf16_t*)(F.ws + WS_WPG); bf16_t* WPP = (bf16_t*)(F.ws + WS_WPP);
    for (int it = lo + gw; it < hi; it += NGW) {
        int r = it;
        if (r < IO_OUT) { const int kb = r / 89, nb = r - kb * 89; transpose_item(a.in[2] + (size_t)l * DM * DIN, DIN, DIN, kb * 64, nb * 64, nullptr, WIN + (size_t)l * DINP * DM, DM, 1, scr, F.lane); continue; }
        if (r < IO_PP) { r -= IO_OUT; const int kb = r >> 5, nb = r & 31; transpose_item(a.in[12] + (size_t)l * DM * DM, DM, DM, kb * 64, nb * 64, a.in[11] + l * DM, WOUT + (size_t)l * DM * DM, DM, 0, scr, F.lane); continue; }
        if (r < IO_PG) { r -= IO_PP; const int kb = r >> 5, nb = r & 31; transpose_item(a.in[25] + (size_t)l * PLE * DM, DM, DM, kb * 64, nb * 64, nullptr, WPP + (size_t)l * DM * PLE, PLE, 0, scr, F.lane); continue; }
        if (r < IO_G) { r -= IO_PG; const int kb = r >> 5, nb = r & 31; transpose_item(a.in[23] + (size_t)l * DM * DM, DM, DM, kb * 64, nb * 64, nullptr, WPG + (size_t)l * DM * DM, DM, 0, scr, F.lane); continue; }
        if (r < IO_U) { r -= IO_G; const int e = r >> 7, q = r & 127, kb = q >> 2, nb = q & 3; transpose_item(a.in[20] + (size_t)(l * NEXP + e) * DM * DEXP, DEXP, DEXP, kb * 64, nb * 64, nullptr, WGU + (size_t)(l * NEXP + e) * 512 * DM, DM, 2, scr, F.lane); continue; }
        if (r < IO_D) { r -= IO_U; const int e = r >> 7, q = r & 127, kb = q >> 2, nb = q & 3; transpose_item(a.in[21] + (size_t)(l * NEXP + e) * DM * DEXP, DEXP, DEXP, kb * 64, nb * 64, nullptr, WGU + (size_t)(l * NEXP + e) * 512 * DM, DM, 3, scr, F.lane); continue; }
        { r -= IO_D; const int e = r >> 7, q = r & 127, kb = q >> 5, nb = q & 31; transpose_item(a.in[22] + (size_t)(l * NEXP + e) * DEXP * DM, DM, DM, kb * 64, nb * 64, nullptr, WD + (size_t)(l * NEXP + e) * DM * DEXP, DEXP, 0, scr, F.lane); }
    }
}
__device__ __forceinline__ void conv_all(const Frame& F, const Args& a, const int l, const int lo, const int hi) { __syncthreads(); conv_items(F, a, l, lo, hi, F.bx * 8 + F.wave, F.G * 8); __syncthreads(); }
__device__ __forceinline__ void phase_prologue(const Frame& F, const Args& a) {
    bf16_t* WIN = (bf16_t*)(F.ws + WS_WIN);
    conv_all(F, a, 0, 0, I_L);
    const size_t gt = (size_t)F.bx * 512 + F.tid, NT = (size_t)F.G * 512;
    for (size_t i = gt; i < (size_t)NL * (DINP - DIN) * DM / 8; i += NT) { const size_t l = i / ((DINP - DIN) * DM / 8), r = i % ((DINP - DIN) * DM / 8);
        *(u32x4*)(WIN + (l * DINP + DIN) * DM + r * 8) = (u32x4){0u, 0u, 0u, 0u}; }
    { const float* x = a.in[0]; bf16_t* XB = (bf16_t*)(F.ws + WS_XB);
      for (size_t i = gt; i < (size_t)MT * DM / 8; i += NT) { const f32x4 v0 = *(const f32x4*)(x + i * 8), v1 = *(const f32x4*)(x + i * 8 + 4);
          *(u32x4*)(XB + i * 8) = (u32x4){pk2(v0[0], v0[1]), pk2(v0[2], v0[3]), pk2(v1[0], v1[1]), pk2(v1[2], v1[3])}; } }
    { const float* p = a.in[1]; bf16_t* PB = (bf16_t*)(F.ws + WS_PB);
      for (size_t i = gt; i < (size_t)NL * MT * PLE / 8; i += NT) { const f32x4 v0 = *(const f32x4*)(p + i * 8), v1 = *(const f32x4*)(p + i * 8 + 4);
          *(u32x4*)(PB + i * 8) = (u32x4){pk2(v0[0], v0[1]), pk2(v0[2], v0[3]), pk2(v1[0], v1[1]), pk2(v1[2], v1[3])}; } }
    { float* bt = (float*)(F.ws + WS_BTAB); const float* rb = a.in[13];
      for (size_t i = gt; i < 3 * 129 * 8; i += NT) { const int h = (int)(i & 7), j = (int)((i >> 3) % 129), br = (int)((i >> 3) / 129); const int dil = br == 0 ? 1 : (br == 1 ? 4 : 16);
          bt[i] = rb[t5_bucket(j * dil) * 8 + h]; } }
    { float* wrt = (float*)(F.ws + WS_WRT);
      for (size_t i = gt; i < (size_t)NL * 36 * DM; i += NT) { const int c = (int)(i % DM), col = (int)((i / DM) % 36), l = (int)(i / (36 * DM));
          wrt[i] = col < 4 ? a.in[16][((size_t)l * DM + c) * 4 + col] : a.in[18][((size_t)l * DM + c) * 32 + (col - 4)]; } }
}

__device__ __forceinline__ void conv_unit(const Frame& F, const Args& a, int l, int unit) {
    const bf16_t* U = (const bf16_t*)(F.ws + WS_U); bf16_t* MIX = (bf16_t*)(F.ws + WS_MIX);
    LAS float* hb = (LAS float*)F.lds;
    const int t0 = unit * 32, tl0 = t0 & (SEQ - 1), tb = t0 - tl0;
    const int tid = F.tid;
    __syncthreads();
#pragma unroll 1
    for (int i = 0; i < 8; ++i) { const int id = tid + 512 * i; if (id < 62 * 64) { const int row = id >> 6, ch = (id & 63) * 8; const int tl = tl0 - 30 + row;
        float o[8];
        if (tl >= 0) { const bf16_t* up = U + (size_t)(tb + tl) * DINP; const u32x4 av = *(const u32x4*)(up + UA_VAL + ch), gv = *(const u32x4*)(up + UA_GATE + ch);
            const unsigned aw[4] = {av.x, av.y, av.z, av.w}, gw[4] = {gv.x, gv.y, gv.z, gv.w};
#pragma unroll
            for (int j = 0; j < 4; ++j) { o[2 * j] = bflo(aw[j]) * sigmoidf_(bflo(gw[j])); o[2 * j + 1] = bfhi(aw[j]) * sigmoidf_(bfhi(gw[j])); } }
        else {
#pragma unroll
            for (int j = 0; j < 8; ++j) o[j] = 0.f; }
        *(LAS f32x4*)(hb + row * 512 + ch) = (f32x4){o[0], o[1], o[2], o[3]}; *(LAS f32x4*)(hb + row * 512 + ch + 4) = (f32x4){o[4], o[5], o[6], o[7]}; } }
    __syncthreads();
    float yv[32];
    { const int c = tid; const float* w = a.in[3] + (size_t)l * 31 * 512; const float bias = a.in[4][l * 512 + c];
      float wv[31];
#pragma unroll
      for (int j = 0; j < 31; ++j) wv[j] = w[j * 512 + c];
      float hv[62];
#pragma unroll
      for (int r = 0; r < 62; ++r) hv[r] = hb[r * 512 + c];
#pragma unroll
      for (int t = 0; t < 32; ++t) { float s = bias;
#pragma unroll
          for (int j = 0; j < 31; ++j) s += wv[j] * hv[t + j];
          yv[t] = s; } }
    __syncthreads();
#pragma unroll
    for (int t = 0; t < 32; ++t) hb[t * 512 + tid] = yv[t];
    __syncthreads();
    { const float* lg = a.in[5] + l * 512; const float* lb = a.in[6] + l * 512;
#pragma unroll 1
      for (int i = 0; i < 4; ++i) { const int t = F.wave + 8 * i;
          const f32x4 v0 = *(const LAS f32x4*)(hb + t * 512 + 4 * F.lane), v1 = *(const LAS f32x4*)(hb + t * 512 + 256 + 4 * F.lane);
          const float mean = wave_sum((v0[0] + v0[1]) + (v0[2] + v0[3]) + (v1[0] + v1[1]) + (v1[2] + v1[3])) * (1.f / 512.f);
          const f32x4 d0 = v0 - mean, d1 = v1 - mean;
          const float var = wave_sum((d0[0] * d0[0] + d0[1] * d0[1]) + (d0[2] * d0[2] + d0[3] * d0[3]) + (d1[0] * d1[0] + d1[1] * d1[1]) + (d1[2] * d1[2] + d1[3] * d1[3])) * (1.f / 512.f);
          const float rstd = 1.0f / sqrtf(var + LN_EPS);
          const f32x4 g0 = *(const f32x4*)(lg + 4 * F.lane), g1 = *(const f32x4*)(lg + 256 + 4 * F.lane), b0 = *(const f32x4*)(lb + 4 * F.lane), b1 = *(const f32x4*)(lb + 256 + 4 * F.lane);
          float o0[4], o1[4];
#pragma unroll
          for (int j = 0; j < 4; ++j) { o0[j] = siluf_(d0[j] * rstd * g0[j] + b0[j]); o1[j] = siluf_(d1[j] * rstd * g1[j] + b1[j]); }
          bf16_t* mp = MIX + (size_t)(t0 + t) * DM;
          *(u32x2*)(mp + 4 * F.lane) = (u32x2){pk2(o0[0], o0[1]), pk2(o0[2], o0[3])}; *(u32x2*)(mp + 256 + 4 * F.lane) = (u32x2){pk2(o1[0], o1[1]), pk2(o1[2], o1[3])}; } }
    { const int c = tid; const float* w = a.in[10] + (size_t)l * 3 * 512; const float w0 = w[c], w1 = w[512 + c], w2 = w[1024 + c];
      float p2 = 0.f, p1 = 0.f;
      if (tl0 >= 2) { const bf16_t* up = U + (size_t)(t0 - 2) * DINP; p2 = bf2f(up[US_C + c]) * bf2f(up[US_H + c]); }
      if (tl0 >= 1) { const bf16_t* up = U + (size_t)(t0 - 1) * DINP; p1 = bf2f(up[US_C + c]) * bf2f(up[US_H + c]); }
#pragma unroll 4
      for (int t = 0; t < 32; ++t) { const bf16_t* up = U + (size_t)(t0 + t) * DINP; const float p0 = bf2f(up[US_C + c]) * bf2f(up[US_H + c]);
          const float y = bf2f(up[US_B + c]) * (w0 * p2 + w1 * p1 + w2 * p0);
          MIX[(size_t)(t0 + t) * DM + 1536 + c] = (bf16_t)f2bf(y); p2 = p1; p1 = p0; } }
}

__device__ __forceinline__ void gla_a_unit(const Frame& F, const Args& a, int l, int unit) {
    const bf16_t* U = (const bf16_t*)(F.ws + WS_U);
    float* GU = (float*)(F.ws + WS_GU); float* GO = (float*)(F.ws + WS_GO); float* GQ = (float*)(F.ws + WS_GQ); float* GD = (float*)(F.ws + WS_GD);
    const int n = unit & 63, h = (unit >> 6) & 3, b = unit >> 8, bh = b * 4 + h;
    const int t0 = b * SEQ + n * 32, tid = F.tid;
    LAS float* L = (LAS float*)F.lds;
    LAS float* qt = L; LAS float* kr = L + 2048; LAS float* kt = L + 4096; LAS float* kh = L + 6144; LAS float* vv = L + 8192; LAS float* bc = L + 12288; LAS float* gl = L + 14336; LAS float* wg = L + 14848; LAS float* sc = L + 15872;
    const int i = tid >> 4, k4 = (tid & 15) * 4, v8 = (tid & 15) * 8;
    __syncthreads();
    { const bf16_t* up = U + (size_t)(t0 + i) * DINP;
      const u32x2 qw = *(const u32x2*)(up + UG_Q + h * 64 + k4), kw = *(const u32x2*)(up + UG_K + h * 64 + k4); const u32x4 vw = *(const u32x4*)(up + UG_V + h * 128 + v8);
      *(LAS f32x4*)(qt + i * 64 + k4) = (f32x4){bflo(qw.x), bfhi(qw.x), bflo(qw.y), bfhi(qw.y)};
      *(LAS f32x4*)(kr + i * 64 + k4) = (f32x4){bflo(kw.x), bfhi(kw.x), bflo(kw.y), bfhi(kw.y)};
      *(LAS f32x4*)(vv + i * 128 + v8) = (f32x4){bflo(vw.x), bfhi(vw.x), bflo(vw.y), bfhi(vw.y)}; *(LAS f32x4*)(vv + i * 128 + v8 + 4) = (f32x4){bflo(vw.z), bfhi(vw.z), bflo(vw.w), bfhi(vw.w)};
      gl[i * 16 + (tid & 15)] = bf2f(up[UG_LOW + (tid & 15)]);
      const float* w2 = a.in[7] + (size_t)l * 16 * 256;
      wg[tid] = w2[(tid >> 6) * 256 + h * 64 + (tid & 63)]; wg[512 + tid] = w2[(8 + (tid >> 6)) * 256 + h * 64 + (tid & 63)]; }
    __syncthreads();
    { const f32x4 bg = *(const f32x4*)(a.in[8] + l * 256 + h * 64 + k4); f32x4 z = bg;
#pragma unroll
      for (int r = 0; r < 16; ++r) { const float g = gl[i * 16 + r]; const f32x4 w = *(const LAS f32x4*)(wg + r * 64 + k4); z = z + w * g; }
      f32x4 la;
#pragma unroll
      for (int j = 0; j < 4; ++j) la[j] = (fminf(z[j], 0.f) - log1pf(expf(-fabsf(z[j])))) * (1.0f / 16.0f);
      *(LAS f32x4*)(bc + i * 64 + k4) = la; }
    __syncthreads();
    f32x4 bv = {0.f, 0.f, 0.f, 0.f}, bl = bv;
#pragma unroll 8
    for (int r = 0; r < 32; ++r) { const f32x4 x = *(const LAS f32x4*)(bc + r * 64 + k4); bl = bl + x; if (r <= i) bv = bv + x; }
    { const f32x4  q = *(const LAS f32x4*)(qt + i * 64 + k4), k = *(const LAS f32x4*)(kr + i * 64 + k4);
      f32x4 qo, ko, ho;
#pragma unroll
      for (int j = 0; j < 4; ++j) { qo[j] = q[j] * expf(bv[j]) * 0.125f; ko[j] = k[j] * expf(-bv[j]); ho[j] = k[j] * expf(bl[j] - bv[j]); }
      *(LAS f32x4*)(qt + i * 64 + k4) = qo; *(LAS f32x4*)(kt + i * 64 + k4) = ko; *(LAS f32x4*)(kh + i * 64 + k4) = ho;
      *(f32x4*)(GQ + (size_t)(t0 + i) * 256 + h * 64 + k4) = qo;
      if (i == 31) { f32x4 d;
#pragma unroll
          for (int j = 0; j < 4; ++j) d[j] = expf(bl[j]);
          *(f32x4*)(GD + ((size_t)bh * 64 + n) * 64 + k4) = d; } }
    __syncthreads();
    { const int j0 = (tid & 15) * 2; float s0 = 0.f, s1 = 0.f;
#pragma unroll
      for (int k = 0; k < 64; k += 4) { const f32x4 q = *(const LAS f32x4*)(qt + i * 64 + k), ka = *(const LAS f32x4*)(kt + j0 * 64 + k), kb = *(const LAS f32x4*)(kt + (j0 + 1) * 64 + k);
          s0 += (q[0] * ka[0] + q[1] * ka[1]) + (q[2] * ka[2] + q[3] * ka[3]); s1 += (q[0] * kb[0] + q[1] * kb[1]) + (q[2] * kb[2] + q[3] * kb[3]); }
      sc[i * 33 + j0] = (j0 <= i) ? s0 : 0.f; sc[i * 33 + j0 + 1] = (j0 + 1 <= i) ? s1 : 0.f; }
    { const int kk = (tid >> 5) * 4, v0 = (tid & 31) * 4; f32x4 u0 = {0.f, 0.f, 0.f, 0.f}, u1 = u0, u2 = u0, u3 = u0;
#pragma unroll 8
      for (int j = 0; j < 32; ++j) { const f32x4 kv = *(const LAS f32x4*)(kh + j * 64 + kk), vx = *(const LAS f32x4*)(vv + j * 128 + v0);
          u0 = u0 + vx * kv[0]; u1 = u1 + vx * kv[1]; u2 = u2 + vx * kv[2]; u3 = u3 + vx * kv[3]; }
      float* gp = GU + (((size_t)bh * 64 + n) * 64 + kk) * 128 + v0;
      *(f32x4*)(gp) = u0; *(f32x4*)(gp + 128) = u1; *(f32x4*)(gp + 256) = u2; *(f32x4*)(gp + 384) = u3; }
    __syncthreads();
    { f32x4 o0 = {0.f, 0.f, 0.f, 0.f}, o1 = o0;
#pragma unroll 8
      for (int j = 0; j < 32; ++j) { const float s = sc[i * 33 + j]; const f32x4 va = *(const LAS f32x4*)(vv + j * 128 + v8), vb = *(const LAS f32x4*)(vv + j * 128 + v8 + 4); o0 = o0 + va * s; o1 = o1 + vb * s; }
      float* gp = GO + (size_t)(t0 + i) * 512 + h * 128 + v8; *(f32x4*)gp = o0; *(f32x4*)(gp + 4) = o1; }
}
__device__ __forceinline__ void gla_scan(const Frame& F) {
    float* GU = (float*)(F.ws + WS_GU); const float* GD = (const float*)(F.ws + WS_GD);
    for (int g = F.bx * 512 + F.tid; g < 16 * 8192; g += F.G * 512) { const int bh = g >> 13, kv = g & 8191, k = kv >> 7;
        float* p = GU + (size_t)bh * 64 * 8192 + kv; const float* d = GD + (size_t)bh * 64 * 64 + k; float S = 0.f;
#pragma unroll 8
        for (int n = 0; n < 64; ++n) { const float u = p[(size_t)n * 8192]; const float dc = d[n * 64]; p[(size_t)n * 8192] = S; S = S * dc + u; } }
}
struct GlaCIn { f32x4 s[4]; f32x4 q, o0, o1; u32x4 rw; };
__device__ __forceinline__ void gla_c_load(const Frame& F, int unit, GlaCIn& in) {
    const bf16_t* U = (const bf16_t*)(F.ws + WS_U); const float* GU = (const float*)(F.ws + WS_GU); const float* GO = (const float*)(F.ws + WS_GO); const float* GQ = (const float*)(F.ws + WS_GQ);
    const int n = unit & 63, h = (unit >> 6) & 3, b = unit >> 8, bh = b * 4 + h, t0 = b * SEQ + n * 32, tid = F.tid, i = tid >> 4, k4 = (tid & 15) * 4, v8 = (tid & 15) * 8;
    const float* sp = GU + ((size_t)bh * 64 + n) * 8192;
#pragma unroll
    for (int j = 0; j < 4; ++j) in.s[j] = *(const f32x4*)(sp + (tid + 512 * j) * 4);
    in.q = *(const f32x4*)(GQ + (size_t)(t0 + i) * 256 + h * 64 + k4);
    const float* gp = GO + (size_t)(t0 + i) * 512 + h * 128 + v8; in.o0 = *(const f32x4*)gp; in.o1 = *(const f32x4*)(gp + 4);
    in.rw = *(const u32x4*)(U + (size_t)(t0 + i) * DINP + UG_R + h * 128 + v8);
}
__device__ __forceinline__ void gla_c_phase(const Frame& F, const Args& a, int l) {
    bf16_t* MIX = (bf16_t*)(F.ws + WS_MIX);
    const int tid = F.tid, i = tid >> 4, k4 = (tid & 15) * 4, v8 = (tid & 15) * 8;
    LAS float* qt = (LAS float*)F.lds; LAS float* Ss = qt + 2048;
    const float* ng = a.in[9] + l * 128 + v8; const f32x4 n0 = *(const f32x4*)ng, n1 = *(const f32x4*)(ng + 4);
    GlaCIn in;
    if (F.bx < 1024) gla_c_load(F, F.bx, in);
#pragma unroll 1
    for (int unit = F.bx; unit < 1024; unit += F.G) {
        const int n = unit & 63, h = (unit >> 6) & 3, b = unit >> 8, t0 = b * SEQ + n * 32;
        __syncthreads();
        *(LAS f32x4*)(qt + i * 64 + k4) = in.q;
#pragma unroll
        for (int j = 0; j < 4; ++j) *(LAS f32x4*)(Ss + (tid + 512 * j) * 4) = in.s[j];
        f32x4 o0 = in.o0, o1 = in.o1; const u32x4 rw = in.rw;
        __syncthreads();
        if (unit + F.G < 1024) gla_c_load(F, unit + F.G, in);
#pragma unroll 8
        for (int k = 0; k < 64; ++k) { const float q = qt[i * 64 + k]; const f32x4 sa = *(const LAS f32x4*)(Ss + k * 128 + v8), sb = *(const LAS f32x4*)(Ss + k * 128 + v8 + 4); o0 = o0 + sa * q; o1 = o1 + sb * q; }
        float ss = (o0[0] * o0[0] + o0[1] * o0[1]) + (o0[2] * o0[2] + o0[3] * o0[3]) + (o1[0] * o1[0] + o1[1] * o1[1]) + (o1[2] * o1[2] + o1[3] * o1[3]);
        ss += __shfl_xor(ss, 1); ss += __shfl_xor(ss, 2); ss += __shfl_xor(ss, 4); ss += __shfl_xor(ss, 8);
        const float rms = 1.0f / sqrtf(ss * (1.f / 128.f) + RMS_EPS);
        const float r[8] = {bflo(rw.x), bfhi(rw.x), bflo(rw.y), bfhi(rw.y), bflo(rw.z), bfhi(rw.z), bflo(rw.w), bfhi(rw.w)};
        float o[8];
#pragma unroll
        for (int j = 0; j < 4; ++j) { o[j] = o0[j] * rms * n0[j] * siluf_(r[j]); o[4 + j] = o1[j] * rms * n1[j] * siluf_(r[4 + j]); }
        *(u32x4*)(MIX + (size_t)(t0 + i) * DM + 512 + h * 128 + v8) = (u32x4){pk2(o[0], o[1]), pk2(o[2], o[3]), pk2(o[4], o[5]), pk2(o[6], o[7])};
    }
}

typedef short s16x4 __attribute__((ext_vector_type(4)));
__device__ __forceinline__ s16x4 vtr(const LAS unsigned char* p) { return __builtin_bit_cast(s16x4, __builtin_amdgcn_ds_read_tr16_b64_v4i16((LAS s16x4*)p)); }
constexpr int AT_VROW = 160, AT_VBUF = 32 * AT_VROW;
__device__ __forceinline__ void attn_job(const Frame& F, int job, LAS unsigned char* vbuf, const LAS float* bt) {
    const bf16_t* U = (const bf16_t*)(F.ws + WS_U); bf16_t* AO = (bf16_t*)(F.ws + WS_AO); float* ALSE = (float*)(F.ws + WS_ALSE);
    const int lane = F.lane, qi = lane & 15, g = lane >> 4;
    const int gidx = job & 127, t2 = job >> 7, br = t2 % 3, bh = t2 / 3, h = bh & 7, b = bh >> 3;
    const int dsh = 2 * br, dil = 1 << dsh, gsh = 7 - dsh, r = gidx >> gsh, gi = gidx & ((1 << gsh) - 1);
    const int q0 = gi * 16, tb = b * SEQ;
    const bf16_t* Ub = U + (size_t)(tb + r) * DINP + h * 64;
    const size_t sstep = (size_t)dil * DINP;
    const bf16_t* qrow = Ub + (size_t)(q0 + qi) * sstep + UC_Q + 8 * g;
    const bf16x8 qf0 = *(const bf16x8*)qrow, qf1 = *(const bf16x8*)(qrow + 32);
    const int klo = (q0 >= 128 ? q0 - 128 : 0) & ~31;
    const int nch = ((q0 + 15 - klo) >> 5) + 1;
    float m_run = -1e30f, l_part = 0.f;
    f32x4 o[4];
#pragma unroll
    for (int d = 0; d < 4; ++d) o[d] = (f32x4){0.f, 0.f, 0.f, 0.f};
    bf16x8 ka0, ka1, kb0, kb1; u32x4 vr[4];
#define AT_LOAD(kc) do { const bf16_t* kp = Ub + (size_t)((kc) + qi) * sstep + UC_K + 8 * g; ka0 = *(const bf16x8*)kp; ka1 = *(const bf16x8*)(kp + 32); kp += 16 * sstep; kb0 = *(const bf16x8*)kp; kb1 = *(const bf16x8*)(kp + 32); \
        const bf16_t* vp = Ub + (size_t)((kc) + (lane >> 3)) * sstep + UC_V + (lane & 7) * 8; _Pragma("unroll") for (int it = 0; it < 4; ++it) vr[it] = *(const u32x4*)(vp + (size_t)(8 * it) * sstep); } while (0)
    AT_LOAD(klo);
#pragma unroll 1
    for (int c = 0; c < nch; ++c) {
        const int kc = klo + 32 * c;
        LAS unsigned char* vb = vbuf + (c & 1) * AT_VBUF;
#pragma unroll
        for (int it = 0; it < 4; ++it) *(LAS u32x4*)(vb + (it * 8 + (lane >> 3)) * AT_VROW + (lane & 7) * 16) = vr[it];
        const bf16x8 ca0 = ka0, ca1 = ka1, cb0 = kb0, cb1 = kb1;
        if (c + 1 < nch) AT_LOAD(kc + 32);
        f32x4 sa = (f32x4){0.f, 0.f, 0.f, 0.f}, sb = sa;
        sa = __builtin_amdgcn_mfma_f32_16x16x32_bf16(ca0, qf0, sa, 0, 0, 0); sa = __builtin_amdgcn_mfma_f32_16x16x32_bf16(ca1, qf1, sa, 0, 0, 0);
        sb = __builtin_amdgcn_mfma_f32_16x16x32_bf16(cb0, qf0, sb, 0, 0, 0); sb = __builtin_amdgcn_mfma_f32_16x16x32_bf16(cb1, qf1, sb, 0, 0, 0);
        const int st0 = (q0 + qi) - (kc + 4 * g);
        float cmax = -1e30f;
#pragma unroll
        for (int rr = 0; rr < 4; ++rr) {
            const int sA = st0 - rr, sB = st0 - rr - 16;
            const int iA = sA < 0 ? 0 : (sA > 128 ? 128 : sA), iB = sB < 0 ? 0 : (sB > 128 ? 128 : sB);
            const float vA = sa[rr] * 0.125f + bt[(br * 129 + iA) * 8 + h], vB = sb[rr] * 0.125f + bt[(br * 129 + iB) * 8 + h];
            sa[rr] = (sA >= 0 && sA <= 128) ? vA : -1e30f; sb[rr] = (sB >= 0 && sB <= 128) ? vB : -1e30f;
            cmax = fmaxf(cmax, fmaxf(sa[rr], sb[rr])); }
        cmax = fmaxf(cmax, __shfl_xor(cmax, 16)); cmax = fmaxf(cmax, __shfl_xor(cmax, 32));
        const float m_new = fmaxf(m_run, cmax), alpha = __expf(m_run - m_new);
        float psum = 0.f;
#pragma unroll
        for (int rr = 0; rr < 4; ++rr) { sa[rr] = __expf(sa[rr] - m_new); sb[rr] = __expf(sb[rr] - m_new); psum += sa[rr] + sb[rr]; }
        l_part = l_part * alpha + psum; m_run = m_new;
#pragma unroll
        for (int d = 0; d < 4; ++d) o[d] = o[d] * alpha;
        const u32x4 pw = (u32x4){pk2(sa[0], sa[1]), pk2(sa[2], sa[3]), pk2(sb[0], sb[1]), pk2(sb[2], sb[3])};
        const bf16x8 pf = __builtin_bit_cast(bf16x8, pw);
        const LAS unsigned char* tp = vb + (4 * g + (qi >> 2)) * AT_VROW + (qi & 3) * 8;
#pragma unroll
        for (int d = 0; d < 4; ++d) { const s16x4 va = vtr(tp + d * 32), vb2 = vtr(tp + 16 * AT_VROW + d * 32);
            const bf16x8 vf = (bf16x8){va[0], va[1], va[2], va[3], vb2[0], vb2[1], vb2[2], vb2[3]};
            o[d] = __builtin_amdgcn_mfma_f32_16x16x32_bf16(vf, pf, o[d], 0, 0, 0); }
    }
#undef AT_LOAD
    float l = l_part; l += __shfl_xor(l, 16); l += __shfl_xor(l, 32);
    const float inv = 1.0f / l;
    const int token = tb + (q0 + qi) * dil + r;
    bf16_t* op = AO + ((size_t)br * MT + token) * 512 + h * 64 + 4 * g;
#pragma unroll
    for (int d = 0; d < 4; ++d) *(u32x2*)(op + d * 16) = (u32x2){pk2(o[d][0] * inv, o[d][1] * inv), pk2(o[d][2] * inv, o[d][3] * inv)};
    if (g == 0) ALSE[((size_t)br * MT + token) * 8 + h] = m_run + logf(l);
}
__device__ __forceinline__ void attn_combine(const Frame& F) {
    const bf16_t* AO = (const bf16_t*)(F.ws + WS_AO); const float* ALSE = (const float*)(F.ws + WS_ALSE); bf16_t* MIX = (bf16_t*)(F.ws + WS_MIX);
    for (int i = F.bx * 512 + F.tid; i < MT * 64; i += F.G * 512) { const int token = i >> 6, c8 = (i & 63) * 8, h = c8 >> 6;
        const float l0 = ALSE[(size_t)token * 8 + h], l1 = ALSE[((size_t)MT + token) * 8 + h], l2 = ALSE[((size_t)2 * MT + token) * 8 + h];
        const float m = fmaxf(l0, fmaxf(l1, l2)); float w0 = __expf(l0 - m), w1 = __expf(l1 - m), w2 = __expf(l2 - m); const float inv = 1.0f / (w0 + w1 + w2); w0 *= inv; w1 *= inv; w2 *= inv;
        const u32x4 a = *(const u32x4*)(AO + (size_t)token * 512 + c8), bq = *(const u32x4*)(AO + ((size_t)MT + token) * 512 + c8), cq = *(const u32x4*)(AO + ((size_t)2 * MT + token) * 512 + c8);
        const unsigned aw[4] = {a.x, a.y, a.z, a.w}, bw[4] = {bq.x, bq.y, bq.z, bq.w}, cw[4] = {cq.x, cq.y, cq.z, cq.w}; unsigned ow[4];
#pragma unroll
        for (int j = 0; j < 4; ++j) ow[j] = pk2(w0 * bflo(aw[j]) + w1 * bflo(bw[j]) + w2 * bflo(cw[j]), w0 * bfhi(aw[j]) + w1 * bfhi(bw[j]) + w2 * bfhi(cw[j]));
        *(u32x4*)(MIX + (size_t)token * DM + 1024 + c8) = (u32x4){ow[0], ow[1], ow[2], ow[3]}; }
}

__device__ __forceinline__ void ln1_unit(const Frame& F, const Args& a, int l, int unit, bool commit) {
    const bf16_t* PRE = (const bf16_t*)(F.ws + WS_PRE); bf16_t* XB = (bf16_t*)(F.ws + WS_XB); const float* wrt = (const float*)(F.ws + WS_WRT) + (size_t)l * 36 * DM;
    int* ltok = (int*)(F.ws + WS_LTOK); float* lgate = (float*)(F.ws + WS_LGATE); int* tinfo = (int*)(F.ws + WS_TINFO); unsigned* cnt = F.ctl + CW_CNT + l * 32 * 64;
    LAS float* Wl = (LAS float*)F.lds;
    const int lane = F.lane, tid = F.tid, row0 = unit * 16 + F.wave * 2;
    const float* g = a.in[14] + (size_t)l * DM; const float* bb = a.in[15] + (size_t)l * DM;
    f32x4 wreg[5];
#pragma unroll
    for (int i = 0; i < 5; ++i) { const int idx = tid + 512 * i; if (idx < 36 * 64) wreg[i] = *(const f32x4*)(wrt + (size_t)(idx >> 6) * DM + (idx & 63) * 4); }
    float mean_[2], rstd_[2];
#pragma unroll
    for (int r = 0; r < 2; ++r) { const int row = row0 + r; const bf16_t* pr = PRE + (size_t)row * DM; f32x4 v[8]; float s = 0.f;
#pragma unroll
      for (int j = 0; j < 8; ++j) { const u32x2 w = *(const u32x2*)(pr + 256 * j + 4 * lane); v[j] = (f32x4){bflo(w.x), bfhi(w.x), bflo(w.y), bfhi(w.y)}; s += (v[j][0] + v[j][1]) + (v[j][2] + v[j][3]); }
      const float mean = wave_sum(s) * (1.f / DM); float q = 0.f;
#pragma unroll
      for (int j = 0; j < 8; ++j) { v[j] = v[j] - mean; q += (v[j][0] * v[j][0] + v[j][1] * v[j][1]) + (v[j][2] * v[j][2] + v[j][3] * v[j][3]); }
      const float rstd = 1.0f / sqrtf(wave_sum(q) * (1.f / DM) + LN_EPS);
      mean_[r] = mean; rstd_[r] = rstd;
#pragma unroll
      for (int j = 0; j < 8; ++j) { const f32x4 gv = *(const f32x4*)(g + 256 * j + 4 * lane), bv = *(const f32x4*)(bb + 256 * j + 4 * lane); const f32x4 y = v[j] * rstd * gv + bv;
          *(u32x2*)(XB + (size_t)row * DM + 256 * j + 4 * lane) = (u32x2){pk2(y[0], y[1]), pk2(y[2], y[3])}; } }
    float acc[2][36];
#pragma unroll
    for (int r = 0; r < 2; ++r)
#pragma unroll
        for (int c = 0; c < 36; ++c) acc[r][c] = 0.f;
    __syncthreads();
#pragma unroll 1
    for (int j = 0; j < 8; ++j) {
        LAS float* Wb = Wl + (j & 1) * (36 * 256);
#pragma unroll
        for (int i = 0; i < 5; ++i) { const int idx = tid + 512 * i; if (idx < 36 * 64) *(LAS f32x4*)(Wb + (idx >> 6) * 256 + (idx & 63) * 4) = wreg[i]; }
        __syncthreads();
        if (j < 7) {
#pragma unroll
            for (int i = 0; i < 5; ++i) { const int idx = tid + 512 * i; if (idx < 36 * 64) wreg[i] = *(const f32x4*)(wrt + (size_t)(idx >> 6) * DM + 256 * (j + 1) + (idx & 63) * 4); } }
        f32x4 xv[2];
        { const f32x4 gv = *(const f32x4*)(g + 256 * j + 4 * lane), bv = *(const f32x4*)(bb + 256 * j + 4 * lane);
#pragma unroll
          for (int r = 0; r < 2; ++r) { const u32x2 w = *(const u32x2*)(PRE + (size_t)(row0 + r) * DM + 256 * j + 4 * lane);
              xv[r] = ((f32x4){bflo(w.x), bfhi(w.x), bflo(w.y), bfhi(w.y)} - mean_[r]) * rstd_[r] * gv + bv; } }
#pragma unroll
        for (int c = 0; c < 36; ++c) { const f32x4 w = *(const LAS f32x4*)(Wb + c * 256 + 4 * lane);
#pragma unroll
            for (int r = 0; r < 2; ++r) acc[r][c] += (xv[r][0] * w[0] + xv[r][1] * w[1]) + (xv[r][2] * w[2] + xv[r][3] * w[3]); }
    }
    const float* gb = a.in[17] + l * 4; const float* eb = a.in[19] + l * 32;
#pragma unroll
    for (int r = 0; r < 2; ++r) {
#pragma unroll
        for (int c = 0; c < 36; ++c) acc[r][c] = wave_sum(acc[r][c]);
        float gl[4];
#pragma unroll
        for (int c = 0; c < 4; ++c) gl[c] = acc[r][c] + gb[c];
        int gi = 0; float gm = gl[0];
#pragma unroll
        for (int c = 1; c < 4; ++c) if (gl[c] > gm) { gm = gl[c]; gi = c; }
        float gs = 0.f;
#pragma unroll
        for (int c = 0; c < 4; ++c) gs += expf(gl[c] - gm);
        const float gtop = 1.0f / gs;
        float ev[8];
#pragma unroll
        for (int c = 0; c < 8; ++c) { const float v0 = acc[r][4 + c] + eb[c], v1 = acc[r][12 + c] + eb[8 + c], v2 = acc[r][20 + c] + eb[16 + c], v3 = acc[r][28 + c] + eb[24 + c]; ev[c] = gi == 0 ? v0 : (gi == 1 ? v1 : (gi == 2 ? v2 : v3)); }
        int i1 = 0; float m1 = ev[0];
#pragma unroll
        for (int c = 1; c < 8; ++c) if (ev[c] > m1) { m1 = ev[c]; i1 = c; }
        int i2 = -1; float m2 = -INFINITY;
#pragma unroll
        for (int c = 0; c < 8; ++c) if (c != i1 && ev[c] > m2) { m2 = ev[c]; i2 = c; }
        const float p2 = expf(m2 - m1), den = 1.0f + p2;
        const float w1 = gtop / den, w2 = gtop * p2 / den;
        if (lane == 0 && commit) { const int tok = row0 + r; const int e1 = gi * 8 + i1, e2 = gi * 8 + i2;
            const unsigned s1 = __hip_atomic_fetch_add(cnt + e1 * 64, 1u, __ATOMIC_RELAXED, __HIP_MEMORY_SCOPE_AGENT), s2 = __hip_atomic_fetch_add(cnt + e2 * 64, 1u, __ATOMIC_RELAXED, __HIP_MEMORY_SCOPE_AGENT);
            ltok[e1 * MT + s1] = tok; lgate[e1 * MT + s1] = w1; ltok[e2 * MT + s2] = tok; lgate[e2 * MT + s2] = w2;
            tinfo[tok * 2] = e1 * MT + (int)s1; tinfo[tok * 2 + 1] = e2 * MT + (int)s2; }
    }
}
__device__ __forceinline__ void moe_tables(const Frame& F, int l) {
    LAS int* toff = (LAS int*)(F.lds + LDS_TOFF); const unsigned* cnt = F.ctl + CW_CNT + l * 32 * 64;
    __syncthreads();
    if (F.tid == 0) { int run = 0; for (int e = 0; e < 32; ++e) { toff[e] = run; run += ((int)cnt[e * 64] + 255) >> 8; } toff[32] = run; }
    __syncthreads();
}
__device__ __forceinline__ void ln2_rows(const Frame& F, const Args& a, int l, float* OUT, bool write_xb) {
    const bf16_t* PRE = (const bf16_t*)(F.ws + WS_PRE); const bf16_t* Y = (const bf16_t*)(F.ws + WS_Y); bf16_t* XB = (bf16_t*)(F.ws + WS_XB); const int* tinfo = (const int*)(F.ws + WS_TINFO);
    const LAS int* toff = (const LAS int*)(F.lds + LDS_TOFF);
    const float* g = a.in[26] + (size_t)l * DM; const float* bb = a.in[27] + (size_t)l * DM; const int lane = F.lane;
    for (int row = F.bx * 8 + F.wave; row < MT; row += F.G * 8) {
        const int i0 = tinfo[row * 2], i1 = tinfo[row * 2 + 1];
        const size_t s0 = (size_t)toff[i0 >> 13] * 256 + (i0 & 8191), s1 = (size_t)toff[i1 >> 13] * 256 + (i1 & 8191);
        const bf16_t* pr = PRE + (size_t)row * DM; const bf16_t* y0 = Y + s0 * DM; const bf16_t* y1 = Y + s1 * DM;
        f32x4 v[8]; float s = 0.f;
#pragma unroll
        for (int j = 0; j < 8; ++j) { const u32x2 pw = *(const u32x2*)(pr + 256 * j + 4 * lane); const f32x4 p = (f32x4){bflo(pw.x), bfhi(pw.x), bflo(pw.y), bfhi(pw.y)}; const u32x2 a0 = *(const u32x2*)(y0 + 256 * j + 4 * lane), a1 = *(const u32x2*)(y1 + 256 * j + 4 * lane);
            v[j][0] = p[0] + (bflo(a0.x) + bflo(a1.x)); v[j][1] = p[1] + (bfhi(a0.x) + bfhi(a1.x)); v[j][2] = p[2] + (bflo(a0.y) + bflo(a1.y)); v[j][3] = p[3] + (bfhi(a0.y) + bfhi(a1.y));
            s += (v[j][0] + v[j][1]) + (v[j][2] + v[j][3]); }
        const float mean = wave_sum(s) * (1.f / DM); float q = 0.f;
#pragma unroll
        for (int j = 0; j < 8; ++j) { v[j] = v[j] - mean; q += (v[j][0] * v[j][0] + v[j][1] * v[j][1]) + (v[j][2] * v[j][2] + v[j][3] * v[j][3]); }
        const float rstd = 1.0f / sqrtf(wave_sum(q) * (1.f / DM) + LN_EPS);
#pragma unroll
        for (int j = 0; j < 8; ++j) { const f32x4 gv = *(const f32x4*)(g + 256 * j + 4 * lane), bv = *(const f32x4*)(bb + 256 * j + 4 * lane); const f32x4 y = v[j] * rstd * gv + bv;
            if (write_xb) *(u32x2*)(XB + (size_t)row * DM + 256 * j + 4 * lane) = (u32x2){pk2(y[0], y[1]), pk2(y[2], y[3])}; else *(f32x4*)(OUT + (size_t)row * DM + 256 * j + 4 * lane) = y; }
    }
}

constexpr int PH_PER_LAYER = 9, N_PHASES = 1 + NL * PH_PER_LAYER;
__global__ void __launch_bounds__(512, 2) mega(Args args) {
    extern __shared__ __attribute__((aligned(16))) unsigned char lds_raw[];
    Frame F; F.lds = (LAS unsigned char*)lds_raw; F.ws = args.ws; F.ctl = (unsigned*)(args.ws + WS_CTL);
    F.tid = threadIdx.x; F.lane = F.tid & 63; F.wave = __builtin_amdgcn_readfirstlane(F.tid >> 6); F.G = gridDim.x; F.bx = blockIdx.x;
    if (F.tid < 4) ((LAS unsigned*)(F.lds + LDS_BARW))[F.tid] = 0u;
    __syncthreads();
#if LAUNCH_PER_PHASE
#define GRID_BAR() do { } while (0)
#else
    XcdBarrier bar = xcd_barrier_post(F.ctl + CW_BAR, (volatile LAS unsigned*)(F.lds + LDS_BARW));
#define GRID_BAR() xcd_barrier(bar)
#endif
    const int lo = args.ph_lo, hi = args.ph_hi;
#define IN(k) (lo <= (k) && (k) < hi)
#define SEAM(k) do { if (IN(k) && IN((k) + 1)) GRID_BAR(); } while (0)
    bf16_t* XB = (bf16_t*)(F.ws + WS_XB); bf16_t* Ub = (bf16_t*)(F.ws + WS_U); bf16_t* MIXb = (bf16_t*)(F.ws + WS_MIX); bf16_t* PRE = (bf16_t*)(F.ws + WS_PRE);
    bf16_t* PPb = (bf16_t*)(F.ws + WS_PP); bf16_t* Hb = (bf16_t*)(F.ws + WS_H); bf16_t* Yb = (bf16_t*)(F.ws + WS_Y);

    if (IN(0)) { for (int rep = 0; rep < REPS(9); ++rep) { const Frame f = F.fresh(); phase_prologue(f, args); if (rep + 1 < REPS(9)) GRID_BAR(); } }
    SEAM(0);
#pragma unroll 1
    for (int l = 0; l < NL; ++l) {
        const int pb = 1 + l * PH_PER_LAYER;
        if (IN(pb + 0)) for (int rep = 0; rep < REPS(0); ++rep) { if (rep) GRID_BAR(); pg8::DenseSched S; S.init(XB, (const bf16_t*)(F.ws + WS_WIN) + (size_t)l * DINP * DM, DM, DM, MT, DINP, F.G, F.bx);
            pg8::EpiBf16 E{Ub, DINP}; pg8::gemm_phase(F.lds, DM, S, E); }
        SEAM(pb + 0);
        if (IN(pb + 1)) for (int rep = 0; rep < REPS(1); ++rep) { if (rep) GRID_BAR(); { const Frame f = F.fresh(); for (int u = F.bx; u < 256; u += F.G) conv_unit(f, args, l, u); }
            { const Frame f = F.fresh(); for (int u = F.bx; u < 1024; u += F.G) gla_a_unit(f, args, l, u); } __syncthreads();
            }
        SEAM(pb + 1);
        if (IN(pb + 2)) { { const Frame f = F.fresh(); gla_scan(f); }
            const Frame f = F.fresh();
            LAS float* bt = (LAS float*)(F.lds + 8 * 2 * AT_VBUF);
            __syncthreads();
            for (int i = f.tid; i < 3 * 129 * 8; i += 512) bt[i] = ((const float*)(F.ws + WS_BTAB))[i];
            __syncthreads();
            for (int rep = 0; rep < REPS(2); ++rep)
            for (int job = F.bx * 8 + F.wave; job < 32 * 3 * 128; job += F.G * 8) attn_job(f, job, F.lds + F.wave * 2 * AT_VBUF, bt);
            __syncthreads();
            }
        SEAM(pb + 2);
        if (IN(pb + 3)) for (int rep = 0; rep < REPS(3); ++rep) { if (rep) GRID_BAR(); { const Frame f = F.fresh(); gla_c_phase(f, args, l); __syncthreads(); } { const Frame f = F.fresh(); attn_combine(f); }
            }
        SEAM(pb + 3);
        if (IN(pb + 4)) for (int rep = 0; rep < REPS(4); ++rep) { if (rep) GRID_BAR(); { pg8::DenseSched S; S.init(MIXb, (const bf16_t*)(F.ws + WS_WOUT) + (size_t)l * DM * DM, DM, DM, MT, DM, F.G, F.bx);
              pg8::EpiRes E{PRE, XB, DM, DN_ALPHA}; pg8::gemm_phase(F.lds, DM, S, E); }
            { pg8::DenseSched S; S.init((const bf16_t*)(F.ws + WS_PB) + (size_t)l * MT * PLE, (const bf16_t*)(F.ws + WS_WPP) + (size_t)l * DM * PLE, PLE, PLE, MT, DM, F.G, F.bx);
              pg8::EpiBf16 E{PPb, DM}; pg8::gemm_phase(F.lds, PLE, S, E); } }
        SEAM(pb + 4);
        if (IN(pb + 5)) for (int rep = 0; rep < REPS(5); ++rep) { if (rep) GRID_BAR(); const Frame f = F.fresh(); for (int u = F.bx; u < MT / 16; u += F.G) ln1_unit(f, args, l, u, rep + 1 == REPS(5)); __syncthreads();
            }
        SEAM(pb + 5);
        if (IN(pb + 6)) for (int rep = 0; rep < REPS(6); ++rep) { if (rep) GRID_BAR(); { pg8::DenseSched S; S.init(XB, (const bf16_t*)(F.ws + WS_WPG) + (size_t)l * DM * DM, DM, DM, MT, DM, F.G, F.bx);
              pg8::EpiPle E{PRE, XB, PPb, args.in[24] + (size_t)l * DM, DM, DN_ALPHA}; pg8::gemm_phase(F.lds, DM, S, E); }
            moe_tables(F, l);
            { pg8::MoeSched<true> S; S.A = XB; S.Bt = (const bf16_t*)(F.ws + WS_WGU) + (size_t)l * NEXP * 512 * DM; S.lda = DM; S.ldb = DM; S.nN = 2; S.G = F.G; S.c = F.bx; S.bexp = (size_t)512 * DM * 2;
              S.toff = (const LAS int*)(F.lds + LDS_TOFF); S.cnt = F.ctl + CW_CNT + l * 32 * 64; S.ltok = (const int*)(F.ws + WS_LTOK);
              pg8::EpiMoe1 E{Hb, (const float*)(F.ws + WS_LGATE), F.ctl + CW_CNT + l * 32 * 64}; pg8::gemm_phase(F.lds, DM, S, E); } }
        SEAM(pb + 6);
        if (IN(pb + 7)) for (int rep = 0; rep < REPS(7); ++rep) { if (rep) GRID_BAR(); moe_tables(F, l);
            pg8::MoeSched<false> S; S.A = Hb; S.Bt = (const bf16_t*)(F.ws + WS_WD) + (size_t)l * NEXP * DM * DEXP; S.lda = DEXP; S.ldb = DEXP; S.nN = 8; S.G = F.G; S.c = F.bx; S.bexp = (size_t)DM * DEXP * 2;
            S.toff = (const LAS int*)(F.lds + LDS_TOFF); S.cnt = F.ctl + CW_CNT + l * 32 * 64; S.ltok = (const int*)(F.ws + WS_LTOK);
            pg8::EpiBf16 E{Yb, DM}; pg8::gemm_phase(F.lds, DEXP, S, E); }
        SEAM(pb + 7);
        if (IN(pb + 8)) { for (int rep = 0; rep < REPS(8); ++rep) { if (rep) GRID_BAR(); const Frame f = F.fresh(); moe_tables(f, l); ln2_rows(f, args, l, args.out, l + 1 < NL); }
            if (l + 1 < NL) { const Frame f = F.fresh(); conv_all(f, args, l + 1, 0, I_L); } }
        SEAM(pb + 8);
    }
#undef IN
#undef SEAM
}

extern "C" void kernel_launch(void* const* d_in, const int* in_sizes, int n_in, void* d_out, int out_size, void* d_ws, size_t ws_size, hipStream_t stream) {
    static int grid = 0;
    if (grid == 0) {
        if (n_in != 28 || out_size != MT * DM || ws_size < WS_END) { fprintf(stderr, "kernel_launch: unexpected shapes (n_in %d, out %d, ws %zu); nothing launched\n", n_in, out_size, ws_size); grid = -1; return; }
        int dev = 0, cus = 0, per_cu = 0;
        if (hipGetDevice(&dev) != hipSuccess || hipDeviceGetAttribute(&cus, hipDeviceAttributeMultiprocessorCount, dev) != hipSuccess) { grid = -1; return; }
        if (hipFuncSetAttribute((const void*)mega, hipFuncAttributeMaxDynamicSharedMemorySize, LDS_BYTES) != hipSuccess) { fprintf(stderr, "kernel_launch: hipFuncSetAttribute failed\n"); grid = -1; return; }
        if (hipOccupancyMaxActiveBlocksPerMultiprocessor(&per_cu, (const void*)mega, 512, LDS_BYTES) != hipSuccess || per_cu < 1) { fprintf(stderr, "kernel_launch: occupancy query says %d\n", per_cu); }
        (void)hipGetLastError();
        grid = cus;
    }
    if (grid < 0) return;
    (void)hipMemsetAsync((char*)d_ws + WS_CTL, 0, CTL_ZERO_BYTES, stream);
    Args a{};
    for (int i = 0; i < 28; ++i) a.in[i] = (const float*)d_in[i];
    a.out = (float*)d_out; a.ws = (unsigned char*)d_ws;
#if LAUNCH_PER_PHASE
    for (int p = 0; p < N_PHASES; ++p) { a.ph_lo = p; a.ph_hi = p + 1; hipLaunchKernelGGL(mega, dim3(grid), dim3(512), LDS_BYTES, stream, a); }
#else
    a.ph_lo = 0; a.ph_hi = N_PHASES; hipLaunchKernelGGL(mega, dim3(grid), dim3(512), LDS_BYTES, stream, a);
#endif
}
```

```cpp
#include <hip/hip_runtime.h>
#include <cstdio>
#include <cstdint>

#ifndef REP_MASK
#define REP_MASK 0
#endif
#define REPS(k) (1 + ((REP_MASK >> (k)) & 1))
#ifndef LAUNCH_PER_PHASE
#define LAUNCH_PER_PHASE 0
#endif

#define LAS __attribute__((address_space(3)))
#define GAS __attribute__((address_space(1)))
typedef unsigned short bf16_t;
typedef short bf16x8 __attribute__((ext_vector_type(8)));
typedef float f32x4 __attribute__((ext_vector_type(4)));
typedef float f32x2 __attribute__((ext_vector_type(2)));
typedef unsigned u32x4 __attribute__((ext_vector_type(4)));
typedef unsigned u32x2 __attribute__((ext_vector_type(2)));

constexpr int NL = 2, NBATCH = 4, SEQ = 2048, DM = 2048, MT = NBATCH * SEQ;
constexpr int DIN = 5648, DINP = 5888, PLE = 256, NEXP = 32, DEXP = 256;
constexpr int UA_VAL = 0, UA_GATE = 512, UG_Q = 1024, UG_K = 1280, UG_V = 1536, UG_R = 2048, UC_Q = 2560, UC_K = 3072, UC_V = 3584, US_B = 4096, US_C = 4608, US_H = 5120, UG_LOW = 5632;
constexpr float DN_ALPHA = 1.41421356237309515f, LN_EPS = 1e-5f, RMS_EPS = 1e-6f;
constexpr int MAXSLOT = 24576;

constexpr size_t MiB = 1u << 20;
constexpr size_t WS_CTL = 0, CTL_ZERO_BYTES = 1 * MiB;
constexpr size_t WS_BTAB = 1 * MiB;
constexpr size_t WS_WRT = 1 * MiB + 64 * 1024;
constexpr size_t WS_LTOK = 2 * MiB;
constexpr size_t WS_LGATE = 3 * MiB;
constexpr size_t WS_TINFO = 4 * MiB;
constexpr size_t WS_WIN = 8 * MiB;
constexpr size_t WS_WOUT = 54 * MiB;
constexpr size_t WS_WGU = 70 * MiB;
constexpr size_t WS_WD = 198 * MiB;
constexpr size_t WS_WPG = 262 * MiB;
constexpr size_t WS_WPP = 278 * MiB;
constexpr size_t WS_XB = 280 * MiB;
constexpr size_t WS_PB = 312 * MiB;
constexpr size_t WS_U = 320 * MiB;
constexpr size_t WS_Y = 320 * MiB;
constexpr size_t WS_MIX = 416 * MiB;
constexpr size_t WS_PRE = 448 * MiB;
constexpr size_t WS_GU = 448 * MiB;
constexpr size_t WS_GO = 480 * MiB;
constexpr size_t WS_GQ = 496 * MiB;
constexpr size_t WS_GD = 504 * MiB;
constexpr size_t WS_PP = 512 * MiB;
constexpr size_t WS_AO = 556 * MiB;
constexpr size_t WS_ALSE = 580 * MiB;
constexpr size_t WS_H = 544 * MiB;
constexpr size_t WS_END = 581 * MiB;
static_assert(WS_U + (size_t)MT * DINP * 2 <= WS_MIX && WS_Y + (size_t)MAXSLOT * 2048 * 2 <= WS_MIX + 32 * MiB, "ws map");
constexpr int CW_BAR = 4096;
constexpr int CW_CNT = 16384;

constexpr int LDS_STAGE = 135168;
constexpr int LDS_TOFF = LDS_STAGE;
constexpr int LDS_BARW = LDS_STAGE + 512;
constexpr int LDS_BYTES = LDS_STAGE + 1024;

__device__ __forceinline__ float bf2f(unsigned b) { return __uint_as_float(b << 16); }
__device__ __forceinline__ unsigned f2bf(float f) { unsigned u = __float_as_uint(f); return (u + 0x7fffu + ((u >> 16) & 1u)) >> 16; }
__device__ __forceinline__ unsigned pk2(float lo, float hi) { return f2bf(lo) | (f2bf(hi) << 16); }
__device__ __forceinline__ float bflo(unsigned w) { return __uint_as_float(w << 16); }
__device__ __forceinline__ float bfhi(unsigned w) { return __uint_as_float(w & 0xffff0000u); }
__device__ __forceinline__ float wave_sum(float v) {
#pragma unroll
    for (int o = 1; o < 64; o <<= 1) v += __shfl_xor(v, o);
    return v;
}
__device__ __forceinline__ float wave_max(float v) {
#pragma unroll
    for (int o = 1; o < 64; o <<= 1) v = fmaxf(v, __shfl_xor(v, o));
    return v;
}
__device__ __forceinline__ float sigmoidf_(float x) { return 1.0f / (1.0f + __expf(-x)); }
__device__ __forceinline__ float siluf_(float x) { return x / (1.0f + __expf(-x)); }
#define LDS_WAIT() asm volatile("s_waitcnt lgkmcnt(0)" ::: "memory")
__device__ __forceinline__ f32x4 zero4() { float z = 0.f; asm volatile("" : "+v"(z)); return (f32x4){z, z, z, z}; }

namespace pg8 {
constexpr int BM = 256, BK = 64, HALF = 128, HTB = HALF * BK * 2, STAGE_BYTES = 8 * HTB, NXCD = 8, WGM = 8;
__host__ __device__ __forceinline__ int lds_byte(int r, int c) { const int st = (r >> 4) * 2 + (c >> 5), rr = r & 15, cc = c & 31, ob = rr * 64 + cc * 2; return st * 1024 + (ob ^ (((ob >> 9) & 1) << 5)); }
__host__ __device__ __forceinline__ void stage_rc(int b, int& R, int& C) { const int st = b / 1024, sb = b % 1024, swz = sb ^ (((sb >> 9) & 1) << 5); R = (st >> 1) * 16 + swz / 64; C = (st & 1) * 32 + (swz % 64) / 2; }
__host__ __device__ __forceinline__ int perm32(int rho) { const int n = rho >> 4, i = rho & 15; return 8 * (i >> 2) + 4 * n + (i & 3); }

struct Unit { int pm, pn, e, r; };

struct DenseSched {
    static constexpr bool GATHER = false;
    const bf16_t* A; const bf16_t* Bt; int lda, ldb, nM, nN, nwg, G, c, wave;
    __device__ void init(const bf16_t* A_, const bf16_t* Bt_, int lda_, int ldb_, int M, int N, int G_, int c_) { A = A_; Bt = Bt_; lda = lda_; ldb = ldb_; nM = M / BM; nN = N / BM; nwg = nM * nN; G = G_; c = c_; }
    __device__ __forceinline__ bool next(int i, Unit& u) const {
        const long L = (long)i * G + c; if (L >= nwg) return false;
        int wgid = (int)L; { const int q = nwg / NXCD, r = nwg % NXCD, xcd = wgid % NXCD, off = wgid / NXCD; wgid = (xcd < r ? xcd * (q + 1) : r * (q + 1) + (xcd - r) * q) + off; }
        const int nig = WGM * nN, gid = wgid / nig, fm = gid * WGM, gsz = (nM - fm) < WGM ? (nM - fm) : WGM;
        u.pm = fm + ((wgid % nig) % gsz); u.pn = (wgid % nig) / gsz; u.e = 0; u.r = 0; return true;
    }
    __device__ __forceinline__ const char* a_base(const Unit& u) const { return (const char*)A + (size_t)u.pm * BM * lda * 2; }
    __device__ __forceinline__ const char* b_base(const Unit& u) const { return (const char*)Bt + (size_t)u.pn * BM * ldb * 2; }
    __device__ __forceinline__ void a_offs(const Unit&, const int (&R)[2], const int (&C)[2], unsigned (&vo)[2][2]) const { }
};
template <bool GATHER_> struct MoeSched {
    static constexpr bool GATHER = GATHER_;
    const bf16_t* A; const bf16_t* Bt; int lda, ldb, nN, G, c, wave; size_t bexp;
    const LAS int* toff; const unsigned* cnt; const int* ltok;
    __device__ __forceinline__ bool next(int i, Unit& u) const {
        const int L = i * G + c; const int total = __builtin_amdgcn_readfirstlane(toff[32]) * nN; if (L >= total) return false;
        const int j = L / nN; u.pn = L - j * nN; int e = 0;
#pragma unroll 1
        for (int k = 1; k < 32; ++k) e = (__builtin_amdgcn_readfirstlane(toff[k]) <= j) ? k : e;
        u.e = e; u.r = j - __builtin_amdgcn_readfirstlane(toff[e]); u.pm = j; return true;
    }
    __device__ __forceinline__ const char* a_base(const Unit& u) const { return GATHER ? (const char*)A : (const char*)A + (size_t)u.pm * BM * lda * 2; }
    __device__ __forceinline__ const char* b_base(const Unit& u) const { return (const char*)Bt + (size_t)u.e * bexp + (size_t)u.pn * BM * ldb * 2; }
    __device__ __forceinline__ void a_offs(const Unit& u, const int (&R)[2], const int (&C)[2], unsigned (&vo)[2][2]) const {
        if constexpr (GATHER) {
        const int n = __builtin_amdgcn_readfirstlane((int)cnt[u.e * 64]);
#pragma unroll
        for (int h = 0; h < 2; ++h)
#pragma unroll
            for (int i = 0; i < 2; ++i) {
                const int sr = u.r * BM + h * HALF + R[i]; const int row = (sr < n) ? ltok[u.e * MT + sr] : 0;
                vo[h][i] = (unsigned)(row * lda + C[i]) * 2u;
            }
        }
    }
};

__device__ __forceinline__ unsigned cvt_pk_bf16(float lo, float hi) { unsigned r; asm volatile("v_cvt_pk_bf16_f32 %0, %1, %2" : "=v"(r) : "v"(lo), "v"(hi)); return r; }

struct EpiBf16 {
    static constexpr bool PERM = true;
    bf16_t* O; int ldc;
    __device__ __forceinline__ void operator()(const f32x4 (&acc)[2][2][4][2], const Unit& u, int wr, int wc, int fr, int fq) const {
        const int row0 = u.pm * BM + wr * 64 + fr, col0 = u.pn * BM + wc * 32 + 8 * fq;
#pragma unroll
        for (int ai = 0; ai < 2; ++ai)
#pragma unroll
            for (int m = 0; m < 4; ++m) { bf16_t* rowp = O + (size_t)(row0 + ai * HALF + m * 16) * ldc + col0;
#pragma unroll
                for (int bj = 0; bj < 2; ++bj) { const f32x4 v0 = acc[ai][bj][m][0], v1 = acc[ai][bj][m][1];
                    u32x4 w; w.x = cvt_pk_bf16(v0[0], v0[1]); w.y = cvt_pk_bf16(v0[2], v0[3]); w.z = cvt_pk_bf16(v1[0], v1[1]); w.w = cvt_pk_bf16(v1[2], v1[3]);
                    *(u32x4*)(rowp + bj * HALF) = w; } }
    }
};
struct EpiRes {
    static constexpr bool PERM = true;
    bf16_t* C; const bf16_t* res; int ldc; float alpha;
    __device__ __forceinline__ void operator()(const f32x4 (&acc)[2][2][4][2], const Unit& u, int wr, int wc, int fr, int fq) const {
        const int row0 = u.pm * BM + wr * 64 + fr, col0 = u.pn * BM + wc * 32 + 8 * fq;
#pragma unroll
        for (int ai = 0; ai < 2; ++ai)
#pragma unroll
            for (int m = 0; m < 4; ++m) { const size_t off = (size_t)(row0 + ai * HALF + m * 16) * ldc + col0;
#pragma unroll
                for (int bj = 0; bj < 2; ++bj) { const u32x4 rv = *(const u32x4*)(res + off + bj * HALF); const f32x4 v0 = acc[ai][bj][m][0], v1 = acc[ai][bj][m][1];
                    u32x4 w; w.x = cvt_pk_bf16(bflo(rv.x) * alpha + v0[0], bfhi(rv.x) * alpha + v0[1]); w.y = cvt_pk_bf16(bflo(rv.y) * alpha + v0[2], bfhi(rv.y) * alpha + v0[3]);
                    w.z = cvt_pk_bf16(bflo(rv.z) * alpha + v1[0], bfhi(rv.z) * alpha + v1[1]); w.w = cvt_pk_bf16(bflo(rv.w) * alpha + v1[2], bfhi(rv.w) * alpha + v1[3]);
                    *(u32x4*)(C + off + bj * HALF) = w; }
                asm volatile("" ::: "memory"); }
    }
};
struct EpiPle {
    static constexpr bool PERM = true;
    bf16_t* C; const bf16_t* x1; const bf16_t* pp; const float* bias; int ldc; float alpha;
    __device__ __forceinline__ void operator()(const f32x4 (&acc)[2][2][4][2], const Unit& u, int wr, int wc, int fr, int fq) const {
        const int row0 = u.pm * BM + wr * 64 + fr, col0 = u.pn * BM + wc * 32 + 8 * fq;
        f32x4 bv[2][2];
#pragma unroll
        for (int bj = 0; bj < 2; ++bj)
#pragma unroll
            for (int n = 0; n < 2; ++n) bv[bj][n] = *(const f32x4*)(bias + col0 + bj * HALF + 4 * n);
#pragma unroll
        for (int ai = 0; ai < 2; ++ai)
#pragma unroll
            for (int m = 0; m < 4; ++m) { const size_t off = (size_t)(row0 + ai * HALF + m * 16) * ldc + col0;
#pragma unroll
                for (int bj = 0; bj < 2; ++bj) { const size_t o = off + bj * HALF; const u32x4 xv = *(const u32x4*)(x1 + o), pw = *(const u32x4*)(pp + o);
                    const f32x4 a0 = acc[ai][bj][m][0] + bv[bj][0], a1 = acc[ai][bj][m][1] + bv[bj][1];
                    u32x4 w;
                    w.x = cvt_pk_bf16(bflo(xv.x) * alpha + sigmoidf_(a0[0]) * bflo(pw.x), bfhi(xv.x) * alpha + sigmoidf_(a0[1]) * bfhi(pw.x));
                    w.y = cvt_pk_bf16(bflo(xv.y) * alpha + sigmoidf_(a0[2]) * bflo(pw.y), bfhi(xv.y) * alpha + sigmoidf_(a0[3]) * bfhi(pw.y));
                    w.z = cvt_pk_bf16(bflo(xv.z) * alpha + sigmoidf_(a1[0]) * bflo(pw.z), bfhi(xv.z) * alpha + sigmoidf_(a1[1]) * bfhi(pw.z));
                    w.w = cvt_pk_bf16(bflo(xv.w) * alpha + sigmoidf_(a1[2]) * bflo(pw.w), bfhi(xv.w) * alpha + sigmoidf_(a1[3]) * bfhi(pw.w));
                    *(u32x4*)(C + o) = w; }
                asm volatile("" ::: "memory"); }
    }
};
struct EpiMoe1 {
    static constexpr bool PERM = true;
    bf16_t* H; const float* lgate; const unsigned* cnt;
    __device__ __forceinline__ void operator()(const f32x4 (&acc)[2][2][4][2], const Unit& u, int wr, int wc, int fr, int fq) const {
        const int n_e = __builtin_amdgcn_readfirstlane((int)cnt[u.e * 64]);
        const int col0 = u.pn * HALF + wc * 32 + 8 * fq;
#pragma unroll
        for (int ai = 0; ai < 2; ++ai)
#pragma unroll
            for (int m = 0; m < 4; ++m) { const int rt = ai * HALF + wr * 64 + m * 16 + fr; const int sr = u.r * BM + rt;
                const float gw = (sr < n_e) ? lgate[u.e * MT + sr] : 0.f;
                const f32x4 g0 = acc[ai][0][m][0], g1 = acc[ai][0][m][1], u0 = acc[ai][1][m][0], u1 = acc[ai][1][m][1];
                float o[8];
#pragma unroll
                for (int j = 0; j < 4; ++j) { o[j] = siluf_(g0[j]) * u0[j] * gw; o[4 + j] = siluf_(g1[j]) * u1[j] * gw; }
                u32x4 w; w.x = cvt_pk_bf16(o[0], o[1]); w.y = cvt_pk_bf16(o[2], o[3]); w.z = cvt_pk_bf16(o[4], o[5]); w.w = cvt_pk_bf16(o[6], o[7]);
                *(u32x4*)(H + (size_t)(u.pm * BM + rt) * DEXP + col0) = w; }
    }
};

template <class Epi, class Sched>
__device__ __forceinline__ void gemm_phase(LAS unsigned char* lds, const int K, const Sched& S, const Epi& E) {
    constexpr bool GA = Sched::GATHER;
    int lane_ = (int)__builtin_amdgcn_mbcnt_hi(~0u, __builtin_amdgcn_mbcnt_lo(~0u, 0u)); asm volatile("" : "+v"(lane_));
    const int wid = S.wave, lane = lane_, tid = wid * 64 + lane_, wr = wid >> 2, wc = wid & 3, fr = lane & 15, fq = lane >> 4;
    const int nt = K / BK, ldb = S.ldb, lda = S.lda;
    int Rr[2], Cc[2]; unsigned voffB[2], voffA[2];
#pragma unroll
    for (int i = 0; i < 2; ++i) { int R, C; stage_rc(tid * 16 + i * 8192, R, C); Rr[i] = R; Cc[i] = C; const int Rb = Epi::PERM ? ((R & ~31) + perm32(R & 31)) : R; voffB[i] = (unsigned)(Rb * ldb + C) * 2u; voffA[i] = (unsigned)(R * lda + C) * 2u; }
    const size_t kstep = (size_t)(BK * 2);
    const size_t hstep = (size_t)HALF * ldb * 2;
    const size_t ahstep = GA ? 0 : (size_t)HALF * lda * 2;
    const unsigned ldsw = (unsigned)wid * 1024u;
    const int aoff = lds_byte(wr * 64 + fr, fq * 8), boff = lds_byte(wc * 32 + fr, fq * 8);
#define PG8_SA(b, h) (((b) * 2 + (h)) * HTB)
#define PG8_SB(b, h) ((4 + (b) * 2 + (h)) * HTB)
#define PG8_STAGE(bufoff, gbase, voff) do { _Pragma("unroll") for (int _i = 0; _i < 2; ++_i) \
        __builtin_amdgcn_global_load_lds((const unsigned*)((const char*)(gbase) + (voff)[_i]), (LAS unsigned*)(lds + (bufoff) + ldsw + _i * 8192), 16, 0, 0); } while (0)
#define PG8_STAGE_A(bufoff, gbase, h) do { if constexpr (GA) PG8_STAGE(bufoff, gbase, voA[h]); else PG8_STAGE(bufoff, (gbase) + (h) * ahstep, voffA); } while (0)
#define PG8_STAGE_A2(bufoff, gbase, h) do { if constexpr (GA) { unsigned _v[2] = {last ? voN[h][0] : voA[h][0], last ? voN[h][1] : voA[h][1]}; PG8_STAGE(bufoff, gbase, _v); } else PG8_STAGE(bufoff, (gbase) + (h) * ahstep, voffA); } while (0)
#define PG8_LDA(dst, b, h) do { _Pragma("unroll") for (int m = 0; m < 4; ++m) _Pragma("unroll") for (int k = 0; k < 2; ++k) dst[m][k] = *(const LAS bf16x8*)(lds + PG8_SA(b, h) + aoff + m * 2048 + k * 1024); } while (0)
#define PG8_LDB(dst, b, h) do { _Pragma("unroll") for (int n = 0; n < 2; ++n) _Pragma("unroll") for (int k = 0; k < 2; ++k) dst[n][k] = *(const LAS bf16x8*)(lds + PG8_SB(b, h) + boff + n * 2048 + k * 1024); } while (0)
#define PG8_MMA(ai, bj, At, Bt) do { __builtin_amdgcn_s_setprio(1); _Pragma("unroll") for (int m = 0; m < 4; ++m) _Pragma("unroll") for (int n = 0; n < 2; ++n) _Pragma("unroll") for (int k = 0; k < 2; ++k) \
        acc[ai][bj][m][n] = __builtin_amdgcn_mfma_f32_16x16x32_bf16(Bt[n][k], At[m][k], acc[ai][bj][m][n], 0, 0, 0); __builtin_amdgcn_s_setprio(0); } while (0)
#define PG8_WAIT_V(n) asm volatile("s_waitcnt vmcnt(" #n ")" ::: "memory")
#define PG8_WAIT_L(n) asm volatile("s_waitcnt lgkmcnt(" #n ")" ::: "memory")
#define PG8_BAR __builtin_amdgcn_s_barrier()
#define PG8_SCHED __builtin_amdgcn_sched_barrier(0)
    Unit cur, nxt; int ui = 0;
    if (!S.next(0, cur)) return;
    f32x4 acc[2][2][4][2];
#pragma unroll
    for (int a = 0; a < 2; ++a)
#pragma unroll
        for (int b = 0; b < 2; ++b)
#pragma unroll
            for (int m = 0; m < 4; ++m)
#pragma unroll
                for (int n = 0; n < 2; ++n) acc[a][b][m][n] = (f32x4){0.f, 0.f, 0.f, 0.f};
    bf16x8 At[4][2], B0[2][2], B1[2][2];
    const char* cA = S.a_base(cur); const char* cB = S.b_base(cur);
    unsigned voA[2][2], voN[2][2];
    if constexpr (GA) S.a_offs(cur, Rr, Cc, voA);
    PG8_STAGE(PG8_SB(0, 0), cB, voffB); PG8_STAGE(PG8_SB(0, 1), cB + hstep, voffB); PG8_STAGE_A(PG8_SA(0, 0), cA, 0); PG8_STAGE_A(PG8_SA(0, 1), cA, 1);
    if (wr == 1) PG8_BAR;
    PG8_WAIT_V(2); PG8_BAR;
    PG8_STAGE(PG8_SB(1, 0), cB + kstep, voffB); PG8_STAGE_A(PG8_SA(1, 0), cA + kstep, 0); PG8_STAGE(PG8_SB(1, 1), cB + hstep + kstep, voffB);
    PG8_WAIT_V(6); PG8_BAR;
    for (;;) {
        const bool has_next = S.next(ui + 1, nxt);
        const char* nA = has_next ? S.a_base(nxt) : cA; const char* nB = has_next ? S.b_base(nxt) : cB;
        if constexpr (GA) {
            if (has_next) S.a_offs(nxt, Rr, Cc, voN);
            else {
#pragma unroll
                for (int h = 0; h < 2; ++h)
#pragma unroll
                    for (int i = 0; i < 2; ++i) voN[h][i] = voA[h][i]; } }
#pragma unroll 1
        for (int t = 0; t < nt; t += 2) {
            const bool last = (t == nt - 2);
            const char* a1 = cA + (size_t)(t + 1) * kstep;
            const char* a2 = last ? nA : cA + (size_t)(t + 2) * kstep; const char* b2 = last ? nB : cB + (size_t)(t + 2) * kstep;
            const char* a3 = a2 + kstep; const char* b3 = b2 + kstep;
            PG8_LDB(B0, 0, 0); PG8_LDB(B1, 0, 1); PG8_SCHED; PG8_LDA(At, 0, 0); PG8_STAGE_A(PG8_SA(1, 1), a1, 1);
            PG8_WAIT_V(8); PG8_WAIT_L(0); PG8_BAR; PG8_MMA(0, 0, At, B0); PG8_MMA(0, 1, At, B1); PG8_BAR; PG8_SCHED;
            PG8_LDA(At, 0, 1); PG8_STAGE(PG8_SB(0, 0), b2, voffB); PG8_STAGE(PG8_SB(0, 1), b2 + hstep, voffB); PG8_STAGE_A2(PG8_SA(0, 0), a2, 0);
            PG8_WAIT_V(8); PG8_WAIT_L(0); PG8_BAR; PG8_MMA(1, 0, At, B0); PG8_MMA(1, 1, At, B1); PG8_BAR; PG8_SCHED;
            PG8_LDB(B0, 1, 0); PG8_LDB(B1, 1, 1); PG8_SCHED; PG8_LDA(At, 1, 0); PG8_STAGE_A2(PG8_SA(0, 1), a2, 1);
            PG8_WAIT_V(8); PG8_WAIT_L(0); PG8_BAR; PG8_MMA(0, 0, At, B0); PG8_MMA(0, 1, At, B1); PG8_BAR; PG8_SCHED;
            PG8_LDA(At, 1, 1); PG8_STAGE(PG8_SB(1, 0), b3, voffB); PG8_STAGE(PG8_SB(1, 1), b3 + hstep, voffB); PG8_STAGE_A2(PG8_SA(1, 0), a3, 0);
            PG8_WAIT_V(8); PG8_WAIT_L(0); PG8_BAR; PG8_MMA(1, 0, At, B0); PG8_MMA(1, 1, At, B1); PG8_BAR; PG8_SCHED;
        }
        if (wr == 0) PG8_BAR;
        E(acc, cur, wr, wc, fr, fq);
        if (!has_next) break;
#pragma unroll
        for (int a = 0; a < 2; ++a)
#pragma unroll
            for (int b = 0; b < 2; ++b)
#pragma unroll
                for (int m = 0; m < 4; ++m)
#pragma unroll
                    for (int n = 0; n < 2; ++n) acc[a][b][m][n] = (f32x4){0.f, 0.f, 0.f, 0.f};
        cur = nxt; cA = nA; cB = nB; ++ui;
        if constexpr (GA) {
#pragma unroll
            for (int h = 0; h < 2; ++h)
#pragma unroll
                for (int i = 0; i < 2; ++i) voA[h][i] = voN[h][i]; }
        if (wr == 1) PG8_BAR;
    }
    PG8_WAIT_V(0);
    PG8_BAR;
#undef PG8_SA
#undef PG8_SB
#undef PG8_STAGE
#undef PG8_STAGE_A
#undef PG8_STAGE_A2
#undef PG8_LDA
#undef PG8_LDB
#undef PG8_MMA
#undef PG8_WAIT_V
#undef PG8_WAIT_L
#undef PG8_BAR
#undef PG8_SCHED
}
}

#define XB_TMO      128
#define XB_XCNT(j)  (256  + 64 * (j))
#define XB_XSUB(j)  (1280 + 64 * (j))
#define XB_XGEN(j)  (2304 + 64 * (j))
#define XB_TOP      3328
#define XB_TOPGEN   3392
#define XCD_BAR_WORDS 3456
#define XB_SPIN_CAP (1u << 18)
__device__ __forceinline__ unsigned xb_ld(unsigned* p)              { return __hip_atomic_load(p, __ATOMIC_RELAXED, __HIP_MEMORY_SCOPE_AGENT); }
__device__ __forceinline__ unsigned xb_add(unsigned* p, unsigned v) { return __hip_atomic_fetch_add(p, v, __ATOMIC_RELAXED, __HIP_MEMORY_SCOPE_AGENT); }
__device__ __forceinline__ unsigned xb_xcc_id() { return (unsigned)__builtin_amdgcn_s_getreg((3 << 11) | 20) & 0xFu; }
#define XB_SPIN(cond, bar) do { unsigned _sp = 0; while (cond) { __builtin_amdgcn_s_sleep(1); \
    if ((++_sp & 255u) == 0u) { if (xb_ld(&(bar)[XB_TMO])) break; if (_sp > XB_SPIN_CAP) { atomicAdd(&(bar)[XB_TMO], 1u); break; } } } } while (0)
struct XcdBarrier { unsigned* bar; unsigned x; volatile LAS unsigned* st; };
__device__ __forceinline__ XcdBarrier xcd_barrier_post(unsigned* bar, volatile LAS unsigned* st) {
    XcdBarrier b; b.bar = bar; b.x = xb_xcc_id(); b.st = st;
    if (threadIdx.x == 0) (void)xb_add(&bar[XB_XCNT(b.x)], 1u);
    return b;
}
__device__ __forceinline__ void xcd_barrier_complete(unsigned* bar, unsigned x, unsigned& nloc, unsigned& nx) {
    const unsigned G = gridDim.x * gridDim.y * gridDim.z;
    unsigned sum, cnt, mine, sp = 0u;
    for (;;) {
        sum = 0u; cnt = 0u; mine = 0u;
#pragma unroll
        for (unsigned j = 0; j < 16; ++j) { const unsigned c = xb_ld(&bar[XB_XCNT(j)]); sum += c; cnt += (c > 0u) ? 1u : 0u; mine = (j == x) ? c : mine; }
        if (sum == G) break;
        __builtin_amdgcn_s_sleep(1);
        if ((++sp & 255u) == 0u) { if (xb_ld(&bar[XB_TMO])) break; if (sp > XB_SPIN_CAP) { atomicAdd(&bar[XB_TMO], 1u); break; } }
    }
    nloc = mine > 0u ? mine : 1u; nx = cnt > 0u ? cnt : 1u;
}
__device__ __forceinline__ void xcd_barrier(const XcdBarrier& b) {
    asm volatile("s_waitcnt vmcnt(0)" ::: "memory");
    __syncthreads();
    if (threadIdx.x == 0) {
        unsigned* bar = b.bar;
        __builtin_amdgcn_s_waitcnt(0);
        unsigned nloc = b.st[0], nx = b.st[1];
        if (nloc == 0u) { xcd_barrier_complete(bar, b.x, nloc, nx); b.st[0] = nloc; b.st[1] = nx; }
        const unsigned old = xb_add(&bar[XB_XSUB(b.x)], 1u);
        const unsigned gen = old / nloc;
        if (old + 1u == (gen + 1u) * nloc) {
            __builtin_amdgcn_fence(__ATOMIC_RELEASE, "agent");
            asm volatile("s_waitcnt vmcnt(0)" ::: "memory");
            const unsigned og = xb_add(&bar[XB_TOP], 1u);
            const unsigned tg = og / nx;
            if (og + 1u == (tg + 1u) * nx) xb_add(&bar[XB_TOPGEN], 1u);
            else XB_SPIN(xb_ld(&bar[XB_TOPGEN]) == tg, bar);
            __builtin_amdgcn_fence(__ATOMIC_ACQUIRE, "agent");
            xb_add(&bar[XB_XGEN(b.x)], 1u);
            asm volatile("s_waitcnt vmcnt(0)" ::: "memory");
        } else {
            XB_SPIN(xb_ld(&bar[XB_XGEN(b.x)]) == gen, bar);
            __builtin_amdgcn_fence(__ATOMIC_ACQUIRE, "agent");
            asm volatile("s_waitcnt vmcnt(0)" ::: "memory");
        }
    }
    __syncthreads();
}

struct Args { const float* in[28]; float* out; unsigned char* ws; int ph_lo, ph_hi; };

struct Frame {
    LAS unsigned char* lds; unsigned char* ws; unsigned* ctl;
    int tid, lane, wave, G, bx;
    __device__ __forceinline__ Frame fresh() const { Frame f = *this; int ln = (int)__builtin_amdgcn_mbcnt_hi(~0u, __builtin_amdgcn_mbcnt_lo(~0u, 0u)); asm volatile("" : "+v"(ln)); f.lane = ln; f.tid = wave * 64 + ln;
        int b = bx, g = G; unsigned char* w = ws; asm volatile("" : "+s"(b), "+s"(g), "+s"(w)); f.bx = b; f.G = g; f.ws = w; f.ctl = (unsigned*)(w + WS_CTL); return f; }
};

__device__ __forceinline__ int dmap(int type, int n) {
    if (type == 1) return n < 2048 ? n : (n < 2064 ? n - 2048 + UG_LOW : n - 16);
    if (type == 2) return (n >> 7) * 256 + (n & 127);
    if (type == 3) return (n >> 7) * 256 + 128 + (n & 127);
    return n;
}
__device__ __forceinline__ void transpose_item(const float* W, int ldw, int ncols, int k0, int n0, const float* kscale, bf16_t* WT, int ldt, int type, LAS float* scr, int lane) {
    const int n4 = (lane & 15) * 4, kr = lane >> 4; const bool okc = (n0 + n4) < ncols;
    f32x4 v[16];
#pragma unroll
    for (int i = 0; i < 16; ++i) v[i] = okc ? __builtin_nontemporal_load((const f32x4*)(W + (size_t)(k0 + 4 * i + kr) * ldw + n0 + n4)) : (f32x4){0.f, 0.f, 0.f, 0.f};
    if (kscale) {
#pragma unroll
        for (int i = 0; i < 16; ++i) v[i] = v[i] * kscale[k0 + 4 * i + kr]; }
#pragma unroll
    for (int i = 0; i < 16; ++i) { LAS float* s = scr + (4 * i + kr) * 65 + n4; s[0] = v[i][0]; s[1] = v[i][1]; s[2] = v[i][2]; s[3] = v[i][3]; }
    LDS_WAIT(); asm volatile("" ::: "memory");
    const int c = lane & 7;
#pragma unroll
    for (int j = 0; j < 8; ++j) { const int n = (lane >> 3) + 8 * j; const LAS float* s = scr + (8 * c) * 65 + n;
        u32x4 o; o.x = pk2(s[0 * 65], s[1 * 65]); o.y = pk2(s[2 * 65], s[3 * 65]); o.z = pk2(s[4 * 65], s[5 * 65]); o.w = pk2(s[6 * 65], s[7 * 65]);
        if (n0 + n < ncols) *(u32x4*)(WT + (size_t)dmap(type, n0 + n) * ldt + k0 + 8 * c) = o; }
    LDS_WAIT(); asm volatile("" ::: "memory");
}
__device__ __forceinline__ int t5_bucket(int d) {
    if (d < 16) return d;
    const float v = logf((float)d / 16.0f) / 4.852030263919617f * 16.0f;
    int b = 16 + (int)v; return b < 31 ? b : 31;
}
constexpr int I_IN = 32 * 89, I_OUT = 32 * 32, I_PP = 4 * 32, I_PG = 32 * 32, I_G = 32 * 128, I_U = 32 * 128, I_D = 32 * 128;
constexpr int IO_OUT = I_IN, IO_PP = IO_OUT + I_OUT, IO_PG = IO_PP + I_PP, IO_G = IO_PG + I_PG, IO_U = IO_G + I_G, IO_D = IO_U + I_U, I_L = IO_D + I_D;
__device__ __forceinline__ void conv_items(const Frame& F, const Args& a, const int l, const int lo, const int hi, const int gw, const int NGW) {
    LAS float* scr = (LAS float*)(F.lds + F.wave * 16640);
    bf16_t* WIN = (bf16_t*)(F.ws + WS_WIN); bf16_t* WOUT = (bf16_t*)(F.ws + WS_WOUT); bf16_t* WGU = (bf16_t*)(F.ws + WS_WGU); bf16_t* WD = (bf16_t*)(F.ws + WS_WD);
    bf16_t* WPG = (bf16_t*)(F.ws + WS_WPG); bf16_t* WPP = (bf16_t*)(F.ws + WS_WPP);
    for (int it = lo + gw; it < hi; it += NGW) {
        int r = it;
        if (r < IO_OUT) { const int kb = r / 89, nb = r - kb * 89; transpose_item(a.in[2] + (size_t)l * DM * DIN, DIN, DIN, kb * 64, nb * 64, nullptr, WIN + (size_t)l * DINP * DM, DM, 1, scr, F.lane); continue; }
        if (r < IO_PP) { r -= IO_OUT; const int kb = r >> 5, nb = r & 31; transpose_item(a.in[12] + (size_t)l * DM * DM, DM, DM, kb * 64, nb * 64, a.in[11] + l * DM, WOUT + (size_t)l * DM * DM, DM, 0, scr, F.lane); continue; }
        if (r < IO_PG) { r -= IO_PP; const int kb = r >> 5, nb = r & 31; transpose_item(a.in[25] + (size_t)l * PLE * DM, DM, DM, kb * 64, nb * 64, nullptr, WPP + (size_t)l * DM * PLE, PLE, 0, scr, F.lane); continue; }
        if (r < IO_G) { r -= IO_PG; const int kb = r >> 5, nb = r & 31; transpose_item(a.in[23] + (size_t)l * DM * DM, DM, DM, kb * 64, nb * 64, nullptr, WPG + (size_t)l * DM * DM, DM, 0, scr, F.lane); continue; }
        if (r < IO_U) { r -= IO_G; const int e = r >> 7, q = r & 127, kb = q >> 2, nb = q & 3; transpose_item(a.in[20] + (size_t)(l * NEXP + e) * DM * DEXP, DEXP, DEXP, kb * 64, nb * 64, nullptr, WGU + (size_t)(l * NEXP + e) * 512 * DM, DM, 2, scr, F.lane); continue; }
        if (r < IO_D) { r -= IO_U; const int e = r >> 7, q = r & 127, kb = q >> 2, nb = q & 3; transpose_item(a.in[21] + (size_t)(l * NEXP + e) * DM * DEXP, DEXP, DEXP, kb * 64, nb * 64, nullptr, WGU + (size_t)(l * NEXP + e) * 512 * DM, DM, 3, scr, F.lane); continue; }
        { r -= IO_D; const int e = r >> 7, q = r & 127, kb = q >> 5, nb = q & 31; transpose_item(a.in[22] + (size_t)(l * NEXP + e) * DEXP * DM, DM, DM, kb * 64, nb * 64, nullptr, WD + (size_t)(l * NEXP + e) * DM * DEXP, DEXP, 0, scr, F.lane); }
    }
}
__device__ __forceinline__ void conv_all(const Frame& F, const Args& a, const int l, const int lo, const int hi) { __syncthreads(); conv_items(F, a, l, lo, hi, F.bx * 8 + F.wave, F.G * 8); __syncthreads(); }
__device__ __forceinline__ void phase_prologue(const Frame& F, const Args& a) {
    bf16_t* WIN = (bf16_t*)(F.ws + WS_WIN);
    conv_all(F, a, 0, 0, I_L);
    const size_t gt = (size_t)F.bx * 512 + F.tid, NT = (size_t)F.G * 512;
    for (size_t i = gt; i < (size_t)NL * (DINP - DIN) * DM / 8; i += NT) { const size_t l = i / ((DINP - DIN) * DM / 8), r = i % ((DINP - DIN) * DM / 8);
        *(u32x4*)(WIN + (l * DINP + DIN) * DM + r * 8) = (u32x4){0u, 0u, 0u, 0u}; }
    { const float* x = a.in[0]; bf16_t* XB = (bf16_t*)(F.ws + WS_XB);
      for (size_t i = gt; i < (size_t)MT * DM / 8; i += NT) { const f32x4 v0 = *(const f32x4*)(x + i * 8), v1 = *(const f32x4*)(x + i * 8 + 4);
          *(u32x4*)(XB + i * 8) = (u32x4){pk2(v0[0], v0[1]), pk2(v0[2], v0[3]), pk2(v1[0], v1[1]), pk2(v1[2], v1[3])}; } }
    { const float* p = a.in[1]; bf16_t* PB = (bf16_t*)(F.ws + WS_PB);
      for (size_t i = gt; i < (size_t)NL * MT * PLE / 8; i += NT) { const f32x4 v0 = *(const f32x4*)(p + i * 8), v1 = *(const f32x4*)(p + i * 8 + 4);
          *(u32x4*)(PB + i * 8) = (u32x4){pk2(v0[0], v0[1]), pk2(v0[2], v0[3]), pk2(v1[0], v1[1]), pk2(v1[2], v1[3])}; } }
    { float* bt = (float*)(F.ws + WS_BTAB); const float* rb = a.in[13];
      for (size_t i = gt; i < 3 * 129 * 8; i += NT) { const int h = (int)(i & 7), j = (int)((i >> 3) % 129), br = (int)((i >> 3) / 129); const int dil = br == 0 ? 1 : (br == 1 ? 4 : 16);
          bt[i] = rb[t5_bucket(j * dil) * 8 + h]; } }
    { float* wrt = (float*)(F.ws + WS_WRT);
      for (size_t i = gt; i < (size_t)NL * 36 * DM; i += NT) { const int c = (int)(i % DM), col = (int)((i / DM) % 36), l = (int)(i / (36 * DM));
          wrt[i] = col < 4 ? a.in[16][((size_t)l * DM + c) * 4 + col] : a.in[18][((size_t)l * DM + c) * 32 + (col - 4)]; } }
}

__device__ __forceinline__ void conv_unit(const Frame& F, const Args& a, int l, int unit) {
    const bf16_t* U = (const bf16_t*)(F.ws + WS_U); bf16_t* MIX = (bf16_t*)(F.ws + WS_MIX);
    LAS float* hb = (LAS float*)F.lds;
    const int t0 = unit * 32, tl0 = t0 & (SEQ - 1), tb = t0 - tl0;
    const int tid = F.tid;
    __syncthreads();
#pragma unroll 1
    for (int i = 0; i < 8; ++i) { const int id = tid + 512 * i; if (id < 62 * 64) { const int row = id >> 6, ch = (id & 63) * 8; const int tl = tl0 - 30 + row;
        float o[8];
        if (tl >= 0) { const bf16_t* up = U + (size_t)(tb + tl) * DINP; const u32x4 av = *(const u32x4*)(up + UA_VAL + ch), gv = *(const u32x4*)(up + UA_GATE + ch);
            const unsigned aw[4] = {av.x, av.y, av.z, av.w}, gw[4] = {gv.x, gv.y, gv.z, gv.w};
#pragma unroll
            for (int j = 0; j < 4; ++j) { o[2 * j] = bflo(aw[j]) * sigmoidf_(bflo(gw[j])); o[2 * j + 1] = bfhi(aw[j]) * sigmoidf_(bfhi(gw[j])); } }
        else {
#pragma unroll
            for (int j = 0; j < 8; ++j) o[j] = 0.f; }
        *(LAS f32x4*)(hb + row * 512 + ch) = (f32x4){o[0], o[1], o[2], o[3]}; *(LAS f32x4*)(hb + row * 512 + ch + 4) = (f32x4){o[4], o[5], o[6], o[7]}; } }
    __syncthreads();
    float yv[32];
    { const int c = tid; const float* w = a.in[3] + (size_t)l * 31 * 512; const float bias = a.in[4][l * 512 + c];
      float wv[31];
#pragma unroll
      for (int j = 0; j < 31; ++j) wv[j] = w[j * 512 + c];
      float hv[62];
#pragma unroll
      for (int r = 0; r < 62; ++r) hv[r] = hb[r * 512 + c];
#pragma unroll
      for (int t = 0; t < 32; ++t) { float s = bias;
#pragma unroll
          for (int j = 0; j < 31; ++j) s += wv[j] * hv[t + j];
          yv[t] = s; } }
    __syncthreads();
#pragma unroll
    for (int t = 0; t < 32; ++t) hb[t * 512 + tid] = yv[t];
    __syncthreads();
    { const float* lg = a.in[5] + l * 512; const float* lb = a.in[6] + l * 512;
#pragma unroll 1
      for (int i = 0; i < 4; ++i) { const int t = F.wave + 8 * i;
          const f32x4 v0 = *(const LAS f32x4*)(hb + t * 512 + 4 * F.lane), v1 = *(const LAS f32x4*)(hb + t * 512 + 256 + 4 * F.lane);
          const float mean = wave_sum((v0[0] + v0[1]) + (v0[2] + v0[3]) + (v1[0] + v1[1]) + (v1[2] + v1[3])) * (1.f / 512.f);
          const f32x4 d0 = v0 - mean, d1 = v1 - mean;
          const float var = wave_sum((d0[0] * d0[0] + d0[1] * d0[1]) + (d0[2] * d0[2] + d0[3] * d0[3]) + (d1[0] * d1[0] + d1[1] * d1[1]) + (d1[2] * d1[2] + d1[3] * d1[3])) * (1.f / 512.f);
          const float rstd = 1.0f / sqrtf(var + LN_EPS);
          const f32x4 g0 = *(const f32x4*)(lg + 4 * F.lane), g1 = *(const f32x4*)(lg + 256 + 4 * F.lane), b0 = *(const f32x4*)(lb + 4 * F.lane), b1 = *(const f32x4*)(lb + 256 + 4 * F.lane);
          float o0[4], o1[4];
#pragma unroll
          for (int j = 0; j < 4; ++j) { o0[j] = siluf_(d0[j] * rstd * g0[j] + b0[j]); o1[j] = siluf_(d1[j] * rstd * g1[j] + b1[j]); }
          bf16_t* mp = MIX + (size_t)(t0 + t) * DM;
          *(u32x2*)(mp + 4 * F.lane) = (u32x2){pk2(o0[0], o0[1]), pk2(o0[2], o0[3])}; *(u32x2*)(mp + 256 + 4 * F.lane) = (u32x2){pk2(o1[0], o1[1]), pk2(o1[2], o1[3])}; } }
    { const int cg = (tid & 63) * 8; const float* w = a.in[10] + (size_t)l * 3 * 512 + cg;
      float wv[3][8];
#pragma unroll
      for (int j = 0; j < 3; ++j) { const f32x4 a0 = *(const f32x4*)(w + j * 512), a1 = *(const f32x4*)(w + j * 512 + 4); wv[j][0] = a0[0]; wv[j][1] = a0[1]; wv[j][2] = a0[2]; wv[j][3] = a0[3]; wv[j][4] = a1[0]; wv[j][5] = a1[1]; wv[j][6] = a1[2]; wv[j][7] = a1[3]; }
#pragma unroll 1
      for (int pass = 0; pass < 2; ++pass) { const int tg = (tid >> 6) + 8 * pass;
      float p[4][8];
#pragma unroll
      for (int rr = 0; rr < 4; ++rr) { const int tl = tl0 + 2 * tg - 2 + rr;
          { const float msk = tl >= 0 ? 1.f : 0.f; const int tlc = tl >= 0 ? tl : 0;
            const bf16_t* up = U + (size_t)(tb + tlc) * DINP; const u32x4 cw = *(const u32x4*)(up + US_C + cg), hw = *(const u32x4*)(up + US_H + cg);
            const unsigned c4[4] = {cw.x, cw.y, cw.z, cw.w}, h4[4] = {hw.x, hw.y, hw.z, hw.w};
#pragma unroll
            for (int j = 0; j < 4; ++j) { p[rr][2 * j] = bflo(c4[j]) * bflo(h4[j]) * msk; p[rr][2 * j + 1] = bfhi(c4[j]) * bfhi(h4[j]) * msk; } } }
#pragma unroll
      for (int tt = 0; tt < 2; ++tt) { const int t = t0 + 2 * tg + tt; const u32x4 bw = *(const u32x4*)(U + (size_t)t * DINP + US_B + cg); const unsigned b4[4] = {bw.x, bw.y, bw.z, bw.w}; unsigned ow[4];
#pragma unroll
          for (int j = 0; j < 4; ++j) { const float y0 = bflo(b4[j]) * (wv[0][2 * j] * p[tt][2 * j] + wv[1][2 * j] * p[tt + 1][2 * j] + wv[2][2 * j] * p[tt + 2][2 * j]);
              const float y1 = bfhi(b4[j]) * (wv[0][2 * j + 1] * p[tt][2 * j + 1] + wv[1][2 * j + 1] * p[tt + 1][2 * j + 1] + wv[2][2 * j + 1] * p[tt + 2][2 * j + 1]); ow[j] = pk2(y0, y1); }
          *(u32x4*)(MIX + (size_t)t * DM + 1536 + cg) = (u32x4){ow[0], ow[1], ow[2], ow[3]}; } } }
}

__device__ __forceinline__ bf16x8 frag_f32(const LAS float* p) { const f32x4 a = *(const LAS f32x4*)p, b = *(const LAS f32x4*)(p + 4);
    const u32x4 w = (u32x4){pk2(a[0], a[1]), pk2(a[2], a[3]), pk2(b[0], b[1]), pk2(b[2], b[3])}; return __builtin_bit_cast(bf16x8, w); }
__device__ __forceinline__ bf16x8 frag_col(const LAS float* p, int stride) {
    const u32x4 w = (u32x4){pk2(p[0], p[stride]), pk2(p[2 * stride], p[3 * stride]), pk2(p[4 * stride], p[5 * stride]), pk2(p[6 * stride], p[7 * stride])}; return __builtin_bit_cast(bf16x8, w); }
__device__ __forceinline__ void gla_a_unit(const Frame& F, const Args& a, int l, int unit) {
    const bf16_t* U = (const bf16_t*)(F.ws + WS_U);
    float* GU = (float*)(F.ws + WS_GU); float* GO = (float*)(F.ws + WS_GO); float* GQ = (float*)(F.ws + WS_GQ); float* GD = (float*)(F.ws + WS_GD);
    const int n = unit & 63, h = (unit >> 6) & 3, b = unit >> 8, bh = b * 4 + h;
    const int t0 = b * SEQ + n * 32, tid = F.tid;
    LAS float* L = (LAS float*)F.lds;
    LAS float* qt = L; LAS float* kr = L + 2048; LAS float* kt = L + 4096; LAS float* kh = L + 6144; LAS float* vv = L + 8192; LAS float* bc = L + 12288; LAS float* gl = L + 14336; LAS float* wg = L + 14848; LAS float* sc = L + 15872;
    const int i = tid >> 4, k4 = (tid & 15) * 4, v8 = (tid & 15) * 8;
    __syncthreads();
    { const bf16_t* up = U + (size_t)(t0 + i) * DINP;
      const u32x2 qw = *(const u32x2*)(up + UG_Q + h * 64 + k4), kw = *(const u32x2*)(up + UG_K + h * 64 + k4); const u32x4 vw = *(const u32x4*)(up + UG_V + h * 128 + v8);
      *(LAS f32x4*)(qt + i * 64 + k4) = (f32x4){bflo(qw.x), bfhi(qw.x), bflo(qw.y), bfhi(qw.y)};
      *(LAS f32x4*)(kr + i * 64 + k4) = (f32x4){bflo(kw.x), bfhi(kw.x), bflo(kw.y), bfhi(kw.y)};
      *(LAS f32x4*)(vv + i * 128 + v8) = (f32x4){bflo(vw.x), bfhi(vw.x), bflo(vw.y), bfhi(vw.y)}; *(LAS f32x4*)(vv + i * 128 + v8 + 4) = (f32x4){bflo(vw.z), bfhi(vw.z), bflo(vw.w), bfhi(vw.w)};
      gl[i * 16 + (tid & 15)] = bf2f(up[UG_LOW + (tid & 15)]);
      const float* w2 = a.in[7] + (size_t)l * 16 * 256;
      wg[tid] = w2[(tid >> 6) * 256 + h * 64 + (tid & 63)]; wg[512 + tid] = w2[(8 + (tid >> 6)) * 256 + h * 64 + (tid & 63)]; }
    __syncthreads();
    { const f32x4 bg = *(const f32x4*)(a.in[8] + l * 256 + h * 64 + k4); f32x4 z = bg;
#pragma unroll
      for (int r = 0; r < 16; ++r) { const float g = gl[i * 16 + r]; const f32x4 w = *(const LAS f32x4*)(wg + r * 64 + k4); z = z + w * g; }
      f32x4 la;
#pragma unroll
      for (int j = 0; j < 4; ++j) la[j] = (fminf(z[j], 0.f) - log1pf(expf(-fabsf(z[j])))) * (1.0f / 16.0f);
      *(LAS f32x4*)(bc + i * 64 + k4) = la; }
    __syncthreads();
    f32x4 bv = {0.f, 0.f, 0.f, 0.f}, bl = bv;
#pragma unroll 8
    for (int r = 0; r < 32; ++r) { const f32x4 x = *(const LAS f32x4*)(bc + r * 64 + k4); bl = bl + x; if (r <= i) bv = bv + x; }
    { const f32x4  q = *(const LAS f32x4*)(qt + i * 64 + k4), k = *(const LAS f32x4*)(kr + i * 64 + k4);
      f32x4 qo, ko, ho;
#pragma unroll
      for (int j = 0; j < 4; ++j) { qo[j] = q[j] * expf(bv[j]) * 0.125f; ko[j] = k[j] * expf(-bv[j]); ho[j] = k[j] * expf(bl[j] - bv[j]); }
      *(LAS f32x4*)(qt + i * 64 + k4) = qo; *(LAS f32x4*)(kt + i * 64 + k4) = ko; *(LAS f32x4*)(kh + i * 64 + k4) = ho;
      *(f32x4*)(GQ + (size_t)(t0 + i) * 256 + h * 64 + k4) = qo;
      if (i == 31) { f32x4 d;
#pragma unroll
          for (int j = 0; j < 4; ++j) d[j] = expf(bl[j]);
          *(f32x4*)(GD + ((size_t)bh * 64 + n) * 64 + k4) = d; } }
    __syncthreads();
    const int lane = F.lane, w = F.wave, fr = lane & 15, fg = lane >> 4;
    if (w < 4) { const int mi = w >> 1, nj = w & 1; f32x4 d = zero4();
#pragma unroll
        for (int ks = 0; ks < 2; ++ks) d = __builtin_amdgcn_mfma_f32_16x16x32_bf16(frag_f32(qt + (16 * mi + fr) * 64 + 8 * fg + 32 * ks), frag_f32(kt + (16 * nj + fr) * 64 + 8 * fg + 32 * ks), d, 0, 0, 0);
#pragma unroll
        for (int r = 0; r < 4; ++r) { const int ii = 16 * mi + 4 * fg + r, jj = 16 * nj + fr; sc[ii * 36 + jj] = (jj <= ii) ? d[r] : 0.f; } }
    const bf16x8 vfrag = frag_col(vv + (8 * fg) * 128 + 16 * w + fr, 128);
    { float* gp = GU + ((size_t)bh * 64 + n) * 8192 + (size_t)(16 * w + fr) * 64 + 4 * fg;
#pragma unroll
      for (int kt4 = 0; kt4 < 4; ++kt4) { const bf16x8 kfrag = frag_col(kh + (8 * fg) * 64 + 16 * kt4 + fr, 64);
          const f32x4 d = __builtin_amdgcn_mfma_f32_16x16x32_bf16(kfrag, vfrag, zero4(), 0, 0, 0);
          *(f32x4*)(gp + 16 * kt4) = d; } }
    __syncthreads();
#pragma unroll
    for (int it = 0; it < 2; ++it) { const bf16x8 sfrag = frag_f32(sc + (16 * it + fr) * 36 + 8 * fg);
        const f32x4 d = __builtin_amdgcn_mfma_f32_16x16x32_bf16(vfrag, sfrag, zero4(), 0, 0, 0);
        *(f32x4*)(GO + (size_t)(t0 + 16 * it + fr) * 512 + h * 128 + 16 * w + 4 * fg) = d; }
}
__device__ __forceinline__ void gla_scan(const Frame& F) {
    float* GU = (float*)(F.ws + WS_GU); const float* GD = (const float*)(F.ws + WS_GD);
    for (int g = F.bx * 512 + F.tid; g < 16 * 8192; g += F.G * 512) { const int bh = g >> 13, kv = g & 8191, k = kv & 63;
        float* p = GU + (size_t)bh * 64 * 8192 + kv; const float* d = GD + (size_t)bh * 64 * 64 + k; float S = 0.f;
#pragma unroll 8
        for (int n = 0; n < 64; ++n) { const float u = p[(size_t)n * 8192]; const float dc = d[n * 64]; p[(size_t)n * 8192] = S; S = S * dc + u; } }
}
struct GlaCIn { f32x4 s[4]; f32x4 q; f32x4 oi[2]; u32x2 rw[2]; };
__device__ __forceinline__ void gla_c_load(const Frame& F, int unit, GlaCIn& in) {
    const bf16_t* U = (const bf16_t*)(F.ws + WS_U); const float* GU = (const float*)(F.ws + WS_GU); const float* GO = (const float*)(F.ws + WS_GO); const float* GQ = (const float*)(F.ws + WS_GQ);
    const int n = unit & 63, h = (unit >> 6) & 3, b = unit >> 8, bh = b * 4 + h, t0 = b * SEQ + n * 32, tid = F.tid, lane = F.lane, w = F.wave, fr = lane & 15, fg = lane >> 4;
    const float* sp = GU + ((size_t)bh * 64 + n) * 8192;
#pragma unroll
    for (int j = 0; j < 4; ++j) in.s[j] = *(const f32x4*)(sp + (tid + 512 * j) * 4);
    in.q = *(const f32x4*)(GQ + (size_t)(t0 + (tid >> 4)) * 256 + h * 64 + (tid & 15) * 4);
#pragma unroll
    for (int it = 0; it < 2; ++it) { const int row = t0 + 16 * it + fr, col = h * 128 + 16 * w + 4 * fg;
        in.oi[it] = *(const f32x4*)(GO + (size_t)row * 512 + col); in.rw[it] = *(const u32x2*)(U + (size_t)row * DINP + UG_R + col); }
}
__device__ __forceinline__ void gla_c_phase(const Frame& F, const Args& a, int l) {
    bf16_t* MIX = (bf16_t*)(F.ws + WS_MIX);
    const int tid = F.tid, lane = F.lane, w = F.wave, fr = lane & 15, fg = lane >> 4;
    LAS float* qt = (LAS float*)F.lds; LAS float* SsT = qt + 32 * 68; LAS float* red = SsT + 128 * 68;
    const f32x4 ng = *(const f32x4*)(a.in[9] + l * 128 + 16 * w + 4 * fg);
    GlaCIn in;
    if (F.bx < 1024) gla_c_load(F, F.bx, in);
#pragma unroll 1
    for (int unit = F.bx; unit < 1024; unit += F.G) {
        const int n = unit & 63, h = (unit >> 6) & 3, b = unit >> 8, t0 = b * SEQ + n * 32;
        __syncthreads();
        *(LAS f32x4*)(qt + (tid >> 4) * 68 + (tid & 15) * 4) = in.q;
#pragma unroll
        for (int j = 0; j < 4; ++j) { const int e = (tid + 512 * j) * 4; *(LAS f32x4*)(SsT + (e >> 6) * 68 + (e & 63)) = in.s[j]; }
        f32x4 o[2] = {in.oi[0], in.oi[1]}; const u32x2 rw0 = in.rw[0], rw1 = in.rw[1];
        __syncthreads();
        if (unit + F.G < 1024) gla_c_load(F, unit + F.G, in);
#pragma unroll
        for (int ks = 0; ks < 2; ++ks) { const bf16x8 sf = frag_f32(SsT + (16 * w + fr) * 68 + 8 * fg + 32 * ks);
#pragma unroll
            for (int it = 0; it < 2; ++it) o[it] = __builtin_amdgcn_mfma_f32_16x16x32_bf16(sf, frag_f32(qt + (16 * it + fr) * 68 + 8 * fg + 32 * ks), o[it], 0, 0, 0); }
#pragma unroll
        for (int it = 0; it < 2; ++it) { float ss = (o[it][0] * o[it][0] + o[it][1] * o[it][1]) + (o[it][2] * o[it][2] + o[it][3] * o[it][3]);
            ss += __shfl_xor(ss, 16); ss += __shfl_xor(ss, 32);
            if (fg == 0) red[w * 32 + 16 * it + fr] = ss; }
        __syncthreads();
#pragma unroll
        for (int it = 0; it < 2; ++it) { float tot = 0.f;
#pragma unroll
            for (int ww = 0; ww < 8; ++ww) tot += red[ww * 32 + 16 * it + fr];
            const float rms = 1.0f / sqrtf(tot * (1.f / 128.f) + RMS_EPS);
            const u32x2 rw = it == 0 ? rw0 : rw1;
            const float y0 = o[it][0] * rms * ng[0] * siluf_(bflo(rw.x)), y1 = o[it][1] * rms * ng[1] * siluf_(bfhi(rw.x)), y2 = o[it][2] * rms * ng[2] * siluf_(bflo(rw.y)), y3 = o[it][3] * rms * ng[3] * siluf_(bfhi(rw.y));
            *(u32x2*)(MIX + (size_t)(t0 + 16 * it + fr) * DM + 512 + h * 128 + 16 * w + 4 * fg) = (u32x2){pk2(y0, y1), pk2(y2, y3)}; }
    }
}

typedef short s16x4 __attribute__((ext_vector_type(4)));
__device__ __forceinline__ s16x4 vtr(const LAS unsigned char* p) { return __builtin_bit_cast(s16x4, __builtin_amdgcn_ds_read_tr16_b64_v4i16((LAS s16x4*)p)); }
constexpr int AT_VROW = 160, AT_VBUF = 32 * AT_VROW;
__device__ __forceinline__ void attn_job(const Frame& F, int job, LAS unsigned char* vbuf, const LAS float* bt) {
    const bf16_t* U = (const bf16_t*)(F.ws + WS_U); bf16_t* AO = (bf16_t*)(F.ws + WS_AO); float* ALSE = (float*)(F.ws + WS_ALSE);
    const int lane = F.lane, qi = lane & 15, g = lane >> 4;
    const int gidx = job & 127, t2 = job >> 7, br = t2 % 3, bh = t2 / 3, h = bh & 7, b = bh >> 3;
    const int dsh = 2 * br, dil = 1 << dsh, gsh = 7 - dsh, r = gidx >> gsh, gi = gidx & ((1 << gsh) - 1);
    const int q0 = gi * 16, tb = b * SEQ;
    const bf16_t* Ub = U + (size_t)(tb + r) * DINP + h * 64;
    const size_t sstep = (size_t)dil * DINP;
    const bf16_t* qrow = Ub + (size_t)(q0 + qi) * sstep + UC_Q + 8 * g;
    const bf16x8 qf0 = *(const bf16x8*)qrow, qf1 = *(const bf16x8*)(qrow + 32);
    const int klo = (q0 >= 128 ? q0 - 128 : 0) & ~31;
    const int nch = ((q0 + 15 - klo) >> 5) + 1;
    float m_run = -1e30f, l_part = 0.f;
    f32x4 o[4];
#pragma unroll
    for (int d = 0; d < 4; ++d) o[d] = (f32x4){0.f, 0.f, 0.f, 0.f};
    bf16x8 ka0, ka1, kb0, kb1; u32x4 vr[4];
#define AT_LOAD(kc) do { const bf16_t* kp = Ub + (size_t)((kc) + qi) * sstep + UC_K + 8 * g; ka0 = *(const bf16x8*)kp; ka1 = *(const bf16x8*)(kp + 32); kp += 16 * sstep; kb0 = *(const bf16x8*)kp; kb1 = *(const bf16x8*)(kp + 32); \
        const bf16_t* vp = Ub + (size_t)((kc) + (lane >> 3)) * sstep + UC_V + (lane & 7) * 8; _Pragma("unroll") for (int it = 0; it < 4; ++it) vr[it] = *(const u32x4*)(vp + (size_t)(8 * it) * sstep); } while (0)
    AT_LOAD(klo);
#pragma unroll 1
    for (int c = 0; c < nch; ++c) {
        const int kc = klo + 32 * c;
        LAS unsigned char* vb = vbuf + (c & 1) * AT_VBUF;
#pragma unroll
        for (int it = 0; it < 4; ++it) *(LAS u32x4*)(vb + (it * 8 + (lane >> 3)) * AT_VROW + (lane & 7) * 16) = vr[it];
        const bf16x8 ca0 = ka0, ca1 = ka1, cb0 = kb0, cb1 = kb1;
        if (c + 1 < nch) AT_LOAD(kc + 32);
        f32x4 sa = (f32x4){0.f, 0.f, 0.f, 0.f}, sb = sa;
        sa = __builtin_amdgcn_mfma_f32_16x16x32_bf16(ca0, qf0, sa, 0, 0, 0); sa = __builtin_amdgcn_mfma_f32_16x16x32_bf16(ca1, qf1, sa, 0, 0, 0);
        sb = __builtin_amdgcn_mfma_f32_16x16x32_bf16(cb0, qf0, sb, 0, 0, 0); sb = __builtin_amdgcn_mfma_f32_16x16x32_bf16(cb1, qf1, sb, 0, 0, 0);
        const int st0 = (q0 + qi) - (kc + 4 * g);
        float cmax = -1e30f;
#pragma unroll
        for (int rr = 0; rr < 4; ++rr) {
            const int sA = st0 - rr, sB = st0 - rr - 16;
            const int iA = sA < 0 ? 0 : (sA > 128 ? 128 : sA), iB = sB < 0 ? 0 : (sB > 128 ? 128 : sB);
            const float vA = sa[rr] * 0.125f + bt[(br * 129 + iA) * 8 + h], vB = sb[rr] * 0.125f + bt[(br * 129 + iB) * 8 + h];
            sa[rr] = (sA >= 0 && sA <= 128) ? vA : -1e30f; sb[rr] = (sB >= 0 && sB <= 128) ? vB : -1e30f;
            cmax = fmaxf(cmax, fmaxf(sa[rr], sb[rr])); }
        cmax = fmaxf(cmax, __shfl_xor(cmax, 16)); cmax = fmaxf(cmax, __shfl_xor(cmax, 32));
        const float m_new = fmaxf(m_run, cmax), alpha = __expf(m_run - m_new);
        float psum = 0.f;
#pragma unroll
        for (int rr = 0; rr < 4; ++rr) { sa[rr] = __expf(sa[rr] - m_new); sb[rr] = __expf(sb[rr] - m_new); psum += sa[rr] + sb[rr]; }
        l_part = l_part * alpha + psum; m_run = m_new;
#pragma unroll
        for (int d = 0; d < 4; ++d) o[d] = o[d] * alpha;
        const u32x4 pw = (u32x4){pk2(sa[0], sa[1]), pk2(sa[2], sa[3]), pk2(sb[0], sb[1]), pk2(sb[2], sb[3])};
        const bf16x8 pf = __builtin_bit_cast(bf16x8, pw);
        const LAS unsigned char* tp = vb + (4 * g + (qi >> 2)) * AT_VROW + (qi & 3) * 8;
#pragma unroll
        for (int d = 0; d < 4; ++d) { const s16x4 va = vtr(tp + d * 32), vb2 = vtr(tp + 16 * AT_VROW + d * 32);
            const bf16x8 vf = (bf16x8){va[0], va[1], va[2], va[3], vb2[0], vb2[1], vb2[2], vb2[3]};
            o[d] = __builtin_amdgcn_mfma_f32_16x16x32_bf16(vf, pf, o[d], 0, 0, 0); }
    }
#undef AT_LOAD
    float l = l_part; l += __shfl_xor(l, 16); l += __shfl_xor(l, 32);
    const float inv = 1.0f / l;
    const int token = tb + (q0 + qi) * dil + r;
    bf16_t* op = AO + ((size_t)br * MT + token) * 512 + h * 64 + 4 * g;
#pragma unroll
    for (int d = 0; d < 4; ++d) *(u32x2*)(op + d * 16) = (u32x2){pk2(o[d][0] * inv, o[d][1] * inv), pk2(o[d][2] * inv, o[d][3] * inv)};
    if (g == 0) ALSE[((size_t)br * MT + token) * 8 + h] = m_run + logf(l);
}
__device__ __forceinline__ void attn_combine(const Frame& F) {
    const bf16_t* AO = (const bf16_t*)(F.ws + WS_AO); const float* ALSE = (const float*)(F.ws + WS_ALSE); bf16_t* MIX = (bf16_t*)(F.ws + WS_MIX);
    for (int i = F.bx * 512 + F.tid; i < MT * 64; i += F.G * 512) { const int token = i >> 6, c8 = (i & 63) * 8, h = c8 >> 6;
        const float l0 = ALSE[(size_t)token * 8 + h], l1 = ALSE[((size_t)MT + token) * 8 + h], l2 = ALSE[((size_t)2 * MT + token) * 8 + h];
        const float m = fmaxf(l0, fmaxf(l1, l2)); float w0 = __expf(l0 - m), w1 = __expf(l1 - m), w2 = __expf(l2 - m); const float inv = 1.0f / (w0 + w1 + w2); w0 *= inv; w1 *= inv; w2 *= inv;
        const u32x4 a = *(const u32x4*)(AO + (size_t)token * 512 + c8), bq = *(const u32x4*)(AO + ((size_t)MT + token) * 512 + c8), cq = *(const u32x4*)(AO + ((size_t)2 * MT + token) * 512 + c8);
        const unsigned aw[4] = {a.x, a.y, a.z, a.w}, bw[4] = {bq.x, bq.y, bq.z, bq.w}, cw[4] = {cq.x, cq.y, cq.z, cq.w}; unsigned ow[4];
#pragma unroll
        for (int j = 0; j < 4; ++j) ow[j] = pk2(w0 * bflo(aw[j]) + w1 * bflo(bw[j]) + w2 * bflo(cw[j]), w0 * bfhi(aw[j]) + w1 * bfhi(bw[j]) + w2 * bfhi(cw[j]));
        *(u32x4*)(MIX + (size_t)token * DM + 1024 + c8) = (u32x4){ow[0], ow[1], ow[2], ow[3]}; }
}

__device__ __forceinline__ void ln1_unit(const Frame& F, const Args& a, int l, int unit, bool commit) {
    const bf16_t* PRE = (const bf16_t*)(F.ws + WS_PRE); bf16_t* XB = (bf16_t*)(F.ws + WS_XB); const float* wrt = (const float*)(F.ws + WS_WRT) + (size_t)l * 36 * DM;
    int* ltok = (int*)(F.ws + WS_LTOK); float* lgate = (float*)(F.ws + WS_LGATE); int* tinfo = (int*)(F.ws + WS_TINFO); unsigned* cnt = F.ctl + CW_CNT + l * 32 * 64;
    LAS float* Wl = (LAS float*)F.lds;
    const int lane = F.lane, tid = F.tid, row0 = unit * 16 + F.wave * 2;
    const float* g = a.in[14] + (size_t)l * DM; const float* bb = a.in[15] + (size_t)l * DM;
    f32x4 wreg[5];
#pragma unroll
    for (int i = 0; i < 5; ++i) { const int idx = tid + 512 * i; if (idx < 36 * 64) wreg[i] = *(const f32x4*)(wrt + (size_t)(idx >> 6) * DM + (idx & 63) * 4); }
    float mean_[2], rstd_[2];
#pragma unroll
    for (int r = 0; r < 2; ++r) { const int row = row0 + r; const bf16_t* pr = PRE + (size_t)row * DM; f32x4 v[8]; float s = 0.f;
#pragma unroll
      for (int j = 0; j < 8; ++j) { const u32x2 w = *(const u32x2*)(pr + 256 * j + 4 * lane); v[j] = (f32x4){bflo(w.x), bfhi(w.x), bflo(w.y), bfhi(w.y)}; s += (v[j][0] + v[j][1]) + (v[j][2] + v[j][3]); }
      const float mean = wave_sum(s) * (1.f / DM); float q = 0.f;
#pragma unroll
      for (int j = 0; j < 8; ++j) { v[j] = v[j] - mean; q += (v[j][0] * v[j][0] + v[j][1] * v[j][1]) + (v[j][2] * v[j][2] + v[j][3] * v[j][3]); }
      const float rstd = 1.0f / sqrtf(wave_sum(q) * (1.f / DM) + LN_EPS);
      mean_[r] = mean; rstd_[r] = rstd;
#pragma unroll
      for (int j = 0; j < 8; ++j) { const f32x4 gv = *(const f32x4*)(g + 256 * j + 4 * lane), bv = *(const f32x4*)(bb + 256 * j + 4 * lane); const f32x4 y = v[j] * rstd * gv + bv;
          *(u32x2*)(XB + (size_t)row * DM + 256 * j + 4 * lane) = (u32x2){pk2(y[0], y[1]), pk2(y[2], y[3])}; } }
    float acc[2][36];
#pragma unroll
    for (int r = 0; r < 2; ++r)
#pragma unroll
        for (int c = 0; c < 36; ++c) acc[r][c] = 0.f;
    __syncthreads();
#pragma unroll 1
    for (int j = 0; j < 8; ++j) {
        LAS float* Wb = Wl + (j & 1) * (36 * 256);
#pragma unroll
        for (int i = 0; i < 5; ++i) { const int idx = tid + 512 * i; if (idx < 36 * 64) *(LAS f32x4*)(Wb + (idx >> 6) * 256 + (idx & 63) * 4) = wreg[i]; }
        __syncthreads();
        if (j < 7) {
#pragma unroll
            for (int i = 0; i < 5; ++i) { const int idx = tid + 512 * i; if (idx < 36 * 64) wreg[i] = *(const f32x4*)(wrt + (size_t)(idx >> 6) * DM + 256 * (j + 1) + (idx & 63) * 4); } }
        f32x4 xv[2];
        { const f32x4 gv = *(const f32x4*)(g + 256 * j + 4 * lane), bv = *(const f32x4*)(bb + 256 * j + 4 * lane);
#pragma unroll
          for (int r = 0; r < 2; ++r) { const u32x2 w = *(const u32x2*)(PRE + (size_t)(row0 + r) * DM + 256 * j + 4 * lane);
              xv[r] = ((f32x4){bflo(w.x), bfhi(w.x), bflo(w.y), bfhi(w.y)} - mean_[r]) * rstd_[r] * gv + bv; } }
#pragma unroll
        for (int c = 0; c < 36; ++c) { const f32x4 w = *(const LAS f32x4*)(Wb + c * 256 + 4 * lane);
#pragma unroll
            for (int r = 0; r < 2; ++r) acc[r][c] += (xv[r][0] * w[0] + xv[r][1] * w[1]) + (xv[r][2] * w[2] + xv[r][3] * w[3]); }
    }
    const float* gb = a.in[17] + l * 4; const float* eb = a.in[19] + l * 32;
#pragma unroll
    for (int r = 0; r < 2; ++r) {
#pragma unroll
        for (int c = 0; c < 36; ++c) acc[r][c] = wave_sum(acc[r][c]);
        float gl[4];
#pragma unroll
        for (int c = 0; c < 4; ++c) gl[c] = acc[r][c] + gb[c];
        int gi = 0; float gm = gl[0];
#pragma unroll
        for (int c = 1; c < 4; ++c) if (gl[c] > gm) { gm = gl[c]; gi = c; }
        float gs = 0.f;
#pragma unroll
        for (int c = 0; c < 4; ++c) gs += expf(gl[c] - gm);
        const float gtop = 1.0f / gs;
        float ev[8];
#pragma unroll
        for (int c = 0; c < 8; ++c) { const float v0 = acc[r][4 + c] + eb[c], v1 = acc[r][12 + c] + eb[8 + c], v2 = acc[r][20 + c] + eb[16 + c], v3 = acc[r][28 + c] + eb[24 + c]; ev[c] = gi == 0 ? v0 : (gi == 1 ? v1 : (gi == 2 ? v2 : v3)); }
        int i1 = 0; float m1 = ev[0];
#pragma unroll
        for (int c = 1; c < 8; ++c) if (ev[c] > m1) { m1 = ev[c]; i1 = c; }
        int i2 = -1; float m2 = -INFINITY;
#pragma unroll
        for (int c = 0; c < 8; ++c) if (c != i1 && ev[c] > m2) { m2 = ev[c]; i2 = c; }
        const float p2 = expf(m2 - m1), den = 1.0f + p2;
        const float w1 = gtop / den, w2 = gtop * p2 / den;
        if (lane == 0 && commit) { const int tok = row0 + r; const int e1 = gi * 8 + i1, e2 = gi * 8 + i2;
            const unsigned s1 = __hip_atomic_fetch_add(cnt + e1 * 64, 1u, __ATOMIC_RELAXED, __HIP_MEMORY_SCOPE_AGENT), s2 = __hip_atomic_fetch_add(cnt + e2 * 64, 1u, __ATOMIC_RELAXED, __HIP_MEMORY_SCOPE_AGENT);
            ltok[e1 * MT + s1] = tok; lgate[e1 * MT + s1] = w1; ltok[e2 * MT + s2] = tok; lgate[e2 * MT + s2] = w2;
            tinfo[tok * 2] = e1 * MT + (int)s1; tinfo[tok * 2 + 1] = e2 * MT + (int)s2; }
    }
}
__device__ __forceinline__ void moe_tables(const Frame& F, int l) {
    LAS int* toff = (LAS int*)(F.lds + LDS_TOFF); const unsigned* cnt = F.ctl + CW_CNT + l * 32 * 64;
    __syncthreads();
    if (F.tid == 0) { int run = 0; for (int e = 0; e < 32; ++e) { toff[e] = run; run += ((int)cnt[e * 64] + 255) >> 8; } toff[32] = run; }
    __syncthreads();
}
__device__ __forceinline__ void ln2_rows(const Frame& F, const Args& a, int l, float* OUT, bool write_xb) {
    const bf16_t* PRE = (const bf16_t*)(F.ws + WS_PRE); const bf16_t* Y = (const bf16_t*)(F.ws + WS_Y); bf16_t* XB = (bf16_t*)(F.ws + WS_XB); const int* tinfo = (const int*)(F.ws + WS_TINFO);
    const LAS int* toff = (const LAS int*)(F.lds + LDS_TOFF);
    const float* g = a.in[26] + (size_t)l * DM; const float* bb = a.in[27] + (size_t)l * DM; const int lane = F.lane;
    for (int row = F.bx * 8 + F.wave; row < MT; row += F.G * 8) {
        const int i0 = tinfo[row * 2], i1 = tinfo[row * 2 + 1];
        const size_t s0 = (size_t)toff[i0 >> 13] * 256 + (i0 & 8191), s1 = (size_t)toff[i1 >> 13] * 256 + (i1 & 8191);
        const bf16_t* pr = PRE + (size_t)row * DM; const bf16_t* y0 = Y + s0 * DM; const bf16_t* y1 = Y + s1 * DM;
        f32x4 v[8]; float s = 0.f;
#pragma unroll
        for (int j = 0; j < 8; ++j) { const u32x2 pw = *(const u32x2*)(pr + 256 * j + 4 * lane); const f32x4 p = (f32x4){bflo(pw.x), bfhi(pw.x), bflo(pw.y), bfhi(pw.y)}; const u32x2 a0 = *(const u32x2*)(y0 + 256 * j + 4 * lane), a1 = *(const u32x2*)(y1 + 256 * j + 4 * lane);
            v[j][0] = p[0] + (bflo(a0.x) + bflo(a1.x)); v[j][1] = p[1] + (bfhi(a0.x) + bfhi(a1.x)); v[j][2] = p[2] + (bflo(a0.y) + bflo(a1.y)); v[j][3] = p[3] + (bfhi(a0.y) + bfhi(a1.y));
            s += (v[j][0] + v[j][1]) + (v[j][2] + v[j][3]); }
        const float mean = wave_sum(s) * (1.f / DM); float q = 0.f;
#pragma unroll
        for (int j = 0; j < 8; ++j) { v[j] = v[j] - mean; q += (v[j][0] * v[j][0] + v[j][1] * v[j][1]) + (v[j][2] * v[j][2] + v[j][3] * v[j][3]); }
        const float rstd = 1.0f / sqrtf(wave_sum(q) * (1.f / DM) + LN_EPS);
#pragma unroll
        for (int j = 0; j < 8; ++j) { const f32x4 gv = *(const f32x4*)(g + 256 * j + 4 * lane), bv = *(const f32x4*)(bb + 256 * j + 4 * lane); const f32x4 y = v[j] * rstd * gv + bv;
            if (write_xb) *(u32x2*)(XB + (size_t)row * DM + 256 * j + 4 * lane) = (u32x2){pk2(y[0], y[1]), pk2(y[2], y[3])}; else *(f32x4*)(OUT + (size_t)row * DM + 256 * j + 4 * lane) = y; }
    }
}

constexpr int PH_PER_LAYER = 9, N_PHASES = 1 + NL * PH_PER_LAYER;
__global__ void __launch_bounds__(512, 2) mega(Args args) {
    extern __shared__ __attribute__((aligned(16))) unsigned char lds_raw[];
    Frame F; F.lds = (LAS unsigned char*)lds_raw; F.ws = args.ws; F.ctl = (unsigned*)(args.ws + WS_CTL);
    F.tid = threadIdx.x; F.lane = F.tid & 63; F.wave = __builtin_amdgcn_readfirstlane(F.tid >> 6); F.G = gridDim.x; F.bx = blockIdx.x;
    if (F.tid < 4) ((LAS unsigned*)(F.lds + LDS_BARW))[F.tid] = 0u;
    __syncthreads();
#if LAUNCH_PER_PHASE
#define GRID_BAR() do { } while (0)
#else
    XcdBarrier bar = xcd_barrier_post(F.ctl + CW_BAR, (volatile LAS unsigned*)(F.lds + LDS_BARW));
#define GRID_BAR() xcd_barrier(bar)
#endif
    const int lo = args.ph_lo, hi = args.ph_hi;
#define IN(k) (lo <= (k) && (k) < hi)
#define SEAM(k) do { if (IN(k) && IN((k) + 1)) GRID_BAR(); } while (0)
#define WSP(T, off) ((T*)(f.ws + (off)))
    if (IN(0)) { for (int rep = 0; rep < REPS(9); ++rep) { const Frame f = F.fresh(); phase_prologue(f, args); if (rep + 1 < REPS(9)) GRID_BAR(); } }
    SEAM(0);
#pragma unroll 1
    for (int l = 0; l < NL; ++l) {
        const int pb = 1 + l * PH_PER_LAYER;
        if (IN(pb + 0)) for (int rep = 0; rep < REPS(0); ++rep) { if (rep) GRID_BAR(); const Frame f = F.fresh();
            pg8::DenseSched S; S.init(WSP(bf16_t, WS_XB), WSP(const bf16_t, WS_WIN) + (size_t)l * DINP * DM, DM, DM, MT, DINP, f.G, f.bx); S.wave = f.wave;
            pg8::EpiBf16 E{WSP(bf16_t, WS_U), DINP}; pg8::gemm_phase(f.lds, DM, S, E); }
        SEAM(pb + 0);
        if (IN(pb + 1)) for (int rep = 0; rep < REPS(1); ++rep) { if (rep) GRID_BAR(); { const Frame f = F.fresh(); for (int u = f.bx; u < 256; u += f.G) conv_unit(f, args, l, u); }
            { const Frame f = F.fresh(); for (int u = f.bx; u < 1024; u += f.G) gla_a_unit(f, args, l, u); } __syncthreads(); }
        SEAM(pb + 1);
        if (IN(pb + 2)) { { const Frame f = F.fresh(); gla_scan(f); }
            const Frame f = F.fresh();
            LAS float* bt = (LAS float*)(f.lds + 8 * 2 * AT_VBUF);
            __syncthreads();
            for (int i = f.tid; i < 3 * 129 * 8; i += 512) bt[i] = WSP(const float, WS_BTAB)[i];
            __syncthreads();
            for (int rep = 0; rep < REPS(2); ++rep)
            for (int job = f.bx * 8 + f.wave; job < 32 * 3 * 128; job += f.G * 8) attn_job(f, job, f.lds + f.wave * 2 * AT_VBUF, bt);
            __syncthreads(); }
        SEAM(pb + 2);
        if (IN(pb + 3)) for (int rep = 0; rep < REPS(3); ++rep) { if (rep) GRID_BAR(); { const Frame f = F.fresh(); gla_c_phase(f, args, l); __syncthreads(); } { const Frame f = F.fresh(); attn_combine(f); } }
        SEAM(pb + 3);
        if (IN(pb + 4)) for (int rep = 0; rep < REPS(4); ++rep) { if (rep) GRID_BAR();
            { const Frame f = F.fresh(); pg8::DenseSched S; S.init(WSP(bf16_t, WS_MIX), WSP(const bf16_t, WS_WOUT) + (size_t)l * DM * DM, DM, DM, MT, DM, f.G, f.bx); S.wave = f.wave;
              pg8::EpiRes E{WSP(bf16_t, WS_PRE), WSP(const bf16_t, WS_XB), DM, DN_ALPHA}; pg8::gemm_phase(f.lds, DM, S, E); }
            { const Frame f = F.fresh(); pg8::DenseSched S; S.init(WSP(const bf16_t, WS_PB) + (size_t)l * MT * PLE, WSP(const bf16_t, WS_WPP) + (size_t)l * DM * PLE, PLE, PLE, MT, DM, f.G, f.bx); S.wave = f.wave;
              pg8::EpiBf16 E{WSP(bf16_t, WS_PP), DM}; pg8::gemm_phase(f.lds, PLE, S, E); } }
        SEAM(pb + 4);
        if (IN(pb + 5)) for (int rep = 0; rep < REPS(5); ++rep) { if (rep) GRID_BAR(); const Frame f = F.fresh(); for (int u = f.bx; u < MT / 16; u += f.G) ln1_unit(f, args, l, u, rep + 1 == REPS(5)); __syncthreads(); }
        SEAM(pb + 5);
        if (IN(pb + 6)) for (int rep = 0; rep < REPS(6); ++rep) { if (rep) GRID_BAR();
            { const Frame f = F.fresh(); pg8::DenseSched S; S.init(WSP(bf16_t, WS_XB), WSP(const bf16_t, WS_WPG) + (size_t)l * DM * DM, DM, DM, MT, DM, f.G, f.bx); S.wave = f.wave;
              pg8::EpiPle E{WSP(bf16_t, WS_PRE), WSP(const bf16_t, WS_XB), WSP(const bf16_t, WS_PP), args.in[24] + (size_t)l * DM, DM, DN_ALPHA}; pg8::gemm_phase(f.lds, DM, S, E); }
            { const Frame f = F.fresh(); moe_tables(f, l);
              pg8::MoeSched<true> S; S.A = WSP(bf16_t, WS_XB); S.Bt = WSP(const bf16_t, WS_WGU) + (size_t)l * NEXP * 512 * DM; S.lda = DM; S.ldb = DM; S.nN = 2; S.G = f.G; S.c = f.bx; S.wave = f.wave; S.bexp = (size_t)512 * DM * 2;
              S.toff = (const LAS int*)(f.lds + LDS_TOFF); S.cnt = f.ctl + CW_CNT + l * 32 * 64; S.ltok = WSP(const int, WS_LTOK);
              pg8::EpiMoe1 E{WSP(bf16_t, WS_H), WSP(const float, WS_LGATE), f.ctl + CW_CNT + l * 32 * 64}; pg8::gemm_phase(f.lds, DM, S, E); } }
        SEAM(pb + 6);
        if (IN(pb + 7)) for (int rep = 0; rep < REPS(7); ++rep) { if (rep) GRID_BAR(); const Frame f = F.fresh(); moe_tables(f, l);
            pg8::MoeSched<false> S; S.A = WSP(bf16_t, WS_H); S.Bt = WSP(const bf16_t, WS_WD) + (size_t)l * NEXP * DM * DEXP; S.lda = DEXP; S.ldb = DEXP; S.nN = 8; S.G = f.G; S.c = f.bx; S.wave = f.wave; S.bexp = (size_t)DM * DEXP * 2;
            S.toff = (const LAS int*)(f.lds + LDS_TOFF); S.cnt = f.ctl + CW_CNT + l * 32 * 64; S.ltok = WSP(const int, WS_LTOK);
            pg8::EpiBf16 E{WSP(bf16_t, WS_Y), DM}; pg8::gemm_phase(f.lds, DEXP, S, E); }
        SEAM(pb + 7);
        if (IN(pb + 8)) { for (int rep = 0; rep < REPS(8); ++rep) { if (rep) GRID_BAR(); const Frame f = F.fresh(); moe_tables(f, l); ln2_rows(f, args, l, args.out, l + 1 < NL); }
            if (l + 1 < NL) { const Frame f = F.fresh(); conv_all(f, args, l + 1, 0, I_L); } }
        SEAM(pb + 8);
    }
#undef WSP
#undef IN
#undef SEAM
}

extern "C" void kernel_launch(void* const* d_in, const int* in_sizes, int n_in, void* d_out, int out_size, void* d_ws, size_t ws_size, hipStream_t stream) {
    static int grid = 0;
    if (grid == 0) {
        if (n_in != 28 || out_size != MT * DM || ws_size < WS_END) { fprintf(stderr, "kernel_launch: unexpected shapes (n_in %d, out %d, ws %zu); nothing launched\n", n_in, out_size, ws_size); grid = -1; return; }
        int dev = 0, cus = 0, per_cu = 0;
        if (hipGetDevice(&dev) != hipSuccess || hipDeviceGetAttribute(&cus, hipDeviceAttributeMultiprocessorCount, dev) != hipSuccess) { grid = -1; return; }
        if (hipFuncSetAttribute((const void*)mega, hipFuncAttributeMaxDynamicSharedMemorySize, LDS_BYTES) != hipSuccess) { fprintf(stderr, "kernel_launch: hipFuncSetAttribute failed\n"); grid = -1; return; }
        if (hipOccupancyMaxActiveBlocksPerMultiprocessor(&per_cu, (const void*)mega, 512, LDS_BYTES) != hipSuccess || per_cu < 1) { fprintf(stderr, "kernel_launch: occupancy query says %d\n", per_cu); }
        (void)hipGetLastError();
        grid = cus;
    }
    if (grid < 0) return;
    (void)hipMemsetAsync((char*)d_ws + WS_CTL, 0, CTL_ZERO_BYTES, stream);
    Args a{};
    for (int i = 0; i < 28; ++i) a.in[i] = (const float*)d_in[i];
    a.out = (float*)d_out; a.ws = (unsigned char*)d_ws;
#if LAUNCH_PER_PHASE
    for (int p = 0; p < N_PHASES; ++p) { a.ph_lo = p; a.ph_hi = p + 1; hipLaunchKernelGGL(mega, dim3(grid), dim3(512), LDS_BYTES, stream, a); }
#else
    a.ph_lo = 0; a.ph_hi = N_PHASES; hipLaunchKernelGGL(mega, dim3(grid), dim3(512), LDS_BYTES, stream, a);
#endif
}
```

```cpp
#include <hip/hip_runtime.h>
#include <cstdio>
#include <cstdint>

#ifndef REP_MASK
#define REP_MASK 0
#endif
#define REPS(k) (1 + ((REP_MASK >> (k)) & 1))
#ifndef LAUNCH_PER_PHASE
#define LAUNCH_PER_PHASE 0
#endif

#define LAS __attribute__((address_space(3)))
#define GAS __attribute__((address_space(1)))
typedef unsigned short bf16_t;
typedef short bf16x8 __attribute__((ext_vector_type(8)));
typedef float f32x4 __attribute__((ext_vector_type(4)));
typedef float f32x2 __attribute__((ext_vector_type(2)));
typedef unsigned u32x4 __attribute__((ext_vector_type(4)));
typedef unsigned u32x2 __attribute__((ext_vector_type(2)));

constexpr int NL = 2, NBATCH = 4, SEQ = 2048, DM = 2048, MT = NBATCH * SEQ;
constexpr int DIN = 5648, DINP = 5888, PLE = 256, NEXP = 32, DEXP = 256;
constexpr int UA_VAL = 0, UA_GATE = 512, UG_Q = 1024, UG_K = 1280, UG_V = 1536, UG_R = 2048, UC_Q = 2560, UC_K = 3072, UC_V = 3584, US_B = 4096, US_C = 4608, US_H = 5120, UG_LOW = 5632;
constexpr float DN_ALPHA = 1.41421356237309515f, LN_EPS = 1e-5f, RMS_EPS = 1e-6f;
constexpr int MAXSLOT = 24576;

constexpr size_t MiB = 1u << 20;
constexpr size_t WS_CTL = 0, CTL_ZERO_BYTES = 1 * MiB;
constexpr size_t WS_BTAB = 1 * MiB;
constexpr size_t WS_WRT = 1 * MiB + 64 * 1024;
constexpr size_t WS_LTOK = 2 * MiB;
constexpr size_t WS_LGATE = 3 * MiB;
constexpr size_t WS_TINFO = 4 * MiB;
constexpr size_t WS_WIN = 8 * MiB;
constexpr size_t WS_WOUT = 54 * MiB;
constexpr size_t WS_WGU = 70 * MiB;
constexpr size_t WS_WD = 198 * MiB;
constexpr size_t WS_WPG = 262 * MiB;
constexpr size_t WS_WPP = 278 * MiB;
constexpr size_t WS_XB = 280 * MiB;
constexpr size_t WS_PB = 312 * MiB;
constexpr size_t WS_U = 320 * MiB;
constexpr size_t WS_Y = 320 * MiB;
constexpr size_t WS_MIX = 416 * MiB;
constexpr size_t WS_PRE = 448 * MiB;
constexpr size_t WS_GU = 448 * MiB;
constexpr size_t WS_GO = 480 * MiB;
constexpr size_t WS_GQ = 496 * MiB;
constexpr size_t WS_GD = 504 * MiB;
constexpr size_t WS_PP = 512 * MiB;
constexpr size_t WS_AO = 556 * MiB;
constexpr size_t WS_ALSE = 580 * MiB;
constexpr size_t WS_H = 544 * MiB;
constexpr size_t WS_END = 581 * MiB;
static_assert(WS_U + (size_t)MT * DINP * 2 <= WS_MIX && WS_Y + (size_t)MAXSLOT * 2048 * 2 <= WS_MIX + 32 * MiB, "ws map");
constexpr int CW_BAR = 4096;
constexpr int CW_CNT = 16384;

constexpr int LDS_STAGE = 135168;
constexpr int LDS_TOFF = LDS_STAGE;
constexpr int LDS_BARW = LDS_STAGE + 512;
constexpr int LDS_BYTES = LDS_STAGE + 1024;

__device__ __forceinline__ float bf2f(unsigned b) { return __uint_as_float(b << 16); }
__device__ __forceinline__ unsigned f2bf(float f) { unsigned u = __float_as_uint(f); return (u + 0x7fffu + ((u >> 16) & 1u)) >> 16; }
__device__ __forceinline__ unsigned pk2(float lo, float hi) { unsigned r; asm("v_cvt_pk_bf16_f32 %0, %1, %2" : "=v"(r) : "v"(lo), "v"(hi)); return r; }
__device__ __forceinline__ float bflo(unsigned w) { return __uint_as_float(w << 16); }
__device__ __forceinline__ float bfhi(unsigned w) { return __uint_as_float(w & 0xffff0000u); }
__device__ __forceinline__ float wave_sum(float v) {
#pragma unroll
    for (int o = 1; o < 64; o <<= 1) v += __shfl_xor(v, o);
    return v;
}
__device__ __forceinline__ float wave_max(float v) {
#pragma unroll
    for (int o = 1; o < 64; o <<= 1) v = fmaxf(v, __shfl_xor(v, o));
    return v;
}
__device__ __forceinline__ float sigmoidf_(float x) { return 1.0f / (1.0f + __expf(-x)); }
__device__ __forceinline__ float siluf_(float x) { return x / (1.0f + __expf(-x)); }
#define LDS_WAIT() asm volatile("s_waitcnt lgkmcnt(0)" ::: "memory")
__device__ __forceinline__ f32x4 zero4() { float z = 0.f; asm volatile("" : "+v"(z)); return (f32x4){z, z, z, z}; }

namespace pg8 {
constexpr int BM = 256, BK = 64, HALF = 128, HTB = HALF * BK * 2, STAGE_BYTES = 8 * HTB, NXCD = 8, WGM = 8;
__host__ __device__ __forceinline__ int lds_byte(int r, int c) { const int st = (r >> 4) * 2 + (c >> 5), rr = r & 15, cc = c & 31, ob = rr * 64 + cc * 2; return st * 1024 + (ob ^ (((ob >> 9) & 1) << 5)); }
__host__ __device__ __forceinline__ void stage_rc(int b, int& R, int& C) { const int st = b / 1024, sb = b % 1024, swz = sb ^ (((sb >> 9) & 1) << 5); R = (st >> 1) * 16 + swz / 64; C = (st & 1) * 32 + (swz % 64) / 2; }
__host__ __device__ __forceinline__ int perm32(int rho) { const int n = rho >> 4, i = rho & 15; return 8 * (i >> 2) + 4 * n + (i & 3); }

struct Unit { int pm, pn, e, r; };

struct DenseSched {
    static constexpr bool GATHER = false;
    const bf16_t* A; const bf16_t* Bt; int lda, ldb, nM, nN, nwg, G, c, wave;
    __device__ void init(const bf16_t* A_, const bf16_t* Bt_, int lda_, int ldb_, int M, int N, int G_, int c_) { A = A_; Bt = Bt_; lda = lda_; ldb = ldb_; nM = M / BM; nN = N / BM; nwg = nM * nN; G = G_; c = c_; }
    __device__ __forceinline__ bool next(int i, Unit& u) const {
        const long L = (long)i * G + c; if (L >= nwg) return false;
        int wgid = (int)L; { const int q = nwg / NXCD, r = nwg % NXCD, xcd = wgid % NXCD, off = wgid / NXCD; wgid = (xcd < r ? xcd * (q + 1) : r * (q + 1) + (xcd - r) * q) + off; }
        const int nig = WGM * nN, gid = wgid / nig, fm = gid * WGM, gsz = (nM - fm) < WGM ? (nM - fm) : WGM;
        u.pm = fm + ((wgid % nig) % gsz); u.pn = (wgid % nig) / gsz; u.e = 0; u.r = 0; return true;
    }
    __device__ __forceinline__ const char* a_base(const Unit& u) const { return (const char*)A + (size_t)u.pm * BM * lda * 2; }
    __device__ __forceinline__ const char* b_base(const Unit& u) const { return (const char*)Bt + (size_t)u.pn * BM * ldb * 2; }
    __device__ __forceinline__ void a_offs(const Unit&, const int (&R)[2], const int (&C)[2], unsigned (&vo)[2][2]) const { }
};
template <bool GATHER_> struct MoeSched {
    static constexpr bool GATHER = GATHER_;
    const bf16_t* A; const bf16_t* Bt; int lda, ldb, nN, G, c, wave; size_t bexp;
    const LAS int* toff; const unsigned* cnt; const int* ltok;
    __device__ __forceinline__ bool next(int i, Unit& u) const {
        const int L = i * G + c; const int total = __builtin_amdgcn_readfirstlane(toff[32]) * nN; if (L >= total) return false;
        const int j = L / nN; u.pn = L - j * nN; int e = 0;
#pragma unroll 1
        for (int k = 1; k < 32; ++k) e = (__builtin_amdgcn_readfirstlane(toff[k]) <= j) ? k : e;
        u.e = e; u.r = j - __builtin_amdgcn_readfirstlane(toff[e]); u.pm = j; return true;
    }
    __device__ __forceinline__ const char* a_base(const Unit& u) const { return GATHER ? (const char*)A : (const char*)A + (size_t)u.pm * BM * lda * 2; }
    __device__ __forceinline__ const char* b_base(const Unit& u) const { return (const char*)Bt + (size_t)u.e * bexp + (size_t)u.pn * BM * ldb * 2; }
    __device__ __forceinline__ void a_offs(const Unit& u, const int (&R)[2], const int (&C)[2], unsigned (&vo)[2][2]) const {
        if constexpr (GATHER) {
        const int n = __builtin_amdgcn_readfirstlane((int)cnt[u.e * 64]);
#pragma unroll
        for (int h = 0; h < 2; ++h)
#pragma unroll
            for (int i = 0; i < 2; ++i) {
                const int sr = u.r * BM + h * HALF + R[i]; const int row = (sr < n) ? ltok[u.e * MT + sr] : 0;
                vo[h][i] = (unsigned)(row * lda + C[i]) * 2u;
            }
        }
    }
};

__device__ __forceinline__ unsigned cvt_pk_bf16(float lo, float hi) { unsigned r; asm volatile("v_cvt_pk_bf16_f32 %0, %1, %2" : "=v"(r) : "v"(lo), "v"(hi)); return r; }

struct EpiBf16 {
    static constexpr bool PERM = true;
    bf16_t* O; int ldc;
    __device__ __forceinline__ void operator()(const f32x4 (&acc)[2][2][4][2], const Unit& u, int wr, int wc, int fr, int fq) const {
        const int row0 = u.pm * BM + wr * 64 + fr, col0 = u.pn * BM + wc * 32 + 8 * fq;
#pragma unroll
        for (int ai = 0; ai < 2; ++ai)
#pragma unroll
            for (int m = 0; m < 4; ++m) { bf16_t* rowp = O + (size_t)(row0 + ai * HALF + m * 16) * ldc + col0;
#pragma unroll
                for (int bj = 0; bj < 2; ++bj) { const f32x4 v0 = acc[ai][bj][m][0], v1 = acc[ai][bj][m][1];
                    u32x4 w; w.x = cvt_pk_bf16(v0[0], v0[1]); w.y = cvt_pk_bf16(v0[2], v0[3]); w.z = cvt_pk_bf16(v1[0], v1[1]); w.w = cvt_pk_bf16(v1[2], v1[3]);
                    *(u32x4*)(rowp + bj * HALF) = w; } }
    }
};
struct EpiRes {
    static constexpr bool PERM = true;
    bf16_t* C; const bf16_t* res; int ldc; float alpha;
    __device__ __forceinline__ void operator()(const f32x4 (&acc)[2][2][4][2], const Unit& u, int wr, int wc, int fr, int fq) const {
        const int row0 = u.pm * BM + wr * 64 + fr, col0 = u.pn * BM + wc * 32 + 8 * fq;
#pragma unroll
        for (int ai = 0; ai < 2; ++ai)
#pragma unroll
            for (int m = 0; m < 4; ++m) { const size_t off = (size_t)(row0 + ai * HALF + m * 16) * ldc + col0;
#pragma unroll
                for (int bj = 0; bj < 2; ++bj) { const u32x4 rv = *(const u32x4*)(res + off + bj * HALF); const f32x4 v0 = acc[ai][bj][m][0], v1 = acc[ai][bj][m][1];
                    u32x4 w; w.x = cvt_pk_bf16(bflo(rv.x) * alpha + v0[0], bfhi(rv.x) * alpha + v0[1]); w.y = cvt_pk_bf16(bflo(rv.y) * alpha + v0[2], bfhi(rv.y) * alpha + v0[3]);
                    w.z = cvt_pk_bf16(bflo(rv.z) * alpha + v1[0], bfhi(rv.z) * alpha + v1[1]); w.w = cvt_pk_bf16(bflo(rv.w) * alpha + v1[2], bfhi(rv.w) * alpha + v1[3]);
                    *(u32x4*)(C + off + bj * HALF) = w; }
                asm volatile("" ::: "memory"); }
    }
};
struct EpiPle {
    static constexpr bool PERM = true;
    bf16_t* C; const bf16_t* x1; const bf16_t* pp; const float* bias; int ldc; float alpha;
    __device__ __forceinline__ void operator()(const f32x4 (&acc)[2][2][4][2], const Unit& u, int wr, int wc, int fr, int fq) const {
        const int row0 = u.pm * BM + wr * 64 + fr, col0 = u.pn * BM + wc * 32 + 8 * fq;
        f32x4 bv[2][2];
#pragma unroll
        for (int bj = 0; bj < 2; ++bj)
#pragma unroll
            for (int n = 0; n < 2; ++n) bv[bj][n] = *(const f32x4*)(bias + col0 + bj * HALF + 4 * n);
#pragma unroll
        for (int ai = 0; ai < 2; ++ai)
#pragma unroll
            for (int m = 0; m < 4; ++m) { const size_t off = (size_t)(row0 + ai * HALF + m * 16) * ldc + col0;
#pragma unroll
                for (int bj = 0; bj < 2; ++bj) { const size_t o = off + bj * HALF; const u32x4 xv = *(const u32x4*)(x1 + o), pw = *(const u32x4*)(pp + o);
                    const f32x4 a0 = acc[ai][bj][m][0] + bv[bj][0], a1 = acc[ai][bj][m][1] + bv[bj][1];
                    u32x4 w;
                    w.x = cvt_pk_bf16(bflo(xv.x) * alpha + sigmoidf_(a0[0]) * bflo(pw.x), bfhi(xv.x) * alpha + sigmoidf_(a0[1]) * bfhi(pw.x));
                    w.y = cvt_pk_bf16(bflo(xv.y) * alpha + sigmoidf_(a0[2]) * bflo(pw.y), bfhi(xv.y) * alpha + sigmoidf_(a0[3]) * bfhi(pw.y));
                    w.z = cvt_pk_bf16(bflo(xv.z) * alpha + sigmoidf_(a1[0]) * bflo(pw.z), bfhi(xv.z) * alpha + sigmoidf_(a1[1]) * bfhi(pw.z));
                    w.w = cvt_pk_bf16(bflo(xv.w) * alpha + sigmoidf_(a1[2]) * bflo(pw.w), bfhi(xv.w) * alpha + sigmoidf_(a1[3]) * bfhi(pw.w));
                    *(u32x4*)(C + o) = w; }
                asm volatile("" ::: "memory"); }
    }
};
struct EpiMoe1 {
    static constexpr bool PERM = true;
    bf16_t* H; const float* lgate; const unsigned* cnt;
    __device__ __forceinline__ void operator()(const f32x4 (&acc)[2][2][4][2], const Unit& u, int wr, int wc, int fr, int fq) const {
        const int n_e = __builtin_amdgcn_readfirstlane((int)cnt[u.e * 64]);
        const int col0 = u.pn * HALF + wc * 32 + 8 * fq;
#pragma unroll
        for (int ai = 0; ai < 2; ++ai)
#pragma unroll
            for (int m = 0; m < 4; ++m) { const int rt = ai * HALF + wr * 64 + m * 16 + fr; const int sr = u.r * BM + rt;
                const float gw = (sr < n_e) ? lgate[u.e * MT + sr] : 0.f;
                const f32x4 g0 = acc[ai][0][m][0], g1 = acc[ai][0][m][1], u0 = acc[ai][1][m][0], u1 = acc[ai][1][m][1];
                float o[8];
#pragma unroll
                for (int j = 0; j < 4; ++j) { o[j] = siluf_(g0[j]) * u0[j] * gw; o[4 + j] = siluf_(g1[j]) * u1[j] * gw; }
                u32x4 w; w.x = cvt_pk_bf16(o[0], o[1]); w.y = cvt_pk_bf16(o[2], o[3]); w.z = cvt_pk_bf16(o[4], o[5]); w.w = cvt_pk_bf16(o[6], o[7]);
                *(u32x4*)(H + (size_t)(u.pm * BM + rt) * DEXP + col0) = w; }
    }
};

template <class Epi, class Sched>
__device__ __forceinline__ void gemm_phase(LAS unsigned char* lds, const int K, const Sched& S, const Epi& E) {
    constexpr bool GA = Sched::GATHER;
    int lane_ = (int)__builtin_amdgcn_mbcnt_hi(~0u, __builtin_amdgcn_mbcnt_lo(~0u, 0u)); asm volatile("" : "+v"(lane_));
    const int wid = S.wave, lane = lane_, tid = wid * 64 + lane_, wr = wid >> 2, wc = wid & 3, fr = lane & 15, fq = lane >> 4;
    const int nt = K / BK, ldb = S.ldb, lda = S.lda;
    int Rr[2], Cc[2]; unsigned voffB[2], voffA[2];
#pragma unroll
    for (int i = 0; i < 2; ++i) { int R, C; stage_rc(tid * 16 + i * 8192, R, C); Rr[i] = R; Cc[i] = C; const int Rb = Epi::PERM ? ((R & ~31) + perm32(R & 31)) : R; voffB[i] = (unsigned)(Rb * ldb + C) * 2u; voffA[i] = (unsigned)(R * lda + C) * 2u; }
    const size_t kstep = (size_t)(BK * 2);
    const size_t hstep = (size_t)HALF * ldb * 2;
    const size_t ahstep = GA ? 0 : (size_t)HALF * lda * 2;
    const unsigned ldsw = (unsigned)wid * 1024u;
    const int aoff = lds_byte(wr * 64 + fr, fq * 8), boff = lds_byte(wc * 32 + fr, fq * 8);
#define PG8_SA(b, h) (((b) * 2 + (h)) * HTB)
#define PG8_SB(b, h) ((4 + (b) * 2 + (h)) * HTB)
#define PG8_STAGE(bufoff, gbase, voff) do { _Pragma("unroll") for (int _i = 0; _i < 2; ++_i) \
        __builtin_amdgcn_global_load_lds((const unsigned*)((const char*)(gbase) + (voff)[_i]), (LAS unsigned*)(lds + (bufoff) + ldsw + _i * 8192), 16, 0, 0); } while (0)
#define PG8_STAGE_A(bufoff, gbase, h) do { if constexpr (GA) PG8_STAGE(bufoff, gbase, voA[h]); else PG8_STAGE(bufoff, (gbase) + (h) * ahstep, voffA); } while (0)
#define PG8_STAGE_A2(bufoff, gbase, h) do { if constexpr (GA) { unsigned _v[2] = {last ? voN[h][0] : voA[h][0], last ? voN[h][1] : voA[h][1]}; PG8_STAGE(bufoff, gbase, _v); } else PG8_STAGE(bufoff, (gbase) + (h) * ahstep, voffA); } while (0)
#define PG8_LDA(dst, b, h) do { _Pragma("unroll") for (int m = 0; m < 4; ++m) _Pragma("unroll") for (int k = 0; k < 2; ++k) dst[m][k] = *(const LAS bf16x8*)(lds + PG8_SA(b, h) + aoff + m * 2048 + k * 1024); } while (0)
#define PG8_LDB(dst, b, h) do { _Pragma("unroll") for (int n = 0; n < 2; ++n) _Pragma("unroll") for (int k = 0; k < 2; ++k) dst[n][k] = *(const LAS bf16x8*)(lds + PG8_SB(b, h) + boff + n * 2048 + k * 1024); } while (0)
#define PG8_MMA(ai, bj, At, Bt) do { __builtin_amdgcn_s_setprio(1); _Pragma("unroll") for (int m = 0; m < 4; ++m) _Pragma("unroll") for (int n = 0; n < 2; ++n) _Pragma("unroll") for (int k = 0; k < 2; ++k) \
        acc[ai][bj][m][n] = __builtin_amdgcn_mfma_f32_16x16x32_bf16(Bt[n][k], At[m][k], acc[ai][bj][m][n], 0, 0, 0); __builtin_amdgcn_s_setprio(0); } while (0)
#define PG8_WAIT_V(n) asm volatile("s_waitcnt vmcnt(" #n ")" ::: "memory")
#define PG8_WAIT_L(n) asm volatile("s_waitcnt lgkmcnt(" #n ")" ::: "memory")
#define PG8_BAR __builtin_amdgcn_s_barrier()
#define PG8_SCHED __builtin_amdgcn_sched_barrier(0)
    Unit cur, nxt; int ui = 0;
    if (!S.next(0, cur)) return;
    f32x4 acc[2][2][4][2];
#pragma unroll
    for (int a = 0; a < 2; ++a)
#pragma unroll
        for (int b = 0; b < 2; ++b)
#pragma unroll
            for (int m = 0; m < 4; ++m)
#pragma unroll
                for (int n = 0; n < 2; ++n) acc[a][b][m][n] = (f32x4){0.f, 0.f, 0.f, 0.f};
    bf16x8 At[4][2], B0[2][2], B1[2][2];
    const char* cA = S.a_base(cur); const char* cB = S.b_base(cur);
    unsigned voA[2][2], voN[2][2];
    if constexpr (GA) S.a_offs(cur, Rr, Cc, voA);
    PG8_STAGE(PG8_SB(0, 0), cB, voffB); PG8_STAGE(PG8_SB(0, 1), cB + hstep, voffB); PG8_STAGE_A(PG8_SA(0, 0), cA, 0); PG8_STAGE_A(PG8_SA(0, 1), cA, 1);
    if (wr == 1) PG8_BAR;
    PG8_WAIT_V(2); PG8_BAR;
    PG8_STAGE(PG8_SB(1, 0), cB + kstep, voffB); PG8_STAGE_A(PG8_SA(1, 0), cA + kstep, 0); PG8_STAGE(PG8_SB(1, 1), cB + hstep + kstep, voffB);
    PG8_WAIT_V(6); PG8_BAR;
    for (;;) {
        const bool has_next = S.next(ui + 1, nxt);
        const char* nA = has_next ? S.a_base(nxt) : cA; const char* nB = has_next ? S.b_base(nxt) : cB;
        if constexpr (GA) {
            if (has_next) S.a_offs(nxt, Rr, Cc, voN);
            else {
#pragma unroll
                for (int h = 0; h < 2; ++h)
#pragma unroll
                    for (int i = 0; i < 2; ++i) voN[h][i] = voA[h][i]; } }
#pragma unroll 1
        for (int t = 0; t < nt; t += 2) {
            const bool last = (t == nt - 2);
            const char* a1 = cA + (size_t)(t + 1) * kstep;
            const char* a2 = last ? nA : cA + (size_t)(t + 2) * kstep; const char* b2 = last ? nB : cB + (size_t)(t + 2) * kstep;
            const char* a3 = a2 + kstep; const char* b3 = b2 + kstep;
            PG8_LDB(B0, 0, 0); PG8_LDB(B1, 0, 1); PG8_SCHED; PG8_LDA(At, 0, 0); PG8_STAGE_A(PG8_SA(1, 1), a1, 1);
            PG8_WAIT_V(8); PG8_WAIT_L(0); PG8_BAR; PG8_MMA(0, 0, At, B0); PG8_MMA(0, 1, At, B1); PG8_BAR; PG8_SCHED;
            PG8_LDA(At, 0, 1); PG8_STAGE(PG8_SB(0, 0), b2, voffB); PG8_STAGE(PG8_SB(0, 1), b2 + hstep, voffB); PG8_STAGE_A2(PG8_SA(0, 0), a2, 0);
            PG8_WAIT_V(8); PG8_WAIT_L(0); PG8_BAR; PG8_MMA(1, 0, At, B0); PG8_MMA(1, 1, At, B1); PG8_BAR; PG8_SCHED;
            PG8_LDB(B0, 1, 0); PG8_LDB(B1, 1, 1); PG8_SCHED; PG8_LDA(At, 1, 0); PG8_STAGE_A2(PG8_SA(0, 1), a2, 1);
            PG8_WAIT_V(8); PG8_WAIT_L(0); PG8_BAR; PG8_MMA(0, 0, At, B0); PG8_MMA(0, 1, At, B1); PG8_BAR; PG8_SCHED;
            PG8_LDA(At, 1, 1); PG8_STAGE(PG8_SB(1, 0), b3, voffB); PG8_STAGE(PG8_SB(1, 1), b3 + hstep, voffB); PG8_STAGE_A2(PG8_SA(1, 0), a3, 0);
            PG8_WAIT_V(8); PG8_WAIT_L(0); PG8_BAR; PG8_MMA(1, 0, At, B0); PG8_MMA(1, 1, At, B1); PG8_BAR; PG8_SCHED;
        }
        if (wr == 0) PG8_BAR;
        E(acc, cur, wr, wc, fr, fq);
        if (!has_next) break;
#pragma unroll
        for (int a = 0; a < 2; ++a)
#pragma unroll
            for (int b = 0; b < 2; ++b)
#pragma unroll
                for (int m = 0; m < 4; ++m)
#pragma unroll
                    for (int n = 0; n < 2; ++n) acc[a][b][m][n] = (f32x4){0.f, 0.f, 0.f, 0.f};
        cur = nxt; cA = nA; cB = nB; ++ui;
        if constexpr (GA) {
#pragma unroll
            for (int h = 0; h < 2; ++h)
#pragma unroll
                for (int i = 0; i < 2; ++i) voA[h][i] = voN[h][i]; }
        if (wr == 1) PG8_BAR;
    }
    PG8_WAIT_V(0);
    PG8_BAR;
#undef PG8_SA
#undef PG8_SB
#undef PG8_STAGE
#undef PG8_STAGE_A
#undef PG8_STAGE_A2
#undef PG8_LDA
#undef PG8_LDB
#undef PG8_MMA
#undef PG8_WAIT_V
#undef PG8_WAIT_L
#undef PG8_BAR
#undef PG8_SCHED
}
}

#define XB_TMO      128
#define XB_XCNT(j)  (256  + 64 * (j))
#define XB_XSUB(j)  (1280 + 64 * (j))
#define XB_XGEN(j)  (2304 + 64 * (j))
#define XB_TOP      3328
#define XB_TOPGEN   3392
#define XCD_BAR_WORDS 3456
#define XB_SPIN_CAP (1u << 18)
__device__ __forceinline__ unsigned xb_ld(unsigned* p)              { return __hip_atomic_load(p, __ATOMIC_RELAXED, __HIP_MEMORY_SCOPE_AGENT); }
__device__ __forceinline__ unsigned xb_add(unsigned* p, unsigned v) { return __hip_atomic_fetch_add(p, v, __ATOMIC_RELAXED, __HIP_MEMORY_SCOPE_AGENT); }
__device__ __forceinline__ unsigned xb_xcc_id() { return (unsigned)__builtin_amdgcn_s_getreg((3 << 11) | 20) & 0xFu; }
#define XB_SPIN(cond, bar) do { unsigned _sp = 0; while (cond) { __builtin_amdgcn_s_sleep(1); \
    if ((++_sp & 255u) == 0u) { if (xb_ld(&(bar)[XB_TMO])) break; if (_sp > XB_SPIN_CAP) { atomicAdd(&(bar)[XB_TMO], 1u); break; } } } } while (0)
struct XcdBarrier { unsigned* bar; unsigned x; volatile LAS unsigned* st; };
__device__ __forceinline__ XcdBarrier xcd_barrier_post(unsigned* bar, volatile LAS unsigned* st) {
    XcdBarrier b; b.bar = bar; b.x = xb_xcc_id(); b.st = st;
    if (threadIdx.x == 0) (void)xb_add(&bar[XB_XCNT(b.x)], 1u);
    return b;
}
__device__ __forceinline__ void xcd_barrier_complete(unsigned* bar, unsigned x, unsigned& nloc, unsigned& nx) {
    const unsigned G = gridDim.x * gridDim.y * gridDim.z;
    unsigned sum, cnt, mine, sp = 0u;
    for (;;) {
        sum = 0u; cnt = 0u; mine = 0u;
#pragma unroll
        for (unsigned j = 0; j < 16; ++j) { const unsigned c = xb_ld(&bar[XB_XCNT(j)]); sum += c; cnt += (c > 0u) ? 1u : 0u; mine = (j == x) ? c : mine; }
        if (sum == G) break;
        __builtin_amdgcn_s_sleep(1);
        if ((++sp & 255u) == 0u) { if (xb_ld(&bar[XB_TMO])) break; if (sp > XB_SPIN_CAP) { atomicAdd(&bar[XB_TMO], 1u); break; } }
    }
    nloc = mine > 0u ? mine : 1u; nx = cnt > 0u ? cnt : 1u;
}
__device__ __forceinline__ void xcd_barrier(const XcdBarrier& b) {
    asm volatile("s_waitcnt vmcnt(0)" ::: "memory");
    __syncthreads();
    if (threadIdx.x == 0) {
        unsigned* bar = b.bar;
        __builtin_amdgcn_s_waitcnt(0);
        unsigned nloc = b.st[0], nx = b.st[1];
        if (nloc == 0u) { xcd_barrier_complete(bar, b.x, nloc, nx); b.st[0] = nloc; b.st[1] = nx; }
        const unsigned old = xb_add(&bar[XB_XSUB(b.x)], 1u);
        const unsigned gen = old / nloc;
        if (old + 1u == (gen + 1u) * nloc) {
            __builtin_amdgcn_fence(__ATOMIC_RELEASE, "agent");
            asm volatile("s_waitcnt vmcnt(0)" ::: "memory");
            const unsigned og = xb_add(&bar[XB_TOP], 1u);
            const unsigned tg = og / nx;
            if (og + 1u == (tg + 1u) * nx) xb_add(&bar[XB_TOPGEN], 1u);
            else XB_SPIN(xb_ld(&bar[XB_TOPGEN]) == tg, bar);
            __builtin_amdgcn_fence(__ATOMIC_ACQUIRE, "agent");
            xb_add(&bar[XB_XGEN(b.x)], 1u);
            asm volatile("s_waitcnt vmcnt(0)" ::: "memory");
        } else {
            XB_SPIN(xb_ld(&bar[XB_XGEN(b.x)]) == gen, bar);
            __builtin_amdgcn_fence(__ATOMIC_ACQUIRE, "agent");
            asm volatile("s_waitcnt vmcnt(0)" ::: "memory");
        }
    }
    __syncthreads();
}

struct Args { const float* in[28]; float* out; unsigned char* ws; int ph_lo, ph_hi; };

struct Frame {
    LAS unsigned char* lds; unsigned char* ws; unsigned* ctl;
    int tid, lane, wave, G, bx;
    __device__ __forceinline__ Frame fresh() const { Frame f = *this; int ln = (int)__builtin_amdgcn_mbcnt_hi(~0u, __builtin_amdgcn_mbcnt_lo(~0u, 0u)); asm volatile("" : "+v"(ln)); f.lane = ln; f.tid = wave * 64 + ln;
        int b = bx, g = G; unsigned char* w = ws; asm volatile("" : "+s"(b), "+s"(g), "+s"(w)); f.bx = b; f.G = g; f.ws = w; f.ctl = (unsigned*)(w + WS_CTL); return f; }
};

__device__ __forceinline__ int dmap(int type, int n) {
    if (type == 1) return n < 2048 ? n : (n < 2064 ? n - 2048 + UG_LOW : n - 16);
    if (type == 2) return (n >> 7) * 256 + (n & 127);
    if (type == 3) return (n >> 7) * 256 + 128 + (n & 127);
    return n;
}
__device__ __forceinline__ void transpose_item(const float* W, int ldw, int ncols, int k0, int n0, const float* kscale, bf16_t* WT, int ldt, int type, LAS float* scr, int lane) {
    const int n4 = (lane & 15) * 4, kr = lane >> 4; const bool okc = (n0 + n4) < ncols;
    f32x4 v[16];
#pragma unroll
    for (int i = 0; i < 16; ++i) v[i] = okc ? __builtin_nontemporal_load((const f32x4*)(W + (size_t)(k0 + 4 * i + kr) * ldw + n0 + n4)) : (f32x4){0.f, 0.f, 0.f, 0.f};
    if (kscale) {
#pragma unroll
        for (int i = 0; i < 16; ++i) v[i] = v[i] * kscale[k0 + 4 * i + kr]; }
#pragma unroll
    for (int i = 0; i < 16; ++i) { LAS float* s = scr + (4 * i + kr) * 65 + n4; s[0] = v[i][0]; s[1] = v[i][1]; s[2] = v[i][2]; s[3] = v[i][3]; }
    LDS_WAIT(); asm volatile("" ::: "memory");
    const int c = lane & 7;
#pragma unroll
    for (int j = 0; j < 8; ++j) { const int n = (lane >> 3) + 8 * j; const LAS float* s = scr + (8 * c) * 65 + n;
        u32x4 o; o.x = pk2(s[0 * 65], s[1 * 65]); o.y = pk2(s[2 * 65], s[3 * 65]); o.z = pk2(s[4 * 65], s[5 * 65]); o.w = pk2(s[6 * 65], s[7 * 65]);
        if (n0 + n < ncols) *(u32x4*)(WT + (size_t)dmap(type, n0 + n) * ldt + k0 + 8 * c) = o; }
    LDS_WAIT(); asm volatile("" ::: "memory");
}
__device__ __forceinline__ int t5_bucket(int d) {
    if (d < 16) return d;
    const float v = logf((float)d / 16.0f) / 4.852030263919617f * 16.0f;
    int b = 16 + (int)v; return b < 31 ? b : 31;
}
constexpr int I_IN = 32 * 89, I_OUT = 32 * 32, I_PP = 4 * 32, I_PG = 32 * 32, I_G = 32 * 128, I_U = 32 * 128, I_D = 32 * 128;
constexpr int IO_OUT = I_IN, IO_PP = IO_OUT + I_OUT, IO_PG = IO_PP + I_PP, IO_G = IO_PG + I_PG, IO_U = IO_G + I_G, IO_D = IO_U + I_U, I_L = IO_D + I_D;
__device__ __forceinline__ void conv_items(const Frame& F, const Args& a, const int l, const int lo, const int hi, const int gw, const int NGW) {
    LAS float* scr = (LAS float*)(F.lds + F.wave * 16640);
    bf16_t* WIN = (bf16_t*)(F.ws + WS_WIN); bf16_t* WOUT = (bf16_t*)(F.ws + WS_WOUT); bf16_t* WGU = (bf16_t*)(F.ws + WS_WGU); bf16_t* WD = (bf16_t*)(F.ws + WS_WD);
    bf16_t* WPG = (bf16_t*)(F.ws + WS_WPG); bf16_t* WPP = (bf16_t*)(F.ws + WS_WPP);
    for (int it = lo + gw; it < hi; it += NGW) {
        int r = it;
        if (r < IO_OUT) { const int kb = r / 89, nb = r - kb * 89; transpose_item(a.in[2] + (size_t)l * DM * DIN, DIN, DIN, kb * 64, nb * 64, nullptr, WIN + (size_t)l * DINP * DM, DM, 1, scr, F.lane); continue; }
        if (r < IO_PP) { r -= IO_OUT; const int kb = r >> 5, nb = r & 31; transpose_item(a.in[12] + (size_t)l * DM * DM, DM, DM, kb * 64, nb * 64, a.in[11] + l * DM, WOUT + (size_t)l * DM * DM, DM, 0, scr, F.lane); continue; }
        if (r < IO_PG) { r -= IO_PP; const int kb = r >> 5, nb = r & 31; transpose_item(a.in[25] + (size_t)l * PLE * DM, DM, DM, kb * 64, nb * 64, nullptr, WPP + (size_t)l * DM * PLE, PLE, 0, scr, F.lane); continue; }
        if (r < IO_G) { r -= IO_PG; const int kb = r >> 5, nb = r & 31; transpose_item(a.in[23] + (size_t)l * DM * DM, DM, DM, kb * 64, nb * 64, nullptr, WPG + (size_t)l * DM * DM, DM, 0, scr, F.lane); continue; }
        if (r < IO_U) { r -= IO_G; const int e = r >> 7, q = r & 127, kb = q >> 2, nb = q & 3; transpose_item(a.in[20] + (size_t)(l * NEXP + e) * DM * DEXP, DEXP, DEXP, kb * 64, nb * 64, nullptr, WGU + (size_t)(l * NEXP + e) * 512 * DM, DM, 2, scr, F.lane); continue; }
        if (r < IO_D) { r -= IO_U; const int e = r >> 7, q = r & 127, kb = q >> 2, nb = q & 3; transpose_item(a.in[21] + (size_t)(l * NEXP + e) * DM * DEXP, DEXP, DEXP, kb * 64, nb * 64, nullptr, WGU + (size_t)(l * NEXP + e) * 512 * DM, DM, 3, scr, F.lane); continue; }
        { r -= IO_D; const int e = r >> 7, q = r & 127, kb = q >> 5, nb = q & 31; transpose_item(a.in[22] + (size_t)(l * NEXP + e) * DEXP * DM, DM, DM, kb * 64, nb * 64, nullptr, WD + (size_t)(l * NEXP + e) * DM * DEXP, DEXP, 0, scr, F.lane); }
    }
}
__device__ __forceinline__ void conv_all(const Frame& F, const Args& a, const int l, const int lo, const int hi) { __syncthreads(); conv_items(F, a, l, lo, hi, F.bx * 8 + F.wave, F.G * 8); __syncthreads(); }
__device__ __forceinline__ void phase_prologue(const Frame& F, const Args& a) {
    bf16_t* WIN = (bf16_t*)(F.ws + WS_WIN);
    conv_all(F, a, 0, 0, IO_PG);
    const size_t gt = (size_t)F.bx * 512 + F.tid, NT = (size_t)F.G * 512;
    for (size_t i = gt; i < (size_t)NL * (DINP - DIN) * DM / 8; i += NT) { const size_t l = i / ((DINP - DIN) * DM / 8), r = i % ((DINP - DIN) * DM / 8);
        *(u32x4*)(WIN + (l * DINP + DIN) * DM + r * 8) = (u32x4){0u, 0u, 0u, 0u}; }
    { const float* x = a.in[0]; bf16_t* XB = (bf16_t*)(F.ws + WS_XB);
      for (size_t i = gt; i < (size_t)MT * DM / 8; i += NT) { const f32x4 v0 = *(const f32x4*)(x + i * 8), v1 = *(const f32x4*)(x + i * 8 + 4);
          *(u32x4*)(XB + i * 8) = (u32x4){pk2(v0[0], v0[1]), pk2(v0[2], v0[3]), pk2(v1[0], v1[1]), pk2(v1[2], v1[3])}; } }
    { const float* p = a.in[1]; bf16_t* PB = (bf16_t*)(F.ws + WS_PB);
      for (size_t i = gt; i < (size_t)NL * MT * PLE / 8; i += NT) { const f32x4 v0 = *(const f32x4*)(p + i * 8), v1 = *(const f32x4*)(p + i * 8 + 4);
          *(u32x4*)(PB + i * 8) = (u32x4){pk2(v0[0], v0[1]), pk2(v0[2], v0[3]), pk2(v1[0], v1[1]), pk2(v1[2], v1[3])}; } }
    { float* bt = (float*)(F.ws + WS_BTAB); const float* rb = a.in[13];
      for (size_t i = gt; i < 3 * 129 * 8; i += NT) { const int h = (int)(i & 7), j = (int)((i >> 3) % 129), br = (int)((i >> 3) / 129); const int dil = br == 0 ? 1 : (br == 1 ? 4 : 16);
          bt[i] = rb[t5_bucket(j * dil) * 8 + h]; } }
    { float* wrt = (float*)(F.ws + WS_WRT);
      for (size_t i = gt; i < (size_t)NL * 36 * DM; i += NT) { const int c = (int)(i % DM), col = (int)((i / DM) % 36), l = (int)(i / (36 * DM));
          wrt[i] = col < 4 ? a.in[16][((size_t)l * DM + c) * 4 + col] : a.in[18][((size_t)l * DM + c) * 32 + (col - 4)]; } }
}

__device__ __forceinline__ void conv_unit(const Frame& F, const Args& a, int l, int unit) {
    const bf16_t* U = (const bf16_t*)(F.ws + WS_U); bf16_t* MIX = (bf16_t*)(F.ws + WS_MIX);
    LAS float* hb = (LAS float*)F.lds;
    const int t0 = unit * 32, tl0 = t0 & (SEQ - 1), tb = t0 - tl0;
    const int tid = F.tid;
    __syncthreads();
#pragma unroll 1
    for (int i = 0; i < 8; ++i) { const int id = tid + 512 * i; if (id < 62 * 64) { const int row = id >> 6, ch = (id & 63) * 8; const int tl = tl0 - 30 + row;
        float o[8];
        if (tl >= 0) { const bf16_t* up = U + (size_t)(tb + tl) * DINP; const u32x4 av = *(const u32x4*)(up + UA_VAL + ch), gv = *(const u32x4*)(up + UA_GATE + ch);
            const unsigned aw[4] = {av.x, av.y, av.z, av.w}, gw[4] = {gv.x, gv.y, gv.z, gv.w};
#pragma unroll
            for (int j = 0; j < 4; ++j) { o[2 * j] = bflo(aw[j]) * sigmoidf_(bflo(gw[j])); o[2 * j + 1] = bfhi(aw[j]) * sigmoidf_(bfhi(gw[j])); } }
        else {
#pragma unroll
            for (int j = 0; j < 8; ++j) o[j] = 0.f; }
        *(LAS f32x4*)(hb + row * 512 + ch) = (f32x4){o[0], o[1], o[2], o[3]}; *(LAS f32x4*)(hb + row * 512 + ch + 4) = (f32x4){o[4], o[5], o[6], o[7]}; } }
    __syncthreads();
    float yv[32];
    { const int c = tid; const float* w = a.in[3] + (size_t)l * 31 * 512; const float bias = a.in[4][l * 512 + c];
      float wv[31];
#pragma unroll
      for (int j = 0; j < 31; ++j) wv[j] = w[j * 512 + c];
      float hv[62];
#pragma unroll
      for (int r = 0; r < 62; ++r) hv[r] = hb[r * 512 + c];
#pragma unroll
      for (int t = 0; t < 32; ++t) { float s = bias;
#pragma unroll
          for (int j = 0; j < 31; ++j) s += wv[j] * hv[t + j];
          yv[t] = s; } }
    __syncthreads();
#pragma unroll
    for (int t = 0; t < 32; ++t) hb[t * 512 + tid] = yv[t];
    __syncthreads();
    { const float* lg = a.in[5] + l * 512; const float* lb = a.in[6] + l * 512;
#pragma unroll 1
      for (int i = 0; i < 4; ++i) { const int t = F.wave + 8 * i;
          const f32x4 v0 = *(const LAS f32x4*)(hb + t * 512 + 4 * F.lane), v1 = *(const LAS f32x4*)(hb + t * 512 + 256 + 4 * F.lane);
          const float mean = wave_sum((v0[0] + v0[1]) + (v0[2] + v0[3]) + (v1[0] + v1[1]) + (v1[2] + v1[3])) * (1.f / 512.f);
          const f32x4 d0 = v0 - mean, d1 = v1 - mean;
          const float var = wave_sum((d0[0] * d0[0] + d0[1] * d0[1]) + (d0[2] * d0[2] + d0[3] * d0[3]) + (d1[0] * d1[0] + d1[1] * d1[1]) + (d1[2] * d1[2] + d1[3] * d1[3])) * (1.f / 512.f);
          const float rstd = 1.0f / sqrtf(var + LN_EPS);
          const f32x4 g0 = *(const f32x4*)(lg + 4 * F.lane), g1 = *(const f32x4*)(lg + 256 + 4 * F.lane), b0 = *(const f32x4*)(lb + 4 * F.lane), b1 = *(const f32x4*)(lb + 256 + 4 * F.lane);
          float o0[4], o1[4];
#pragma unroll
          for (int j = 0; j < 4; ++j) { o0[j] = siluf_(d0[j] * rstd * g0[j] + b0[j]); o1[j] = siluf_(d1[j] * rstd * g1[j] + b1[j]); }
          bf16_t* mp = MIX + (size_t)(t0 + t) * DM;
          *(u32x2*)(mp + 4 * F.lane) = (u32x2){pk2(o0[0], o0[1]), pk2(o0[2], o0[3])}; *(u32x2*)(mp + 256 + 4 * F.lane) = (u32x2){pk2(o1[0], o1[1]), pk2(o1[2], o1[3])}; } }
    { const int cg = (tid & 63) * 8; const float* w = a.in[10] + (size_t)l * 3 * 512 + cg;
      float wv[3][8];
#pragma unroll
      for (int j = 0; j < 3; ++j) { const f32x4 a0 = *(const f32x4*)(w + j * 512), a1 = *(const f32x4*)(w + j * 512 + 4); wv[j][0] = a0[0]; wv[j][1] = a0[1]; wv[j][2] = a0[2]; wv[j][3] = a0[3]; wv[j][4] = a1[0]; wv[j][5] = a1[1]; wv[j][6] = a1[2]; wv[j][7] = a1[3]; }
#pragma unroll 1
      for (int pass = 0; pass < 2; ++pass) { const int tg = (tid >> 6) + 8 * pass;
      float p[4][8];
#pragma unroll
      for (int rr = 0; rr < 4; ++rr) { const int tl = tl0 + 2 * tg - 2 + rr;
          { const float msk = tl >= 0 ? 1.f : 0.f; const int tlc = tl >= 0 ? tl : 0;
            const bf16_t* up = U + (size_t)(tb + tlc) * DINP; const u32x4 cw = *(const u32x4*)(up + US_C + cg), hw = *(const u32x4*)(up + US_H + cg);
            const unsigned c4[4] = {cw.x, cw.y, cw.z, cw.w}, h4[4] = {hw.x, hw.y, hw.z, hw.w};
#pragma unroll
            for (int j = 0; j < 4; ++j) { p[rr][2 * j] = bflo(c4[j]) * bflo(h4[j]) * msk; p[rr][2 * j + 1] = bfhi(c4[j]) * bfhi(h4[j]) * msk; } } }
#pragma unroll
      for (int tt = 0; tt < 2; ++tt) { const int t = t0 + 2 * tg + tt; const u32x4 bw = *(const u32x4*)(U + (size_t)t * DINP + US_B + cg); const unsigned b4[4] = {bw.x, bw.y, bw.z, bw.w}; unsigned ow[4];
#pragma unroll
          for (int j = 0; j < 4; ++j) { const float y0 = bflo(b4[j]) * (wv[0][2 * j] * p[tt][2 * j] + wv[1][2 * j] * p[tt + 1][2 * j] + wv[2][2 * j] * p[tt + 2][2 * j]);
              const float y1 = bfhi(b4[j]) * (wv[0][2 * j + 1] * p[tt][2 * j + 1] + wv[1][2 * j + 1] * p[tt + 1][2 * j + 1] + wv[2][2 * j + 1] * p[tt + 2][2 * j + 1]); ow[j] = pk2(y0, y1); }
          *(u32x4*)(MIX + (size_t)t * DM + 1536 + cg) = (u32x4){ow[0], ow[1], ow[2], ow[3]}; } } }
}

__device__ __forceinline__ bf16x8 frag_f32(const LAS float* p) { const f32x4 a = *(const LAS f32x4*)p, b = *(const LAS f32x4*)(p + 4);
    const u32x4 w = (u32x4){pk2(a[0], a[1]), pk2(a[2], a[3]), pk2(b[0], b[1]), pk2(b[2], b[3])}; return __builtin_bit_cast(bf16x8, w); }
__device__ __forceinline__ bf16x8 frag_col(const LAS float* p, int stride) {
    const u32x4 w = (u32x4){pk2(p[0], p[stride]), pk2(p[2 * stride], p[3 * stride]), pk2(p[4 * stride], p[5 * stride]), pk2(p[6 * stride], p[7 * stride])}; return __builtin_bit_cast(bf16x8, w); }
__device__ __forceinline__ void gla_a_unit(const Frame& F, const Args& a, int l, int unit) {
    const bf16_t* U = (const bf16_t*)(F.ws + WS_U);
    float* GU = (float*)(F.ws + WS_GU); float* GO = (float*)(F.ws + WS_GO); float* GQ = (float*)(F.ws + WS_GQ); float* GD = (float*)(F.ws + WS_GD);
    const int n = unit & 63, h = (unit >> 6) & 3, b = unit >> 8, bh = b * 4 + h;
    const int t0 = b * SEQ + n * 32, tid = F.tid;
    LAS float* L = (LAS float*)F.lds;
    LAS float* qt = L; LAS float* kr = L + 2048; LAS float* kt = L + 4096; LAS float* kh = L + 6144; LAS float* vv = L + 8192; LAS float* bc = L + 12288; LAS float* gl = L + 14336; LAS float* wg = L + 14848; LAS float* sc = L + 15872;
    const int i = tid >> 4, k4 = (tid & 15) * 4, v8 = (tid & 15) * 8;
    __syncthreads();
    { const bf16_t* up = U + (size_t)(t0 + i) * DINP;
      const u32x2 qw = *(const u32x2*)(up + UG_Q + h * 64 + k4), kw = *(const u32x2*)(up + UG_K + h * 64 + k4); const u32x4 vw = *(const u32x4*)(up + UG_V + h * 128 + v8);
      *(LAS f32x4*)(qt + i * 64 + k4) = (f32x4){bflo(qw.x), bfhi(qw.x), bflo(qw.y), bfhi(qw.y)};
      *(LAS f32x4*)(kr + i * 64 + k4) = (f32x4){bflo(kw.x), bfhi(kw.x), bflo(kw.y), bfhi(kw.y)};
      *(LAS f32x4*)(vv + i * 128 + v8) = (f32x4){bflo(vw.x), bfhi(vw.x), bflo(vw.y), bfhi(vw.y)}; *(LAS f32x4*)(vv + i * 128 + v8 + 4) = (f32x4){bflo(vw.z), bfhi(vw.z), bflo(vw.w), bfhi(vw.w)};
      gl[i * 16 + (tid & 15)] = bf2f(up[UG_LOW + (tid & 15)]);
      const float* w2 = a.in[7] + (size_t)l * 16 * 256;
      wg[tid] = w2[(tid >> 6) * 256 + h * 64 + (tid & 63)]; wg[512 + tid] = w2[(8 + (tid >> 6)) * 256 + h * 64 + (tid & 63)]; }
    __syncthreads();
    { const f32x4 bg = *(const f32x4*)(a.in[8] + l * 256 + h * 64 + k4); f32x4 z = bg;
#pragma unroll
      for (int r = 0; r < 16; ++r) { const float g = gl[i * 16 + r]; const f32x4 w = *(const LAS f32x4*)(wg + r * 64 + k4); z = z + w * g; }
      f32x4 la;
#pragma unroll
      for (int j = 0; j < 4; ++j) la[j] = (fminf(z[j], 0.f) - log1pf(expf(-fabsf(z[j])))) * (1.0f / 16.0f);
      *(LAS f32x4*)(bc + i * 64 + k4) = la; }
    __syncthreads();
    f32x4 bv = {0.f, 0.f, 0.f, 0.f}, bl = bv;
#pragma unroll 8
    for (int r = 0; r < 32; ++r) { const f32x4 x = *(const LAS f32x4*)(bc + r * 64 + k4); bl = bl + x; if (r <= i) bv = bv + x; }
    { const f32x4  q = *(const LAS f32x4*)(qt + i * 64 + k4), k = *(const LAS f32x4*)(kr + i * 64 + k4);
      f32x4 qo, ko, ho;
#pragma unroll
      for (int j = 0; j < 4; ++j) { qo[j] = q[j] * expf(bv[j]) * 0.125f; ko[j] = k[j] * expf(-bv[j]); ho[j] = k[j] * expf(bl[j] - bv[j]); }
      *(LAS f32x4*)(qt + i * 64 + k4) = qo; *(LAS f32x4*)(kt + i * 64 + k4) = ko; *(LAS f32x4*)(kh + i * 64 + k4) = ho;
      *(f32x4*)(GQ + (size_t)(t0 + i) * 256 + h * 64 + k4) = qo;
      if (i == 31) { f32x4 d;
#pragma unroll
          for (int j = 0; j < 4; ++j) d[j] = expf(bl[j]);
          *(f32x4*)(GD + ((size_t)bh * 64 + n) * 64 + k4) = d; } }
    __syncthreads();
    const int lane = F.lane, w = F.wave, fr = lane & 15, fg = lane >> 4;
    if (w < 4) { const int mi = w >> 1, nj = w & 1; f32x4 d = zero4();
#pragma unroll
        for (int ks = 0; ks < 2; ++ks) d = __builtin_amdgcn_mfma_f32_16x16x32_bf16(frag_f32(qt + (16 * mi + fr) * 64 + 8 * fg + 32 * ks), frag_f32(kt + (16 * nj + fr) * 64 + 8 * fg + 32 * ks), d, 0, 0, 0);
#pragma unroll
        for (int r = 0; r < 4; ++r) { const int ii = 16 * mi + 4 * fg + r, jj = 16 * nj + fr; sc[ii * 36 + jj] = (jj <= ii) ? d[r] : 0.f; } }
    const bf16x8 vfrag = frag_col(vv + (8 * fg) * 128 + 16 * w + fr, 128);
    { float* gp = GU + ((size_t)bh * 64 + n) * 8192 + (size_t)(16 * w + fr) * 64 + 4 * fg;
#pragma unroll
      for (int kt4 = 0; kt4 < 4; ++kt4) { const bf16x8 kfrag = frag_col(kh + (8 * fg) * 64 + 16 * kt4 + fr, 64);
          const f32x4 d = __builtin_amdgcn_mfma_f32_16x16x32_bf16(kfrag, vfrag, zero4(), 0, 0, 0);
          *(f32x4*)(gp + 16 * kt4) = d; } }
    __syncthreads();
#pragma unroll
    for (int it = 0; it < 2; ++it) { const bf16x8 sfrag = frag_f32(sc + (16 * it + fr) * 36 + 8 * fg);
        const f32x4 d = __builtin_amdgcn_mfma_f32_16x16x32_bf16(vfrag, sfrag, zero4(), 0, 0, 0);
        *(f32x4*)(GO + (size_t)(t0 + 16 * it + fr) * 512 + h * 128 + 16 * w + 4 * fg) = d; }
}
__device__ __forceinline__ void gla_scan(const Frame& F) {
    float* GU = (float*)(F.ws + WS_GU); const float* GD = (const float*)(F.ws + WS_GD);
    for (int g = F.bx * 512 + F.tid; g < 16 * 8192; g += F.G * 512) { const int bh = g >> 13, kv = g & 8191, k = kv & 63;
        float* p = GU + (size_t)bh * 64 * 8192 + kv; const float* d = GD + (size_t)bh * 64 * 64 + k; float S = 0.f;
#pragma unroll 8
        for (int n = 0; n < 64; ++n) { const float u = p[(size_t)n * 8192]; const float dc = d[n * 64]; p[(size_t)n * 8192] = S; S = S * dc + u; } }
}
struct GlaCIn { f32x4 s[4]; f32x4 q; f32x4 oi[2]; u32x2 rw[2]; };
__device__ __forceinline__ void gla_c_load(const Frame& F, int unit, GlaCIn& in) {
    const bf16_t* U = (const bf16_t*)(F.ws + WS_U); const float* GU = (const float*)(F.ws + WS_GU); const float* GO = (const float*)(F.ws + WS_GO); const float* GQ = (const float*)(F.ws + WS_GQ);
    const int n = unit & 63, h = (unit >> 6) & 3, b = unit >> 8, bh = b * 4 + h, t0 = b * SEQ + n * 32, tid = F.tid, lane = F.lane, w = F.wave, fr = lane & 15, fg = lane >> 4;
    const float* sp = GU + ((size_t)bh * 64 + n) * 8192;
#pragma unroll
    for (int j = 0; j < 4; ++j) in.s[j] = *(const f32x4*)(sp + (tid + 512 * j) * 4);
    in.q = *(const f32x4*)(GQ + (size_t)(t0 + (tid >> 4)) * 256 + h * 64 + (tid & 15) * 4);
#pragma unroll
    for (int it = 0; it < 2; ++it) { const int row = t0 + 16 * it + fr, col = h * 128 + 16 * w + 4 * fg;
        in.oi[it] = *(const f32x4*)(GO + (size_t)row * 512 + col); in.rw[it] = *(const u32x2*)(U + (size_t)row * DINP + UG_R + col); }
}
__device__ __forceinline__ void gla_c_phase(const Frame& F, const Args& a, int l) {
    bf16_t* MIX = (bf16_t*)(F.ws + WS_MIX);
    const int tid = F.tid, lane = F.lane, w = F.wave, fr = lane & 15, fg = lane >> 4;
    LAS float* qt = (LAS float*)F.lds; LAS float* SsT = qt + 32 * 68; LAS float* red = SsT + 128 * 68;
    const f32x4 ng = *(const f32x4*)(a.in[9] + l * 128 + 16 * w + 4 * fg);
    GlaCIn in;
    if (F.bx < 1024) gla_c_load(F, F.bx, in);
#pragma unroll 1
    for (int unit = F.bx; unit < 1024; unit += F.G) {
        const int n = unit & 63, h = (unit >> 6) & 3, b = unit >> 8, t0 = b * SEQ + n * 32;
        __syncthreads();
        *(LAS f32x4*)(qt + (tid >> 4) * 68 + (tid & 15) * 4) = in.q;
#pragma unroll
        for (int j = 0; j < 4; ++j) { const int e = (tid + 512 * j) * 4; *(LAS f32x4*)(SsT + (e >> 6) * 68 + (e & 63)) = in.s[j]; }
        f32x4 o[2] = {in.oi[0], in.oi[1]}; const u32x2 rw0 = in.rw[0], rw1 = in.rw[1];
        __syncthreads();
        if (unit + F.G < 1024) gla_c_load(F, unit + F.G, in);
#pragma unroll
        for (int ks = 0; ks < 2; ++ks) { const bf16x8 sf = frag_f32(SsT + (16 * w + fr) * 68 + 8 * fg + 32 * ks);
#pragma unroll
            for (int it = 0; it < 2; ++it) o[it] = __builtin_amdgcn_mfma_f32_16x16x32_bf16(sf, frag_f32(qt + (16 * it + fr) * 68 + 8 * fg + 32 * ks), o[it], 0, 0, 0); }
#pragma unroll
        for (int it = 0; it < 2; ++it) { float ss = (o[it][0] * o[it][0] + o[it][1] * o[it][1]) + (o[it][2] * o[it][2] + o[it][3] * o[it][3]);
            ss += __shfl_xor(ss, 16); ss += __shfl_xor(ss, 32);
            if (fg == 0) red[w * 32 + 16 * it + fr] = ss; }
        __syncthreads();
#pragma unroll
        for (int it = 0; it < 2; ++it) { float tot = 0.f;
#pragma unroll
            for (int ww = 0; ww < 8; ++ww) tot += red[ww * 32 + 16 * it + fr];
            const float rms = 1.0f / sqrtf(tot * (1.f / 128.f) + RMS_EPS);
            const u32x2 rw = it == 0 ? rw0 : rw1;
            const float y0 = o[it][0] * rms * ng[0] * siluf_(bflo(rw.x)), y1 = o[it][1] * rms * ng[1] * siluf_(bfhi(rw.x)), y2 = o[it][2] * rms * ng[2] * siluf_(bflo(rw.y)), y3 = o[it][3] * rms * ng[3] * siluf_(bfhi(rw.y));
            *(u32x2*)(MIX + (size_t)(t0 + 16 * it + fr) * DM + 512 + h * 128 + 16 * w + 4 * fg) = (u32x2){pk2(y0, y1), pk2(y2, y3)}; }
    }
}

typedef short s16x4 __attribute__((ext_vector_type(4)));
__device__ __forceinline__ s16x4 vtr(const LAS unsigned char* p) { return __builtin_bit_cast(s16x4, __builtin_amdgcn_ds_read_tr16_b64_v4i16((LAS s16x4*)p)); }
constexpr int AT_VROW = 160, AT_VBUF = 32 * AT_VROW;
__device__ __forceinline__ void attn_job(const Frame& F, int job, LAS unsigned char* vbuf, const LAS float* bt) {
    const bf16_t* U = (const bf16_t*)(F.ws + WS_U); bf16_t* AO = (bf16_t*)(F.ws + WS_AO); float* ALSE = (float*)(F.ws + WS_ALSE);
    const int lane = F.lane, qi = lane & 15, g = lane >> 4;
    const int gidx = job & 127, t2 = job >> 7, br = t2 % 3, bh = t2 / 3, h = bh & 7, b = bh >> 3;
    const int dsh = 2 * br, dil = 1 << dsh, gsh = 7 - dsh, r = gidx >> gsh, gi = gidx & ((1 << gsh) - 1);
    const int q0 = gi * 16, tb = b * SEQ;
    const bf16_t* Ub = U + (size_t)(tb + r) * DINP + h * 64;
    const size_t sstep = (size_t)dil * DINP;
    const bf16_t* qrow = Ub + (size_t)(q0 + qi) * sstep + UC_Q + 8 * g;
    const bf16x8 qf0 = *(const bf16x8*)qrow, qf1 = *(const bf16x8*)(qrow + 32);
    const int klo = (q0 >= 128 ? q0 - 128 : 0) & ~31;
    const int nch = ((q0 + 15 - klo) >> 5) + 1;
    float m_run = -1e30f, l_part = 0.f;
    f32x4 o[4];
#pragma unroll
    for (int d = 0; d < 4; ++d) o[d] = (f32x4){0.f, 0.f, 0.f, 0.f};
    bf16x8 ka0, ka1, kb0, kb1; u32x4 vr[4];
#define AT_LOAD(kc) do { const bf16_t* kp = Ub + (size_t)((kc) + qi) * sstep + UC_K + 8 * g; ka0 = *(const bf16x8*)kp; ka1 = *(const bf16x8*)(kp + 32); kp += 16 * sstep; kb0 = *(const bf16x8*)kp; kb1 = *(const bf16x8*)(kp + 32); \
        const bf16_t* vp = Ub + (size_t)((kc) + (lane >> 3)) * sstep + UC_V + (lane & 7) * 8; _Pragma("unroll") for (int it = 0; it < 4; ++it) vr[it] = *(const u32x4*)(vp + (size_t)(8 * it) * sstep); } while (0)
    AT_LOAD(klo);
#pragma unroll 1
    for (int c = 0; c < nch; ++c) {
        const int kc = klo + 32 * c;
        LAS unsigned char* vb = vbuf + (c & 1) * AT_VBUF;
#pragma unroll
        for (int it = 0; it < 4; ++it) *(LAS u32x4*)(vb + (it * 8 + (lane >> 3)) * AT_VROW + (lane & 7) * 16) = vr[it];
        const bf16x8 ca0 = ka0, ca1 = ka1, cb0 = kb0, cb1 = kb1;
        if (c + 1 < nch) AT_LOAD(kc + 32);
        f32x4 sa = (f32x4){0.f, 0.f, 0.f, 0.f}, sb = sa;
        sa = __builtin_amdgcn_mfma_f32_16x16x32_bf16(ca0, qf0, sa, 0, 0, 0); sa = __builtin_amdgcn_mfma_f32_16x16x32_bf16(ca1, qf1, sa, 0, 0, 0);
        sb = __builtin_amdgcn_mfma_f32_16x16x32_bf16(cb0, qf0, sb, 0, 0, 0); sb = __builtin_amdgcn_mfma_f32_16x16x32_bf16(cb1, qf1, sb, 0, 0, 0);
        const int st0 = (q0 + qi) - (kc + 4 * g);
        float cmax = -1e30f;
#pragma unroll
        for (int rr = 0; rr < 4; ++rr) {
            const int sA = st0 - rr, sB = st0 - rr - 16;
            const int iA = sA < 0 ? 0 : (sA > 128 ? 128 : sA), iB = sB < 0 ? 0 : (sB > 128 ? 128 : sB);
            const float vA = sa[rr] * 0.125f + bt[(br * 129 + iA) * 8 + h], vB = sb[rr] * 0.125f + bt[(br * 129 + iB) * 8 + h];
            sa[rr] = (sA >= 0 && sA <= 128) ? vA : -1e30f; sb[rr] = (sB >= 0 && sB <= 128) ? vB : -1e30f;
            cmax = fmaxf(cmax, fmaxf(sa[rr], sb[rr])); }
        cmax = fmaxf(cmax, __shfl_xor(cmax, 16)); cmax = fmaxf(cmax, __shfl_xor(cmax, 32));
        const float m_new = fmaxf(m_run, cmax), alpha = __expf(m_run - m_new);
        float psum = 0.f;
#pragma unroll
        for (int rr = 0; rr < 4; ++rr) { sa[rr] = __expf(sa[rr] - m_new); sb[rr] = __expf(sb[rr] - m_new); psum += sa[rr] + sb[rr]; }
        l_part = l_part * alpha + psum; m_run = m_new;
#pragma unroll
        for (int d = 0; d < 4; ++d) o[d] = o[d] * alpha;
        const u32x4 pw = (u32x4){pk2(sa[0], sa[1]), pk2(sa[2], sa[3]), pk2(sb[0], sb[1]), pk2(sb[2], sb[3])};
        const bf16x8 pf = __builtin_bit_cast(bf16x8, pw);
        const LAS unsigned char* tp = vb + (4 * g + (qi >> 2)) * AT_VROW + (qi & 3) * 8;
#pragma unroll
        for (int d = 0; d < 4; ++d) { const s16x4 va = vtr(tp + d * 32), vb2 = vtr(tp + 16 * AT_VROW + d * 32);
            const bf16x8 vf = (bf16x8){va[0], va[1], va[2], va[3], vb2[0], vb2[1], vb2[2], vb2[3]};
            o[d] = __builtin_amdgcn_mfma_f32_16x16x32_bf16(vf, pf, o[d], 0, 0, 0); }
    }
#undef AT_LOAD
    float l = l_part; l += __shfl_xor(l, 16); l += __shfl_xor(l, 32);
    const float inv = 1.0f / l;
    const int token = tb + (q0 + qi) * dil + r;
    bf16_t* op = AO + ((size_t)br * MT + token) * 512 + h * 64 + 4 * g;
#pragma unroll
    for (int d = 0; d < 4; ++d) *(u32x2*)(op + d * 16) = (u32x2){pk2(o[d][0] * inv, o[d][1] * inv), pk2(o[d][2] * inv, o[d][3] * inv)};
    if (g == 0) ALSE[((size_t)br * MT + token) * 8 + h] = m_run + logf(l);
}
__device__ __forceinline__ void attn_combine(const Frame& F) {
    const bf16_t* AO = (const bf16_t*)(F.ws + WS_AO); const float* ALSE = (const float*)(F.ws + WS_ALSE); bf16_t* MIX = (bf16_t*)(F.ws + WS_MIX);
    for (int i = F.bx * 512 + F.tid; i < MT * 64; i += F.G * 512) { const int token = i >> 6, c8 = (i & 63) * 8, h = c8 >> 6;
        const float l0 = ALSE[(size_t)token * 8 + h], l1 = ALSE[((size_t)MT + token) * 8 + h], l2 = ALSE[((size_t)2 * MT + token) * 8 + h];
        const float m = fmaxf(l0, fmaxf(l1, l2)); float w0 = __expf(l0 - m), w1 = __expf(l1 - m), w2 = __expf(l2 - m); const float inv = 1.0f / (w0 + w1 + w2); w0 *= inv; w1 *= inv; w2 *= inv;
        const u32x4 a = *(const u32x4*)(AO + (size_t)token * 512 + c8), bq = *(const u32x4*)(AO + ((size_t)MT + token) * 512 + c8), cq = *(const u32x4*)(AO + ((size_t)2 * MT + token) * 512 + c8);
        const unsigned aw[4] = {a.x, a.y, a.z, a.w}, bw[4] = {bq.x, bq.y, bq.z, bq.w}, cw[4] = {cq.x, cq.y, cq.z, cq.w}; unsigned ow[4];
#pragma unroll
        for (int j = 0; j < 4; ++j) ow[j] = pk2(w0 * bflo(aw[j]) + w1 * bflo(bw[j]) + w2 * bflo(cw[j]), w0 * bfhi(aw[j]) + w1 * bfhi(bw[j]) + w2 * bfhi(cw[j]));
        *(u32x4*)(MIX + (size_t)token * DM + 1024 + c8) = (u32x4){ow[0], ow[1], ow[2], ow[3]}; }
}

__device__ __forceinline__ void ln1_unit(const Frame& F, const Args& a, int l, int unit, bool commit) {
    const bf16_t* PRE = (const bf16_t*)(F.ws + WS_PRE); bf16_t* XB = (bf16_t*)(F.ws + WS_XB); const float* wrt = (const float*)(F.ws + WS_WRT) + (size_t)l * 36 * DM;
    int* ltok = (int*)(F.ws + WS_LTOK); float* lgate = (float*)(F.ws + WS_LGATE); int* tinfo = (int*)(F.ws + WS_TINFO); unsigned* cnt = F.ctl + CW_CNT + l * 32 * 64;
    LAS float* Wl = (LAS float*)F.lds;
    const int lane = F.lane, tid = F.tid, row0 = unit * 16 + F.wave * 2;
    const float* g = a.in[14] + (size_t)l * DM; const float* bb = a.in[15] + (size_t)l * DM;
    f32x4 wreg[5];
#pragma unroll
    for (int i = 0; i < 5; ++i) { const int idx = tid + 512 * i; if (idx < 36 * 64) wreg[i] = *(const f32x4*)(wrt + (size_t)(idx >> 6) * DM + (idx & 63) * 4); }
    float mean_[2], rstd_[2];
#pragma unroll
    for (int r = 0; r < 2; ++r) { const int row = row0 + r; const bf16_t* pr = PRE + (size_t)row * DM; f32x4 v[8]; float s = 0.f;
#pragma unroll
      for (int j = 0; j < 8; ++j) { const u32x2 w = *(const u32x2*)(pr + 256 * j + 4 * lane); v[j] = (f32x4){bflo(w.x), bfhi(w.x), bflo(w.y), bfhi(w.y)}; s += (v[j][0] + v[j][1]) + (v[j][2] + v[j][3]); }
      const float mean = wave_sum(s) * (1.f / DM); float q = 0.f;
#pragma unroll
      for (int j = 0; j < 8; ++j) { v[j] = v[j] - mean; q += (v[j][0] * v[j][0] + v[j][1] * v[j][1]) + (v[j][2] * v[j][2] + v[j][3] * v[j][3]); }
      const float rstd = 1.0f / sqrtf(wave_sum(q) * (1.f / DM) + LN_EPS);
      mean_[r] = mean; rstd_[r] = rstd;
#pragma unroll
      for (int j = 0; j < 8; ++j) { const f32x4 gv = *(const f32x4*)(g + 256 * j + 4 * lane), bv = *(const f32x4*)(bb + 256 * j + 4 * lane); const f32x4 y = v[j] * rstd * gv + bv;
          *(u32x2*)(XB + (size_t)row * DM + 256 * j + 4 * lane) = (u32x2){pk2(y[0], y[1]), pk2(y[2], y[3])}; } }
    float acc[2][36];
#pragma unroll
    for (int r = 0; r < 2; ++r)
#pragma unroll
        for (int c = 0; c < 36; ++c) acc[r][c] = 0.f;
    __syncthreads();
#pragma unroll 1
    for (int j = 0; j < 8; ++j) {
        LAS float* Wb = Wl + (j & 1) * (36 * 256);
#pragma unroll
        for (int i = 0; i < 5; ++i) { const int idx = tid + 512 * i; if (idx < 36 * 64) *(LAS f32x4*)(Wb + (idx >> 6) * 256 + (idx & 63) * 4) = wreg[i]; }
        __syncthreads();
        if (j < 7) {
#pragma unroll
            for (int i = 0; i < 5; ++i) { const int idx = tid + 512 * i; if (idx < 36 * 64) wreg[i] = *(const f32x4*)(wrt + (size_t)(idx >> 6) * DM + 256 * (j + 1) + (idx & 63) * 4); } }
        f32x4 xv[2];
        { const f32x4 gv = *(const f32x4*)(g + 256 * j + 4 * lane), bv = *(const f32x4*)(bb + 256 * j + 4 * lane);
#pragma unroll
          for (int r = 0; r < 2; ++r) { const u32x2 w = *(const u32x2*)(PRE + (size_t)(row0 + r) * DM + 256 * j + 4 * lane);
              xv[r] = ((f32x4){bflo(w.x), bfhi(w.x), bflo(w.y), bfhi(w.y)} - mean_[r]) * rstd_[r] * gv + bv; } }
#pragma unroll
        for (int c = 0; c < 36; ++c) { const f32x4 w = *(const LAS f32x4*)(Wb + c * 256 + 4 * lane);
#pragma unroll
            for (int r = 0; r < 2; ++r) acc[r][c] += (xv[r][0] * w[0] + xv[r][1] * w[1]) + (xv[r][2] * w[2] + xv[r][3] * w[3]); }
    }
    const float* gb = a.in[17] + l * 4; const float* eb = a.in[19] + l * 32;
#pragma unroll
    for (int r = 0; r < 2; ++r) {
#pragma unroll
        for (int c = 0; c < 36; ++c) acc[r][c] = wave_sum(acc[r][c]);
        float gl[4];
#pragma unroll
        for (int c = 0; c < 4; ++c) gl[c] = acc[r][c] + gb[c];
        int gi = 0; float gm = gl[0];
#pragma unroll
        for (int c = 1; c < 4; ++c) if (gl[c] > gm) { gm = gl[c]; gi = c; }
        float gs = 0.f;
#pragma unroll
        for (int c = 0; c < 4; ++c) gs += expf(gl[c] - gm);
        const float gtop = 1.0f / gs;
        float ev[8];
#pragma unroll
        for (int c = 0; c < 8; ++c) { const float v0 = acc[r][4 + c] + eb[c], v1 = acc[r][12 + c] + eb[8 + c], v2 = acc[r][20 + c] + eb[16 + c], v3 = acc[r][28 + c] + eb[24 + c]; ev[c] = gi == 0 ? v0 : (gi == 1 ? v1 : (gi == 2 ? v2 : v3)); }
        int i1 = 0; float m1 = ev[0];
#pragma unroll
        for (int c = 1; c < 8; ++c) if (ev[c] > m1) { m1 = ev[c]; i1 = c; }
        int i2 = -1; float m2 = -INFINITY;
#pragma unroll
        for (int c = 0; c < 8; ++c) if (c != i1 && ev[c] > m2) { m2 = ev[c]; i2 = c; }
        const float p2 = expf(m2 - m1), den = 1.0f + p2;
        const float w1 = gtop / den, w2 = gtop * p2 / den;
        if (lane == 0 && commit) { const int tok = row0 + r; const int e1 = gi * 8 + i1, e2 = gi * 8 + i2;
            const unsigned s1 = __hip_atomic_fetch_add(cnt + e1 * 64, 1u, __ATOMIC_RELAXED, __HIP_MEMORY_SCOPE_AGENT), s2 = __hip_atomic_fetch_add(cnt + e2 * 64, 1u, __ATOMIC_RELAXED, __HIP_MEMORY_SCOPE_AGENT);
            ltok[e1 * MT + s1] = tok; lgate[e1 * MT + s1] = w1; ltok[e2 * MT + s2] = tok; lgate[e2 * MT + s2] = w2;
            tinfo[tok * 2] = e1 * MT + (int)s1; tinfo[tok * 2 + 1] = e2 * MT + (int)s2; }
    }
}
__device__ __forceinline__ void moe_tables(const Frame& F, int l) {
    LAS int* toff = (LAS int*)(F.lds + LDS_TOFF); const unsigned* cnt = F.ctl + CW_CNT + l * 32 * 64;
    __syncthreads();
    if (F.tid == 0) { int run = 0; for (int e = 0; e < 32; ++e) { toff[e] = run; run += ((int)cnt[e * 64] + 255) >> 8; } toff[32] = run; }
    __syncthreads();
}
__device__ __forceinline__ void ln2_rows(const Frame& F, const Args& a, int l, float* OUT, bool write_xb) {
    const bf16_t* PRE = (const bf16_t*)(F.ws + WS_PRE); const bf16_t* Y = (const bf16_t*)(F.ws + WS_Y); bf16_t* XB = (bf16_t*)(F.ws + WS_XB); const int* tinfo = (const int*)(F.ws + WS_TINFO);
    const LAS int* toff = (const LAS int*)(F.lds + LDS_TOFF);
    const float* g = a.in[26] + (size_t)l * DM; const float* bb = a.in[27] + (size_t)l * DM; const int lane = F.lane;
    for (int row0 = (F.bx * 8 + F.wave) * 2; row0 < MT; row0 += F.G * 16) {
        f32x4 v[2][8]; float s[2] = {0.f, 0.f};
#pragma unroll
        for (int r = 0; r < 2; ++r) { const int row = row0 + r; const int i0 = tinfo[row * 2], i1 = tinfo[row * 2 + 1];
            const size_t s0 = (size_t)toff[i0 >> 13] * 256 + (i0 & 8191), s1 = (size_t)toff[i1 >> 13] * 256 + (i1 & 8191);
            const bf16_t* pr = PRE + (size_t)row * DM; const bf16_t* y0 = Y + s0 * DM; const bf16_t* y1 = Y + s1 * DM;
#pragma unroll
            for (int j = 0; j < 8; ++j) { const u32x2 pw = *(const u32x2*)(pr + 256 * j + 4 * lane), a0 = *(const u32x2*)(y0 + 256 * j + 4 * lane), a1 = *(const u32x2*)(y1 + 256 * j + 4 * lane);
                v[r][j][0] = bflo(pw.x) + (bflo(a0.x) + bflo(a1.x)); v[r][j][1] = bfhi(pw.x) + (bfhi(a0.x) + bfhi(a1.x)); v[r][j][2] = bflo(pw.y) + (bflo(a0.y) + bflo(a1.y)); v[r][j][3] = bfhi(pw.y) + (bfhi(a0.y) + bfhi(a1.y));
                s[r] += (v[r][j][0] + v[r][j][1]) + (v[r][j][2] + v[r][j][3]); } }
#pragma unroll
        for (int r = 0; r < 2; ++r) { const int row = row0 + r;
            const float mean = wave_sum(s[r]) * (1.f / DM); float q = 0.f;
#pragma unroll
            for (int j = 0; j < 8; ++j) { v[r][j] = v[r][j] - mean; q += (v[r][j][0] * v[r][j][0] + v[r][j][1] * v[r][j][1]) + (v[r][j][2] * v[r][j][2] + v[r][j][3] * v[r][j][3]); }
            const float rstd = 1.0f / sqrtf(wave_sum(q) * (1.f / DM) + LN_EPS);
#pragma unroll
            for (int j = 0; j < 8; ++j) { const f32x4 gv = *(const f32x4*)(g + 256 * j + 4 * lane), bv = *(const f32x4*)(bb + 256 * j + 4 * lane); const f32x4 y = v[r][j] * rstd * gv + bv;
                if (write_xb) *(u32x2*)(XB + (size_t)row * DM + 256 * j + 4 * lane) = (u32x2){pk2(y[0], y[1]), pk2(y[2], y[3])}; else *(f32x4*)(OUT + (size_t)row * DM + 256 * j + 4 * lane) = y; } }
    }
}

constexpr int PH_PER_LAYER = 9, N_PHASES = 1 + NL * PH_PER_LAYER;
__global__ void __launch_bounds__(512, 2) mega(Args args) {
    extern __shared__ __attribute__((aligned(16))) unsigned char lds_raw[];
    Frame F; F.lds = (LAS unsigned char*)lds_raw; F.ws = args.ws; F.ctl = (unsigned*)(args.ws + WS_CTL);
    F.tid = threadIdx.x; F.lane = F.tid & 63; F.wave = __builtin_amdgcn_readfirstlane(F.tid >> 6); F.G = gridDim.x; F.bx = blockIdx.x;
    if (F.tid < 4) ((LAS unsigned*)(F.lds + LDS_BARW))[F.tid] = 0u;
    __syncthreads();
#if LAUNCH_PER_PHASE
#define GRID_BAR() do { } while (0)
#else
    XcdBarrier bar = xcd_barrier_post(F.ctl + CW_BAR, (volatile LAS unsigned*)(F.lds + LDS_BARW));
#define GRID_BAR() xcd_barrier(bar)
#endif
    const int lo = args.ph_lo, hi = args.ph_hi;
#define IN(k) (lo <= (k) && (k) < hi)
#define SEAM(k) do { if (IN(k) && IN((k) + 1)) GRID_BAR(); } while (0)
#define WSP(T, off) ((T*)(f.ws + (off)))
    if (IN(0)) { for (int rep = 0; rep < REPS(9); ++rep) { const Frame f = F.fresh(); phase_prologue(f, args); if (rep + 1 < REPS(9)) GRID_BAR(); } }
    SEAM(0);
#pragma unroll 1
    for (int l = 0; l < NL; ++l) {
        const int pb = 1 + l * PH_PER_LAYER;
        if (IN(pb + 0)) for (int rep = 0; rep < REPS(0); ++rep) { if (rep) GRID_BAR(); const Frame f = F.fresh();
            pg8::DenseSched S; S.init(WSP(bf16_t, WS_XB), WSP(const bf16_t, WS_WIN) + (size_t)l * DINP * DM, DM, DM, MT, DINP, f.G, f.bx); S.wave = f.wave;
            pg8::EpiBf16 E{WSP(bf16_t, WS_U), DINP}; pg8::gemm_phase(f.lds, DM, S, E); }
        SEAM(pb + 0);
        if (IN(pb + 1)) for (int rep = 0; rep < REPS(1); ++rep) { if (rep) GRID_BAR(); { const Frame f = F.fresh(); for (int u = f.bx; u < 256; u += f.G) conv_unit(f, args, l, u); }
            { const Frame f = F.fresh(); for (int u = f.bx; u < 1024; u += f.G) gla_a_unit(f, args, l, u); } __syncthreads(); }
        SEAM(pb + 1);
        if (IN(pb + 2)) { { const Frame f = F.fresh(); gla_scan(f); }
            const Frame f = F.fresh();
            LAS float* bt = (LAS float*)(f.lds + 8 * 2 * AT_VBUF);
            __syncthreads();
            for (int i = f.tid; i < 3 * 129 * 8; i += 512) bt[i] = WSP(const float, WS_BTAB)[i];
            __syncthreads();
            for (int rep = 0; rep < REPS(2); ++rep)
            for (int job = f.bx * 8 + f.wave; job < 32 * 3 * 128; job += f.G * 8) attn_job(f, job, f.lds + f.wave * 2 * AT_VBUF, bt);
            __syncthreads(); }
        SEAM(pb + 2);
        if (IN(pb + 3)) for (int rep = 0; rep < REPS(3); ++rep) { if (rep) GRID_BAR(); { const Frame f = F.fresh(); gla_c_phase(f, args, l); __syncthreads(); } { const Frame f = F.fresh(); attn_combine(f); } }
        SEAM(pb + 3);
        if (IN(pb + 4)) for (int rep = 0; rep < REPS(4); ++rep) { if (rep) GRID_BAR();
            { const Frame f = F.fresh(); const int GH = f.G / 2;
              if (f.bx < GH) { pg8::DenseSched S; S.init(WSP(bf16_t, WS_MIX), WSP(const bf16_t, WS_WOUT) + (size_t)l * DM * DM, DM, DM, MT, DM, GH, f.bx); S.wave = f.wave;
                  pg8::EpiRes E{WSP(bf16_t, WS_PRE), WSP(const bf16_t, WS_XB), DM, DN_ALPHA}; pg8::gemm_phase(f.lds, DM, S, E); }
              else if (rep + 1 == REPS(4)) { __syncthreads(); conv_items(f, args, l, IO_PG, I_L, (f.bx - GH) * 8 + f.wave, (f.G - GH) * 8); __syncthreads(); } }
            { const Frame f = F.fresh(); pg8::DenseSched S; S.init(WSP(const bf16_t, WS_PB) + (size_t)l * MT * PLE, WSP(const bf16_t, WS_WPP) + (size_t)l * DM * PLE, PLE, PLE, MT, DM, f.G, f.bx); S.wave = f.wave;
              pg8::EpiBf16 E{WSP(bf16_t, WS_PP), DM}; pg8::gemm_phase(f.lds, PLE, S, E); } }
        SEAM(pb + 4);
        if (IN(pb + 5)) for (int rep = 0; rep < REPS(5); ++rep) { if (rep) GRID_BAR(); const Frame f = F.fresh(); for (int u = f.bx; u < MT / 16; u += f.G) ln1_unit(f, args, l, u, rep + 1 == REPS(5)); __syncthreads(); }
        SEAM(pb + 5);
        if (IN(pb + 6)) for (int rep = 0; rep < REPS(6); ++rep) { if (rep) GRID_BAR();
            { const Frame f = F.fresh(); pg8::DenseSched S; S.init(WSP(bf16_t, WS_XB), WSP(const bf16_t, WS_WPG) + (size_t)l * DM * DM, DM, DM, MT, DM, f.G, f.bx); S.wave = f.wave;
              pg8::EpiPle E{WSP(bf16_t, WS_PRE), WSP(const bf16_t, WS_XB), WSP(const bf16_t, WS_PP), args.in[24] + (size_t)l * DM, DM, DN_ALPHA}; pg8::gemm_phase(f.lds, DM, S, E); }
            { const Frame f = F.fresh(); moe_tables(f, l);
              pg8::MoeSched<true> S; S.A = WSP(bf16_t, WS_XB); S.Bt = WSP(const bf16_t, WS_WGU) + (size_t)l * NEXP * 512 * DM; S.lda = DM; S.ldb = DM; S.nN = 2; S.G = f.G; S.c = f.bx; S.wave = f.wave; S.bexp = (size_t)512 * DM * 2;
              S.toff = (const LAS int*)(f.lds + LDS_TOFF); S.cnt = f.ctl + CW_CNT + l * 32 * 64; S.ltok = WSP(const int, WS_LTOK);
              pg8::EpiMoe1 E{WSP(bf16_t, WS_H), WSP(const float, WS_LGATE), f.ctl + CW_CNT + l * 32 * 64}; pg8::gemm_phase(f.lds, DM, S, E); } }
        SEAM(pb + 6);
        if (IN(pb + 7)) for (int rep = 0; rep < REPS(7); ++rep) { if (rep) GRID_BAR(); const Frame f = F.fresh(); moe_tables(f, l);
            pg8::MoeSched<false> S; S.A = WSP(bf16_t, WS_H); S.Bt = WSP(const bf16_t, WS_WD) + (size_t)l * NEXP * DM * DEXP; S.lda = DEXP; S.ldb = DEXP; S.nN = 8; S.G = f.G; S.c = f.bx; S.wave = f.wave; S.bexp = (size_t)DM * DEXP * 2;
            S.toff = (const LAS int*)(f.lds + LDS_TOFF); S.cnt = f.ctl + CW_CNT + l * 32 * 64; S.ltok = WSP(const int, WS_LTOK);
            pg8::EpiBf16 E{WSP(bf16_t, WS_Y), DM}; pg8::gemm_phase(f.lds, DEXP, S, E); }
        SEAM(pb + 7);
        if (IN(pb + 8)) { for (int rep = 0; rep < REPS(8); ++rep) { if (rep) GRID_BAR(); const Frame f = F.fresh(); moe_tables(f, l); ln2_rows(f, args, l, args.out, l + 1 < NL); }
            if (l + 1 < NL) { const Frame f = F.fresh(); conv_all(f, args, l + 1, 0, IO_PG); } }
        SEAM(pb + 8);
    }
#undef WSP
#undef IN
#undef SEAM
}

extern "C" void kernel_launch(void* const* d_in, const int* in_sizes, int n_in, void* d_out, int out_size, void* d_ws, size_t ws_size, hipStream_t stream) {
    static int grid = 0;
    if (grid == 0) {
        if (n_in != 28 || out_size != MT * DM || ws_size < WS_END) { fprintf(stderr, "kernel_launch: unexpected shapes (n_in %d, out %d, ws %zu); nothing launched\n", n_in, out_size, ws_size); grid = -1; return; }
        int dev = 0, cus = 0, per_cu = 0;
        if (hipGetDevice(&dev) != hipSuccess || hipDeviceGetAttribute(&cus, hipDeviceAttributeMultiprocessorCount, dev) != hipSuccess) { grid = -1; return; }
        if (hipFuncSetAttribute((const void*)mega, hipFuncAttributeMaxDynamicSharedMemorySize, LDS_BYTES) != hipSuccess) { fprintf(stderr, "kernel_launch: hipFuncSetAttribute failed\n"); grid = -1; return; }
        if (hipOccupancyMaxActiveBlocksPerMultiprocessor(&per_cu, (const void*)mega, 512, LDS_BYTES) != hipSuccess || per_cu < 1) { fprintf(stderr, "kernel_launch: occupancy query says %d\n", per_cu); }
        (void)hipGetLastError();
        grid = cus;
    }
    if (grid < 0) return;
    (void)hipMemsetAsync((char*)d_ws + WS_CTL, 0, CTL_ZERO_BYTES, stream);
    Args a{};
    for (int i = 0; i < 28; ++i) a.in[i] = (const float*)d_in[i];
    a.out = (float*)d_out; a.ws = (unsigned char*)d_ws;
#if LAUNCH_PER_PHASE
    for (int p = 0; p < N_PHASES; ++p) { a.ph_lo = p; a.ph_hi = p + 1; hipLaunchKernelGGL(mega, dim3(grid), dim3(512), LDS_BYTES, stream, a); }
#else
    a.ph_lo = 0; a.ph_hi = N_PHASES; hipLaunchKernelGGL(mega, dim3(grid), dim3(512), LDS_BYTES, stream, a);
#endif
}
```

```cpp
#include <hip/hip_runtime.h>
#include <cstdio>
#include <cstdint>

#ifndef REP_MASK
#define REP_MASK 0
#endif
#define REPS(k) (1 + ((REP_MASK >> (k)) & 1))
#ifndef LAUNCH_PER_PHASE
#define LAUNCH_PER_PHASE 0
#endif

#define LAS __attribute__((address_space(3)))
#define GAS __attribute__((address_space(1)))
typedef unsigned short bf16_t;
typedef short bf16x8 __attribute__((ext_vector_type(8)));
typedef float f32x4 __attribute__((ext_vector_type(4)));
typedef float f32x2 __attribute__((ext_vector_type(2)));
typedef unsigned u32x4 __attribute__((ext_vector_type(4)));
typedef unsigned u32x2 __attribute__((ext_vector_type(2)));

constexpr int NL = 2, NBATCH = 4, SEQ = 2048, DM = 2048, MT = NBATCH * SEQ;
constexpr int DIN = 5648, DINP = 5888, PLE = 256, NEXP = 32, DEXP = 256;
constexpr int UA_VAL = 0, UA_GATE = 512, UG_Q = 1024, UG_K = 1280, UG_V = 1536, UG_R = 2048, UC_Q = 2560, UC_K = 3072, UC_V = 3584, US_B = 4096, US_C = 4608, US_H = 5120, UG_LOW = 5632;
constexpr float DN_ALPHA = 1.41421356237309515f, LN_EPS = 1e-5f, RMS_EPS = 1e-6f;
constexpr int NSTREAM = 2, SMT = MT / NSTREAM;
constexpr int MAXSLOT = 16384;

constexpr size_t MiB = 1u << 20;
constexpr size_t WS_CTL = 0, CTL_ZERO_BYTES = 1 * MiB;
constexpr size_t WS_BTAB = 1 * MiB;
constexpr size_t WS_WRT = 1 * MiB + 64 * 1024;
constexpr size_t WS_LTOK = 2 * MiB;
constexpr size_t WS_LGATE = 3 * MiB;
constexpr size_t WS_TINFO = 4 * MiB;
constexpr size_t WS_WIN = 8 * MiB;
constexpr size_t WS_WOUT = 54 * MiB;
constexpr size_t WS_WGU = 70 * MiB;
constexpr size_t WS_WD = 198 * MiB;
constexpr size_t WS_WPG = 262 * MiB;
constexpr size_t WS_WPP = 278 * MiB;
constexpr size_t WS_XB = 280 * MiB;
constexpr size_t WS_PB = 312 * MiB;
constexpr size_t WS_ARENA = 320 * MiB, ARENA = 64 * MiB;
constexpr size_t ARENA_MIX = 46 * MiB;
constexpr size_t WS_PRE = 448 * MiB;
constexpr size_t WS_GU = 448 * MiB;
constexpr size_t WS_GO = 480 * MiB;
constexpr size_t WS_GQ = 496 * MiB;
constexpr size_t WS_GD = 504 * MiB;
constexpr size_t WS_PP = 512 * MiB;
constexpr size_t WS_AO = 560 * MiB;
constexpr size_t WS_ALSE = 584 * MiB;
constexpr size_t WS_H = 544 * MiB, HSTREAM = 8 * MiB;
constexpr size_t WS_END = 585 * MiB;
static_assert((size_t)SMT * DINP * 2 <= ARENA_MIX && ARENA_MIX + (size_t)SMT * DM * 2 <= ARENA && (size_t)MAXSLOT * DM * 2 <= ARENA && WS_ARENA + NSTREAM * ARENA <= 448 * MiB, "ws map");
constexpr int CW_BAR = 4096;
constexpr int CW_FLAG = 14592;
constexpr int CW_CNT = 16384;

constexpr int LDS_STAGE = 135168;
constexpr int LDS_TOFF = LDS_STAGE;
constexpr int LDS_BARW = LDS_STAGE + 512;
constexpr int LDS_BYTES = LDS_STAGE + 1024;

__device__ __forceinline__ float bf2f(unsigned b) { return __uint_as_float(b << 16); }
__device__ __forceinline__ unsigned f2bf(float f) { unsigned u = __float_as_uint(f); return (u + 0x7fffu + ((u >> 16) & 1u)) >> 16; }
__device__ __forceinline__ unsigned pk2(float lo, float hi) { unsigned r; asm("v_cvt_pk_bf16_f32 %0, %1, %2" : "=v"(r) : "v"(lo), "v"(hi)); return r; }
__device__ __forceinline__ float bflo(unsigned w) { return __uint_as_float(w << 16); }
__device__ __forceinline__ float bfhi(unsigned w) { return __uint_as_float(w & 0xffff0000u); }
__device__ __forceinline__ float wave_sum(float v) {
#pragma unroll
    for (int o = 1; o < 64; o <<= 1) v += __shfl_xor(v, o);
    return v;
}
__device__ __forceinline__ float wave_max(float v) {
#pragma unroll
    for (int o = 1; o < 64; o <<= 1) v = fmaxf(v, __shfl_xor(v, o));
    return v;
}
__device__ __forceinline__ float sigmoidf_(float x) { return 1.0f / (1.0f + __expf(-x)); }
__device__ __forceinline__ float siluf_(float x) { return x / (1.0f + __expf(-x)); }
#define LDS_WAIT() asm volatile("s_waitcnt lgkmcnt(0)" ::: "memory")
__device__ __forceinline__ f32x4 zero4() { float z = 0.f; asm volatile("" : "+v"(z)); return (f32x4){z, z, z, z}; }

namespace pg8 {
constexpr int BM = 256, BK = 64, HALF = 128, HTB = HALF * BK * 2, STAGE_BYTES = 8 * HTB, NXCD = 8, WGM = 8;
__host__ __device__ __forceinline__ int lds_byte(int r, int c) { const int st = (r >> 4) * 2 + (c >> 5), rr = r & 15, cc = c & 31, ob = rr * 64 + cc * 2; return st * 1024 + (ob ^ (((ob >> 9) & 1) << 5)); }
__host__ __device__ __forceinline__ void stage_rc(int b, int& R, int& C) { const int st = b / 1024, sb = b % 1024, swz = sb ^ (((sb >> 9) & 1) << 5); R = (st >> 1) * 16 + swz / 64; C = (st & 1) * 32 + (swz % 64) / 2; }
__host__ __device__ __forceinline__ int perm32(int rho) { const int n = rho >> 4, i = rho & 15; return 8 * (i >> 2) + 4 * n + (i & 3); }

struct Unit { int pm, pn, e, r; };

struct DenseSched {
    static constexpr bool GATHER = false;
    const bf16_t* A; const bf16_t* Bt; int lda, ldb, nM, nN, nwg, G, c, wave;
    __device__ void init(const bf16_t* A_, const bf16_t* Bt_, int lda_, int ldb_, int M, int N, int G_, int c_) { A = A_; Bt = Bt_; lda = lda_; ldb = ldb_; nM = M / BM; nN = N / BM; nwg = nM * nN; G = G_; c = c_; }
    __device__ __forceinline__ bool next(int i, Unit& u) const {
        const long L = (long)i * G + c; if (L >= nwg) return false;
        int wgid = (int)L; { const int q = nwg / NXCD, r = nwg % NXCD, xcd = wgid % NXCD, off = wgid / NXCD; wgid = (xcd < r ? xcd * (q + 1) : r * (q + 1) + (xcd - r) * q) + off; }
        const int nig = WGM * nN, gid = wgid / nig, fm = gid * WGM, gsz = (nM - fm) < WGM ? (nM - fm) : WGM;
        u.pm = fm + ((wgid % nig) % gsz); u.pn = (wgid % nig) / gsz; u.e = 0; u.r = 0; return true;
    }
    __device__ __forceinline__ const char* a_base(const Unit& u) const { return (const char*)A + (size_t)u.pm * BM * lda * 2; }
    __device__ __forceinline__ const char* b_base(const Unit& u) const { return (const char*)Bt + (size_t)u.pn * BM * ldb * 2; }
    __device__ __forceinline__ void a_offs(const Unit&, int, unsigned (&vo)[2][2]) const { }
};
template <bool GATHER_> struct MoeSched {
    static constexpr bool GATHER = GATHER_;
    const bf16_t* A; const bf16_t* Bt; int lda, ldb, nN, G, c, wave; size_t bexp;
    const LAS int* toff; const unsigned* cnt; const int* ltok; int round0 = 0;
    __device__ __forceinline__ bool next(int i, Unit& u) const {
        const int L = (i + round0) * G + c; const int total = __builtin_amdgcn_readfirstlane(toff[32]) * nN; if (L >= total) return false;
        const int j = L / nN; u.pn = L - j * nN; int e = 0;
#pragma unroll 1
        for (int k = 1; k < 32; ++k) e = (__builtin_amdgcn_readfirstlane(toff[k]) <= j) ? k : e;
        u.e = e; u.r = j - __builtin_amdgcn_readfirstlane(toff[e]); u.pm = j; return true;
    }
    __device__ __forceinline__ const char* a_base(const Unit& u) const { return GATHER ? (const char*)A : (const char*)A + (size_t)u.pm * BM * lda * 2; }
    __device__ __forceinline__ const char* b_base(const Unit& u) const { return (const char*)Bt + (size_t)u.e * bexp + (size_t)u.pn * BM * ldb * 2; }
    __device__ __forceinline__ void a_offs(const Unit& u, int tid, unsigned (&vo)[2][2]) const {
        if constexpr (GATHER) {
        int R[2], C[2]; stage_rc(tid * 16, R[0], C[0]); stage_rc(tid * 16 + 8192, R[1], C[1]);
        const int n = __builtin_amdgcn_readfirstlane((int)cnt[u.e * 64]);
#pragma unroll
        for (int h = 0; h < 2; ++h)
#pragma unroll
            for (int i = 0; i < 2; ++i) {
                const int sr = u.r * BM + h * HALF + R[i]; const int row = (sr < n) ? ltok[u.e * SMT + sr] : 0;
                vo[h][i] = (unsigned)(row * lda + C[i]) * 2u;
            }
        }
    }
};

__device__ __forceinline__ unsigned cvt_pk_bf16(float lo, float hi) { unsigned r; asm volatile("v_cvt_pk_bf16_f32 %0, %1, %2" : "=v"(r) : "v"(lo), "v"(hi)); return r; }

struct EpiBf16 {
    static constexpr bool PERM = true;
    bf16_t* O; int ldc;
    __device__ __forceinline__ void operator()(const f32x4 (&acc)[2][2][4][2], const Unit& u, int wr, int wc, int fr, int fq) const {
        const int row0 = u.pm * BM + wr * 64 + fr, col0 = u.pn * BM + wc * 32 + 8 * fq;
#pragma unroll
        for (int ai = 0; ai < 2; ++ai)
#pragma unroll
            for (int m = 0; m < 4; ++m) { bf16_t* rowp = O + (size_t)(row0 + ai * HALF + m * 16) * ldc + col0;
#pragma unroll
                for (int bj = 0; bj < 2; ++bj) { const f32x4 v0 = acc[ai][bj][m][0], v1 = acc[ai][bj][m][1];
                    u32x4 w; w.x = cvt_pk_bf16(v0[0], v0[1]); w.y = cvt_pk_bf16(v0[2], v0[3]); w.z = cvt_pk_bf16(v1[0], v1[1]); w.w = cvt_pk_bf16(v1[2], v1[3]);
                    *(u32x4*)(rowp + bj * HALF) = w; } }
    }
};
struct EpiRes {
    static constexpr bool PERM = true;
    bf16_t* C; const bf16_t* res; int ldc; float alpha;
    __device__ __forceinline__ void operator()(const f32x4 (&acc)[2][2][4][2], const Unit& u, int wr, int wc, int fr, int fq) const {
        const int row0 = u.pm * BM + wr * 64 + fr, col0 = u.pn * BM + wc * 32 + 8 * fq;
#pragma unroll
        for (int ai = 0; ai < 2; ++ai)
#pragma unroll
            for (int m = 0; m < 4; ++m) { const size_t off = (size_t)(row0 + ai * HALF + m * 16) * ldc + col0;
#pragma unroll
                for (int bj = 0; bj < 2; ++bj) { const u32x4 rv = *(const u32x4*)(res + off + bj * HALF); const f32x4 v0 = acc[ai][bj][m][0], v1 = acc[ai][bj][m][1];
                    u32x4 w; w.x = cvt_pk_bf16(bflo(rv.x) * alpha + v0[0], bfhi(rv.x) * alpha + v0[1]); w.y = cvt_pk_bf16(bflo(rv.y) * alpha + v0[2], bfhi(rv.y) * alpha + v0[3]);
                    w.z = cvt_pk_bf16(bflo(rv.z) * alpha + v1[0], bfhi(rv.z) * alpha + v1[1]); w.w = cvt_pk_bf16(bflo(rv.w) * alpha + v1[2], bfhi(rv.w) * alpha + v1[3]);
                    *(u32x4*)(C + off + bj * HALF) = w; }
                asm volatile("" ::: "memory"); }
    }
};
struct EpiPle {
    static constexpr bool PERM = true;
    bf16_t* C; const bf16_t* x1; const bf16_t* pp; const float* bias; int ldc; float alpha;
    __device__ __forceinline__ void operator()(const f32x4 (&acc)[2][2][4][2], const Unit& u, int wr, int wc, int fr, int fq) const {
        const int row0 = u.pm * BM + wr * 64 + fr, col0 = u.pn * BM + wc * 32 + 8 * fq;
        f32x4 bv[2][2];
#pragma unroll
        for (int bj = 0; bj < 2; ++bj)
#pragma unroll
            for (int n = 0; n < 2; ++n) bv[bj][n] = *(const f32x4*)(bias + col0 + bj * HALF + 4 * n);
#pragma unroll
        for (int ai = 0; ai < 2; ++ai)
#pragma unroll
            for (int m = 0; m < 4; ++m) { const size_t off = (size_t)(row0 + ai * HALF + m * 16) * ldc + col0;
#pragma unroll
                for (int bj = 0; bj < 2; ++bj) { const size_t o = off + bj * HALF; const u32x4 xv = *(const u32x4*)(x1 + o), pw = *(const u32x4*)(pp + o);
                    const f32x4 a0 = acc[ai][bj][m][0] + bv[bj][0], a1 = acc[ai][bj][m][1] + bv[bj][1];
                    u32x4 w;
                    w.x = cvt_pk_bf16(bflo(xv.x) * alpha + sigmoidf_(a0[0]) * bflo(pw.x), bfhi(xv.x) * alpha + sigmoidf_(a0[1]) * bfhi(pw.x));
                    w.y = cvt_pk_bf16(bflo(xv.y) * alpha + sigmoidf_(a0[2]) * bflo(pw.y), bfhi(xv.y) * alpha + sigmoidf_(a0[3]) * bfhi(pw.y));
                    w.z = cvt_pk_bf16(bflo(xv.z) * alpha + sigmoidf_(a1[0]) * bflo(pw.z), bfhi(xv.z) * alpha + sigmoidf_(a1[1]) * bfhi(pw.z));
                    w.w = cvt_pk_bf16(bflo(xv.w) * alpha + sigmoidf_(a1[2]) * bflo(pw.w), bfhi(xv.w) * alpha + sigmoidf_(a1[3]) * bfhi(pw.w));
                    *(u32x4*)(C + o) = w; }
                asm volatile("" ::: "memory"); }
    }
};
struct EpiMoe1 {
    static constexpr bool PERM = true;
    bf16_t* H; const float* lgate; const unsigned* cnt;
    __device__ __forceinline__ void operator()(const f32x4 (&acc)[2][2][4][2], const Unit& u, int wr, int wc, int fr, int fq) const {
        const int n_e = __builtin_amdgcn_readfirstlane((int)cnt[u.e * 64]);
        const int col0 = u.pn * HALF + wc * 32 + 8 * fq;
#pragma unroll
        for (int ai = 0; ai < 2; ++ai)
#pragma unroll
            for (int m = 0; m < 4; ++m) { const int rt = ai * HALF + wr * 64 + m * 16 + fr; const int sr = u.r * BM + rt;
                const float gw = (sr < n_e) ? lgate[u.e * SMT + sr] : 0.f;
                const f32x4 g0 = acc[ai][0][m][0], g1 = acc[ai][0][m][1], u0 = acc[ai][1][m][0], u1 = acc[ai][1][m][1];
                float o[8];
#pragma unroll
                for (int j = 0; j < 4; ++j) { o[j] = siluf_(g0[j]) * u0[j] * gw; o[4 + j] = siluf_(g1[j]) * u1[j] * gw; }
                u32x4 w; w.x = cvt_pk_bf16(o[0], o[1]); w.y = cvt_pk_bf16(o[2], o[3]); w.z = cvt_pk_bf16(o[4], o[5]); w.w = cvt_pk_bf16(o[6], o[7]);
                *(u32x4*)(H + (size_t)(u.pm * BM + rt) * DEXP + col0) = w; }
    }
};

template <class Epi, class Sched, bool SINGLE = false>
__device__ __forceinline__ void gemm_phase(LAS unsigned char* lds, const int K, const Sched& S, const Epi& E) {
    constexpr bool GA = Sched::GATHER;
    int lane_ = (int)__builtin_amdgcn_mbcnt_hi(~0u, __builtin_amdgcn_mbcnt_lo(~0u, 0u)); asm volatile("" : "+v"(lane_));
    const int wid = S.wave, lane = lane_, tid = wid * 64 + lane_, wr = wid >> 2, wc = wid & 3, fr = lane & 15, fq = lane >> 4;
    const int nt = K / BK, ldb = S.ldb, lda = S.lda;
    unsigned voffB[2], voffA[2];
#pragma unroll
    for (int i = 0; i < 2; ++i) { int R, C; stage_rc(tid * 16 + i * 8192, R, C); const int Rb = Epi::PERM ? ((R & ~31) + perm32(R & 31)) : R; voffB[i] = (unsigned)(Rb * ldb + C) * 2u; voffA[i] = (unsigned)(R * lda + C) * 2u; }
    const size_t kstep = (size_t)(BK * 2);
    const size_t hstep = (size_t)HALF * ldb * 2;
    const size_t ahstep = GA ? 0 : (size_t)HALF * lda * 2;
    const unsigned ldsw = (unsigned)wid * 1024u;
    const int aoff = lds_byte(wr * 64 + fr, fq * 8), boff = lds_byte(wc * 32 + fr, fq * 8);
#define PG8_SA(b, h) (((b) * 2 + (h)) * HTB)
#define PG8_SB(b, h) ((4 + (b) * 2 + (h)) * HTB)
#define PG8_STAGE(bufoff, gbase, voff) do { _Pragma("unroll") for (int _i = 0; _i < 2; ++_i) \
        __builtin_amdgcn_global_load_lds((const unsigned*)((const char*)(gbase) + (voff)[_i]), (LAS unsigned*)(lds + (bufoff) + ldsw + _i * 8192), 16, 0, 0); } while (0)
#define PG8_STAGE_A(bufoff, gbase, h) do { if constexpr (GA) PG8_STAGE(bufoff, gbase, voA[h]); else PG8_STAGE(bufoff, (gbase) + (h) * ahstep, voffA); } while (0)
#define PG8_STAGE_A2(bufoff, gbase, h) do { if constexpr (GA) { unsigned _v[2] = {last ? voN[h][0] : voA[h][0], last ? voN[h][1] : voA[h][1]}; PG8_STAGE(bufoff, gbase, _v); } else PG8_STAGE(bufoff, (gbase) + (h) * ahstep, voffA); } while (0)
#define PG8_LDA(dst, b, h) do { _Pragma("unroll") for (int m = 0; m < 4; ++m) _Pragma("unroll") for (int k = 0; k < 2; ++k) dst[m][k] = *(const LAS bf16x8*)(lds + PG8_SA(b, h) + aoff + m * 2048 + k * 1024); } while (0)
#define PG8_LDB(dst, b, h) do { _Pragma("unroll") for (int n = 0; n < 2; ++n) _Pragma("unroll") for (int k = 0; k < 2; ++k) dst[n][k] = *(const LAS bf16x8*)(lds + PG8_SB(b, h) + boff + n * 2048 + k * 1024); } while (0)
#define PG8_MMA(ai, bj, At, Bt) do { __builtin_amdgcn_s_setprio(1); _Pragma("unroll") for (int m = 0; m < 4; ++m) _Pragma("unroll") for (int n = 0; n < 2; ++n) _Pragma("unroll") for (int k = 0; k < 2; ++k) \
        acc[ai][bj][m][n] = __builtin_amdgcn_mfma_f32_16x16x32_bf16(Bt[n][k], At[m][k], acc[ai][bj][m][n], 0, 0, 0); __builtin_amdgcn_s_setprio(0); } while (0)
#define PG8_WAIT_V(n) asm volatile("s_waitcnt vmcnt(" #n ")" ::: "memory")
#define PG8_WAIT_L(n) asm volatile("s_waitcnt lgkmcnt(" #n ")" ::: "memory")
#define PG8_BAR __builtin_amdgcn_s_barrier()
#define PG8_SCHED __builtin_amdgcn_sched_barrier(0)
    Unit cur, nxt; int ui = 0;
    if (!S.next(0, cur)) return;
    f32x4 acc[2][2][4][2];
#pragma unroll
    for (int a = 0; a < 2; ++a)
#pragma unroll
        for (int b = 0; b < 2; ++b)
#pragma unroll
            for (int m = 0; m < 4; ++m)
#pragma unroll
                for (int n = 0; n < 2; ++n) acc[a][b][m][n] = (f32x4){0.f, 0.f, 0.f, 0.f};
    bf16x8 At[4][2], B0[2][2], B1[2][2];
    const char* cA = S.a_base(cur); const char* cB = S.b_base(cur);
    unsigned voA[2][2], voN[2][2];
    if constexpr (GA) S.a_offs(cur, tid, voA);
    PG8_STAGE(PG8_SB(0, 0), cB, voffB); PG8_STAGE(PG8_SB(0, 1), cB + hstep, voffB); PG8_STAGE_A(PG8_SA(0, 0), cA, 0); PG8_STAGE_A(PG8_SA(0, 1), cA, 1);
    if (wr == 1) PG8_BAR;
    PG8_WAIT_V(2); PG8_BAR;
    PG8_STAGE(PG8_SB(1, 0), cB + kstep, voffB); PG8_STAGE_A(PG8_SA(1, 0), cA + kstep, 0); PG8_STAGE(PG8_SB(1, 1), cB + hstep + kstep, voffB);
    PG8_WAIT_V(6); PG8_BAR;
    for (;;) {
        bool has_next = false; if constexpr (!SINGLE) has_next = S.next(ui + 1, nxt);
        const char* nA = has_next ? S.a_base(nxt) : cA; const char* nB = has_next ? S.b_base(nxt) : cB;
        if constexpr (GA) {
            if (has_next) S.a_offs(nxt, tid, voN);
            else {
#pragma unroll
                for (int h = 0; h < 2; ++h)
#pragma unroll
                    for (int i = 0; i < 2; ++i) voN[h][i] = voA[h][i]; } }
#pragma unroll 1
        for (int t = 0; t < nt; t += 2) {
            const bool last = (t == nt - 2);
            const char* a1 = cA + (size_t)(t + 1) * kstep;
            const char* a2 = last ? nA : cA + (size_t)(t + 2) * kstep; const char* b2 = last ? nB : cB + (size_t)(t + 2) * kstep;
            const char* a3 = a2 + kstep; const char* b3 = b2 + kstep;
            PG8_LDB(B0, 0, 0); PG8_LDB(B1, 0, 1); PG8_SCHED; PG8_LDA(At, 0, 0); PG8_STAGE_A(PG8_SA(1, 1), a1, 1);
            PG8_WAIT_V(8); PG8_WAIT_L(0); PG8_BAR; PG8_MMA(0, 0, At, B0); PG8_MMA(0, 1, At, B1); PG8_BAR; PG8_SCHED;
            PG8_LDA(At, 0, 1); PG8_STAGE(PG8_SB(0, 0), b2, voffB); PG8_STAGE(PG8_SB(0, 1), b2 + hstep, voffB); PG8_STAGE_A2(PG8_SA(0, 0), a2, 0);
            PG8_WAIT_V(8); PG8_WAIT_L(0); PG8_BAR; PG8_MMA(1, 0, At, B0); PG8_MMA(1, 1, At, B1); PG8_BAR; PG8_SCHED;
            PG8_LDB(B0, 1, 0); PG8_LDB(B1, 1, 1); PG8_SCHED; PG8_LDA(At, 1, 0); PG8_STAGE_A2(PG8_SA(0, 1), a2, 1);
            PG8_WAIT_V(8); PG8_WAIT_L(0); PG8_BAR; PG8_MMA(0, 0, At, B0); PG8_MMA(0, 1, At, B1); PG8_BAR; PG8_SCHED;
            PG8_LDA(At, 1, 1); PG8_STAGE(PG8_SB(1, 0), b3, voffB); PG8_STAGE(PG8_SB(1, 1), b3 + hstep, voffB); PG8_STAGE_A2(PG8_SA(1, 0), a3, 0);
            PG8_WAIT_V(8); PG8_WAIT_L(0); PG8_BAR; PG8_MMA(1, 0, At, B0); PG8_MMA(1, 1, At, B1); PG8_BAR; PG8_SCHED;
        }
        if (wr == 0) PG8_BAR;
        E(acc, cur, wr, wc, fr, fq);
        if (!has_next) break;
#pragma unroll
        for (int a = 0; a < 2; ++a)
#pragma unroll
            for (int b = 0; b < 2; ++b)
#pragma unroll
                for (int m = 0; m < 4; ++m)
#pragma unroll
                    for (int n = 0; n < 2; ++n) acc[a][b][m][n] = (f32x4){0.f, 0.f, 0.f, 0.f};
        cur = nxt; cA = nA; cB = nB; ++ui;
        if constexpr (GA) {
#pragma unroll
            for (int h = 0; h < 2; ++h)
#pragma unroll
                for (int i = 0; i < 2; ++i) voA[h][i] = voN[h][i]; }
        if (wr == 1) PG8_BAR;
    }
    PG8_WAIT_V(0);
    PG8_BAR;
#undef PG8_SA
#undef PG8_SB
#undef PG8_STAGE
#undef PG8_STAGE_A
#undef PG8_STAGE_A2
#undef PG8_LDA
#undef PG8_LDB
#undef PG8_MMA
#undef PG8_WAIT_V
#undef PG8_WAIT_L
#undef PG8_BAR
#undef PG8_SCHED
}
}

#define XB_TMO      128
#define XB_XCNT(j)  (256  + 64 * (j))
#define XB_XSUB(j)  (1280 + 64 * (j))
#define XB_XGEN(j)  (2304 + 64 * (j))
#define XB_TOP      3328
#define XB_TOPGEN   3392
#define XCD_BAR_WORDS 3456
#define XB_SPIN_CAP (1u << 18)
__device__ __forceinline__ unsigned xb_ld(unsigned* p)              { return __hip_atomic_load(p, __ATOMIC_RELAXED, __HIP_MEMORY_SCOPE_AGENT); }
__device__ __forceinline__ unsigned xb_add(unsigned* p, unsigned v) { return __hip_atomic_fetch_add(p, v, __ATOMIC_RELAXED, __HIP_MEMORY_SCOPE_AGENT); }
__device__ __forceinline__ unsigned xb_xcc_id() { return (unsigned)__builtin_amdgcn_s_getreg((3 << 11) | 20) & 0xFu; }
#define XB_SPIN(cond, bar) do { unsigned _sp = 0; while (cond) { __builtin_amdgcn_s_sleep(1); \
    if ((++_sp & 255u) == 0u) { if (xb_ld(&(bar)[XB_TMO])) break; if (_sp > XB_SPIN_CAP) { atomicAdd(&(bar)[XB_TMO], 1u); break; } } } } while (0)
struct XcdBarrier { unsigned* bar; unsigned x; volatile LAS unsigned* st; unsigned ng; int wave; };
__device__ __forceinline__ XcdBarrier xcd_barrier_post(unsigned* bar, volatile LAS unsigned* st, unsigned ng) {
    XcdBarrier b; b.bar = bar; b.x = xb_xcc_id(); b.st = st; b.ng = ng; b.wave = __builtin_amdgcn_readfirstlane((int)threadIdx.x >> 6);
    if (threadIdx.x == 0) (void)xb_add(&bar[XB_XCNT(b.x)], 1u);
    return b;
}
__device__ __forceinline__ void xcd_barrier_complete(unsigned* bar, unsigned x, unsigned& nloc, unsigned& nx, const unsigned G) {
    unsigned sum, cnt, mine, sp = 0u;
    for (;;) {
        sum = 0u; cnt = 0u; mine = 0u;
#pragma unroll
        for (unsigned j = 0; j < 16; ++j) { const unsigned c = xb_ld(&bar[XB_XCNT(j)]); sum += c; cnt += (c > 0u) ? 1u : 0u; mine = (j == x) ? c : mine; }
        if (sum == G) break;
        __builtin_amdgcn_s_sleep(1);
        if ((++sp & 255u) == 0u) { if (xb_ld(&bar[XB_TMO])) break; if (sp > XB_SPIN_CAP) { atomicAdd(&bar[XB_TMO], 1u); break; } }
    }
    nloc = mine > 0u ? mine : 1u; nx = cnt > 0u ? cnt : 1u;
}
__device__ __forceinline__ void xcd_barrier(const XcdBarrier& b) {
    asm volatile("s_waitcnt vmcnt(0)" ::: "memory");
    __syncthreads();
    int ln_ = (int)__builtin_amdgcn_mbcnt_hi(~0u, __builtin_amdgcn_mbcnt_lo(~0u, 0u)); asm volatile("" : "+v"(ln_));
    if (b.wave == 0 && ln_ == 0) {
        unsigned* bar = b.bar;
        __builtin_amdgcn_s_waitcnt(0);
        unsigned nloc = b.st[0], nx = b.st[1];
        if (nloc == 0u) { xcd_barrier_complete(bar, b.x, nloc, nx, b.ng); b.st[0] = nloc; b.st[1] = nx; }
        const unsigned old = xb_add(&bar[XB_XSUB(b.x)], 1u);
        const unsigned gen = old / nloc;
        if (old + 1u == (gen + 1u) * nloc) {
            __builtin_amdgcn_fence(__ATOMIC_RELEASE, "agent");
            asm volatile("s_waitcnt vmcnt(0)" ::: "memory");
            const unsigned og = xb_add(&bar[XB_TOP], 1u);
            const unsigned tg = og / nx;
            if (og + 1u == (tg + 1u) * nx) xb_add(&bar[XB_TOPGEN], 1u);
            else XB_SPIN(xb_ld(&bar[XB_TOPGEN]) == tg, bar);
            __builtin_amdgcn_fence(__ATOMIC_ACQUIRE, "agent");
            xb_add(&bar[XB_XGEN(b.x)], 1u);
            asm volatile("s_waitcnt vmcnt(0)" ::: "memory");
        } else {
            XB_SPIN(xb_ld(&bar[XB_XGEN(b.x)]) == gen, bar);
            __builtin_amdgcn_fence(__ATOMIC_ACQUIRE, "agent");
            asm volatile("s_waitcnt vmcnt(0)" ::: "memory");
        }
    }
    __syncthreads();
}


__device__ __forceinline__ void flag_publish(unsigned* flag, int tid) {
    asm volatile("s_waitcnt vmcnt(0)" ::: "memory");
    __syncthreads();
    if (tid == 0) { __builtin_amdgcn_fence(__ATOMIC_RELEASE, "agent"); asm volatile("s_waitcnt vmcnt(0)" ::: "memory"); (void)xb_add(flag, 1u); }
}
__device__ __forceinline__ void flag_wait(unsigned* flag, unsigned want, unsigned* tmo, int tid) {
    if (tid == 0) { unsigned sp = 0;
        while (xb_ld(flag) < want) { __builtin_amdgcn_s_sleep(2); if ((++sp & 255u) == 0u) { if (xb_ld(tmo)) break; if (sp > (1u << 22)) { atomicAdd(tmo, 1u); break; } } }
        __builtin_amdgcn_fence(__ATOMIC_ACQUIRE, "agent"); asm volatile("s_waitcnt vmcnt(0)" ::: "memory"); }
    __syncthreads();
}

struct Args { const float* in[28]; float* out; unsigned char* ws; int ph_lo, ph_hi; };

struct Frame {
    LAS unsigned char* lds; unsigned char* ws; unsigned* ctl;
    int tid, lane, wave, G, bx, sid, row0;
    bf16_t *U, *MIX, *Y, *H;
    __device__ __forceinline__ Frame fresh() const { Frame f = *this; int ln = (int)__builtin_amdgcn_mbcnt_hi(~0u, __builtin_amdgcn_mbcnt_lo(~0u, 0u)); asm volatile("" : "+v"(ln)); f.lane = ln; f.tid = wave * 64 + ln;
        int b = bx, g = G, s = sid, wv = wave; unsigned char* w = ws; asm volatile("" : "+s"(b), "+s"(g), "+s"(w), "+s"(s), "+s"(wv)); f.bx = b; f.G = g; f.ws = w; f.sid = s; f.wave = wv; f.tid = wv * 64 + ln; f.row0 = s * SMT; f.ctl = (unsigned*)(w + WS_CTL);
        unsigned char* ar = w + WS_ARENA + (size_t)s * ARENA;
        f.U = (bf16_t*)ar - (size_t)f.row0 * DINP; f.MIX = (bf16_t*)(ar + ARENA_MIX) - (size_t)f.row0 * DM; f.Y = (bf16_t*)ar; f.H = (bf16_t*)(w + WS_H + (size_t)s * HSTREAM); return f; }
};

__device__ __forceinline__ int dmap(int type, int n) {
    if (type == 1) return n < 2048 ? n : (n < 2064 ? n - 2048 + UG_LOW : n - 16);
    if (type == 2) return (n >> 7) * 256 + (n & 127);
    if (type == 3) return (n >> 7) * 256 + 128 + (n & 127);
    return n;
}
__device__ __forceinline__ void transpose_item(const float* W, int ldw, int ncols, int k0, int n0, const float* kscale, bf16_t* WT, int ldt, int type, LAS float* scr, int lane) {
    const int n4 = (lane & 15) * 4, kr = lane >> 4; const bool okc = (n0 + n4) < ncols;
    f32x4 v[16];
#pragma unroll
    for (int i = 0; i < 16; ++i) v[i] = okc ? __builtin_nontemporal_load((const f32x4*)(W + (size_t)(k0 + 4 * i + kr) * ldw + n0 + n4)) : (f32x4){0.f, 0.f, 0.f, 0.f};
    if (kscale) {
#pragma unroll
        for (int i = 0; i < 16; ++i) v[i] = v[i] * kscale[k0 + 4 * i + kr]; }
#pragma unroll
    for (int i = 0; i < 16; ++i) { LAS float* s = scr + (4 * i + kr) * 65 + n4; s[0] = v[i][0]; s[1] = v[i][1]; s[2] = v[i][2]; s[3] = v[i][3]; }
    LDS_WAIT(); asm volatile("" ::: "memory");
    const int c = lane & 7;
#pragma unroll
    for (int j = 0; j < 8; ++j) { const int n = (lane >> 3) + 8 * j; const LAS float* s = scr + (8 * c) * 65 + n;
        u32x4 o; o.x = pk2(s[0 * 65], s[1 * 65]); o.y = pk2(s[2 * 65], s[3 * 65]); o.z = pk2(s[4 * 65], s[5 * 65]); o.w = pk2(s[6 * 65], s[7 * 65]);
        if (n0 + n < ncols) *(u32x4*)(WT + (size_t)dmap(type, n0 + n) * ldt + k0 + 8 * c) = o; }
    LDS_WAIT(); asm volatile("" ::: "memory");
}
__device__ __forceinline__ int t5_bucket(int d) {
    if (d < 16) return d;
    const float v = logf((float)d / 16.0f) / 4.852030263919617f * 16.0f;
    int b = 16 + (int)v; return b < 31 ? b : 31;
}
constexpr int I_IN = 32 * 89, I_OUT = 32 * 32, I_PP = 4 * 32, I_PG = 32 * 32, I_G = 32 * 128, I_U = 32 * 128, I_D = 32 * 128;
constexpr int IO_OUT = I_IN, IO_PP = IO_OUT + I_OUT, IO_PG = IO_PP + I_PP, IO_G = IO_PG + I_PG, IO_U = IO_G + I_G, IO_D = IO_U + I_U, I_L = IO_D + I_D;
__device__ __forceinline__ void conv_items(const Frame& F, const Args& a, const int l, const int lo, const int hi, const int gw, const int NGW) {
    LAS float* scr = (LAS float*)(F.lds + F.wave * 16640);
    bf16_t* WIN = (bf16_t*)(F.ws + WS_WIN); bf16_t* WOUT = (bf16_t*)(F.ws + WS_WOUT); bf16_t* WGU = (bf16_t*)(F.ws + WS_WGU); bf16_t* WD = (bf16_t*)(F.ws + WS_WD);
    bf16_t* WPG = (bf16_t*)(F.ws + WS_WPG); bf16_t* WPP = (bf16_t*)(F.ws + WS_WPP);
    for (int it = lo + gw; it < hi; it += NGW) {
        int r = it;
        if (r < IO_OUT) { const int kb = r / 89, nb = r - kb * 89; transpose_item(a.in[2] + (size_t)l * DM * DIN, DIN, DIN, kb * 64, nb * 64, nullptr, WIN + (size_t)l * DINP * DM, DM, 1, scr, F.lane); continue; }
        if (r < IO_PP) { r -= IO_OUT; const int kb = r >> 5, nb = r & 31; transpose_item(a.in[12] + (size_t)l * DM * DM, DM, DM, kb * 64, nb * 64, a.in[11] + l * DM, WOUT + (size_t)l * DM * DM, DM, 0, scr, F.lane); continue; }
        if (r < IO_PG) { r -= IO_PP; const int kb = r >> 5, nb = r & 31; transpose_item(a.in[25] + (size_t)l * PLE * DM, DM, DM, kb * 64, nb * 64, nullptr, WPP + (size_t)l * DM * PLE, PLE, 0, scr, F.lane); continue; }
        if (r < IO_G) { r -= IO_PG; const int kb = r >> 5, nb = r & 31; transpose_item(a.in[23] + (size_t)l * DM * DM, DM, DM, kb * 64, nb * 64, nullptr, WPG + (size_t)l * DM * DM, DM, 0, scr, F.lane); continue; }
        if (r < IO_U) { r -= IO_G; const int e = r >> 7, q = r & 127, kb = q >> 2, nb = q & 3; transpose_item(a.in[20] + (size_t)(l * NEXP + e) * DM * DEXP, DEXP, DEXP, kb * 64, nb * 64, nullptr, WGU + (size_t)(l * NEXP + e) * 512 * DM, DM, 2, scr, F.lane); continue; }
        if (r < IO_D) { r -= IO_U; const int e = r >> 7, q = r & 127, kb = q >> 2, nb = q & 3; transpose_item(a.in[21] + (size_t)(l * NEXP + e) * DM * DEXP, DEXP, DEXP, kb * 64, nb * 64, nullptr, WGU + (size_t)(l * NEXP + e) * 512 * DM, DM, 3, scr, F.lane); continue; }
        { r -= IO_D; const int e = r >> 7, q = r & 127, kb = q >> 5, nb = q & 31; transpose_item(a.in[22] + (size_t)(l * NEXP + e) * DEXP * DM, DM, DM, kb * 64, nb * 64, nullptr, WD + (size_t)(l * NEXP + e) * DM * DEXP, DEXP, 0, scr, F.lane); }
    }
}
__device__ __forceinline__ void conv_all(const Frame& F, const Args& a, const int l, const int lo, const int hi) { __syncthreads(); conv_items(F, a, l, lo, hi, F.bx * 8 + F.wave, F.G * 8); __syncthreads(); }
__device__ __forceinline__ void phase_prologue(const Frame& F, const Args& a) {
    bf16_t* WIN = (bf16_t*)(F.ws + WS_WIN);
    conv_all(F, a, 0, 0, IO_PG);
    const size_t gt = (size_t)F.bx * 512 + F.tid, NT = (size_t)F.G * 512;
    for (size_t i = gt; i < (size_t)NL * (DINP - DIN) * DM / 8; i += NT) { const size_t l = i / ((DINP - DIN) * DM / 8), r = i % ((DINP - DIN) * DM / 8);
        *(u32x4*)(WIN + (l * DINP + DIN) * DM + r * 8) = (u32x4){0u, 0u, 0u, 0u}; }
    { const float* x = a.in[0]; bf16_t* XB = (bf16_t*)(F.ws + WS_XB);
      for (size_t i = gt; i < (size_t)MT * DM / 8; i += NT) { const f32x4 v0 = *(const f32x4*)(x + i * 8), v1 = *(const f32x4*)(x + i * 8 + 4);
          *(u32x4*)(XB + i * 8) = (u32x4){pk2(v0[0], v0[1]), pk2(v0[2], v0[3]), pk2(v1[0], v1[1]), pk2(v1[2], v1[3])}; } }
    { const float* p = a.in[1]; bf16_t* PB = (bf16_t*)(F.ws + WS_PB);
      for (size_t i = gt; i < (size_t)NL * MT * PLE / 8; i += NT) { const f32x4 v0 = *(const f32x4*)(p + i * 8), v1 = *(const f32x4*)(p + i * 8 + 4);
          *(u32x4*)(PB + i * 8) = (u32x4){pk2(v0[0], v0[1]), pk2(v0[2], v0[3]), pk2(v1[0], v1[1]), pk2(v1[2], v1[3])}; } }
    { float* bt = (float*)(F.ws + WS_BTAB); const float* rb = a.in[13];
      for (size_t i = gt; i < 3 * 129 * 8; i += NT) { const int h = (int)(i & 7), j = (int)((i >> 3) % 129), br = (int)((i >> 3) / 129); const int dil = br == 0 ? 1 : (br == 1 ? 4 : 16);
          bt[i] = rb[t5_bucket(j * dil) * 8 + h]; } }
    { float* wrt = (float*)(F.ws + WS_WRT);
      for (size_t i = gt; i < (size_t)NL * 36 * DM; i += NT) { const int c = (int)(i % DM), col = (int)((i / DM) % 36), l = (int)(i / (36 * DM));
          wrt[i] = col < 4 ? a.in[16][((size_t)l * DM + c) * 4 + col] : a.in[18][((size_t)l * DM + c) * 32 + (col - 4)]; } }
}

__device__ __forceinline__ void conv_unit(const Frame& F, const Args& a, int l, int unit) {
    const bf16_t* U = F.U; bf16_t* MIX = F.MIX;
    LAS float* hb = (LAS float*)F.lds;
    const int t0 = unit * 32, tl0 = t0 & (SEQ - 1), tb = t0 - tl0;
    const int tid = F.tid;
    __syncthreads();
#pragma unroll 1
    for (int i = 0; i < 8; ++i) { const int id = tid + 512 * i; if (id < 62 * 64) { const int row = id >> 6, ch = (id & 63) * 8; const int tl = tl0 - 30 + row;
        float o[8];
        if (tl >= 0) { const bf16_t* up = U + (size_t)(tb + tl) * DINP; const u32x4 av = *(const u32x4*)(up + UA_VAL + ch), gv = *(const u32x4*)(up + UA_GATE + ch);
            const unsigned aw[4] = {av.x, av.y, av.z, av.w}, gw[4] = {gv.x, gv.y, gv.z, gv.w};
#pragma unroll
            for (int j = 0; j < 4; ++j) { o[2 * j] = bflo(aw[j]) * sigmoidf_(bflo(gw[j])); o[2 * j + 1] = bfhi(aw[j]) * sigmoidf_(bfhi(gw[j])); } }
        else {
#pragma unroll
            for (int j = 0; j < 8; ++j) o[j] = 0.f; }
        *(LAS f32x4*)(hb + row * 512 + ch) = (f32x4){o[0], o[1], o[2], o[3]}; *(LAS f32x4*)(hb + row * 512 + ch + 4) = (f32x4){o[4], o[5], o[6], o[7]}; } }
    __syncthreads();
    float yv[32];
    { const int c = tid; const float* w = a.in[3] + (size_t)l * 31 * 512; const float bias = a.in[4][l * 512 + c];
      float wv[31];
#pragma unroll
      for (int j = 0; j < 31; ++j) wv[j] = w[j * 512 + c];
      float hv[62];
#pragma unroll
      for (int r = 0; r < 62; ++r) hv[r] = hb[r * 512 + c];
#pragma unroll
      for (int t = 0; t < 32; ++t) { float s = bias;
#pragma unroll
          for (int j = 0; j < 31; ++j) s += wv[j] * hv[t + j];
          yv[t] = s; } }
    __syncthreads();
#pragma unroll
    for (int t = 0; t < 32; ++t) hb[t * 512 + tid] = yv[t];
    __syncthreads();
    { const float* lg = a.in[5] + l * 512; const float* lb = a.in[6] + l * 512;
#pragma unroll 1
      for (int i = 0; i < 4; ++i) { const int t = F.wave + 8 * i;
          const f32x4 v0 = *(const LAS f32x4*)(hb + t * 512 + 4 * F.lane), v1 = *(const LAS f32x4*)(hb + t * 512 + 256 + 4 * F.lane);
          const float mean = wave_sum((v0[0] + v0[1]) + (v0[2] + v0[3]) + (v1[0] + v1[1]) + (v1[2] + v1[3])) * (1.f / 512.f);
          const f32x4 d0 = v0 - mean, d1 = v1 - mean;
          const float var = wave_sum((d0[0] * d0[0] + d0[1] * d0[1]) + (d0[2] * d0[2] + d0[3] * d0[3]) + (d1[0] * d1[0] + d1[1] * d1[1]) + (d1[2] * d1[2] + d1[3] * d1[3])) * (1.f / 512.f);
          const float rstd = 1.0f / sqrtf(var + LN_EPS);
          const f32x4 g0 = *(const f32x4*)(lg + 4 * F.lane), g1 = *(const f32x4*)(lg + 256 + 4 * F.lane), b0 = *(const f32x4*)(lb + 4 * F.lane), b1 = *(const f32x4*)(lb + 256 + 4 * F.lane);
          float o0[4], o1[4];
#pragma unroll
          for (int j = 0; j < 4; ++j) { o0[j] = siluf_(d0[j] * rstd * g0[j] + b0[j]); o1[j] = siluf_(d1[j] * rstd * g1[j] + b1[j]); }
          bf16_t* mp = MIX + (size_t)(t0 + t) * DM;
          *(u32x2*)(mp + 4 * F.lane) = (u32x2){pk2(o0[0], o0[1]), pk2(o0[2], o0[3])}; *(u32x2*)(mp + 256 + 4 * F.lane) = (u32x2){pk2(o1[0], o1[1]), pk2(o1[2], o1[3])}; } }
    { const int cg = (tid & 63) * 8; const float* w = a.in[10] + (size_t)l * 3 * 512 + cg;
      float wv[3][8];
#pragma unroll
      for (int j = 0; j < 3; ++j) { const f32x4 a0 = *(const f32x4*)(w + j * 512), a1 = *(const f32x4*)(w + j * 512 + 4); wv[j][0] = a0[0]; wv[j][1] = a0[1]; wv[j][2] = a0[2]; wv[j][3] = a0[3]; wv[j][4] = a1[0]; wv[j][5] = a1[1]; wv[j][6] = a1[2]; wv[j][7] = a1[3]; }
#pragma unroll 1
      for (int pass = 0; pass < 2; ++pass) { const int tg = (tid >> 6) + 8 * pass;
      float p[4][8];
#pragma unroll
      for (int rr = 0; rr < 4; ++rr) { const int tl = tl0 + 2 * tg - 2 + rr;
          { const float msk = tl >= 0 ? 1.f : 0.f; const int tlc = tl >= 0 ? tl : 0;
            const bf16_t* up = U + (size_t)(tb + tlc) * DINP; const u32x4 cw = *(const u32x4*)(up + US_C + cg), hw = *(const u32x4*)(up + US_H + cg);
            const unsigned c4[4] = {cw.x, cw.y, cw.z, cw.w}, h4[4] = {hw.x, hw.y, hw.z, hw.w};
#pragma unroll
            for (int j = 0; j < 4; ++j) { p[rr][2 * j] = bflo(c4[j]) * bflo(h4[j]) * msk; p[rr][2 * j + 1] = bfhi(c4[j]) * bfhi(h4[j]) * msk; } } }
#pragma unroll
      for (int tt = 0; tt < 2; ++tt) { const int t = t0 + 2 * tg + tt; const u32x4 bw = *(const u32x4*)(U + (size_t)t * DINP + US_B + cg); const unsigned b4[4] = {bw.x, bw.y, bw.z, bw.w}; unsigned ow[4];
#pragma unroll
          for (int j = 0; j < 4; ++j) { const float y0 = bflo(b4[j]) * (wv[0][2 * j] * p[tt][2 * j] + wv[1][2 * j] * p[tt + 1][2 * j] + wv[2][2 * j] * p[tt + 2][2 * j]);
              const float y1 = bfhi(b4[j]) * (wv[0][2 * j + 1] * p[tt][2 * j + 1] + wv[1][2 * j + 1] * p[tt + 1][2 * j + 1] + wv[2][2 * j + 1] * p[tt + 2][2 * j + 1]); ow[j] = pk2(y0, y1); }
          *(u32x4*)(MIX + (size_t)t * DM + 1536 + cg) = (u32x4){ow[0], ow[1], ow[2], ow[3]}; } } }
}

__device__ __forceinline__ bf16x8 frag_f32(const LAS float* p) { const f32x4 a = *(const LAS f32x4*)p, b = *(const LAS f32x4*)(p + 4);
    const u32x4 w = (u32x4){pk2(a[0], a[1]), pk2(a[2], a[3]), pk2(b[0], b[1]), pk2(b[2], b[3])}; return __builtin_bit_cast(bf16x8, w); }
__device__ __forceinline__ bf16x8 frag_col(const LAS float* p, int stride) {
    const u32x4 w = (u32x4){pk2(p[0], p[stride]), pk2(p[2 * stride], p[3 * stride]), pk2(p[4 * stride], p[5 * stride]), pk2(p[6 * stride], p[7 * stride])}; return __builtin_bit_cast(bf16x8, w); }
__device__ __forceinline__ void gla_a_unit(const Frame& F, const Args& a, int l, int unit) {
    const bf16_t* U = F.U;
    float* GU = (float*)(F.ws + WS_GU); float* GO = (float*)(F.ws + WS_GO); float* GQ = (float*)(F.ws + WS_GQ); float* GD = (float*)(F.ws + WS_GD);
    const int n = unit & 63, h = (unit >> 6) & 3, b = unit >> 8, bh = b * 4 + h;
    const int t0 = b * SEQ + n * 32, tid = F.tid;
    LAS float* L = (LAS float*)F.lds;
    LAS float* qt = L; LAS float* kr = L + 2048; LAS float* kt = L + 4096; LAS float* kh = L + 6144; LAS float* vv = L + 8192; LAS float* bc = L + 12288; LAS float* gl = L + 14336; LAS float* wg = L + 14848; LAS float* sc = L + 15872;
    const int i = tid >> 4, k4 = (tid & 15) * 4, v8 = (tid & 15) * 8;
    __syncthreads();
    { const bf16_t* up = U + (size_t)(t0 + i) * DINP;
      const u32x2 qw = *(const u32x2*)(up + UG_Q + h * 64 + k4), kw = *(const u32x2*)(up + UG_K + h * 64 + k4); const u32x4 vw = *(const u32x4*)(up + UG_V + h * 128 + v8);
      *(LAS f32x4*)(qt + i * 64 + k4) = (f32x4){bflo(qw.x), bfhi(qw.x), bflo(qw.y), bfhi(qw.y)};
      *(LAS f32x4*)(kr + i * 64 + k4) = (f32x4){bflo(kw.x), bfhi(kw.x), bflo(kw.y), bfhi(kw.y)};
      *(LAS f32x4*)(vv + i * 128 + v8) = (f32x4){bflo(vw.x), bfhi(vw.x), bflo(vw.y), bfhi(vw.y)}; *(LAS f32x4*)(vv + i * 128 + v8 + 4) = (f32x4){bflo(vw.z), bfhi(vw.z), bflo(vw.w), bfhi(vw.w)};
      gl[i * 16 + (tid & 15)] = bf2f(up[UG_LOW + (tid & 15)]);
      const float* w2 = a.in[7] + (size_t)l * 16 * 256;
      wg[tid] = w2[(tid >> 6) * 256 + h * 64 + (tid & 63)]; wg[512 + tid] = w2[(8 + (tid >> 6)) * 256 + h * 64 + (tid & 63)]; }
    __syncthreads();
    { const f32x4 bg = *(const f32x4*)(a.in[8] + l * 256 + h * 64 + k4); f32x4 z = bg;
#pragma unroll
      for (int r = 0; r < 16; ++r) { const float g = gl[i * 16 + r]; const f32x4 w = *(const LAS f32x4*)(wg + r * 64 + k4); z = z + w * g; }
      f32x4 la;
#pragma unroll
      for (int j = 0; j < 4; ++j) la[j] = (fminf(z[j], 0.f) - log1pf(expf(-fabsf(z[j])))) * (1.0f / 16.0f);
      *(LAS f32x4*)(bc + i * 64 + k4) = la; }
    __syncthreads();
    f32x4 bv = {0.f, 0.f, 0.f, 0.f}, bl = bv;
#pragma unroll 8
    for (int r = 0; r < 32; ++r) { const f32x4 x = *(const LAS f32x4*)(bc + r * 64 + k4); bl = bl + x; if (r <= i) bv = bv + x; }
    { const f32x4  q = *(const LAS f32x4*)(qt + i * 64 + k4), k = *(const LAS f32x4*)(kr + i * 64 + k4);
      f32x4 qo, ko, ho;
#pragma unroll
      for (int j = 0; j < 4; ++j) { qo[j] = q[j] * expf(bv[j]) * 0.125f; ko[j] = k[j] * expf(-bv[j]); ho[j] = k[j] * expf(bl[j] - bv[j]); }
      *(LAS f32x4*)(qt + i * 64 + k4) = qo; *(LAS f32x4*)(kt + i * 64 + k4) = ko; *(LAS f32x4*)(kh + i * 64 + k4) = ho;
      *(f32x4*)(GQ + (size_t)(t0 + i) * 256 + h * 64 + k4) = qo;
      if (i == 31) { f32x4 d;
#pragma unroll
          for (int j = 0; j < 4; ++j) d[j] = expf(bl[j]);
          *(f32x4*)(GD + ((size_t)bh * 64 + n) * 64 + k4) = d; } }
    __syncthreads();
    const int lane = F.lane, w = F.wave, fr = lane & 15, fg = lane >> 4;
    if (w < 4) { const int mi = w >> 1, nj = w & 1; f32x4 d = zero4();
#pragma unroll
        for (int ks = 0; ks < 2; ++ks) d = __builtin_amdgcn_mfma_f32_16x16x32_bf16(frag_f32(qt + (16 * mi + fr) * 64 + 8 * fg + 32 * ks), frag_f32(kt + (16 * nj + fr) * 64 + 8 * fg + 32 * ks), d, 0, 0, 0);
#pragma unroll
        for (int r = 0; r < 4; ++r) { const int ii = 16 * mi + 4 * fg + r, jj = 16 * nj + fr; sc[ii * 36 + jj] = (jj <= ii) ? d[r] : 0.f; } }
    const bf16x8 vfrag = frag_col(vv + (8 * fg) * 128 + 16 * w + fr, 128);
    { float* gp = GU + ((size_t)bh * 64 + n) * 8192 + (size_t)(16 * w + fr) * 64 + 4 * fg;
#pragma unroll
      for (int kt4 = 0; kt4 < 4; ++kt4) { const bf16x8 kfrag = frag_col(kh + (8 * fg) * 64 + 16 * kt4 + fr, 64);
          const f32x4 d = __builtin_amdgcn_mfma_f32_16x16x32_bf16(kfrag, vfrag, zero4(), 0, 0, 0);
          *(f32x4*)(gp + 16 * kt4) = d; } }
    __syncthreads();
#pragma unroll
    for (int it = 0; it < 2; ++it) { const bf16x8 sfrag = frag_f32(sc + (16 * it + fr) * 36 + 8 * fg);
        const f32x4 d = __builtin_amdgcn_mfma_f32_16x16x32_bf16(vfrag, sfrag, zero4(), 0, 0, 0);
        *(f32x4*)(GO + (size_t)(t0 + 16 * it + fr) * 512 + h * 128 + 16 * w + 4 * fg) = d; }
}
__device__ __forceinline__ void gla_scan(const Frame& F) {
    float* GU = (float*)(F.ws + WS_GU); const float* GD = (const float*)(F.ws + WS_GD);
    for (int g = F.sid * 8 * 8192 + F.bx * 512 + F.tid; g < (F.sid + 1) * 8 * 8192; g += F.G * 512) { const int bh = g >> 13, kv = g & 8191, k = kv & 63;
        float* p = GU + (size_t)bh * 64 * 8192 + kv; const float* d = GD + (size_t)bh * 64 * 64 + k; float S = 0.f;
#pragma unroll 8
        for (int n = 0; n < 64; ++n) { const float u = p[(size_t)n * 8192]; const float dc = d[n * 64]; p[(size_t)n * 8192] = S; S = S * dc + u; } }
}
struct GlaCIn { f32x4 s[4]; f32x4 q; f32x4 oi[2]; u32x2 rw[2]; };
__device__ __forceinline__ void gla_c_load(const Frame& F, int unit, GlaCIn& in) {
    const bf16_t* U = F.U; const float* GU = (const float*)(F.ws + WS_GU); const float* GO = (const float*)(F.ws + WS_GO); const float* GQ = (const float*)(F.ws + WS_GQ);
    const int n = unit & 63, h = (unit >> 6) & 3, b = unit >> 8, bh = b * 4 + h, t0 = b * SEQ + n * 32, tid = F.tid, lane = F.lane, w = F.wave, fr = lane & 15, fg = lane >> 4;
    const float* sp = GU + ((size_t)bh * 64 + n) * 8192;
#pragma unroll
    for (int j = 0; j < 4; ++j) in.s[j] = *(const f32x4*)(sp + (tid + 512 * j) * 4);
    in.q = *(const f32x4*)(GQ + (size_t)(t0 + (tid >> 4)) * 256 + h * 64 + (tid & 15) * 4);
#pragma unroll
    for (int it = 0; it < 2; ++it) { const int row = t0 + 16 * it + fr, col = h * 128 + 16 * w + 4 * fg;
        in.oi[it] = *(const f32x4*)(GO + (size_t)row * 512 + col); in.rw[it] = *(const u32x2*)(U + (size_t)row * DINP + UG_R + col); }
}
__device__ __forceinline__ void gla_c_phase(const Frame& F, const Args& a, int l) {
    bf16_t* MIX = F.MIX;
    const int tid = F.tid, lane = F.lane, w = F.wave, fr = lane & 15, fg = lane >> 4;
    LAS float* qt = (LAS float*)F.lds; LAS float* SsT = qt + 32 * 68; LAS float* red = SsT + 128 * 68;
    const f32x4 ng = *(const f32x4*)(a.in[9] + l * 128 + 16 * w + 4 * fg);
    GlaCIn in; const int ubeg = F.sid * 512 + F.bx, uend = (F.sid + 1) * 512;
    if (ubeg < uend) gla_c_load(F, ubeg, in);
#pragma unroll 1
    for (int unit = ubeg; unit < uend; unit += F.G) {
        const int n = unit & 63, h = (unit >> 6) & 3, b = unit >> 8, t0 = b * SEQ + n * 32;
        __syncthreads();
        *(LAS f32x4*)(qt + (tid >> 4) * 68 + (tid & 15) * 4) = in.q;
#pragma unroll
        for (int j = 0; j < 4; ++j) { const int e = (tid + 512 * j) * 4; *(LAS f32x4*)(SsT + (e >> 6) * 68 + (e & 63)) = in.s[j]; }
        f32x4 o[2] = {in.oi[0], in.oi[1]}; const u32x2 rw0 = in.rw[0], rw1 = in.rw[1];
        __syncthreads();
        if (unit + F.G < uend) gla_c_load(F, unit + F.G, in);
#pragma unroll
        for (int ks = 0; ks < 2; ++ks) { const bf16x8 sf = frag_f32(SsT + (16 * w + fr) * 68 + 8 * fg + 32 * ks);
#pragma unroll
            for (int it = 0; it < 2; ++it) o[it] = __builtin_amdgcn_mfma_f32_16x16x32_bf16(sf, frag_f32(qt + (16 * it + fr) * 68 + 8 * fg + 32 * ks), o[it], 0, 0, 0); }
#pragma unroll
        for (int it = 0; it < 2; ++it) { float ss = (o[it][0] * o[it][0] + o[it][1] * o[it][1]) + (o[it][2] * o[it][2] + o[it][3] * o[it][3]);
            ss += __shfl_xor(ss, 16); ss += __shfl_xor(ss, 32);
            if (fg == 0) red[w * 32 + 16 * it + fr] = ss; }
        __syncthreads();
#pragma unroll
        for (int it = 0; it < 2; ++it) { float tot = 0.f;
#pragma unroll
            for (int ww = 0; ww < 8; ++ww) tot += red[ww * 32 + 16 * it + fr];
            const float rms = 1.0f / sqrtf(tot * (1.f / 128.f) + RMS_EPS);
            const u32x2 rw = it == 0 ? rw0 : rw1;
            const float y0 = o[it][0] * rms * ng[0] * siluf_(bflo(rw.x)), y1 = o[it][1] * rms * ng[1] * siluf_(bfhi(rw.x)), y2 = o[it][2] * rms * ng[2] * siluf_(bflo(rw.y)), y3 = o[it][3] * rms * ng[3] * siluf_(bfhi(rw.y));
            *(u32x2*)(MIX + (size_t)(t0 + 16 * it + fr) * DM + 512 + h * 128 + 16 * w + 4 * fg) = (u32x2){pk2(y0, y1), pk2(y2, y3)}; }
    }
}

typedef short s16x4 __attribute__((ext_vector_type(4)));
__device__ __forceinline__ s16x4 vtr(const LAS unsigned char* p) { return __builtin_bit_cast(s16x4, __builtin_amdgcn_ds_read_tr16_b64_v4i16((LAS s16x4*)p)); }
constexpr int AT_VROW = 160, AT_VBUF = 32 * AT_VROW;
__device__ __forceinline__ void attn_job(const Frame& F, int job, LAS unsigned char* vbuf, const LAS float* bt) {
    const bf16_t* U = F.U; bf16_t* AO = (bf16_t*)(F.ws + WS_AO); float* ALSE = (float*)(F.ws + WS_ALSE);
    const int lane = F.lane, qi = lane & 15, g = lane >> 4;
    const int gidx = job & 127, t2 = job >> 7, br = t2 % 3, bh = t2 / 3, h = bh & 7, b = bh >> 3;
    const int dsh = 2 * br, dil = 1 << dsh, gsh = 7 - dsh, r = gidx >> gsh, gi = gidx & ((1 << gsh) - 1);
    const int q0 = gi * 16, tb = b * SEQ;
    const bf16_t* Ub = U + (size_t)(tb + r) * DINP + h * 64;
    const size_t sstep = (size_t)dil * DINP;
    const bf16_t* qrow = Ub + (size_t)(q0 + qi) * sstep + UC_Q + 8 * g;
    const bf16x8 qf0 = *(const bf16x8*)qrow, qf1 = *(const bf16x8*)(qrow + 32);
    const int klo = (q0 >= 128 ? q0 - 128 : 0) & ~31;
    const int nch = ((q0 + 15 - klo) >> 5) + 1;
    float m_run = -1e30f, l_part = 0.f;
    f32x4 o[4];
#pragma unroll
    for (int d = 0; d < 4; ++d) o[d] = (f32x4){0.f, 0.f, 0.f, 0.f};
    bf16x8 ka0, ka1, kb0, kb1; u32x4 vr[4];
#define AT_LOAD(kc) do { const bf16_t* kp = Ub + (size_t)((kc) + qi) * sstep + UC_K + 8 * g; ka0 = *(const bf16x8*)kp; ka1 = *(const bf16x8*)(kp + 32); kp += 16 * sstep; kb0 = *(const bf16x8*)kp; kb1 = *(const bf16x8*)(kp + 32); \
        const bf16_t* vp = Ub + (size_t)((kc) + (lane >> 3)) * sstep + UC_V + (lane & 7) * 8; _Pragma("unroll") for (int it = 0; it < 4; ++it) vr[it] = *(const u32x4*)(vp + (size_t)(8 * it) * sstep); } while (0)
    AT_LOAD(klo);
#pragma unroll 1
    for (int c = 0; c < nch; ++c) {
        const int kc = klo + 32 * c;
        LAS unsigned char* vb = vbuf + (c & 1) * AT_VBUF;
#pragma unroll
        for (int it = 0; it < 4; ++it) *(LAS u32x4*)(vb + (it * 8 + (lane >> 3)) * AT_VROW + (lane & 7) * 16) = vr[it];
        const bf16x8 ca0 = ka0, ca1 = ka1, cb0 = kb0, cb1 = kb1;
        if (c + 1 < nch) AT_LOAD(kc + 32);
        f32x4 sa = (f32x4){0.f, 0.f, 0.f, 0.f}, sb = sa;
        sa = __builtin_amdgcn_mfma_f32_16x16x32_bf16(ca0, qf0, sa, 0, 0, 0); sa = __builtin_amdgcn_mfma_f32_16x16x32_bf16(ca1, qf1, sa, 0, 0, 0);
        sb = __builtin_amdgcn_mfma_f32_16x16x32_bf16(cb0, qf0, sb, 0, 0, 0); sb = __builtin_amdgcn_mfma_f32_16x16x32_bf16(cb1, qf1, sb, 0, 0, 0);
        const int st0 = (q0 + qi) - (kc + 4 * g);
        float cmax = -1e30f;
#pragma unroll
        for (int rr = 0; rr < 4; ++rr) {
            const int sA = st0 - rr, sB = st0 - rr - 16;
            const int iA = sA < 0 ? 0 : (sA > 128 ? 128 : sA), iB = sB < 0 ? 0 : (sB > 128 ? 128 : sB);
            const float vA = sa[rr] * 0.125f + bt[(br * 129 + iA) * 8 + h], vB = sb[rr] * 0.125f + bt[(br * 129 + iB) * 8 + h];
            sa[rr] = (sA >= 0 && sA <= 128) ? vA : -1e30f; sb[rr] = (sB >= 0 && sB <= 128) ? vB : -1e30f;
            cmax = fmaxf(cmax, fmaxf(sa[rr], sb[rr])); }
        cmax = fmaxf(cmax, __shfl_xor(cmax, 16)); cmax = fmaxf(cmax, __shfl_xor(cmax, 32));
        const float m_new = fmaxf(m_run, cmax), alpha = __expf(m_run - m_new);
        float psum = 0.f;
#pragma unroll
        for (int rr = 0; rr < 4; ++rr) { sa[rr] = __expf(sa[rr] - m_new); sb[rr] = __expf(sb[rr] - m_new); psum += sa[rr] + sb[rr]; }
        l_part = l_part * alpha + psum; m_run = m_new;
#pragma unroll
        for (int d = 0; d < 4; ++d) o[d] = o[d] * alpha;
        const u32x4 pw = (u32x4){pk2(sa[0], sa[1]), pk2(sa[2], sa[3]), pk2(sb[0], sb[1]), pk2(sb[2], sb[3])};
        const bf16x8 pf = __builtin_bit_cast(bf16x8, pw);
        const LAS unsigned char* tp = vb + (4 * g + (qi >> 2)) * AT_VROW + (qi & 3) * 8;
#pragma unroll
        for (int d = 0; d < 4; ++d) { const s16x4 va = vtr(tp + d * 32), vb2 = vtr(tp + 16 * AT_VROW + d * 32);
            const bf16x8 vf = (bf16x8){va[0], va[1], va[2], va[3], vb2[0], vb2[1], vb2[2], vb2[3]};
            o[d] = __builtin_amdgcn_mfma_f32_16x16x32_bf16(vf, pf, o[d], 0, 0, 0); }
    }
#undef AT_LOAD
    float l = l_part; l += __shfl_xor(l, 16); l += __shfl_xor(l, 32);
    const float inv = 1.0f / l;
    const int token = tb + (q0 + qi) * dil + r;
    bf16_t* op = AO + ((size_t)br * MT + token) * 512 + h * 64 + 4 * g;
#pragma unroll
    for (int d = 0; d < 4; ++d) *(u32x2*)(op + d * 16) = (u32x2){pk2(o[d][0] * inv, o[d][1] * inv), pk2(o[d][2] * inv, o[d][3] * inv)};
    if (g == 0) ALSE[((size_t)br * MT + token) * 8 + h] = m_run + logf(l);
}
__device__ __forceinline__ void attn_combine(const Frame& F) {
    const bf16_t* AO = (const bf16_t*)(F.ws + WS_AO); const float* ALSE = (const float*)(F.ws + WS_ALSE); bf16_t* MIX = F.MIX;
    for (int i = F.row0 * 64 + F.bx * 512 + F.tid; i < (F.row0 + SMT) * 64; i += F.G * 512) { const int token = i >> 6, c8 = (i & 63) * 8, h = c8 >> 6;
        const float l0 = ALSE[(size_t)token * 8 + h], l1 = ALSE[((size_t)MT + token) * 8 + h], l2 = ALSE[((size_t)2 * MT + token) * 8 + h];
        const float m = fmaxf(l0, fmaxf(l1, l2)); float w0 = __expf(l0 - m), w1 = __expf(l1 - m), w2 = __expf(l2 - m); const float inv = 1.0f / (w0 + w1 + w2); w0 *= inv; w1 *= inv; w2 *= inv;
        const u32x4 a = *(const u32x4*)(AO + (size_t)token * 512 + c8), bq = *(const u32x4*)(AO + ((size_t)MT + token) * 512 + c8), cq = *(const u32x4*)(AO + ((size_t)2 * MT + token) * 512 + c8);
        const unsigned aw[4] = {a.x, a.y, a.z, a.w}, bw[4] = {bq.x, bq.y, bq.z, bq.w}, cw[4] = {cq.x, cq.y, cq.z, cq.w}; unsigned ow[4];
#pragma unroll
        for (int j = 0; j < 4; ++j) ow[j] = pk2(w0 * bflo(aw[j]) + w1 * bflo(bw[j]) + w2 * bflo(cw[j]), w0 * bfhi(aw[j]) + w1 * bfhi(bw[j]) + w2 * bfhi(cw[j]));
        *(u32x4*)(MIX + (size_t)token * DM + 1024 + c8) = (u32x4){ow[0], ow[1], ow[2], ow[3]}; }
}

__device__ __forceinline__ void ln1_unit(const Frame& F, const Args& a, int l, int unit, bool commit) {
    const bf16_t* PRE = (const bf16_t*)(F.ws + WS_PRE); bf16_t* XB = (bf16_t*)(F.ws + WS_XB); const float* wrt = (const float*)(F.ws + WS_WRT) + (size_t)l * 36 * DM;
    int* ltok = (int*)(F.ws + WS_LTOK) + F.sid * 32 * SMT; float* lgate = (float*)(F.ws + WS_LGATE) + F.sid * 32 * SMT; int* tinfo = (int*)(F.ws + WS_TINFO); unsigned* cnt = F.ctl + CW_CNT + (l * 2 + F.sid) * 32 * 64;
    LAS float* Wl = (LAS float*)F.lds;
    const int lane = F.lane, tid = F.tid, row0 = unit * 16 + F.wave * 2;
    const float* g = a.in[14] + (size_t)l * DM; const float* bb = a.in[15] + (size_t)l * DM;
    f32x4 wreg[5];
#pragma unroll
    for (int i = 0; i < 5; ++i) { const int idx = tid + 512 * i; if (idx < 36 * 64) wreg[i] = *(const f32x4*)(wrt + (size_t)(idx >> 6) * DM + (idx & 63) * 4); }
    float mean_[2], rstd_[2];
#pragma unroll
    for (int r = 0; r < 2; ++r) { const int row = row0 + r; const bf16_t* pr = PRE + (size_t)row * DM; f32x4 v[8]; float s = 0.f;
#pragma unroll
      for (int j = 0; j < 8; ++j) { const u32x2 w = *(const u32x2*)(pr + 256 * j + 4 * lane); v[j] = (f32x4){bflo(w.x), bfhi(w.x), bflo(w.y), bfhi(w.y)}; s += (v[j][0] + v[j][1]) + (v[j][2] + v[j][3]); }
      const float mean = wave_sum(s) * (1.f / DM); float q = 0.f;
#pragma unroll
      for (int j = 0; j < 8; ++j) { v[j] = v[j] - mean; q += (v[j][0] * v[j][0] + v[j][1] * v[j][1]) + (v[j][2] * v[j][2] + v[j][3] * v[j][3]); }
      const float rstd = 1.0f / sqrtf(wave_sum(q) * (1.f / DM) + LN_EPS);
      mean_[r] = mean; rstd_[r] = rstd;
#pragma unroll
      for (int j = 0; j < 8; ++j) { const f32x4 gv = *(const f32x4*)(g + 256 * j + 4 * lane), bv = *(const f32x4*)(bb + 256 * j + 4 * lane); const f32x4 y = v[j] * rstd * gv + bv;
          *(u32x2*)(XB + (size_t)row * DM + 256 * j + 4 * lane) = (u32x2){pk2(y[0], y[1]), pk2(y[2], y[3])}; } }
    float acc[2][36];
#pragma unroll
    for (int r = 0; r < 2; ++r)
#pragma unroll
        for (int c = 0; c < 36; ++c) acc[r][c] = 0.f;
    __syncthreads();
#pragma unroll 1
    for (int j = 0; j < 8; ++j) {
        LAS float* Wb = Wl + (j & 1) * (36 * 256);
#pragma unroll
        for (int i = 0; i < 5; ++i) { const int idx = tid + 512 * i; if (idx < 36 * 64) *(LAS f32x4*)(Wb + (idx >> 6) * 256 + (idx & 63) * 4) = wreg[i]; }
        __syncthreads();
        if (j < 7) {
#pragma unroll
            for (int i = 0; i < 5; ++i) { const int idx = tid + 512 * i; if (idx < 36 * 64) wreg[i] = *(const f32x4*)(wrt + (size_t)(idx >> 6) * DM + 256 * (j + 1) + (idx & 63) * 4); } }
        f32x4 xv[2];
        { const f32x4 gv = *(const f32x4*)(g + 256 * j + 4 * lane), bv = *(const f32x4*)(bb + 256 * j + 4 * lane);
#pragma unroll
          for (int r = 0; r < 2; ++r) { const u32x2 w = *(const u32x2*)(PRE + (size_t)(row0 + r) * DM + 256 * j + 4 * lane);
              xv[r] = ((f32x4){bflo(w.x), bfhi(w.x), bflo(w.y), bfhi(w.y)} - mean_[r]) * rstd_[r] * gv + bv; } }
#pragma unroll
        for (int c = 0; c < 36; ++c) { const f32x4 w = *(const LAS f32x4*)(Wb + c * 256 + 4 * lane);
#pragma unroll
            for (int r = 0; r < 2; ++r) acc[r][c] += (xv[r][0] * w[0] + xv[r][1] * w[1]) + (xv[r][2] * w[2] + xv[r][3] * w[3]); }
    }
    const float* gb = a.in[17] + l * 4; const float* eb = a.in[19] + l * 32;
#pragma unroll
    for (int r = 0; r < 2; ++r) {
#pragma unroll
        for (int c = 0; c < 36; ++c) acc[r][c] = wave_sum(acc[r][c]);
        float gl[4];
#pragma unroll
        for (int c = 0; c < 4; ++c) gl[c] = acc[r][c] + gb[c];
        int gi = 0; float gm = gl[0];
#pragma unroll
        for (int c = 1; c < 4; ++c) if (gl[c] > gm) { gm = gl[c]; gi = c; }
        float gs = 0.f;
#pragma unroll
        for (int c = 0; c < 4; ++c) gs += expf(gl[c] - gm);
        const float gtop = 1.0f / gs;
        float ev[8];
#pragma unroll
        for (int c = 0; c < 8; ++c) { const float v0 = acc[r][4 + c] + eb[c], v1 = acc[r][12 + c] + eb[8 + c], v2 = acc[r][20 + c] + eb[16 + c], v3 = acc[r][28 + c] + eb[24 + c]; ev[c] = gi == 0 ? v0 : (gi == 1 ? v1 : (gi == 2 ? v2 : v3)); }
        int i1 = 0; float m1 = ev[0];
#pragma unroll
        for (int c = 1; c < 8; ++c) if (ev[c] > m1) { m1 = ev[c]; i1 = c; }
        int i2 = -1; float m2 = -INFINITY;
#pragma unroll
        for (int c = 0; c < 8; ++c) if (c != i1 && ev[c] > m2) { m2 = ev[c]; i2 = c; }
        const float p2 = expf(m2 - m1), den = 1.0f + p2;
        const float w1 = gtop / den, w2 = gtop * p2 / den;
        if (lane == 0 && commit) { const int tok = row0 + r; const int e1 = gi * 8 + i1, e2 = gi * 8 + i2;
            const unsigned s1 = __hip_atomic_fetch_add(cnt + e1 * 64, 1u, __ATOMIC_RELAXED, __HIP_MEMORY_SCOPE_AGENT), s2 = __hip_atomic_fetch_add(cnt + e2 * 64, 1u, __ATOMIC_RELAXED, __HIP_MEMORY_SCOPE_AGENT);
            ltok[e1 * SMT + s1] = tok; lgate[e1 * SMT + s1] = w1; ltok[e2 * SMT + s2] = tok; lgate[e2 * SMT + s2] = w2;
            tinfo[tok * 2] = e1 * SMT + (int)s1; tinfo[tok * 2 + 1] = e2 * SMT + (int)s2; }
    }
}
__device__ __forceinline__ void moe_tables(const Frame& F, int l) {
    LAS int* toff = (LAS int*)(F.lds + LDS_TOFF); const unsigned* cnt = F.ctl + CW_CNT + (l * 2 + F.sid) * 32 * 64;
    __syncthreads();
    if (F.tid == 0) { int run = 0; for (int e = 0; e < 32; ++e) { toff[e] = run; run += ((int)cnt[e * 64] + 255) >> 8; } toff[32] = run; }
    __syncthreads();
}
__device__ __forceinline__ void ln2_rows(const Frame& F, const Args& a, int l, float* OUT, bool write_xb) {
    const bf16_t* PRE = (const bf16_t*)(F.ws + WS_PRE); const bf16_t* Y = F.Y; bf16_t* XB = (bf16_t*)(F.ws + WS_XB); const int* tinfo = (const int*)(F.ws + WS_TINFO);
    const LAS int* toff = (const LAS int*)(F.lds + LDS_TOFF);
    const float* g = a.in[26] + (size_t)l * DM; const float* bb = a.in[27] + (size_t)l * DM; const int lane = F.lane;
    for (int row0 = F.row0 + (F.bx * 8 + F.wave) * 2; row0 < F.row0 + SMT; row0 += F.G * 16) {
        f32x4 v[2][8]; float s[2] = {0.f, 0.f};
#pragma unroll
        for (int r = 0; r < 2; ++r) { const int row = row0 + r; const int i0 = tinfo[row * 2], i1 = tinfo[row * 2 + 1];
            const size_t s0 = (size_t)toff[i0 >> 12] * 256 + (i0 & 4095), s1 = (size_t)toff[i1 >> 12] * 256 + (i1 & 4095);
            const bf16_t* pr = PRE + (size_t)row * DM; const bf16_t* y0 = Y + s0 * DM; const bf16_t* y1 = Y + s1 * DM;
#pragma unroll
            for (int j = 0; j < 8; ++j) { const u32x2 pw = *(const u32x2*)(pr + 256 * j + 4 * lane), a0 = *(const u32x2*)(y0 + 256 * j + 4 * lane), a1 = *(const u32x2*)(y1 + 256 * j + 4 * lane);
                v[r][j][0] = bflo(pw.x) + (bflo(a0.x) + bflo(a1.x)); v[r][j][1] = bfhi(pw.x) + (bfhi(a0.x) + bfhi(a1.x)); v[r][j][2] = bflo(pw.y) + (bflo(a0.y) + bflo(a1.y)); v[r][j][3] = bfhi(pw.y) + (bfhi(a0.y) + bfhi(a1.y));
                s[r] += (v[r][j][0] + v[r][j][1]) + (v[r][j][2] + v[r][j][3]); } }
#pragma unroll
        for (int r = 0; r < 2; ++r) { const int row = row0 + r;
            const float mean = wave_sum(s[r]) * (1.f / DM); float q = 0.f;
#pragma unroll
            for (int j = 0; j < 8; ++j) { v[r][j] = v[r][j] - mean; q += (v[r][j][0] * v[r][j][0] + v[r][j][1] * v[r][j][1]) + (v[r][j][2] * v[r][j][2] + v[r][j][3] * v[r][j][3]); }
            const float rstd = 1.0f / sqrtf(wave_sum(q) * (1.f / DM) + LN_EPS);
#pragma unroll
            for (int j = 0; j < 8; ++j) { const f32x4 gv = *(const f32x4*)(g + 256 * j + 4 * lane), bv = *(const f32x4*)(bb + 256 * j + 4 * lane); const f32x4 y = v[r][j] * rstd * gv + bv;
                if (write_xb) *(u32x2*)(XB + (size_t)row * DM + 256 * j + 4 * lane) = (u32x2){pk2(y[0], y[1]), pk2(y[2], y[3])}; else *(f32x4*)(OUT + (size_t)row * DM + 256 * j + 4 * lane) = y; } }
    }
}

constexpr int PH_PER_LAYER = 9, N_PHASES = 1 + NL * PH_PER_LAYER;
__global__ void __launch_bounds__(512, 2) mega(Args args) {
    extern __shared__ __attribute__((aligned(16))) unsigned char lds_raw[];
    const int bxg = blockIdx.x, Gg = gridDim.x;
    Frame F; F.lds = (LAS unsigned char*)lds_raw; F.ws = args.ws; F.ctl = (unsigned*)(args.ws + WS_CTL);
    F.tid = threadIdx.x; F.lane = F.tid & 63; F.wave = __builtin_amdgcn_readfirstlane(F.tid >> 6);
    F.sid = (bxg >> 3) & 1; F.row0 = F.sid * SMT; F.G = Gg >> 1; F.bx = ((bxg >> 4) << 3) | (bxg & 7);
    F.U = nullptr; F.MIX = nullptr; F.Y = nullptr; F.H = nullptr;
    if (F.tid < 4) ((LAS unsigned*)(F.lds + LDS_BARW))[F.tid] = 0u;
    __syncthreads();
    XcdBarrier barS = xcd_barrier_post(F.ctl + CW_BAR + F.sid * XCD_BAR_WORDS, (volatile LAS unsigned*)(F.lds + LDS_BARW), (unsigned)(Gg >> 1));
    XcdBarrier barG = xcd_barrier_post(F.ctl + CW_BAR + 2 * XCD_BAR_WORDS, (volatile LAS unsigned*)(F.lds + LDS_BARW + 8), (unsigned)Gg);
#define SBAR() xcd_barrier(barS)
#define WSP(T, off) ((T*)(f.ws + (off)))

    { Frame g = F; g.G = Gg; g.bx = bxg; g.sid = 0; const Frame f = g.fresh(); phase_prologue(f, args); }
    xcd_barrier(barG);
    { const Frame f = F.fresh(); if (f.sid == 1) { conv_all(f, args, 0, IO_PG, I_L); flag_publish(f.ctl + CW_FLAG + 0 * 64, f.tid); } }

#pragma unroll 1
    for (int l = 0; l < NL; ++l) {
        { const Frame f = F.fresh(); if (l == 1 && f.sid == 1) flag_wait(f.ctl + CW_FLAG + 1 * 64, (unsigned)f.G, f.ctl + CW_BAR + XB_TMO, f.tid);
            pg8::DenseSched S; S.init(WSP(const bf16_t, WS_XB) + (size_t)f.row0 * DM, WSP(const bf16_t, WS_WIN) + (size_t)l * DINP * DM, DM, DM, SMT, DINP, f.G, f.bx); S.wave = f.wave;
            pg8::EpiBf16 E{f.U + (size_t)f.row0 * DINP, DINP}; pg8::gemm_phase(f.lds, DM, S, E); }
        SBAR();
        { { const Frame f = F.fresh(); for (int u = f.bx; u < 128; u += f.G) conv_unit(f, args, l, f.sid * 128 + u); }
          { const Frame f = F.fresh(); for (int u = f.bx; u < 512; u += f.G) gla_a_unit(f, args, l, f.sid * 512 + u); } __syncthreads(); }
        SBAR();
        { { const Frame f = F.fresh(); gla_scan(f); }
            const Frame f = F.fresh();
            LAS float* bt = (LAS float*)(f.lds + 8 * 2 * AT_VBUF);
            __syncthreads();
            for (int i = f.tid; i < 3 * 129 * 8; i += 512) bt[i] = WSP(const float, WS_BTAB)[i];
            __syncthreads();
            for (int job = f.bx * 8 + f.wave; job < 16 * 3 * 128; job += f.G * 8) attn_job(f, f.sid * 16 * 3 * 128 + job, f.lds + f.wave * 2 * AT_VBUF, bt);
            __syncthreads(); }
        SBAR();
        { { const Frame f = F.fresh(); gla_c_phase(f, args, l); __syncthreads(); } { const Frame f = F.fresh(); attn_combine(f); } }
        SBAR();
        { { const Frame f = F.fresh(); pg8::DenseSched S; S.init(f.MIX + (size_t)f.row0 * DM, WSP(const bf16_t, WS_WOUT) + (size_t)l * DM * DM, DM, DM, SMT, DM, f.G, f.bx); S.wave = f.wave;
              pg8::EpiRes E{WSP(bf16_t, WS_PRE) + (size_t)f.row0 * DM, WSP(const bf16_t, WS_XB) + (size_t)f.row0 * DM, DM, DN_ALPHA}; pg8::gemm_phase(f.lds, DM, S, E); }
          { const Frame f = F.fresh(); pg8::DenseSched S; S.init(WSP(const bf16_t, WS_PB) + ((size_t)l * MT + f.row0) * PLE, WSP(const bf16_t, WS_WPP) + (size_t)l * DM * PLE, PLE, PLE, SMT, DM, f.G, f.bx); S.wave = f.wave;
              pg8::EpiBf16 E{WSP(bf16_t, WS_PP) + (size_t)f.row0 * DM, DM}; pg8::gemm_phase(f.lds, PLE, S, E); } }
        SBAR();
        { const Frame f = F.fresh(); for (int u = f.bx; u < SMT / 16; u += f.G) ln1_unit(f, args, l, f.sid * (SMT / 16) + u, true); __syncthreads(); }
        SBAR();
        { { const Frame f = F.fresh(); if (f.sid == 0) flag_wait(f.ctl + CW_FLAG + (l == 0 ? 0 : 2) * 64, (unsigned)f.G, f.ctl + CW_BAR + XB_TMO, f.tid);
              pg8::DenseSched S; S.init(WSP(const bf16_t, WS_XB) + (size_t)f.row0 * DM, WSP(const bf16_t, WS_WPG) + (size_t)l * DM * DM, DM, DM, SMT, DM, f.G, f.bx); S.wave = f.wave;
              pg8::EpiPle E{WSP(bf16_t, WS_PRE) + (size_t)f.row0 * DM, WSP(const bf16_t, WS_XB) + (size_t)f.row0 * DM, WSP(const bf16_t, WS_PP) + (size_t)f.row0 * DM, args.in[24] + (size_t)l * DM, DM, DN_ALPHA}; pg8::gemm_phase(f.lds, DM, S, E); }
          { const Frame f = F.fresh(); moe_tables(f, l);
              pg8::MoeSched<true> S; S.A = WSP(const bf16_t, WS_XB); S.Bt = WSP(const bf16_t, WS_WGU) + (size_t)l * NEXP * 512 * DM; S.lda = DM; S.ldb = DM; S.nN = 2; S.G = f.G; S.c = f.bx; S.wave = f.wave; S.bexp = (size_t)512 * DM * 2;
              S.toff = (const LAS int*)(f.lds + LDS_TOFF); S.cnt = f.ctl + CW_CNT + (l * 2 + f.sid) * 32 * 64; S.ltok = WSP(const int, WS_LTOK) + f.sid * 32 * SMT;
              pg8::EpiMoe1 E{f.H, WSP(const float, WS_LGATE) + f.sid * 32 * SMT, f.ctl + CW_CNT + (l * 2 + f.sid) * 32 * 64};
              const int total = __builtin_amdgcn_readfirstlane(S.toff[32]) * 2;
#pragma unroll 1
              for (int r0 = 0; r0 * f.G < total; ++r0) { S.round0 = r0; pg8::gemm_phase<pg8::EpiMoe1, pg8::MoeSched<true>, true>(f.lds, DM, S, E); } } }
        SBAR();
        { const Frame f = F.fresh(); moe_tables(f, l);
            pg8::MoeSched<false> S; S.A = f.H; S.Bt = WSP(const bf16_t, WS_WD) + (size_t)l * NEXP * DM * DEXP; S.lda = DEXP; S.ldb = DEXP; S.nN = 8; S.G = f.G; S.c = f.bx; S.wave = f.wave; S.bexp = (size_t)DM * DEXP * 2;
            S.toff = (const LAS int*)(f.lds + LDS_TOFF); S.cnt = f.ctl + CW_CNT + (l * 2 + f.sid) * 32 * 64; S.ltok = WSP(const int, WS_LTOK) + f.sid * 32 * SMT;
            pg8::EpiBf16 E{f.Y, DM}; pg8::gemm_phase(f.lds, DEXP, S, E); }
        SBAR();
        { { const Frame f = F.fresh(); moe_tables(f, l); ln2_rows(f, args, l, args.out, l + 1 < NL); }
          if (l + 1 < NL) { const Frame f = F.fresh();
              if (f.sid == 0) { conv_all(f, args, l + 1, 0, IO_PG); flag_publish(f.ctl + CW_FLAG + 1 * 64, f.tid); }
              else            { conv_all(f, args, l + 1, IO_PG, I_L); flag_publish(f.ctl + CW_FLAG + 2 * 64, f.tid); } } }
        SBAR();
    }
#undef WSP
#undef SBAR
}

extern "C" void kernel_launch(void* const* d_in, const int* in_sizes, int n_in, void* d_out, int out_size, void* d_ws, size_t ws_size, hipStream_t stream) {
    static int grid = 0;
    if (grid == 0) {
        if (n_in != 28 || out_size != MT * DM || ws_size < WS_END) { fprintf(stderr, "kernel_launch: unexpected shapes (n_in %d, out %d, ws %zu); nothing launched\n", n_in, out_size, ws_size); grid = -1; return; }
        int dev = 0, cus = 0, per_cu = 0;
        if (hipGetDevice(&dev) != hipSuccess || hipDeviceGetAttribute(&cus, hipDeviceAttributeMultiprocessorCount, dev) != hipSuccess) { grid = -1; return; }
        if (hipFuncSetAttribute((const void*)mega, hipFuncAttributeMaxDynamicSharedMemorySize, LDS_BYTES) != hipSuccess) { fprintf(stderr, "kernel_launch: hipFuncSetAttribute failed\n"); grid = -1; return; }
        if (hipOccupancyMaxActiveBlocksPerMultiprocessor(&per_cu, (const void*)mega, 512, LDS_BYTES) != hipSuccess || per_cu < 1) { fprintf(stderr, "kernel_launch: occupancy query says %d\n", per_cu); }
        (void)hipGetLastError();
        grid = cus;
    }
    if (grid < 0) return;
    (void)hipMemsetAsync((char*)d_ws + WS_CTL, 0, CTL_ZERO_BYTES, stream);
    Args a{};
    for (int i = 0; i < 28; ++i) a.in[i] = (const float*)d_in[i];
    a.out = (float*)d_out; a.ws = (unsigned char*)d_ws;
    a.ph_lo = 0; a.ph_hi = 0; hipLaunchKernelGGL(mega, dim3(grid), dim3(512), LDS_BYTES, stream, a);
}
```

```cpp
#include <hip/hip_runtime.h>
#include <cstdio>
#include <cstdint>

#ifndef REP_MASK
#define REP_MASK 0
#endif
#define REPS(k) (1 + ((REP_MASK >> (k)) & 1))
#ifndef LAUNCH_PER_PHASE
#define LAUNCH_PER_PHASE 0
#endif

#define LAS __attribute__((address_space(3)))
#define GAS __attribute__((address_space(1)))
typedef unsigned short bf16_t;
typedef short bf16x8 __attribute__((ext_vector_type(8)));
typedef float f32x4 __attribute__((ext_vector_type(4)));
typedef float f32x2 __attribute__((ext_vector_type(2)));
typedef unsigned u32x4 __attribute__((ext_vector_type(4)));
typedef unsigned u32x2 __attribute__((ext_vector_type(2)));

constexpr int NL = 2, NBATCH = 4, SEQ = 2048, DM = 2048, MT = NBATCH * SEQ;
constexpr int DIN = 5648, DINP = 5888, PLE = 256, NEXP = 32, DEXP = 256;
constexpr int UA_VAL = 0, UA_GATE = 512, UG_Q = 1024, UG_K = 1280, UG_V = 1536, UG_R = 2048, UC_Q = 2560, UC_K = 3072, UC_V = 3584, US_B = 4096, US_C = 4608, US_H = 5120, UG_LOW = 5632;
constexpr float DN_ALPHA = 1.41421356237309515f, LN_EPS = 1e-5f, RMS_EPS = 1e-6f;
constexpr int NSTREAM = 2, SMT = MT / NSTREAM;
constexpr int MAXSLOT = 16384;

constexpr size_t MiB = 1u << 20;
constexpr size_t WS_CTL = 0, CTL_ZERO_BYTES = 1 * MiB;
constexpr size_t WS_BTAB = 1 * MiB;
constexpr size_t WS_WRT = 1 * MiB + 64 * 1024;
constexpr size_t WS_LTOK = 2 * MiB;
constexpr size_t WS_LGATE = 3 * MiB;
constexpr size_t WS_TINFO = 4 * MiB;
constexpr size_t WS_WIN = 8 * MiB;
constexpr size_t WS_WOUT = 54 * MiB;
constexpr size_t WS_WGU = 70 * MiB;
constexpr size_t WS_WD = 198 * MiB;
constexpr size_t WS_WPG = 262 * MiB;
constexpr size_t WS_WPP = 278 * MiB;
constexpr size_t WS_XB = 280 * MiB;
constexpr size_t WS_PB = 312 * MiB;
constexpr size_t WS_ARENA = 320 * MiB, ARENA = 64 * MiB;
constexpr size_t ARENA_MIX = 46 * MiB;
constexpr size_t WS_PRE = 448 * MiB;
constexpr size_t WS_GU = 448 * MiB;
constexpr size_t WS_GO = 480 * MiB;
constexpr size_t WS_GQ = 496 * MiB;
constexpr size_t WS_GD = 504 * MiB;
constexpr size_t WS_PP = 512 * MiB;
constexpr size_t WS_AO = 560 * MiB;
constexpr size_t WS_ALSE = 584 * MiB;
constexpr size_t WS_H = 544 * MiB, HSTREAM = 8 * MiB;
constexpr size_t WS_END = 585 * MiB;
static_assert((size_t)SMT * DINP * 2 <= ARENA_MIX && ARENA_MIX + (size_t)SMT * DM * 2 <= ARENA && (size_t)MAXSLOT * DM * 2 <= ARENA && WS_ARENA + NSTREAM * ARENA <= 448 * MiB, "ws map");
constexpr int CW_BAR = 4096;
constexpr int CW_FLAG = 14592;
constexpr int CW_CNT = 16384;

constexpr int LDS_STAGE = 135168;
constexpr int LDS_TOFF = LDS_STAGE;
constexpr int LDS_BARW = LDS_STAGE + 512;
constexpr int LDS_BYTES = LDS_STAGE + 1024;

__device__ __forceinline__ float bf2f(unsigned b) { return __uint_as_float(b << 16); }
__device__ __forceinline__ unsigned f2bf(float f) { unsigned u = __float_as_uint(f); return (u + 0x7fffu + ((u >> 16) & 1u)) >> 16; }
__device__ __forceinline__ unsigned pk2(float lo, float hi) { unsigned r; asm("v_cvt_pk_bf16_f32 %0, %1, %2" : "=v"(r) : "v"(lo), "v"(hi)); return r; }
__device__ __forceinline__ float bflo(unsigned w) { return __uint_as_float(w << 16); }
__device__ __forceinline__ float bfhi(unsigned w) { return __uint_as_float(w & 0xffff0000u); }
__device__ __forceinline__ float wave_sum(float v) {
#pragma unroll
    for (int o = 1; o < 64; o <<= 1) v += __shfl_xor(v, o);
    return v;
}
__device__ __forceinline__ float wave_max(float v) {
#pragma unroll
    for (int o = 1; o < 64; o <<= 1) v = fmaxf(v, __shfl_xor(v, o));
    return v;
}
__device__ __forceinline__ float sigmoidf_(float x) { return 1.0f / (1.0f + __expf(-x)); }
__device__ __forceinline__ float siluf_(float x) { return x / (1.0f + __expf(-x)); }
#define LDS_WAIT() asm volatile("s_waitcnt lgkmcnt(0)" ::: "memory")
__device__ __forceinline__ f32x4 zero4() { float z = 0.f; asm volatile("" : "+v"(z)); return (f32x4){z, z, z, z}; }

namespace pg8 {
constexpr int BM = 256, BK = 64, HALF = 128, HTB = HALF * BK * 2, STAGE_BYTES = 8 * HTB, NXCD = 8, WGM = 8;
__host__ __device__ __forceinline__ int lds_byte(int r, int c) { const int st = (r >> 4) * 2 + (c >> 5), rr = r & 15, cc = c & 31, ob = rr * 64 + cc * 2; return st * 1024 + (ob ^ (((ob >> 9) & 1) << 5)); }
__host__ __device__ __forceinline__ void stage_rc(int b, int& R, int& C) { const int st = b / 1024, sb = b % 1024, swz = sb ^ (((sb >> 9) & 1) << 5); R = (st >> 1) * 16 + swz / 64; C = (st & 1) * 32 + (swz % 64) / 2; }
__host__ __device__ __forceinline__ int perm32(int rho) { const int n = rho >> 4, i = rho & 15; return 8 * (i >> 2) + 4 * n + (i & 3); }

struct Unit { int pm, pn, e, r; };

struct DenseSched {
    static constexpr bool GATHER = false;
    const bf16_t* A; const bf16_t* Bt; int lda, ldb, nM, nN, nwg, G, c, wave;
    __device__ void init(const bf16_t* A_, const bf16_t* Bt_, int lda_, int ldb_, int M, int N, int G_, int c_) { A = A_; Bt = Bt_; lda = lda_; ldb = ldb_; nM = M / BM; nN = N / BM; nwg = nM * nN; G = G_; c = c_; }
    __device__ __forceinline__ bool next(int i, Unit& u) const {
        const long L = (long)i * G + c; if (L >= nwg) return false;
        int wgid = (int)L; { const int q = nwg / NXCD, r = nwg % NXCD, xcd = wgid % NXCD, off = wgid / NXCD; wgid = (xcd < r ? xcd * (q + 1) : r * (q + 1) + (xcd - r) * q) + off; }
        const int nig = WGM * nN, gid = wgid / nig, fm = gid * WGM, gsz = (nM - fm) < WGM ? (nM - fm) : WGM;
        u.pm = fm + ((wgid % nig) % gsz); u.pn = (wgid % nig) / gsz; u.e = 0; u.r = 0; return true;
    }
    __device__ __forceinline__ const char* a_base(const Unit& u) const { return (const char*)A + (size_t)u.pm * BM * lda * 2; }
    __device__ __forceinline__ const char* b_base(const Unit& u) const { return (const char*)Bt + (size_t)u.pn * BM * ldb * 2; }
    __device__ __forceinline__ void a_offs(const Unit&, int, unsigned (&vo)[2][2]) const { }
};
template <bool GATHER_> struct MoeSched {
    static constexpr bool GATHER = GATHER_;
    const bf16_t* A; const bf16_t* Bt; int lda, ldb, nN, G, c, wave; size_t bexp;
    const LAS int* toff; const unsigned* cnt; const int* ltok; int round0 = 0;
    __device__ __forceinline__ bool next(int i, Unit& u) const {
        const int L = (i + round0) * G + c; const int total = __builtin_amdgcn_readfirstlane(toff[32]) * nN; if (L >= total) return false;
        const int j = L / nN; u.pn = L - j * nN; int e = 0;
#pragma unroll 1
        for (int k = 1; k < 32; ++k) e = (__builtin_amdgcn_readfirstlane(toff[k]) <= j) ? k : e;
        u.e = e; u.r = j - __builtin_amdgcn_readfirstlane(toff[e]); u.pm = j; return true;
    }
    __device__ __forceinline__ const char* a_base(const Unit& u) const { return GATHER ? (const char*)A : (const char*)A + (size_t)u.pm * BM * lda * 2; }
    __device__ __forceinline__ const char* b_base(const Unit& u) const { return (const char*)Bt + (size_t)u.e * bexp + (size_t)u.pn * BM * ldb * 2; }
    __device__ __forceinline__ void a_offs(const Unit& u, int tid, unsigned (&vo)[2][2]) const {
        if constexpr (GATHER) {
        int R[2], C[2]; stage_rc(tid * 16, R[0], C[0]); stage_rc(tid * 16 + 8192, R[1], C[1]);
        const int n = __builtin_amdgcn_readfirstlane((int)cnt[u.e * 64]);
#pragma unroll
        for (int h = 0; h < 2; ++h)
#pragma unroll
            for (int i = 0; i < 2; ++i) {
                const int sr = u.r * BM + h * HALF + R[i]; const int row = (sr < n) ? ltok[u.e * SMT + sr] : 0;
                vo[h][i] = (unsigned)(row * lda + C[i]) * 2u;
            }
        }
    }
};

__device__ __forceinline__ unsigned cvt_pk_bf16(float lo, float hi) { unsigned r; asm volatile("v_cvt_pk_bf16_f32 %0, %1, %2" : "=v"(r) : "v"(lo), "v"(hi)); return r; }

struct EpiBf16 {
    static constexpr bool PERM = true;
    bf16_t* O; int ldc;
    __device__ __forceinline__ void operator()(const f32x4 (&acc)[2][2][4][2], const Unit& u, int wr, int wc, int fr, int fq) const {
        const int row0 = u.pm * BM + wr * 64 + fr, col0 = u.pn * BM + wc * 32 + 8 * fq;
#pragma unroll
        for (int ai = 0; ai < 2; ++ai)
#pragma unroll
            for (int m = 0; m < 4; ++m) { bf16_t* rowp = O + (size_t)(row0 + ai * HALF + m * 16) * ldc + col0;
#pragma unroll
                for (int bj = 0; bj < 2; ++bj) { const f32x4 v0 = acc[ai][bj][m][0], v1 = acc[ai][bj][m][1];
                    u32x4 w; w.x = cvt_pk_bf16(v0[0], v0[1]); w.y = cvt_pk_bf16(v0[2], v0[3]); w.z = cvt_pk_bf16(v1[0], v1[1]); w.w = cvt_pk_bf16(v1[2], v1[3]);
                    *(u32x4*)(rowp + bj * HALF) = w; } }
    }
};
struct EpiRes {
    static constexpr bool PERM = true;
    bf16_t* C; const bf16_t* res; int ldc; float alpha;
    __device__ __forceinline__ void operator()(const f32x4 (&acc)[2][2][4][2], const Unit& u, int wr, int wc, int fr, int fq) const {
        const int row0 = u.pm * BM + wr * 64 + fr, col0 = u.pn * BM + wc * 32 + 8 * fq;
#pragma unroll
        for (int ai = 0; ai < 2; ++ai)
#pragma unroll
            for (int m = 0; m < 4; ++m) { const size_t off = (size_t)(row0 + ai * HALF + m * 16) * ldc + col0;
#pragma unroll
                for (int bj = 0; bj < 2; ++bj) { const u32x4 rv = *(const u32x4*)(res + off + bj * HALF); const f32x4 v0 = acc[ai][bj][m][0], v1 = acc[ai][bj][m][1];
                    u32x4 w; w.x = cvt_pk_bf16(bflo(rv.x) * alpha + v0[0], bfhi(rv.x) * alpha + v0[1]); w.y = cvt_pk_bf16(bflo(rv.y) * alpha + v0[2], bfhi(rv.y) * alpha + v0[3]);
                    w.z = cvt_pk_bf16(bflo(rv.z) * alpha + v1[0], bfhi(rv.z) * alpha + v1[1]); w.w = cvt_pk_bf16(bflo(rv.w) * alpha + v1[2], bfhi(rv.w) * alpha + v1[3]);
                    *(u32x4*)(C + off + bj * HALF) = w; }
                asm volatile("" ::: "memory"); }
    }
};
struct EpiPle {
    static constexpr bool PERM = true;
    bf16_t* C; const bf16_t* x1; const bf16_t* pp; const float* bias; int ldc; float alpha;
    __device__ __forceinline__ void operator()(const f32x4 (&acc)[2][2][4][2], const Unit& u, int wr, int wc, int fr, int fq) const {
        const int row0 = u.pm * BM + wr * 64 + fr, col0 = u.pn * BM + wc * 32 + 8 * fq;
        f32x4 bv[2][2];
#pragma unroll
        for (int bj = 0; bj < 2; ++bj)
#pragma unroll
            for (int n = 0; n < 2; ++n) bv[bj][n] = *(const f32x4*)(bias + col0 + bj * HALF + 4 * n);
#pragma unroll
        for (int ai = 0; ai < 2; ++ai)
#pragma unroll
            for (int m = 0; m < 4; ++m) { const size_t off = (size_t)(row0 + ai * HALF + m * 16) * ldc + col0;
#pragma unroll
                for (int bj = 0; bj < 2; ++bj) { const size_t o = off + bj * HALF; const u32x4 xv = *(const u32x4*)(x1 + o), pw = *(const u32x4*)(pp + o);
                    const f32x4 a0 = acc[ai][bj][m][0] + bv[bj][0], a1 = acc[ai][bj][m][1] + bv[bj][1];
                    u32x4 w;
                    w.x = cvt_pk_bf16(bflo(xv.x) * alpha + sigmoidf_(a0[0]) * bflo(pw.x), bfhi(xv.x) * alpha + sigmoidf_(a0[1]) * bfhi(pw.x));
                    w.y = cvt_pk_bf16(bflo(xv.y) * alpha + sigmoidf_(a0[2]) * bflo(pw.y), bfhi(xv.y) * alpha + sigmoidf_(a0[3]) * bfhi(pw.y));
                    w.z = cvt_pk_bf16(bflo(xv.z) * alpha + sigmoidf_(a1[0]) * bflo(pw.z), bfhi(xv.z) * alpha + sigmoidf_(a1[1]) * bfhi(pw.z));
                    w.w = cvt_pk_bf16(bflo(xv.w) * alpha + sigmoidf_(a1[2]) * bflo(pw.w), bfhi(xv.w) * alpha + sigmoidf_(a1[3]) * bfhi(pw.w));
                    *(u32x4*)(C + o) = w; }
                asm volatile("" ::: "memory"); }
    }
};
struct EpiMoe1 {
    static constexpr bool PERM = true;
    bf16_t* H; const float* lgate; const unsigned* cnt;
    __device__ __forceinline__ void operator()(const f32x4 (&acc)[2][2][4][2], const Unit& u, int wr, int wc, int fr, int fq) const {
        const int n_e = __builtin_amdgcn_readfirstlane((int)cnt[u.e * 64]);
        const int col0 = u.pn * HALF + wc * 32 + 8 * fq;
#pragma unroll
        for (int ai = 0; ai < 2; ++ai)
#pragma unroll
            for (int m = 0; m < 4; ++m) { const int rt = ai * HALF + wr * 64 + m * 16 + fr; const int sr = u.r * BM + rt;
                const float gw = (sr < n_e) ? lgate[u.e * SMT + sr] : 0.f;
                const f32x4 g0 = acc[ai][0][m][0], g1 = acc[ai][0][m][1], u0 = acc[ai][1][m][0], u1 = acc[ai][1][m][1];
                float o[8];
#pragma unroll
                for (int j = 0; j < 4; ++j) { o[j] = siluf_(g0[j]) * u0[j] * gw; o[4 + j] = siluf_(g1[j]) * u1[j] * gw; }
                u32x4 w; w.x = cvt_pk_bf16(o[0], o[1]); w.y = cvt_pk_bf16(o[2], o[3]); w.z = cvt_pk_bf16(o[4], o[5]); w.w = cvt_pk_bf16(o[6], o[7]);
                *(u32x4*)(H + (size_t)(u.pm * BM + rt) * DEXP + col0) = w; }
    }
};

template <class Epi, class Sched, bool SINGLE = false>
__device__ __forceinline__ void gemm_phase(LAS unsigned char* lds, const int K, const Sched& S, const Epi& E) {
    constexpr bool GA = Sched::GATHER;
    int lane_ = (int)__builtin_amdgcn_mbcnt_hi(~0u, __builtin_amdgcn_mbcnt_lo(~0u, 0u)); asm volatile("" : "+v"(lane_));
    const int wid = S.wave, lane = lane_, tid = wid * 64 + lane_, wr = wid >> 2, wc = wid & 3, fr = lane & 15, fq = lane >> 4;
    const int nt = K / BK, ldb = S.ldb, lda = S.lda;
    unsigned voffB[2], voffA[2];
#pragma unroll
    for (int i = 0; i < 2; ++i) { int R, C; stage_rc(tid * 16 + i * 8192, R, C); const int Rb = Epi::PERM ? ((R & ~31) + perm32(R & 31)) : R; voffB[i] = (unsigned)(Rb * ldb + C) * 2u; voffA[i] = (unsigned)(R * lda + C) * 2u; }
    const size_t kstep = (size_t)(BK * 2);
    const size_t hstep = (size_t)HALF * ldb * 2;
    const size_t ahstep = GA ? 0 : (size_t)HALF * lda * 2;
    const unsigned ldsw = (unsigned)wid * 1024u;
    const int aoff = lds_byte(wr * 64 + fr, fq * 8), boff = lds_byte(wc * 32 + fr, fq * 8);
#define PG8_SA(b, h) (((b) * 2 + (h)) * HTB)
#define PG8_SB(b, h) ((4 + (b) * 2 + (h)) * HTB)
#define PG8_STAGE(bufoff, gbase, voff) do { _Pragma("unroll") for (int _i = 0; _i < 2; ++_i) \
        __builtin_amdgcn_global_load_lds((const unsigned*)((const char*)(gbase) + (voff)[_i]), (LAS unsigned*)(lds + (bufoff) + ldsw + _i * 8192), 16, 0, 0); } while (0)
#define PG8_STAGE_A(bufoff, gbase, h) do { if constexpr (GA) PG8_STAGE(bufoff, gbase, voA[h]); else PG8_STAGE(bufoff, (gbase) + (h) * ahstep, voffA); } while (0)
#define PG8_STAGE_A2(bufoff, gbase, h) do { if constexpr (GA) { unsigned _v[2] = {last ? voN[h][0] : voA[h][0], last ? voN[h][1] : voA[h][1]}; PG8_STAGE(bufoff, gbase, _v); } else PG8_STAGE(bufoff, (gbase) + (h) * ahstep, voffA); } while (0)
#define PG8_LDA(dst, b, h) do { _Pragma("unroll") for (int m = 0; m < 4; ++m) _Pragma("unroll") for (int k = 0; k < 2; ++k) dst[m][k] = *(const LAS bf16x8*)(lds + PG8_SA(b, h) + aoff + m * 2048 + k * 1024); } while (0)
#define PG8_LDB(dst, b, h) do { _Pragma("unroll") for (int n = 0; n < 2; ++n) _Pragma("unroll") for (int k = 0; k < 2; ++k) dst[n][k] = *(const LAS bf16x8*)(lds + PG8_SB(b, h) + boff + n * 2048 + k * 1024); } while (0)
#define PG8_MMA(ai, bj, At, Bt) do { __builtin_amdgcn_s_setprio(1); _Pragma("unroll") for (int m = 0; m < 4; ++m) _Pragma("unroll") for (int n = 0; n < 2; ++n) _Pragma("unroll") for (int k = 0; k < 2; ++k) \
        acc[ai][bj][m][n] = __builtin_amdgcn_mfma_f32_16x16x32_bf16(Bt[n][k], At[m][k], acc[ai][bj][m][n], 0, 0, 0); __builtin_amdgcn_s_setprio(0); } while (0)
#define PG8_WAIT_V(n) asm volatile("s_waitcnt vmcnt(" #n ")" ::: "memory")
#define PG8_WAIT_L(n) asm volatile("s_waitcnt lgkmcnt(" #n ")" ::: "memory")
#define PG8_BAR __builtin_amdgcn_s_barrier()
#define PG8_SCHED __builtin_amdgcn_sched_barrier(0)
    Unit cur, nxt; int ui = 0;
    if (!S.next(0, cur)) return;
    f32x4 acc[2][2][4][2];
#pragma unroll
    for (int a = 0; a < 2; ++a)
#pragma unroll
        for (int b = 0; b < 2; ++b)
#pragma unroll
            for (int m = 0; m < 4; ++m)
#pragma unroll
                for (int n = 0; n < 2; ++n) acc[a][b][m][n] = (f32x4){0.f, 0.f, 0.f, 0.f};
    bf16x8 At[4][2], B0[2][2], B1[2][2];
    const char* cA = S.a_base(cur); const char* cB = S.b_base(cur);
    unsigned voA[2][2], voN[2][2];
    if constexpr (GA) S.a_offs(cur, tid, voA);
    PG8_STAGE(PG8_SB(0, 0), cB, voffB); PG8_STAGE(PG8_SB(0, 1), cB + hstep, voffB); PG8_STAGE_A(PG8_SA(0, 0), cA, 0); PG8_STAGE_A(PG8_SA(0, 1), cA, 1);
    if (wr == 1) PG8_BAR;
    PG8_WAIT_V(2); PG8_BAR;
    PG8_STAGE(PG8_SB(1, 0), cB + kstep, voffB); PG8_STAGE_A(PG8_SA(1, 0), cA + kstep, 0); PG8_STAGE(PG8_SB(1, 1), cB + hstep + kstep, voffB);
    PG8_WAIT_V(6); PG8_BAR;
    for (;;) {
        bool has_next = false; if constexpr (!SINGLE) has_next = S.next(ui + 1, nxt);
        const char* nA = has_next ? S.a_base(nxt) : cA; const char* nB = has_next ? S.b_base(nxt) : cB;
        if constexpr (GA) {
            if (has_next) S.a_offs(nxt, tid, voN);
            else {
#pragma unroll
                for (int h = 0; h < 2; ++h)
#pragma unroll
                    for (int i = 0; i < 2; ++i) voN[h][i] = voA[h][i]; } }
#pragma unroll 1
        for (int t = 0; t < nt; t += 2) {
            const bool last = (t == nt - 2);
            const char* a1 = cA + (size_t)(t + 1) * kstep;
            const char* a2 = last ? nA : cA + (size_t)(t + 2) * kstep; const char* b2 = last ? nB : cB + (size_t)(t + 2) * kstep;
            const char* a3 = a2 + kstep; const char* b3 = b2 + kstep;
            PG8_LDB(B0, 0, 0); PG8_LDB(B1, 0, 1); PG8_SCHED; PG8_LDA(At, 0, 0); PG8_STAGE_A(PG8_SA(1, 1), a1, 1);
            PG8_WAIT_V(8); PG8_WAIT_L(0); PG8_BAR; PG8_MMA(0, 0, At, B0); PG8_MMA(0, 1, At, B1); PG8_BAR; PG8_SCHED;
            PG8_LDA(At, 0, 1); PG8_STAGE(PG8_SB(0, 0), b2, voffB); PG8_STAGE(PG8_SB(0, 1), b2 + hstep, voffB); PG8_STAGE_A2(PG8_SA(0, 0), a2, 0);
            PG8_WAIT_V(8); PG8_WAIT_L(0); PG8_BAR; PG8_MMA(1, 0, At, B0); PG8_MMA(1, 1, At, B1); PG8_BAR; PG8_SCHED;
            PG8_LDB(B0, 1, 0); PG8_LDB(B1, 1, 1); PG8_SCHED; PG8_LDA(At, 1, 0); PG8_STAGE_A2(PG8_SA(0, 1), a2, 1);
            PG8_WAIT_V(8); PG8_WAIT_L(0); PG8_BAR; PG8_MMA(0, 0, At, B0); PG8_MMA(0, 1, At, B1); PG8_BAR; PG8_SCHED;
            PG8_LDA(At, 1, 1); PG8_STAGE(PG8_SB(1, 0), b3, voffB); PG8_STAGE(PG8_SB(1, 1), b3 + hstep, voffB); PG8_STAGE_A2(PG8_SA(1, 0), a3, 0);
            PG8_WAIT_V(8); PG8_WAIT_L(0); PG8_BAR; PG8_MMA(1, 0, At, B0); PG8_MMA(1, 1, At, B1); PG8_BAR; PG8_SCHED;
        }
        if (wr == 0) PG8_BAR;
        E(acc, cur, wr, wc, fr, fq);
        if (!has_next) break;
#pragma unroll
        for (int a = 0; a < 2; ++a)
#pragma unroll
            for (int b = 0; b < 2; ++b)
#pragma unroll
                for (int m = 0; m < 4; ++m)
#pragma unroll
                    for (int n = 0; n < 2; ++n) acc[a][b][m][n] = (f32x4){0.f, 0.f, 0.f, 0.f};
        cur = nxt; cA = nA; cB = nB; ++ui;
        if constexpr (GA) {
#pragma unroll
            for (int h = 0; h < 2; ++h)
#pragma unroll
                for (int i = 0; i < 2; ++i) voA[h][i] = voN[h][i]; }
        if (wr == 1) PG8_BAR;
    }
    PG8_WAIT_V(0);
    PG8_BAR;
#undef PG8_SA
#undef PG8_SB
#undef PG8_STAGE
#undef PG8_STAGE_A
#undef PG8_STAGE_A2
#undef PG8_LDA
#undef PG8_LDB
#undef PG8_MMA
#undef PG8_WAIT_V
#undef PG8_WAIT_L
#undef PG8_BAR
#undef PG8_SCHED
}
}

#define XB_TMO      128
#define XB_XCNT(j)  (256  + 64 * (j))
#define XB_XSUB(j)  (1280 + 64 * (j))
#define XB_XGEN(j)  (2304 + 64 * (j))
#define XB_TOP      3328
#define XB_TOPGEN   3392
#define XCD_BAR_WORDS 3456
#define XB_SPIN_CAP (1u << 18)
__device__ __forceinline__ unsigned xb_ld(unsigned* p)              { return __hip_atomic_load(p, __ATOMIC_RELAXED, __HIP_MEMORY_SCOPE_AGENT); }
__device__ __forceinline__ unsigned xb_add(unsigned* p, unsigned v) { return __hip_atomic_fetch_add(p, v, __ATOMIC_RELAXED, __HIP_MEMORY_SCOPE_AGENT); }
__device__ __forceinline__ unsigned xb_xcc_id() { return (unsigned)__builtin_amdgcn_s_getreg((3 << 11) | 20) & 0xFu; }
#define XB_SPIN(cond, bar) do { unsigned _sp = 0; while (cond) { __builtin_amdgcn_s_sleep(1); \
    if ((++_sp & 255u) == 0u) { if (xb_ld(&(bar)[XB_TMO])) break; if (_sp > XB_SPIN_CAP) { atomicAdd(&(bar)[XB_TMO], 1u); break; } } } } while (0)
struct XcdBarrier { unsigned* bar; unsigned x; volatile LAS unsigned* st; unsigned ng; int wave; };
__device__ __forceinline__ XcdBarrier xcd_barrier_post(unsigned* bar, volatile LAS unsigned* st, unsigned ng) {
    XcdBarrier b; b.bar = bar; b.x = xb_xcc_id(); b.st = st; b.ng = ng; b.wave = __builtin_amdgcn_readfirstlane((int)threadIdx.x >> 6);
    if (threadIdx.x == 0) (void)xb_add(&bar[XB_XCNT(b.x)], 1u);
    return b;
}
__device__ __forceinline__ void xcd_barrier_complete(unsigned* bar, unsigned x, unsigned& nloc, unsigned& nx, const unsigned G) {
    unsigned sum, cnt, mine, sp = 0u;
    for (;;) {
        sum = 0u; cnt = 0u; mine = 0u;
#pragma unroll
        for (unsigned j = 0; j < 16; ++j) { const unsigned c = xb_ld(&bar[XB_XCNT(j)]); sum += c; cnt += (c > 0u) ? 1u : 0u; mine = (j == x) ? c : mine; }
        if (sum == G) break;
        __builtin_amdgcn_s_sleep(1);
        if ((++sp & 255u) == 0u) { if (xb_ld(&bar[XB_TMO])) break; if (sp > XB_SPIN_CAP) { atomicAdd(&bar[XB_TMO], 1u); break; } }
    }
    nloc = mine > 0u ? mine : 1u; nx = cnt > 0u ? cnt : 1u;
}
__device__ __forceinline__ void xcd_barrier(const XcdBarrier& b) {
    asm volatile("s_waitcnt vmcnt(0)" ::: "memory");
    __syncthreads();
    int ln_ = (int)__builtin_amdgcn_mbcnt_hi(~0u, __builtin_amdgcn_mbcnt_lo(~0u, 0u)); asm volatile("" : "+v"(ln_));
    if (b.wave == 0 && ln_ == 0) {
        unsigned* bar = b.bar;
        __builtin_amdgcn_s_waitcnt(0);
        unsigned nloc = b.st[0], nx = b.st[1];
        if (nloc == 0u) { xcd_barrier_complete(bar, b.x, nloc, nx, b.ng); b.st[0] = nloc; b.st[1] = nx; }
        const unsigned old = xb_add(&bar[XB_XSUB(b.x)], 1u);
        const unsigned gen = old / nloc;
        if (old + 1u == (gen + 1u) * nloc) {
            __builtin_amdgcn_fence(__ATOMIC_RELEASE, "agent");
            asm volatile("s_waitcnt vmcnt(0)" ::: "memory");
            const unsigned og = xb_add(&bar[XB_TOP], 1u);
            const unsigned tg = og / nx;
            if (og + 1u == (tg + 1u) * nx) xb_add(&bar[XB_TOPGEN], 1u);
            else XB_SPIN(xb_ld(&bar[XB_TOPGEN]) == tg, bar);
            __builtin_amdgcn_fence(__ATOMIC_ACQUIRE, "agent");
            xb_add(&bar[XB_XGEN(b.x)], 1u);
            asm volatile("s_waitcnt vmcnt(0)" ::: "memory");
        } else {
            XB_SPIN(xb_ld(&bar[XB_XGEN(b.x)]) == gen, bar);
            __builtin_amdgcn_fence(__ATOMIC_ACQUIRE, "agent");
            asm volatile("s_waitcnt vmcnt(0)" ::: "memory");
        }
    }
    __syncthreads();
}


__device__ __forceinline__ void flag_publish(unsigned* flag, int tid) {
    asm volatile("s_waitcnt vmcnt(0)" ::: "memory");
    __syncthreads();
    if (tid == 0) { __builtin_amdgcn_fence(__ATOMIC_RELEASE, "agent"); asm volatile("s_waitcnt vmcnt(0)" ::: "memory"); (void)xb_add(flag, 1u); }
}
__device__ __forceinline__ void flag_wait(unsigned* flag, unsigned want, unsigned* tmo, int tid) {
    if (tid == 0) { unsigned sp = 0;
        while (xb_ld(flag) < want) { __builtin_amdgcn_s_sleep(2); if ((++sp & 255u) == 0u) { if (xb_ld(tmo)) break; if (sp > (1u << 22)) { atomicAdd(tmo, 1u); break; } } }
        __builtin_amdgcn_fence(__ATOMIC_ACQUIRE, "agent"); asm volatile("s_waitcnt vmcnt(0)" ::: "memory"); }
    __syncthreads();
}

struct Args { const float* in[28]; float* out; unsigned char* ws; int ph_lo, ph_hi; };

struct Frame {
    LAS unsigned char* lds; unsigned char* ws; unsigned* ctl;
    int tid, lane, wave, G, bx, sid, row0;
    bf16_t *U, *MIX, *Y, *H;
    __device__ __forceinline__ Frame fresh() const { Frame f = *this; int ln = (int)__builtin_amdgcn_mbcnt_hi(~0u, __builtin_amdgcn_mbcnt_lo(~0u, 0u)); asm volatile("" : "+v"(ln)); f.lane = ln; f.tid = wave * 64 + ln;
        int b = bx, g = G, s = sid, wv = wave; unsigned char* w = ws; asm volatile("" : "+s"(b), "+s"(g), "+s"(w), "+s"(s), "+s"(wv)); f.bx = b; f.G = g; f.ws = w; f.sid = s; f.wave = wv; f.tid = wv * 64 + ln; f.row0 = s * SMT; f.ctl = (unsigned*)(w + WS_CTL);
        unsigned char* ar = w + WS_ARENA + (size_t)s * ARENA;
        f.U = (bf16_t*)ar - (size_t)f.row0 * DINP; f.MIX = (bf16_t*)(ar + ARENA_MIX) - (size_t)f.row0 * DM; f.Y = (bf16_t*)ar; f.H = (bf16_t*)(w + WS_H + (size_t)s * HSTREAM); return f; }
};

__device__ __forceinline__ int dmap(int type, int n) {
    if (type == 1) return n < 2048 ? n : (n < 2064 ? n - 2048 + UG_LOW : n - 16);
    if (type == 2) return (n >> 7) * 256 + (n & 127);
    if (type == 3) return (n >> 7) * 256 + 128 + (n & 127);
    return n;
}
__device__ __forceinline__ void transpose_item(const float* W, int ldw, int ncols, int k0, int n0, const float* kscale, bf16_t* WT, int ldt, int type, LAS float* scr, int lane) {
    const int n4 = (lane & 15) * 4, kr = lane >> 4; const bool okc = (n0 + n4) < ncols;
    f32x4 v[16];
#pragma unroll
    for (int i = 0; i < 16; ++i) v[i] = okc ? __builtin_nontemporal_load((const f32x4*)(W + (size_t)(k0 + 4 * i + kr) * ldw + n0 + n4)) : (f32x4){0.f, 0.f, 0.f, 0.f};
    if (kscale) {
#pragma unroll
        for (int i = 0; i < 16; ++i) v[i] = v[i] * kscale[k0 + 4 * i + kr]; }
#pragma unroll
    for (int i = 0; i < 16; ++i) { LAS float* s = scr + (4 * i + kr) * 65 + n4; s[0] = v[i][0]; s[1] = v[i][1]; s[2] = v[i][2]; s[3] = v[i][3]; }
    LDS_WAIT(); asm volatile("" ::: "memory");
    const int c = lane & 7;
#pragma unroll
    for (int j = 0; j < 8; ++j) { const int n = (lane >> 3) + 8 * j; const LAS float* s = scr + (8 * c) * 65 + n;
        u32x4 o; o.x = pk2(s[0 * 65], s[1 * 65]); o.y = pk2(s[2 * 65], s[3 * 65]); o.z = pk2(s[4 * 65], s[5 * 65]); o.w = pk2(s[6 * 65], s[7 * 65]);
        if (n0 + n < ncols) *(u32x4*)(WT + (size_t)dmap(type, n0 + n) * ldt + k0 + 8 * c) = o; }
    LDS_WAIT(); asm volatile("" ::: "memory");
}
__device__ __forceinline__ int t5_bucket(int d) {
    if (d < 16) return d;
    const float v = logf((float)d / 16.0f) / 4.852030263919617f * 16.0f;
    int b = 16 + (int)v; return b < 31 ? b : 31;
}
constexpr int I_IN = 32 * 89, I_OUT = 32 * 32, I_PP = 4 * 32, I_PG = 32 * 32, I_G = 32 * 128, I_U = 32 * 128, I_D = 32 * 128;
constexpr int IO_OUT = I_IN, IO_PP = IO_OUT + I_OUT, IO_PG = IO_PP + I_PP, IO_G = IO_PG + I_PG, IO_U = IO_G + I_G, IO_D = IO_U + I_U, I_L = IO_D + I_D;
__device__ __forceinline__ void conv_items(const Frame& F, const Args& a, const int l, const int lo, const int hi, const int gw, const int NGW) {
    LAS float* scr = (LAS float*)(F.lds + F.wave * 16640);
    bf16_t* WIN = (bf16_t*)(F.ws + WS_WIN); bf16_t* WOUT = (bf16_t*)(F.ws + WS_WOUT); bf16_t* WGU = (bf16_t*)(F.ws + WS_WGU); bf16_t* WD = (bf16_t*)(F.ws + WS_WD);
    bf16_t* WPG = (bf16_t*)(F.ws + WS_WPG); bf16_t* WPP = (bf16_t*)(F.ws + WS_WPP);
    for (int it = lo + gw; it < hi; it += NGW) {
        int r = it;
        if (r < IO_OUT) { const int kb = r / 89, nb = r - kb * 89; transpose_item(a.in[2] + (size_t)l * DM * DIN, DIN, DIN, kb * 64, nb * 64, nullptr, WIN + (size_t)l * DINP * DM, DM, 1, scr, F.lane); continue; }
        if (r < IO_PP) { r -= IO_OUT; const int kb = r >> 5, nb = r & 31; transpose_item(a.in[12] + (size_t)l * DM * DM, DM, DM, kb * 64, nb * 64, a.in[11] + l * DM, WOUT + (size_t)l * DM * DM, DM, 0, scr, F.lane); continue; }
        if (r < IO_PG) { r -= IO_PP; const int kb = r >> 5, nb = r & 31; transpose_item(a.in[25] + (size_t)l * PLE * DM, DM, DM, kb * 64, nb * 64, nullptr, WPP + (size_t)l * DM * PLE, PLE, 0, scr, F.lane); continue; }
        if (r < IO_G) { r -= IO_PG; const int kb = r >> 5, nb = r & 31; transpose_item(a.in[23] + (size_t)l * DM * DM, DM, DM, kb * 64, nb * 64, nullptr, WPG + (size_t)l * DM * DM, DM, 0, scr, F.lane); continue; }
        if (r < IO_U) { r -= IO_G; const int e = r >> 7, q = r & 127, kb = q >> 2, nb = q & 3; transpose_item(a.in[20] + (size_t)(l * NEXP + e) * DM * DEXP, DEXP, DEXP, kb * 64, nb * 64, nullptr, WGU + (size_t)(l * NEXP + e) * 512 * DM, DM, 2, scr, F.lane); continue; }
        if (r < IO_D) { r -= IO_U; const int e = r >> 7, q = r & 127, kb = q >> 2, nb = q & 3; transpose_item(a.in[21] + (size_t)(l * NEXP + e) * DM * DEXP, DEXP, DEXP, kb * 64, nb * 64, nullptr, WGU + (size_t)(l * NEXP + e) * 512 * DM, DM, 3, scr, F.lane); continue; }
        { r -= IO_D; const int e = r >> 7, q = r & 127, kb = q >> 5, nb = q & 31; transpose_item(a.in[22] + (size_t)(l * NEXP + e) * DEXP * DM, DM, DM, kb * 64, nb * 64, nullptr, WD + (size_t)(l * NEXP + e) * DM * DEXP, DEXP, 0, scr, F.lane); }
    }
}
__device__ __forceinline__ void conv_all(const Frame& F, const Args& a, const int l, const int lo, const int hi) { __syncthreads(); conv_items(F, a, l, lo, hi, F.bx * 8 + F.wave, F.G * 8); __syncthreads(); }
__device__ __forceinline__ void phase_prologue(const Frame& F, const Args& a) {
    bf16_t* WIN = (bf16_t*)(F.ws + WS_WIN);
    conv_all(F, a, 0, 0, IO_PG);
    const size_t gt = (size_t)F.bx * 512 + F.tid, NT = (size_t)F.G * 512;
    for (size_t i = gt; i < (size_t)NL * (DINP - DIN) * DM / 8; i += NT) { const size_t l = i / ((DINP - DIN) * DM / 8), r = i % ((DINP - DIN) * DM / 8);
        *(u32x4*)(WIN + (l * DINP + DIN) * DM + r * 8) = (u32x4){0u, 0u, 0u, 0u}; }
    { const float* x = a.in[0]; bf16_t* XB = (bf16_t*)(F.ws + WS_XB);
      for (size_t i = gt; i < (size_t)MT * DM / 8; i += NT) { const f32x4 v0 = *(const f32x4*)(x + i * 8), v1 = *(const f32x4*)(x + i * 8 + 4);
          *(u32x4*)(XB + i * 8) = (u32x4){pk2(v0[0], v0[1]), pk2(v0[2], v0[3]), pk2(v1[0], v1[1]), pk2(v1[2], v1[3])}; } }
    { const float* p = a.in[1]; bf16_t* PB = (bf16_t*)(F.ws + WS_PB);
      for (size_t i = gt; i < (size_t)NL * MT * PLE / 8; i += NT) { const f32x4 v0 = *(const f32x4*)(p + i * 8), v1 = *(const f32x4*)(p + i * 8 + 4);
          *(u32x4*)(PB + i * 8) = (u32x4){pk2(v0[0], v0[1]), pk2(v0[2], v0[3]), pk2(v1[0], v1[1]), pk2(v1[2], v1[3])}; } }
    { float* bt = (float*)(F.ws + WS_BTAB); const float* rb = a.in[13];
      for (size_t i = gt; i < 3 * 129 * 8; i += NT) { const int h = (int)(i & 7), j = (int)((i >> 3) % 129), br = (int)((i >> 3) / 129); const int dil = br == 0 ? 1 : (br == 1 ? 4 : 16);
          bt[i] = rb[t5_bucket(j * dil) * 8 + h]; } }
    { float* wrt = (float*)(F.ws + WS_WRT);
      for (size_t i = gt; i < (size_t)NL * 36 * DM; i += NT) { const int c = (int)(i % DM), col = (int)((i / DM) % 36), l = (int)(i / (36 * DM));
          wrt[i] = col < 4 ? a.in[16][((size_t)l * DM + c) * 4 + col] : a.in[18][((size_t)l * DM + c) * 32 + (col - 4)]; } }
}

__device__ __forceinline__ void conv_unit(const Frame& F, const Args& a, int l, int unit) {
    const bf16_t* U = F.U; bf16_t* MIX = F.MIX;
    LAS float* hb = (LAS float*)F.lds;
    const int t0 = unit * 32, tl0 = t0 & (SEQ - 1), tb = t0 - tl0;
    const int tid = F.tid;
    __syncthreads();
#pragma unroll 1
    for (int i = 0; i < 8; ++i) { const int id = tid + 512 * i; if (id < 62 * 64) { const int row = id >> 6, ch = (id & 63) * 8; const int tl = tl0 - 30 + row;
        float o[8];
        if (tl >= 0) { const bf16_t* up = U + (size_t)(tb + tl) * DINP; const u32x4 av = *(const u32x4*)(up + UA_VAL + ch), gv = *(const u32x4*)(up + UA_GATE + ch);
            const unsigned aw[4] = {av.x, av.y, av.z, av.w}, gw[4] = {gv.x, gv.y, gv.z, gv.w};
#pragma unroll
            for (int j = 0; j < 4; ++j) { o[2 * j] = bflo(aw[j]) * sigmoidf_(bflo(gw[j])); o[2 * j + 1] = bfhi(aw[j]) * sigmoidf_(bfhi(gw[j])); } }
        else {
#pragma unroll
            for (int j = 0; j < 8; ++j) o[j] = 0.f; }
        *(LAS f32x4*)(hb + row * 512 + ch) = (f32x4){o[0], o[1], o[2], o[3]}; *(LAS f32x4*)(hb + row * 512 + ch + 4) = (f32x4){o[4], o[5], o[6], o[7]}; } }
    __syncthreads();
    float yv[32];
    { const int c = tid; const float* w = a.in[3] + (size_t)l * 31 * 512; const float bias = a.in[4][l * 512 + c];
      float wv[31];
#pragma unroll
      for (int j = 0; j < 31; ++j) wv[j] = w[j * 512 + c];
      float hv[62];
#pragma unroll
      for (int r = 0; r < 62; ++r) hv[r] = hb[r * 512 + c];
#pragma unroll
      for (int t = 0; t < 32; ++t) { float s = bias;
#pragma unroll
          for (int j = 0; j < 31; ++j) s += wv[j] * hv[t + j];
          yv[t] = s; } }
    __syncthreads();
#pragma unroll
    for (int t = 0; t < 32; ++t) hb[t * 512 + tid] = yv[t];
    __syncthreads();
    { const float* lg = a.in[5] + l * 512; const float* lb = a.in[6] + l * 512;
#pragma unroll 1
      for (int i = 0; i < 4; ++i) { const int t = F.wave + 8 * i;
          const f32x4 v0 = *(const LAS f32x4*)(hb + t * 512 + 4 * F.lane), v1 = *(const LAS f32x4*)(hb + t * 512 + 256 + 4 * F.lane);
          const float mean = wave_sum((v0[0] + v0[1]) + (v0[2] + v0[3]) + (v1[0] + v1[1]) + (v1[2] + v1[3])) * (1.f / 512.f);
          const f32x4 d0 = v0 - mean, d1 = v1 - mean;
          const float var = wave_sum((d0[0] * d0[0] + d0[1] * d0[1]) + (d0[2] * d0[2] + d0[3] * d0[3]) + (d1[0] * d1[0] + d1[1] * d1[1]) + (d1[2] * d1[2] + d1[3] * d1[3])) * (1.f / 512.f);
          const float rstd = 1.0f / sqrtf(var + LN_EPS);
          const f32x4 g0 = *(const f32x4*)(lg + 4 * F.lane), g1 = *(const f32x4*)(lg + 256 + 4 * F.lane), b0 = *(const f32x4*)(lb + 4 * F.lane), b1 = *(const f32x4*)(lb + 256 + 4 * F.lane);
          float o0[4], o1[4];
#pragma unroll
          for (int j = 0; j < 4; ++j) { o0[j] = siluf_(d0[j] * rstd * g0[j] + b0[j]); o1[j] = siluf_(d1[j] * rstd * g1[j] + b1[j]); }
          bf16_t* mp = MIX + (size_t)(t0 + t) * DM;
          *(u32x2*)(mp + 4 * F.lane) = (u32x2){pk2(o0[0], o0[1]), pk2(o0[2], o0[3])}; *(u32x2*)(mp + 256 + 4 * F.lane) = (u32x2){pk2(o1[0], o1[1]), pk2(o1[2], o1[3])}; } }
    { const int cg = (tid & 63) * 8; const float* w = a.in[10] + (size_t)l * 3 * 512 + cg;
      float wv[3][8];
#pragma unroll
      for (int j = 0; j < 3; ++j) { const f32x4 a0 = *(const f32x4*)(w + j * 512), a1 = *(const f32x4*)(w + j * 512 + 4); wv[j][0] = a0[0]; wv[j][1] = a0[1]; wv[j][2] = a0[2]; wv[j][3] = a0[3]; wv[j][4] = a1[0]; wv[j][5] = a1[1]; wv[j][6] = a1[2]; wv[j][7] = a1[3]; }
#pragma unroll 1
      for (int pass = 0; pass < 2; ++pass) { const int tg = (tid >> 6) + 8 * pass;
      float p[4][8];
#pragma unroll
      for (int rr = 0; rr < 4; ++rr) { const int tl = tl0 + 2 * tg - 2 + rr;
          { const float msk = tl >= 0 ? 1.f : 0.f; const int tlc = tl >= 0 ? tl : 0;
            const bf16_t* up = U + (size_t)(tb + tlc) * DINP; const u32x4 cw = *(const u32x4*)(up + US_C + cg), hw = *(const u32x4*)(up + US_H + cg);
            const unsigned c4[4] = {cw.x, cw.y, cw.z, cw.w}, h4[4] = {hw.x, hw.y, hw.z, hw.w};
#pragma unroll
            for (int j = 0; j < 4; ++j) { p[rr][2 * j] = bflo(c4[j]) * bflo(h4[j]) * msk; p[rr][2 * j + 1] = bfhi(c4[j]) * bfhi(h4[j]) * msk; } } }
#pragma unroll
      for (int tt = 0; tt < 2; ++tt) { const int t = t0 + 2 * tg + tt; const u32x4 bw = *(const u32x4*)(U + (size_t)t * DINP + US_B + cg); const unsigned b4[4] = {bw.x, bw.y, bw.z, bw.w}; unsigned ow[4];
#pragma unroll
          for (int j = 0; j < 4; ++j) { const float y0 = bflo(b4[j]) * (wv[0][2 * j] * p[tt][2 * j] + wv[1][2 * j] * p[tt + 1][2 * j] + wv[2][2 * j] * p[tt + 2][2 * j]);
              const float y1 = bfhi(b4[j]) * (wv[0][2 * j + 1] * p[tt][2 * j + 1] + wv[1][2 * j + 1] * p[tt + 1][2 * j + 1] + wv[2][2 * j + 1] * p[tt + 2][2 * j + 1]); ow[j] = pk2(y0, y1); }
          *(u32x4*)(MIX + (size_t)t * DM + 1536 + cg) = (u32x4){ow[0], ow[1], ow[2], ow[3]}; } } }
}

__device__ __forceinline__ bf16x8 frag_f32(const LAS float* p) { const f32x4 a = *(const LAS f32x4*)p, b = *(const LAS f32x4*)(p + 4);
    const u32x4 w = (u32x4){pk2(a[0], a[1]), pk2(a[2], a[3]), pk2(b[0], b[1]), pk2(b[2], b[3])}; return __builtin_bit_cast(bf16x8, w); }
__device__ __forceinline__ bf16x8 frag_col(const LAS float* p, int stride) {
    const u32x4 w = (u32x4){pk2(p[0], p[stride]), pk2(p[2 * stride], p[3 * stride]), pk2(p[4 * stride], p[5 * stride]), pk2(p[6 * stride], p[7 * stride])}; return __builtin_bit_cast(bf16x8, w); }
__device__ __forceinline__ void gla_a_unit(const Frame& F, const Args& a, int l, int unit) {
    const bf16_t* U = F.U;
    float* GU = (float*)(F.ws + WS_GU); float* GO = (float*)(F.ws + WS_GO); float* GQ = (float*)(F.ws + WS_GQ); float* GD = (float*)(F.ws + WS_GD);
    const int n = unit & 63, h = (unit >> 6) & 3, b = unit >> 8, bh = b * 4 + h;
    const int t0 = b * SEQ + n * 32, tid = F.tid;
    LAS float* L = (LAS float*)F.lds;
    LAS float* qt = L; LAS float* kr = L + 2048; LAS float* kt = L + 4096; LAS float* kh = L + 6144; LAS float* vv = L + 8192; LAS float* bc = L + 12288; LAS float* gl = L + 14336; LAS float* wg = L + 14848; LAS float* sc = L + 15872;
    const int i = tid >> 4, k4 = (tid & 15) * 4, v8 = (tid & 15) * 8;
    __syncthreads();
    { const bf16_t* up = U + (size_t)(t0 + i) * DINP;
      const u32x2 qw = *(const u32x2*)(up + UG_Q + h * 64 + k4), kw = *(const u32x2*)(up + UG_K + h * 64 + k4); const u32x4 vw = *(const u32x4*)(up + UG_V + h * 128 + v8);
      *(LAS f32x4*)(qt + i * 64 + k4) = (f32x4){bflo(qw.x), bfhi(qw.x), bflo(qw.y), bfhi(qw.y)};
      *(LAS f32x4*)(kr + i * 64 + k4) = (f32x4){bflo(kw.x), bfhi(kw.x), bflo(kw.y), bfhi(kw.y)};
      *(LAS f32x4*)(vv + i * 128 + v8) = (f32x4){bflo(vw.x), bfhi(vw.x), bflo(vw.y), bfhi(vw.y)}; *(LAS f32x4*)(vv + i * 128 + v8 + 4) = (f32x4){bflo(vw.z), bfhi(vw.z), bflo(vw.w), bfhi(vw.w)};
      gl[i * 16 + (tid & 15)] = bf2f(up[UG_LOW + (tid & 15)]);
      const float* w2 = a.in[7] + (size_t)l * 16 * 256;
      wg[tid] = w2[(tid >> 6) * 256 + h * 64 + (tid & 63)]; wg[512 + tid] = w2[(8 + (tid >> 6)) * 256 + h * 64 + (tid & 63)]; }
    __syncthreads();
    { const f32x4 bg = *(const f32x4*)(a.in[8] + l * 256 + h * 64 + k4); f32x4 z = bg;
#pragma unroll
      for (int r = 0; r < 16; ++r) { const float g = gl[i * 16 + r]; const f32x4 w = *(const LAS f32x4*)(wg + r * 64 + k4); z = z + w * g; }
      f32x4 la;
#pragma unroll
      for (int j = 0; j < 4; ++j) la[j] = (fminf(z[j], 0.f) - log1pf(expf(-fabsf(z[j])))) * (1.0f / 16.0f);
      *(LAS f32x4*)(bc + i * 64 + k4) = la; }
    __syncthreads();
    f32x4 bv = {0.f, 0.f, 0.f, 0.f}, bl = bv;
#pragma unroll 8
    for (int r = 0; r < 32; ++r) { const f32x4 x = *(const LAS f32x4*)(bc + r * 64 + k4); bl = bl + x; if (r <= i) bv = bv + x; }
    { const f32x4  q = *(const LAS f32x4*)(qt + i * 64 + k4), k = *(const LAS f32x4*)(kr + i * 64 + k4);
      f32x4 qo, ko, ho;
#pragma unroll
      for (int j = 0; j < 4; ++j) { qo[j] = q[j] * expf(bv[j]) * 0.125f; ko[j] = k[j] * expf(-bv[j]); ho[j] = k[j] * expf(bl[j] - bv[j]); }
      *(LAS f32x4*)(qt + i * 64 + k4) = qo; *(LAS f32x4*)(kt + i * 64 + k4) = ko; *(LAS f32x4*)(kh + i * 64 + k4) = ho;
      *(f32x4*)(GQ + (size_t)(t0 + i) * 256 + h * 64 + k4) = qo;
      if (i == 31) { f32x4 d;
#pragma unroll
          for (int j = 0; j < 4; ++j) d[j] = expf(bl[j]);
          *(f32x4*)(GD + ((size_t)bh * 64 + n) * 64 + k4) = d; } }
    __syncthreads();
    const int lane = F.lane, w = F.wave, fr = lane & 15, fg = lane >> 4;
    if (w < 4) { const int mi = w >> 1, nj = w & 1; f32x4 d = zero4();
#pragma unroll
        for (int ks = 0; ks < 2; ++ks) d = __builtin_amdgcn_mfma_f32_16x16x32_bf16(frag_f32(qt + (16 * mi + fr) * 64 + 8 * fg + 32 * ks), frag_f32(kt + (16 * nj + fr) * 64 + 8 * fg + 32 * ks), d, 0, 0, 0);
#pragma unroll
        for (int r = 0; r < 4; ++r) { const int ii = 16 * mi + 4 * fg + r, jj = 16 * nj + fr; sc[ii * 36 + jj] = (jj <= ii) ? d[r] : 0.f; } }
    const bf16x8 vfrag = frag_col(vv + (8 * fg) * 128 + 16 * w + fr, 128);
    { float* gp = GU + ((size_t)bh * 64 + n) * 8192 + (size_t)(16 * w + fr) * 64 + 4 * fg;
#pragma unroll
      for (int kt4 = 0; kt4 < 4; ++kt4) { const bf16x8 kfrag = frag_col(kh + (8 * fg) * 64 + 16 * kt4 + fr, 64);
          const f32x4 d = __builtin_amdgcn_mfma_f32_16x16x32_bf16(kfrag, vfrag, zero4(), 0, 0, 0);
          *(f32x4*)(gp + 16 * kt4) = d; } }
    __syncthreads();
#pragma unroll
    for (int it = 0; it < 2; ++it) { const bf16x8 sfrag = frag_f32(sc + (16 * it + fr) * 36 + 8 * fg);
        const f32x4 d = __builtin_amdgcn_mfma_f32_16x16x32_bf16(vfrag, sfrag, zero4(), 0, 0, 0);
        *(f32x4*)(GO + (size_t)(t0 + 16 * it + fr) * 512 + h * 128 + 16 * w + 4 * fg) = d; }
}
__device__ __forceinline__ void gla_scan(const Frame& F) {
    float* GU = (float*)(F.ws + WS_GU); const float* GD = (const float*)(F.ws + WS_GD);
    for (int g = F.sid * 8 * 8192 + F.bx * 512 + F.tid; g < (F.sid + 1) * 8 * 8192; g += F.G * 512) { const int bh = g >> 13, kv = g & 8191, k = kv & 63;
        float* p = GU + (size_t)bh * 64 * 8192 + kv; const float* d = GD + (size_t)bh * 64 * 64 + k; float S = 0.f;
#pragma unroll 8
        for (int n = 0; n < 64; ++n) { const float u = p[(size_t)n * 8192]; const float dc = d[n * 64]; p[(size_t)n * 8192] = S; S = S * dc + u; } }
}
struct GlaCIn { f32x4 s[4]; f32x4 q; f32x4 oi[2]; u32x2 rw[2]; };
__device__ __forceinline__ void gla_c_load(const Frame& F, int unit, GlaCIn& in) {
    const bf16_t* U = F.U; const float* GU = (const float*)(F.ws + WS_GU); const float* GO = (const float*)(F.ws + WS_GO); const float* GQ = (const float*)(F.ws + WS_GQ);
    const int n = unit & 63, h = (unit >> 6) & 3, b = unit >> 8, bh = b * 4 + h, t0 = b * SEQ + n * 32, tid = F.tid, lane = F.lane, w = F.wave, fr = lane & 15, fg = lane >> 4;
    const float* sp = GU + ((size_t)bh * 64 + n) * 8192;
#pragma unroll
    for (int j = 0; j < 4; ++j) in.s[j] = *(const f32x4*)(sp + (tid + 512 * j) * 4);
    in.q = *(const f32x4*)(GQ + (size_t)(t0 + (tid >> 4)) * 256 + h * 64 + (tid & 15) * 4);
#pragma unroll
    for (int it = 0; it < 2; ++it) { const int row = t0 + 16 * it + fr, col = h * 128 + 16 * w + 4 * fg;
        in.oi[it] = *(const f32x4*)(GO + (size_t)row * 512 + col); in.rw[it] = *(const u32x2*)(U + (size_t)row * DINP + UG_R + col); }
}
__device__ __forceinline__ void gla_c_phase(const Frame& F, const Args& a, int l) {
    bf16_t* MIX = F.MIX;
    const int tid = F.tid, lane = F.lane, w = F.wave, fr = lane & 15, fg = lane >> 4;
    LAS float* qt = (LAS float*)F.lds; LAS float* SsT = qt + 32 * 68; LAS float* red = SsT + 128 * 68;
    const f32x4 ng = *(const f32x4*)(a.in[9] + l * 128 + 16 * w + 4 * fg);
    GlaCIn in; const int ubeg = F.sid * 512 + F.bx, uend = (F.sid + 1) * 512;
    if (ubeg < uend) gla_c_load(F, ubeg, in);
#pragma unroll 1
    for (int unit = ubeg; unit < uend; unit += F.G) {
        const int n = unit & 63, h = (unit >> 6) & 3, b = unit >> 8, t0 = b * SEQ + n * 32;
        __syncthreads();
        *(LAS f32x4*)(qt + (tid >> 4) * 68 + (tid & 15) * 4) = in.q;
#pragma unroll
        for (int j = 0; j < 4; ++j) { const int e = (tid + 512 * j) * 4; *(LAS f32x4*)(SsT + (e >> 6) * 68 + (e & 63)) = in.s[j]; }
        f32x4 o[2] = {in.oi[0], in.oi[1]}; const u32x2 rw0 = in.rw[0], rw1 = in.rw[1];
        __syncthreads();
        if (unit + F.G < uend) gla_c_load(F, unit + F.G, in);
#pragma unroll
        for (int ks = 0; ks < 2; ++ks) { const bf16x8 sf = frag_f32(SsT + (16 * w + fr) * 68 + 8 * fg + 32 * ks);
#pragma unroll
            for (int it = 0; it < 2; ++it) o[it] = __builtin_amdgcn_mfma_f32_16x16x32_bf16(sf, frag_f32(qt + (16 * it + fr) * 68 + 8 * fg + 32 * ks), o[it], 0, 0, 0); }
#pragma unroll
        for (int it = 0; it < 2; ++it) { float ss = (o[it][0] * o[it][0] + o[it][1] * o[it][1]) + (o[it][2] * o[it][2] + o[it][3] * o[it][3]);
            ss += __shfl_xor(ss, 16); ss += __shfl_xor(ss, 32);
            if (fg == 0) red[w * 32 + 16 * it + fr] = ss; }
        __syncthreads();
#pragma unroll
        for (int it = 0; it < 2; ++it) { float tot = 0.f;
#pragma unroll
            for (int ww = 0; ww < 8; ++ww) tot += red[ww * 32 + 16 * it + fr];
            const float rms = 1.0f / sqrtf(tot * (1.f / 128.f) + RMS_EPS);
            const u32x2 rw = it == 0 ? rw0 : rw1;
            const float y0 = o[it][0] * rms * ng[0] * siluf_(bflo(rw.x)), y1 = o[it][1] * rms * ng[1] * siluf_(bfhi(rw.x)), y2 = o[it][2] * rms * ng[2] * siluf_(bflo(rw.y)), y3 = o[it][3] * rms * ng[3] * siluf_(bfhi(rw.y));
            *(u32x2*)(MIX + (size_t)(t0 + 16 * it + fr) * DM + 512 + h * 128 + 16 * w + 4 * fg) = (u32x2){pk2(y0, y1), pk2(y2, y3)}; }
    }
}

typedef short s16x4 __attribute__((ext_vector_type(4)));
__device__ __forceinline__ s16x4 vtr(const LAS unsigned char* p) { return __builtin_bit_cast(s16x4, __builtin_amdgcn_ds_read_tr16_b64_v4i16((LAS s16x4*)p)); }
constexpr int AT_VROW = 160, AT_VBUF = 32 * AT_VROW;
__device__ __forceinline__ void attn_job(const Frame& F, int job, LAS unsigned char* vbuf, const LAS float* bt) {
    const bf16_t* U = F.U; bf16_t* AO = (bf16_t*)(F.ws + WS_AO); float* ALSE = (float*)(F.ws + WS_ALSE);
    const int lane = F.lane, qi = lane & 15, g = lane >> 4;
    const int gidx = job & 127, t2 = job >> 7, br = t2 % 3, bh = t2 / 3, h = bh & 7, b = bh >> 3;
    const int dsh = 2 * br, dil = 1 << dsh, gsh = 7 - dsh, r = gidx >> gsh, gi = gidx & ((1 << gsh) - 1);
    const int q0 = gi * 16, tb = b * SEQ;
    const bf16_t* Ub = U + (size_t)(tb + r) * DINP + h * 64;
    const size_t sstep = (size_t)dil * DINP;
    const bf16_t* qrow = Ub + (size_t)(q0 + qi) * sstep + UC_Q + 8 * g;
    const bf16x8 qf0 = *(const bf16x8*)qrow, qf1 = *(const bf16x8*)(qrow + 32);
    const int klo = (q0 >= 128 ? q0 - 128 : 0) & ~31;
    const int nch = ((q0 + 15 - klo) >> 5) + 1;
    float m_run = -1e30f, l_part = 0.f;
    f32x4 o[4];
#pragma unroll
    for (int d = 0; d < 4; ++d) o[d] = (f32x4){0.f, 0.f, 0.f, 0.f};
    bf16x8 ka0, ka1, kb0, kb1; u32x4 vr[4];
#define AT_LOAD(kc) do { const bf16_t* kp = Ub + (size_t)((kc) + qi) * sstep + UC_K + 8 * g; ka0 = *(const bf16x8*)kp; ka1 = *(const bf16x8*)(kp + 32); kp += 16 * sstep; kb0 = *(const bf16x8*)kp; kb1 = *(const bf16x8*)(kp + 32); \
        const bf16_t* vp = Ub + (size_t)((kc) + (lane >> 3)) * sstep + UC_V + (lane & 7) * 8; _Pragma("unroll") for (int it = 0; it < 4; ++it) vr[it] = *(const u32x4*)(vp + (size_t)(8 * it) * sstep); } while (0)
    AT_LOAD(klo);
#pragma unroll 1
    for (int c = 0; c < nch; ++c) {
        const int kc = klo + 32 * c;
        LAS unsigned char* vb = vbuf + (c & 1) * AT_VBUF;
#pragma unroll
        for (int it = 0; it < 4; ++it) *(LAS u32x4*)(vb + (it * 8 + (lane >> 3)) * AT_VROW + (lane & 7) * 16) = vr[it];
        const bf16x8 ca0 = ka0, ca1 = ka1, cb0 = kb0, cb1 = kb1;
        if (c + 1 < nch) AT_LOAD(kc + 32);
        f32x4 sa = (f32x4){0.f, 0.f, 0.f, 0.f}, sb = sa;
        sa = __builtin_amdgcn_mfma_f32_16x16x32_bf16(ca0, qf0, sa, 0, 0, 0); sa = __builtin_amdgcn_mfma_f32_16x16x32_bf16(ca1, qf1, sa, 0, 0, 0);
        sb = __builtin_amdgcn_mfma_f32_16x16x32_bf16(cb0, qf0, sb, 0, 0, 0); sb = __builtin_amdgcn_mfma_f32_16x16x32_bf16(cb1, qf1, sb, 0, 0, 0);
        const int st0 = (q0 + qi) - (kc + 4 * g);
        float cmax = -1e30f;
#pragma unroll
        for (int rr = 0; rr < 4; ++rr) {
            const int sA = st0 - rr, sB = st0 - rr - 16;
            const int iA = sA < 0 ? 0 : (sA > 128 ? 128 : sA), iB = sB < 0 ? 0 : (sB > 128 ? 128 : sB);
            const float vA = sa[rr] * 0.125f + bt[(br * 129 + iA) * 8 + h], vB = sb[rr] * 0.125f + bt[(br * 129 + iB) * 8 + h];
            sa[rr] = (sA >= 0 && sA <= 128) ? vA : -1e30f; sb[rr] = (sB >= 0 && sB <= 128) ? vB : -1e30f;
            cmax = fmaxf(cmax, fmaxf(sa[rr], sb[rr])); }
        cmax = fmaxf(cmax, __shfl_xor(cmax, 16)); cmax = fmaxf(cmax, __shfl_xor(cmax, 32));
        const float m_new = fmaxf(m_run, cmax), alpha = __expf(m_run - m_new);
        float psum = 0.f;
#pragma unroll
        for (int rr = 0; rr < 4; ++rr) { sa[rr] = __expf(sa[rr] - m_new); sb[rr] = __expf(sb[rr] - m_new); psum += sa[rr] + sb[rr]; }
        l_part = l_part * alpha + psum; m_run = m_new;
#pragma unroll
        for (int d = 0; d < 4; ++d) o[d] = o[d] * alpha;
        const u32x4 pw = (u32x4){pk2(sa[0], sa[1]), pk2(sa[2], sa[3]), pk2(sb[0], sb[1]), pk2(sb[2], sb[3])};
        const bf16x8 pf = __builtin_bit_cast(bf16x8, pw);
        const LAS unsigned char* tp = vb + (4 * g + (qi >> 2)) * AT_VROW + (qi & 3) * 8;
#pragma unroll
        for (int d = 0; d < 4; ++d) { const s16x4 va = vtr(tp + d * 32), vb2 = vtr(tp + 16 * AT_VROW + d * 32);
            const bf16x8 vf = (bf16x8){va[0], va[1], va[2], va[3], vb2[0], vb2[1], vb2[2], vb2[3]};
            o[d] = __builtin_amdgcn_mfma_f32_16x16x32_bf16(vf, pf, o[d], 0, 0, 0); }
    }
#undef AT_LOAD
    float l = l_part; l += __shfl_xor(l, 16); l += __shfl_xor(l, 32);
    const float inv = 1.0f / l;
    const int token = tb + (q0 + qi) * dil + r;
    bf16_t* op = AO + ((size_t)br * MT + token) * 512 + h * 64 + 4 * g;
#pragma unroll
    for (int d = 0; d < 4; ++d) *(u32x2*)(op + d * 16) = (u32x2){pk2(o[d][0] * inv, o[d][1] * inv), pk2(o[d][2] * inv, o[d][3] * inv)};
    if (g == 0) ALSE[((size_t)br * MT + token) * 8 + h] = m_run + logf(l);
}
__device__ __forceinline__ void attn_combine(const Frame& F) {
    const bf16_t* AO = (const bf16_t*)(F.ws + WS_AO); const float* ALSE = (const float*)(F.ws + WS_ALSE); bf16_t* MIX = F.MIX;
    for (int i = F.row0 * 64 + F.bx * 512 + F.tid; i < (F.row0 + SMT) * 64; i += F.G * 512) { const int token = i >> 6, c8 = (i & 63) * 8, h = c8 >> 6;
        const float l0 = ALSE[(size_t)token * 8 + h], l1 = ALSE[((size_t)MT + token) * 8 + h], l2 = ALSE[((size_t)2 * MT + token) * 8 + h];
        const float m = fmaxf(l0, fmaxf(l1, l2)); float w0 = __expf(l0 - m), w1 = __expf(l1 - m), w2 = __expf(l2 - m); const float inv = 1.0f / (w0 + w1 + w2); w0 *= inv; w1 *= inv; w2 *= inv;
        const u32x4 a = *(const u32x4*)(AO + (size_t)token * 512 + c8), bq = *(const u32x4*)(AO + ((size_t)MT + token) * 512 + c8), cq = *(const u32x4*)(AO + ((size_t)2 * MT + token) * 512 + c8);
        const unsigned aw[4] = {a.x, a.y, a.z, a.w}, bw[4] = {bq.x, bq.y, bq.z, bq.w}, cw[4] = {cq.x, cq.y, cq.z, cq.w}; unsigned ow[4];
#pragma unroll
        for (int j = 0; j < 4; ++j) ow[j] = pk2(w0 * bflo(aw[j]) + w1 * bflo(bw[j]) + w2 * bflo(cw[j]), w0 * bfhi(aw[j]) + w1 * bfhi(bw[j]) + w2 * bfhi(cw[j]));
        *(u32x4*)(MIX + (size_t)token * DM + 1024 + c8) = (u32x4){ow[0], ow[1], ow[2], ow[3]}; }
}

__device__ __forceinline__ void ln1_unit(const Frame& F, const Args& a, int l, int unit, bool commit) {
    const bf16_t* PRE = (const bf16_t*)(F.ws + WS_PRE); bf16_t* XB = (bf16_t*)(F.ws + WS_XB); const float* wrt = (const float*)(F.ws + WS_WRT) + (size_t)l * 36 * DM;
    int* ltok = (int*)(F.ws + WS_LTOK) + F.sid * 32 * SMT; float* lgate = (float*)(F.ws + WS_LGATE) + F.sid * 32 * SMT; int* tinfo = (int*)(F.ws + WS_TINFO); unsigned* cnt = F.ctl + CW_CNT + (l * 2 + F.sid) * 32 * 64;
    LAS float* Wl = (LAS float*)F.lds;
    const int lane = F.lane, tid = F.tid, row0 = unit * 16 + F.wave * 2;
    const float* g = a.in[14] + (size_t)l * DM; const float* bb = a.in[15] + (size_t)l * DM;
    f32x4 wreg[5];
#pragma unroll
    for (int i = 0; i < 5; ++i) { const int idx = tid + 512 * i; if (idx < 36 * 64) wreg[i] = *(const f32x4*)(wrt + (size_t)(idx >> 6) * DM + (idx & 63) * 4); }
    float mean_[2], rstd_[2];
#pragma unroll
    for (int r = 0; r < 2; ++r) { const int row = row0 + r; const bf16_t* pr = PRE + (size_t)row * DM; f32x4 v[8]; float s = 0.f;
#pragma unroll
      for (int j = 0; j < 8; ++j) { const u32x2 w = *(const u32x2*)(pr + 256 * j + 4 * lane); v[j] = (f32x4){bflo(w.x), bfhi(w.x), bflo(w.y), bfhi(w.y)}; s += (v[j][0] + v[j][1]) + (v[j][2] + v[j][3]); }
      const float mean = wave_sum(s) * (1.f / DM); float q = 0.f;
#pragma unroll
      for (int j = 0; j < 8; ++j) { v[j] = v[j] - mean; q += (v[j][0] * v[j][0] + v[j][1] * v[j][1]) + (v[j][2] * v[j][2] + v[j][3] * v[j][3]); }
      const float rstd = 1.0f / sqrtf(wave_sum(q) * (1.f / DM) + LN_EPS);
      mean_[r] = mean; rstd_[r] = rstd;
#pragma unroll
      for (int j = 0; j < 8; ++j) { const f32x4 gv = *(const f32x4*)(g + 256 * j + 4 * lane), bv = *(const f32x4*)(bb + 256 * j + 4 * lane); const f32x4 y = v[j] * rstd * gv + bv;
          *(u32x2*)(XB + (size_t)row * DM + 256 * j + 4 * lane) = (u32x2){pk2(y[0], y[1]), pk2(y[2], y[3])}; } }
    float acc[2][36];
#pragma unroll
    for (int r = 0; r < 2; ++r)
#pragma unroll
        for (int c = 0; c < 36; ++c) acc[r][c] = 0.f;
    __syncthreads();
#pragma unroll 1
    for (int j = 0; j < 8; ++j) {
        LAS float* Wb = Wl + (j & 1) * (36 * 256);
#pragma unroll
        for (int i = 0; i < 5; ++i) { const int idx = tid + 512 * i; if (idx < 36 * 64) *(LAS f32x4*)(Wb + (idx >> 6) * 256 + (idx & 63) * 4) = wreg[i]; }
        __syncthreads();
        if (j < 7) {
#pragma unroll
            for (int i = 0; i < 5; ++i) { const int idx = tid + 512 * i; if (idx < 36 * 64) wreg[i] = *(const f32x4*)(wrt + (size_t)(idx >> 6) * DM + 256 * (j + 1) + (idx & 63) * 4); } }
        f32x4 xv[2];
        { const f32x4 gv = *(const f32x4*)(g + 256 * j + 4 * lane), bv = *(const f32x4*)(bb + 256 * j + 4 * lane);
#pragma unroll
          for (int r = 0; r < 2; ++r) { const u32x2 w = *(const u32x2*)(PRE + (size_t)(row0 + r) * DM + 256 * j + 4 * lane);
              xv[r] = ((f32x4){bflo(w.x), bfhi(w.x), bflo(w.y), bfhi(w.y)} - mean_[r]) * rstd_[r] * gv + bv; } }
#pragma unroll
        for (int c = 0; c < 36; ++c) { const f32x4 w = *(const LAS f32x4*)(Wb + c * 256 + 4 * lane);
#pragma unroll
            for (int r = 0; r < 2; ++r) acc[r][c] += (xv[r][0] * w[0] + xv[r][1] * w[1]) + (xv[r][2] * w[2] + xv[r][3] * w[3]); }
    }
    const float* gb = a.in[17] + l * 4; const float* eb = a.in[19] + l * 32;
#pragma unroll
    for (int r = 0; r < 2; ++r) {
#pragma unroll
        for (int c = 0; c < 36; ++c) acc[r][c] = wave_sum(acc[r][c]);
        float gl[4];
#pragma unroll
        for (int c = 0; c < 4; ++c) gl[c] = acc[r][c] + gb[c];
        int gi = 0; float gm = gl[0];
#pragma unroll
        for (int c = 1; c < 4; ++c) if (gl[c] > gm) { gm = gl[c]; gi = c; }
        float gs = 0.f;
#pragma unroll
        for (int c = 0; c < 4; ++c) gs += expf(gl[c] - gm);
        const float gtop = 1.0f / gs;
        float ev[8];
#pragma unroll
        for (int c = 0; c < 8; ++c) { const float v0 = acc[r][4 + c] + eb[c], v1 = acc[r][12 + c] + eb[8 + c], v2 = acc[r][20 + c] + eb[16 + c], v3 = acc[r][28 + c] + eb[24 + c]; ev[c] = gi == 0 ? v0 : (gi == 1 ? v1 : (gi == 2 ? v2 : v3)); }
        int i1 = 0; float m1 = ev[0];
#pragma unroll
        for (int c = 1; c < 8; ++c) if (ev[c] > m1) { m1 = ev[c]; i1 = c; }
        int i2 = -1; float m2 = -INFINITY;
#pragma unroll
        for (int c = 0; c < 8; ++c) if (c != i1 && ev[c] > m2) { m2 = ev[c]; i2 = c; }
        const float p2 = expf(m2 - m1), den = 1.0f + p2;
        const float w1 = gtop / den, w2 = gtop * p2 / den;
        if (lane == 0 && commit) { const int tok = row0 + r; const int e1 = gi * 8 + i1, e2 = gi * 8 + i2;
            const unsigned s1 = __hip_atomic_fetch_add(cnt + e1 * 64, 1u, __ATOMIC_RELAXED, __HIP_MEMORY_SCOPE_AGENT), s2 = __hip_atomic_fetch_add(cnt + e2 * 64, 1u, __ATOMIC_RELAXED, __HIP_MEMORY_SCOPE_AGENT);
            ltok[e1 * SMT + s1] = tok; lgate[e1 * SMT + s1] = w1; ltok[e2 * SMT + s2] = tok; lgate[e2 * SMT + s2] = w2;
            tinfo[tok * 2] = e1 * SMT + (int)s1; tinfo[tok * 2 + 1] = e2 * SMT + (int)s2; }
    }
}
__device__ __forceinline__ void moe_tables(const Frame& F, int l) {
    LAS int* toff = (LAS int*)(F.lds + LDS_TOFF); const unsigned* cnt = F.ctl + CW_CNT + (l * 2 + F.sid) * 32 * 64;
    __syncthreads();
    if (F.tid == 0) { int run = 0; for (int e = 0; e < 32; ++e) { toff[e] = run; run += ((int)cnt[e * 64] + 255) >> 8; } toff[32] = run; }
    __syncthreads();
}
__device__ __forceinline__ void ln2_rows(const Frame& F, const Args& a, int l, float* OUT, bool write_xb) {
    const bf16_t* PRE = (const bf16_t*)(F.ws + WS_PRE); const bf16_t* Y = F.Y; bf16_t* XB = (bf16_t*)(F.ws + WS_XB); const int* tinfo = (const int*)(F.ws + WS_TINFO);
    const LAS int* toff = (const LAS int*)(F.lds + LDS_TOFF);
    const float* g = a.in[26] + (size_t)l * DM; const float* bb = a.in[27] + (size_t)l * DM; const int lane = F.lane;
    for (int row0 = F.row0 + (F.bx * 8 + F.wave) * 2; row0 < F.row0 + SMT; row0 += F.G * 16) {
        f32x4 v[2][8]; float s[2] = {0.f, 0.f};
#pragma unroll
        for (int r = 0; r < 2; ++r) { const int row = row0 + r; const int i0 = tinfo[row * 2], i1 = tinfo[row * 2 + 1];
            const size_t s0 = (size_t)toff[i0 >> 12] * 256 + (i0 & 4095), s1 = (size_t)toff[i1 >> 12] * 256 + (i1 & 4095);
            const bf16_t* pr = PRE + (size_t)row * DM; const bf16_t* y0 = Y + s0 * DM; const bf16_t* y1 = Y + s1 * DM;
#pragma unroll
            for (int j = 0; j < 8; ++j) { const u32x2 pw = *(const u32x2*)(pr + 256 * j + 4 * lane), a0 = *(const u32x2*)(y0 + 256 * j + 4 * lane), a1 = *(const u32x2*)(y1 + 256 * j + 4 * lane);
                v[r][j][0] = bflo(pw.x) + (bflo(a0.x) + bflo(a1.x)); v[r][j][1] = bfhi(pw.x) + (bfhi(a0.x) + bfhi(a1.x)); v[r][j][2] = bflo(pw.y) + (bflo(a0.y) + bflo(a1.y)); v[r][j][3] = bfhi(pw.y) + (bfhi(a0.y) + bfhi(a1.y));
                s[r] += (v[r][j][0] + v[r][j][1]) + (v[r][j][2] + v[r][j][3]); } }
#pragma unroll
        for (int r = 0; r < 2; ++r) { const int row = row0 + r;
            const float mean = wave_sum(s[r]) * (1.f / DM); float q = 0.f;
#pragma unroll
            for (int j = 0; j < 8; ++j) { v[r][j] = v[r][j] - mean; q += (v[r][j][0] * v[r][j][0] + v[r][j][1] * v[r][j][1]) + (v[r][j][2] * v[r][j][2] + v[r][j][3] * v[r][j][3]); }
            const float rstd = 1.0f / sqrtf(wave_sum(q) * (1.f / DM) + LN_EPS);
#pragma unroll
            for (int j = 0; j < 8; ++j) { const f32x4 gv = *(const f32x4*)(g + 256 * j + 4 * lane), bv = *(const f32x4*)(bb + 256 * j + 4 * lane); const f32x4 y = v[r][j] * rstd * gv + bv;
                if (write_xb) *(u32x2*)(XB + (size_t)row * DM + 256 * j + 4 * lane) = (u32x2){pk2(y[0], y[1]), pk2(y[2], y[3])}; else *(f32x4*)(OUT + (size_t)row * DM + 256 * j + 4 * lane) = y; } }
    }
}

constexpr int PH_PER_LAYER = 9, N_PHASES = 1 + NL * PH_PER_LAYER;
__global__ void __launch_bounds__(512, 2) mega(Args args) {
    extern __shared__ __attribute__((aligned(16))) unsigned char lds_raw[];
    const int bxg = blockIdx.x, Gg = gridDim.x;
    Frame F; F.lds = (LAS unsigned char*)lds_raw; F.ws = args.ws; F.ctl = (unsigned*)(args.ws + WS_CTL);
    F.tid = threadIdx.x; F.lane = F.tid & 63; F.wave = __builtin_amdgcn_readfirstlane(F.tid >> 6);
    F.sid = (bxg >> 3) & 1; F.row0 = F.sid * SMT; F.G = Gg >> 1; F.bx = ((bxg >> 4) << 3) | (bxg & 7);
    F.U = nullptr; F.MIX = nullptr; F.Y = nullptr; F.H = nullptr;
    if (F.tid < 4) ((LAS unsigned*)(F.lds + LDS_BARW))[F.tid] = 0u;
    __syncthreads();
    XcdBarrier barS = xcd_barrier_post(F.ctl + CW_BAR + F.sid * XCD_BAR_WORDS, (volatile LAS unsigned*)(F.lds + LDS_BARW), (unsigned)(Gg >> 1));
    XcdBarrier barG = xcd_barrier_post(F.ctl + CW_BAR + 2 * XCD_BAR_WORDS, (volatile LAS unsigned*)(F.lds + LDS_BARW + 8), (unsigned)Gg);
#define SBAR() xcd_barrier(barS)
#define WSP(T, off) ((T*)(f.ws + (off)))

    { Frame g = F; g.G = Gg; g.bx = bxg; g.sid = 0; const Frame f = g.fresh(); phase_prologue(f, args); }
    xcd_barrier(barG);
    { const Frame f = F.fresh(); if (f.sid == 1) { conv_all(f, args, 0, IO_PG, I_L); flag_publish(f.ctl + CW_FLAG + 0 * 64, f.tid); } }

#pragma unroll 1
    for (int l = 0; l < NL; ++l) {
        { const Frame f = F.fresh(); if (l == 1 && f.sid == 1) flag_wait(f.ctl + CW_FLAG + 1 * 64, (unsigned)f.G, f.ctl + CW_BAR + XB_TMO, f.tid);
            pg8::DenseSched S; S.init(WSP(const bf16_t, WS_XB) + (size_t)f.row0 * DM, WSP(const bf16_t, WS_WIN) + (size_t)l * DINP * DM, DM, DM, SMT, DINP, f.G, f.bx); S.wave = f.wave;
            pg8::EpiBf16 E{f.U + (size_t)f.row0 * DINP, DINP}; pg8::gemm_phase(f.lds, DM, S, E); }
        SBAR();
        { { const Frame f = F.fresh(); for (int u = f.bx; u < 128; u += f.G) conv_unit(f, args, l, f.sid * 128 + u); }
          { const Frame f = F.fresh(); for (int u = f.bx; u < 512; u += f.G) gla_a_unit(f, args, l, f.sid * 512 + u); } __syncthreads(); }
        SBAR();
        { { const Frame f = F.fresh(); gla_scan(f); }
            const Frame f = F.fresh();
            LAS float* bt = (LAS float*)(f.lds + 8 * 2 * AT_VBUF);
            __syncthreads();
            for (int i = f.tid; i < 3 * 129 * 8; i += 512) bt[i] = WSP(const float, WS_BTAB)[i];
            __syncthreads();
            for (int job = f.bx * 8 + f.wave; job < 16 * 3 * 128; job += f.G * 8) attn_job(f, f.sid * 16 * 3 * 128 + job, f.lds + f.wave * 2 * AT_VBUF, bt);
            __syncthreads(); }
        SBAR();
        { { const Frame f = F.fresh(); gla_c_phase(f, args, l); __syncthreads(); } { const Frame f = F.fresh(); attn_combine(f); } }
        SBAR();
        { { const Frame f = F.fresh(); pg8::DenseSched S; S.init(f.MIX + (size_t)f.row0 * DM, WSP(const bf16_t, WS_WOUT) + (size_t)l * DM * DM, DM, DM, SMT, DM, f.G, f.bx); S.wave = f.wave;
              pg8::EpiRes E{WSP(bf16_t, WS_PRE) + (size_t)f.row0 * DM, WSP(const bf16_t, WS_XB) + (size_t)f.row0 * DM, DM, DN_ALPHA}; pg8::gemm_phase(f.lds, DM, S, E); }
          { const Frame f = F.fresh(); pg8::DenseSched S; S.init(WSP(const bf16_t, WS_PB) + ((size_t)l * MT + f.row0) * PLE, WSP(const bf16_t, WS_WPP) + (size_t)l * DM * PLE, PLE, PLE, SMT, DM, f.G, f.bx); S.wave = f.wave;
              pg8::EpiBf16 E{WSP(bf16_t, WS_PP) + (size_t)f.row0 * DM, DM}; pg8::gemm_phase(f.lds, PLE, S, E); } }
        SBAR();
        { const Frame f = F.fresh(); for (int u = f.bx; u < SMT / 16; u += f.G) ln1_unit(f, args, l, f.sid * (SMT / 16) + u, true); __syncthreads(); }
        SBAR();
        { { const Frame f = F.fresh(); if (f.sid == l) flag_wait(f.ctl + CW_FLAG + (l == 0 ? 0 : 2) * 64, (unsigned)f.G, f.ctl + CW_BAR + XB_TMO, f.tid);
              pg8::DenseSched S; S.init(WSP(const bf16_t, WS_XB) + (size_t)f.row0 * DM, WSP(const bf16_t, WS_WPG) + (size_t)l * DM * DM, DM, DM, SMT, DM, f.G, f.bx); S.wave = f.wave;
              pg8::EpiPle E{WSP(bf16_t, WS_PRE) + (size_t)f.row0 * DM, WSP(const bf16_t, WS_XB) + (size_t)f.row0 * DM, WSP(const bf16_t, WS_PP) + (size_t)f.row0 * DM, args.in[24] + (size_t)l * DM, DM, DN_ALPHA}; pg8::gemm_phase(f.lds, DM, S, E); }
          { const Frame f = F.fresh(); moe_tables(f, l);
              pg8::MoeSched<true> S; S.A = WSP(const bf16_t, WS_XB); S.Bt = WSP(const bf16_t, WS_WGU) + (size_t)l * NEXP * 512 * DM; S.lda = DM; S.ldb = DM; S.nN = 2; S.G = f.G; S.c = f.bx; S.wave = f.wave; S.bexp = (size_t)512 * DM * 2;
              S.toff = (const LAS int*)(f.lds + LDS_TOFF); S.cnt = f.ctl + CW_CNT + (l * 2 + f.sid) * 32 * 64; S.ltok = WSP(const int, WS_LTOK) + f.sid * 32 * SMT;
              pg8::EpiMoe1 E{f.H, WSP(const float, WS_LGATE) + f.sid * 32 * SMT, f.ctl + CW_CNT + (l * 2 + f.sid) * 32 * 64};
              const int total = __builtin_amdgcn_readfirstlane(S.toff[32]) * 2;
#pragma unroll 1
              for (int r0 = 0; r0 * f.G < total; ++r0) { S.round0 = r0; pg8::gemm_phase<pg8::EpiMoe1, pg8::MoeSched<true>, true>(f.lds, DM, S, E); } } }
        SBAR();
        { const Frame f = F.fresh(); moe_tables(f, l);
            pg8::MoeSched<false> S; S.A = f.H; S.Bt = WSP(const bf16_t, WS_WD) + (size_t)l * NEXP * DM * DEXP; S.lda = DEXP; S.ldb = DEXP; S.nN = 8; S.G = f.G; S.c = f.bx; S.wave = f.wave; S.bexp = (size_t)DM * DEXP * 2;
            S.toff = (const LAS int*)(f.lds + LDS_TOFF); S.cnt = f.ctl + CW_CNT + (l * 2 + f.sid) * 32 * 64; S.ltok = WSP(const int, WS_LTOK) + f.sid * 32 * SMT;
            pg8::EpiBf16 E{f.Y, DM}; pg8::gemm_phase(f.lds, DEXP, S, E); }
        SBAR();
        { { const Frame f = F.fresh(); moe_tables(f, l); ln2_rows(f, args, l, args.out, l + 1 < NL); }
          if (l + 1 < NL) { const Frame f = F.fresh();
              if (f.sid == 0) { conv_all(f, args, l + 1, 0, IO_PG); flag_publish(f.ctl + CW_FLAG + 1 * 64, f.tid); conv_all(f, args, l + 1, IO_PG, I_L); flag_publish(f.ctl + CW_FLAG + 2 * 64, f.tid); } } }
        SBAR();
    }
#undef WSP
#undef SBAR
}

extern "C" void kernel_launch(void* const* d_in, const int* in_sizes, int n_in, void* d_out, int out_size, void* d_ws, size_t ws_size, hipStream_t stream) {
    static int grid = 0;
    if (grid == 0) {
        if (n_in != 28 || out_size != MT * DM || ws_size < WS_END) { fprintf(stderr, "kernel_launch: unexpected shapes (n_in %d, out %d, ws %zu); nothing launched\n", n_in, out_size, ws_size); grid = -1; return; }
        int dev = 0, cus = 0, per_cu = 0;
        if (hipGetDevice(&dev) != hipSuccess || hipDeviceGetAttribute(&cus, hipDeviceAttributeMultiprocessorCount, dev) != hipSuccess) { grid = -1; return; }
        if (hipFuncSetAttribute((const void*)mega, hipFuncAttributeMaxDynamicSharedMemorySize, LDS_BYTES) != hipSuccess) { fprintf(stderr, "kernel_launch: hipFuncSetAttribute failed\n"); grid = -1; return; }
        if (hipOccupancyMaxActiveBlocksPerMultiprocessor(&per_cu, (const void*)mega, 512, LDS_BYTES) != hipSuccess || per_cu < 1) { fprintf(stderr, "kernel_launch: occupancy query says %d\n", per_cu); }
        (void)hipGetLastError();
        grid = cus;
    }
    if (grid < 0) return;
    (void)hipMemsetAsync((char*)d_ws + WS_CTL, 0, CTL_ZERO_BYTES, stream);
    Args a{};
    for (int i = 0; i < 28; ++i) a.in[i] = (const float*)d_in[i];
    a.out = (float*)d_out; a.ws = (unsigned char*)d_ws;
    a.ph_lo = 0; a.ph_hi = 0; hipLaunchKernelGGL(mega, dim3(grid), dim3(512), LDS_BYTES, stream, a);
}
```

```cpp
#include <hip/hip_runtime.h>
#include <cstdio>
#include <cstdint>

#ifndef REP_MASK
#define REP_MASK 0
#endif
#define REPS(k) (1 + ((REP_MASK >> (k)) & 1))
#ifndef TPROBE
#define TPROBE 0
#endif
#ifndef TP_SID
#define TP_SID 0
#endif
#ifndef TP_K
#define TP_K 0
#endif
#ifndef TP_MULT
#define TP_MULT 16
#endif
#ifndef LAUNCH_PER_PHASE
#define LAUNCH_PER_PHASE 0
#endif

#define LAS __attribute__((address_space(3)))
#define GAS __attribute__((address_space(1)))
typedef unsigned short bf16_t;
typedef short bf16x8 __attribute__((ext_vector_type(8)));
typedef float f32x4 __attribute__((ext_vector_type(4)));
typedef float f32x2 __attribute__((ext_vector_type(2)));
typedef unsigned u32x4 __attribute__((ext_vector_type(4)));
typedef unsigned u32x2 __attribute__((ext_vector_type(2)));

constexpr int NL = 2, NBATCH = 4, SEQ = 2048, DM = 2048, MT = NBATCH * SEQ;
constexpr int DIN = 5648, DINP = 5888, PLE = 256, NEXP = 32, DEXP = 256;
constexpr int UA_VAL = 0, UA_GATE = 512, UG_Q = 1024, UG_K = 1280, UG_V = 1536, UG_R = 2048, UC_Q = 2560, UC_K = 3072, UC_V = 3584, US_B = 4096, US_C = 4608, US_H = 5120, UG_LOW = 5632;
constexpr float DN_ALPHA = 1.41421356237309515f, LN_EPS = 1e-5f, RMS_EPS = 1e-6f;
constexpr int NSTREAM = 2, SMT = MT / NSTREAM;
constexpr int MAXSLOT = 16384;

constexpr size_t MiB = 1u << 20;
constexpr size_t WS_CTL = 0, CTL_ZERO_BYTES = 1 * MiB;
constexpr size_t WS_BTAB = 1 * MiB;
constexpr size_t WS_WRT = 1 * MiB + 64 * 1024;
constexpr size_t WS_WRH = 5 * MiB;
constexpr size_t WS_WRL = 5 * MiB + 512 * 1024;
constexpr size_t WS_WRS = 6 * MiB;
constexpr size_t WS_LTOK = 2 * MiB;
constexpr size_t WS_LGATE = 3 * MiB;
constexpr size_t WS_TINFO = 4 * MiB;
constexpr size_t WS_WIN = 8 * MiB;
constexpr size_t WS_WOUT = 54 * MiB;
constexpr size_t WS_WGU = 70 * MiB;
constexpr size_t WS_WD = 198 * MiB;
constexpr size_t WS_WPG = 262 * MiB;
constexpr size_t WS_WPP = 278 * MiB;
constexpr size_t WS_XB = 280 * MiB;
constexpr size_t WS_PB = 312 * MiB;
constexpr size_t WS_ARENA = 320 * MiB, ARENA = 64 * MiB;
constexpr size_t ARENA_MIX = 46 * MiB;
constexpr size_t WS_PRE = 448 * MiB;
constexpr size_t WS_GU = 448 * MiB;
constexpr size_t WS_GO = 480 * MiB;
constexpr size_t WS_GQ = 496 * MiB;
constexpr size_t WS_GD = 504 * MiB;
constexpr size_t WS_PP = 512 * MiB;
constexpr size_t WS_AO = 560 * MiB;
constexpr size_t WS_ALSE = 584 * MiB;
constexpr size_t WS_H = 544 * MiB, HSTREAM = 8 * MiB;
constexpr size_t WS_END = 585 * MiB;
static_assert((size_t)SMT * DINP * 2 <= ARENA_MIX && ARENA_MIX + (size_t)SMT * DM * 2 <= ARENA && (size_t)MAXSLOT * DM * 2 <= ARENA && WS_ARENA + NSTREAM * ARENA <= 448 * MiB, "ws map");
constexpr int CW_BAR = 4096;
constexpr int CW_FLAG = 14592;
constexpr int CW_CNT = 16384;

constexpr int LDS_STAGE = 135168;
constexpr int LDS_TOFF = LDS_STAGE;
constexpr int LDS_BARW = LDS_STAGE + 512;
constexpr int LDS_ARGS = LDS_STAGE + 1024;
constexpr int LDS_BYTES = LDS_STAGE + 1792;

__device__ __forceinline__ float bf2f(unsigned b) { return __uint_as_float(b << 16); }
__device__ __forceinline__ unsigned f2bf(float f) { unsigned u = __float_as_uint(f); return (u + 0x7fffu + ((u >> 16) & 1u)) >> 16; }
__device__ __forceinline__ unsigned pk2(float lo, float hi) { unsigned r; asm("v_cvt_pk_bf16_f32 %0, %1, %2" : "=v"(r) : "v"(lo), "v"(hi)); return r; }
__device__ __forceinline__ float bflo(unsigned w) { return __uint_as_float(w << 16); }
__device__ __forceinline__ float bfhi(unsigned w) { return __uint_as_float(w & 0xffff0000u); }
__device__ __forceinline__ float wave_sum(float v) {
#pragma unroll
    for (int o = 1; o < 64; o <<= 1) v += __shfl_xor(v, o);
    return v;
}
__device__ __forceinline__ float wave_max(float v) {
#pragma unroll
    for (int o = 1; o < 64; o <<= 1) v = fmaxf(v, __shfl_xor(v, o));
    return v;
}
__device__ __forceinline__ float sigmoidf_(float x) { return 1.0f / (1.0f + __expf(-x)); }
__device__ __forceinline__ float siluf_(float x) { return x / (1.0f + __expf(-x)); }
#define LDS_WAIT() asm volatile("s_waitcnt lgkmcnt(0)" ::: "memory")
__device__ __forceinline__ f32x4 zero4() { float z = 0.f; asm volatile("" : "+v"(z)); return (f32x4){z, z, z, z}; }

namespace pg8 {
constexpr int BM = 256, BK = 64, HALF = 128, HTB = HALF * BK * 2, STAGE_BYTES = 8 * HTB, NXCD = 8, WGM = 8;
__host__ __device__ __forceinline__ int lds_byte(int r, int c) { const int st = (r >> 4) * 2 + (c >> 5), rr = r & 15, cc = c & 31, ob = rr * 64 + cc * 2; return st * 1024 + (ob ^ (((ob >> 9) & 1) << 5)); }
__host__ __device__ __forceinline__ void stage_rc(int b, int& R, int& C) { const int st = b / 1024, sb = b % 1024, swz = sb ^ (((sb >> 9) & 1) << 5); R = (st >> 1) * 16 + swz / 64; C = (st & 1) * 32 + (swz % 64) / 2; }
__host__ __device__ __forceinline__ int perm32(int rho) { const int n = rho >> 4, i = rho & 15; return 8 * (i >> 2) + 4 * n + (i & 3); }

struct Unit { int pm, pn, e, r; };

struct DenseSched {
    static constexpr bool GATHER = false;
    const bf16_t* A; const bf16_t* Bt; int lda, ldb, nM, nN, nwg, G, c, wave;
    __device__ void init(const bf16_t* A_, const bf16_t* Bt_, int lda_, int ldb_, int M, int N, int G_, int c_) { A = A_; Bt = Bt_; lda = lda_; ldb = ldb_; nM = M / BM; nN = N / BM; nwg = nM * nN; G = G_; c = c_; }
    __device__ __forceinline__ bool next(int i, Unit& u) const {
        const long L = (long)i * G + c; if (L >= nwg) return false;
        int wgid = (int)L; { const int q = nwg / NXCD, r = nwg % NXCD, xcd = wgid % NXCD, off = wgid / NXCD; wgid = (xcd < r ? xcd * (q + 1) : r * (q + 1) + (xcd - r) * q) + off; }
        const int nig = WGM * nN, gid = wgid / nig, fm = gid * WGM, gsz = (nM - fm) < WGM ? (nM - fm) : WGM;
        u.pm = fm + ((wgid % nig) % gsz); u.pn = (wgid % nig) / gsz; u.e = 0; u.r = 0; return true;
    }
    __device__ __forceinline__ const char* a_base(const Unit& u) const { return (const char*)A + (size_t)u.pm * BM * lda * 2; }
    __device__ __forceinline__ const char* b_base(const Unit& u) const { return (const char*)Bt + (size_t)u.pn * BM * ldb * 2; }
    __device__ __forceinline__ void a_offs(const Unit&, int, unsigned (&vo)[2][2]) const { }
};
template <bool GATHER_> struct MoeSched {
    static constexpr bool GATHER = GATHER_;
    const bf16_t* A; const bf16_t* Bt; int lda, ldb, nN, G, c, wave; size_t bexp;
    const LAS int* toff; const unsigned* cnt; const int* ltok; int round0 = 0;
    __device__ __forceinline__ bool next(int i, Unit& u) const {
        const int L = (i + round0) * G + c; const int total = __builtin_amdgcn_readfirstlane(toff[32]) * nN; if (L >= total) return false;
        const int j = L / nN; u.pn = L - j * nN; int e = 0;
#pragma unroll 1
        for (int k = 1; k < 32; ++k) e = (__builtin_amdgcn_readfirstlane(toff[k]) <= j) ? k : e;
        u.e = e; u.r = j - __builtin_amdgcn_readfirstlane(toff[e]); u.pm = j; return true;
    }
    __device__ __forceinline__ const char* a_base(const Unit& u) const { return GATHER ? (const char*)A : (const char*)A + (size_t)u.pm * BM * lda * 2; }
    __device__ __forceinline__ const char* b_base(const Unit& u) const { return (const char*)Bt + (size_t)u.e * bexp + (size_t)u.pn * BM * ldb * 2; }
    __device__ __forceinline__ void a_offs(const Unit& u, int tid, unsigned (&vo)[2][2]) const {
        if constexpr (GATHER) {
        int R[2], C[2]; stage_rc(tid * 16, R[0], C[0]); stage_rc(tid * 16 + 8192, R[1], C[1]);
        const int n = __builtin_amdgcn_readfirstlane((int)cnt[u.e * 64]);
#pragma unroll
        for (int h = 0; h < 2; ++h)
#pragma unroll
            for (int i = 0; i < 2; ++i) {
                const int sr = u.r * BM + h * HALF + R[i]; const int row = (sr < n) ? ltok[u.e * SMT + sr] : 0;
                vo[h][i] = (unsigned)(row * lda + C[i]) * 2u;
            }
        }
    }
};

__device__ __forceinline__ unsigned cvt_pk_bf16(float lo, float hi) { unsigned r; asm volatile("v_cvt_pk_bf16_f32 %0, %1, %2" : "=v"(r) : "v"(lo), "v"(hi)); return r; }

struct EpiBf16 {
    static constexpr bool PERM = true;
    bf16_t* O; int ldc;
    __device__ __forceinline__ void operator()(const f32x4 (&acc)[2][2][4][2], const Unit& u, int wr, int wc, int fr, int fq) const {
        const int row0 = u.pm * BM + wr * 64 + fr, col0 = u.pn * BM + wc * 32 + 8 * fq;
#pragma unroll
        for (int ai = 0; ai < 2; ++ai)
#pragma unroll
            for (int m = 0; m < 4; ++m) { bf16_t* rowp = O + (size_t)(row0 + ai * HALF + m * 16) * ldc + col0;
#pragma unroll
                for (int bj = 0; bj < 2; ++bj) { const f32x4 v0 = acc[ai][bj][m][0], v1 = acc[ai][bj][m][1];
                    u32x4 w; w.x = cvt_pk_bf16(v0[0], v0[1]); w.y = cvt_pk_bf16(v0[2], v0[3]); w.z = cvt_pk_bf16(v1[0], v1[1]); w.w = cvt_pk_bf16(v1[2], v1[3]);
                    *(u32x4*)(rowp + bj * HALF) = w; } }
    }
};
struct EpiRes {
    static constexpr bool PERM = true;
    bf16_t* C; const bf16_t* res; int ldc; float alpha;
    __device__ __forceinline__ void operator()(const f32x4 (&acc)[2][2][4][2], const Unit& u, int wr, int wc, int fr, int fq) const {
        const int row0 = u.pm * BM + wr * 64 + fr, col0 = u.pn * BM + wc * 32 + 8 * fq;
#pragma unroll
        for (int ai = 0; ai < 2; ++ai)
#pragma unroll
            for (int m = 0; m < 4; ++m) { const size_t off = (size_t)(row0 + ai * HALF + m * 16) * ldc + col0;
#pragma unroll
                for (int bj = 0; bj < 2; ++bj) { const u32x4 rv = *(const u32x4*)(res + off + bj * HALF); const f32x4 v0 = acc[ai][bj][m][0], v1 = acc[ai][bj][m][1];
                    u32x4 w; w.x = cvt_pk_bf16(bflo(rv.x) * alpha + v0[0], bfhi(rv.x) * alpha + v0[1]); w.y = cvt_pk_bf16(bflo(rv.y) * alpha + v0[2], bfhi(rv.y) * alpha + v0[3]);
                    w.z = cvt_pk_bf16(bflo(rv.z) * alpha + v1[0], bfhi(rv.z) * alpha + v1[1]); w.w = cvt_pk_bf16(bflo(rv.w) * alpha + v1[2], bfhi(rv.w) * alpha + v1[3]);
                    *(u32x4*)(C + off + bj * HALF) = w; }
                asm volatile("" ::: "memory"); }
    }
};
struct EpiPle {
    static constexpr bool PERM = true;
    bf16_t* C; const bf16_t* x1; const bf16_t* pp; const float* bias; int ldc; float alpha;
    __device__ __forceinline__ void operator()(const f32x4 (&acc)[2][2][4][2], const Unit& u, int wr, int wc, int fr, int fq) const {
        const int row0 = u.pm * BM + wr * 64 + fr, col0 = u.pn * BM + wc * 32 + 8 * fq;
        f32x4 bv[2][2];
#pragma unroll
        for (int bj = 0; bj < 2; ++bj)
#pragma unroll
            for (int n = 0; n < 2; ++n) bv[bj][n] = *(const f32x4*)(bias + col0 + bj * HALF + 4 * n);
#pragma unroll
        for (int ai = 0; ai < 2; ++ai)
#pragma unroll
            for (int m = 0; m < 4; ++m) { const size_t off = (size_t)(row0 + ai * HALF + m * 16) * ldc + col0;
#pragma unroll
                for (int bj = 0; bj < 2; ++bj) { const size_t o = off + bj * HALF; const u32x4 xv = *(const u32x4*)(x1 + o), pw = *(const u32x4*)(pp + o);
                    const f32x4 a0 = acc[ai][bj][m][0] + bv[bj][0], a1 = acc[ai][bj][m][1] + bv[bj][1];
                    u32x4 w;
                    w.x = cvt_pk_bf16(bflo(xv.x) * alpha + sigmoidf_(a0[0]) * bflo(pw.x), bfhi(xv.x) * alpha + sigmoidf_(a0[1]) * bfhi(pw.x));
                    w.y = cvt_pk_bf16(bflo(xv.y) * alpha + sigmoidf_(a0[2]) * bflo(pw.y), bfhi(xv.y) * alpha + sigmoidf_(a0[3]) * bfhi(pw.y));
                    w.z = cvt_pk_bf16(bflo(xv.z) * alpha + sigmoidf_(a1[0]) * bflo(pw.z), bfhi(xv.z) * alpha + sigmoidf_(a1[1]) * bfhi(pw.z));
                    w.w = cvt_pk_bf16(bflo(xv.w) * alpha + sigmoidf_(a1[2]) * bflo(pw.w), bfhi(xv.w) * alpha + sigmoidf_(a1[3]) * bfhi(pw.w));
                    *(u32x4*)(C + o) = w; }
                asm volatile("" ::: "memory"); }
    }
};
struct EpiMoe1 {
    static constexpr bool PERM = true;
    bf16_t* H; const float* lgate; const unsigned* cnt;
    __device__ __forceinline__ void operator()(const f32x4 (&acc)[2][2][4][2], const Unit& u, int wr, int wc, int fr, int fq) const {
        const int n_e = __builtin_amdgcn_readfirstlane((int)cnt[u.e * 64]);
        const int col0 = u.pn * HALF + wc * 32 + 8 * fq;
#pragma unroll
        for (int ai = 0; ai < 2; ++ai)
#pragma unroll
            for (int m = 0; m < 4; ++m) { const int rt = ai * HALF + wr * 64 + m * 16 + fr; const int sr = u.r * BM + rt;
                const float gw = (sr < n_e) ? lgate[u.e * SMT + sr] : 0.f;
                const f32x4 g0 = acc[ai][0][m][0], g1 = acc[ai][0][m][1], u0 = acc[ai][1][m][0], u1 = acc[ai][1][m][1];
                float o[8];
#pragma unroll
                for (int j = 0; j < 4; ++j) { o[j] = siluf_(g0[j]) * u0[j] * gw; o[4 + j] = siluf_(g1[j]) * u1[j] * gw; }
                u32x4 w; w.x = cvt_pk_bf16(o[0], o[1]); w.y = cvt_pk_bf16(o[2], o[3]); w.z = cvt_pk_bf16(o[4], o[5]); w.w = cvt_pk_bf16(o[6], o[7]);
                *(u32x4*)(H + (size_t)(u.pm * BM + rt) * DEXP + col0) = w; }
    }
};

template <class Epi, class Sched, bool SINGLE = false>
__device__ __forceinline__ void gemm_phase(LAS unsigned char* lds, const int K, const Sched& S, const Epi& E) {
    constexpr bool GA = Sched::GATHER;
    int lane_ = (int)__builtin_amdgcn_mbcnt_hi(~0u, __builtin_amdgcn_mbcnt_lo(~0u, 0u)); asm volatile("" : "+v"(lane_));
    const int wid = S.wave, lane = lane_, tid = wid * 64 + lane_, wr = wid >> 2, wc = wid & 3, fr = lane & 15, fq = lane >> 4;
    const int nt = K / BK, ldb = S.ldb, lda = S.lda;
    unsigned voffB[2], voffA[2];
#pragma unroll
    for (int i = 0; i < 2; ++i) { int R, C; stage_rc(tid * 16 + i * 8192, R, C); const int Rb = Epi::PERM ? ((R & ~31) + perm32(R & 31)) : R; voffB[i] = (unsigned)(Rb * ldb + C) * 2u; voffA[i] = (unsigned)(R * lda + C) * 2u; }
    const size_t kstep = (size_t)(BK * 2);
    const size_t hstep = (size_t)HALF * ldb * 2;
    const size_t ahstep = GA ? 0 : (size_t)HALF * lda * 2;
    const unsigned ldsw = (unsigned)wid * 1024u;
    const int aoff = lds_byte(wr * 64 + fr, fq * 8), boff = lds_byte(wc * 32 + fr, fq * 8);
#define PG8_SA(b, h) (((b) * 2 + (h)) * HTB)
#define PG8_SB(b, h) ((4 + (b) * 2 + (h)) * HTB)
#define PG8_STAGE(bufoff, gbase, voff) do { _Pragma("unroll") for (int _i = 0; _i < 2; ++_i) \
        __builtin_amdgcn_global_load_lds((const unsigned*)((const char*)(gbase) + (voff)[_i]), (LAS unsigned*)(lds + (bufoff) + ldsw + _i * 8192), 16, 0, 0); } while (0)
#define PG8_STAGE_A(bufoff, gbase, h) do { if constexpr (GA) PG8_STAGE(bufoff, gbase, voA[h]); else PG8_STAGE(bufoff, (gbase) + (h) * ahstep, voffA); } while (0)
#define PG8_STAGE_A2(bufoff, gbase, h) do { if constexpr (GA) { unsigned _v[2] = {last ? voN[h][0] : voA[h][0], last ? voN[h][1] : voA[h][1]}; PG8_STAGE(bufoff, gbase, _v); } else PG8_STAGE(bufoff, (gbase) + (h) * ahstep, voffA); } while (0)
#define PG8_LDA(dst, b, h) do { _Pragma("unroll") for (int m = 0; m < 4; ++m) _Pragma("unroll") for (int k = 0; k < 2; ++k) dst[m][k] = *(const LAS bf16x8*)(lds + PG8_SA(b, h) + aoff + m * 2048 + k * 1024); } while (0)
#define PG8_LDB(dst, b, h) do { _Pragma("unroll") for (int n = 0; n < 2; ++n) _Pragma("unroll") for (int k = 0; k < 2; ++k) dst[n][k] = *(const LAS bf16x8*)(lds + PG8_SB(b, h) + boff + n * 2048 + k * 1024); } while (0)
#define PG8_MMA(ai, bj, At, Bt) do { __builtin_amdgcn_s_setprio(1); _Pragma("unroll") for (int m = 0; m < 4; ++m) _Pragma("unroll") for (int n = 0; n < 2; ++n) _Pragma("unroll") for (int k = 0; k < 2; ++k) \
        acc[ai][bj][m][n] = __builtin_amdgcn_mfma_f32_16x16x32_bf16(Bt[n][k], At[m][k], acc[ai][bj][m][n], 0, 0, 0); __builtin_amdgcn_s_setprio(0); } while (0)
#define PG8_WAIT_V(n) asm volatile("s_waitcnt vmcnt(" #n ")" ::: "memory")
#define PG8_WAIT_L(n) asm volatile("s_waitcnt lgkmcnt(" #n ")" ::: "memory")
#define PG8_BAR __builtin_amdgcn_s_barrier()
#define PG8_SCHED __builtin_amdgcn_sched_barrier(0)
    Unit cur, nxt; int ui = 0;
    if (!S.next(0, cur)) return;
    f32x4 acc[2][2][4][2];
#pragma unroll
    for (int a = 0; a < 2; ++a)
#pragma unroll
        for (int b = 0; b < 2; ++b)
#pragma unroll
            for (int m = 0; m < 4; ++m)
#pragma unroll
                for (int n = 0; n < 2; ++n) acc[a][b][m][n] = (f32x4){0.f, 0.f, 0.f, 0.f};
    bf16x8 At[4][2], B0[2][2], B1[2][2];
    const char* cA = S.a_base(cur); const char* cB = S.b_base(cur);
    unsigned voA[2][2], voN[2][2];
    if constexpr (GA) S.a_offs(cur, tid, voA);
    PG8_STAGE(PG8_SB(0, 0), cB, voffB); PG8_STAGE(PG8_SB(0, 1), cB + hstep, voffB); PG8_STAGE_A(PG8_SA(0, 0), cA, 0); PG8_STAGE_A(PG8_SA(0, 1), cA, 1);
    if (wr == 1) PG8_BAR;
    PG8_WAIT_V(2); PG8_BAR;
    PG8_STAGE(PG8_SB(1, 0), cB + kstep, voffB); PG8_STAGE_A(PG8_SA(1, 0), cA + kstep, 0); PG8_STAGE(PG8_SB(1, 1), cB + hstep + kstep, voffB);
    PG8_WAIT_V(6); PG8_BAR;
    for (;;) {
        bool has_next = false; if constexpr (!SINGLE) has_next = S.next(ui + 1, nxt);
        const char* nA = has_next ? S.a_base(nxt) : cA; const char* nB = has_next ? S.b_base(nxt) : cB;
        if constexpr (GA) {
            if (has_next) S.a_offs(nxt, tid, voN);
            else {
#pragma unroll
                for (int h = 0; h < 2; ++h)
#pragma unroll
                    for (int i = 0; i < 2; ++i) voN[h][i] = voA[h][i]; } }
#pragma unroll 1
        for (int t = 0; t < nt; t += 2) {
            const bool last = (t == nt - 2);
            const char* a1 = cA + (size_t)(t + 1) * kstep;
            const char* a2 = last ? nA : cA + (size_t)(t + 2) * kstep; const char* b2 = last ? nB : cB + (size_t)(t + 2) * kstep;
            const char* a3 = a2 + kstep; const char* b3 = b2 + kstep;
            PG8_LDB(B0, 0, 0); PG8_LDB(B1, 0, 1); PG8_SCHED; PG8_LDA(At, 0, 0); PG8_STAGE_A(PG8_SA(1, 1), a1, 1);
            PG8_WAIT_V(8); PG8_WAIT_L(0); PG8_BAR; PG8_MMA(0, 0, At, B0); PG8_MMA(0, 1, At, B1); PG8_BAR; PG8_SCHED;
            PG8_LDA(At, 0, 1); PG8_STAGE(PG8_SB(0, 0), b2, voffB); PG8_STAGE(PG8_SB(0, 1), b2 + hstep, voffB); PG8_STAGE_A2(PG8_SA(0, 0), a2, 0);
            PG8_WAIT_V(8); PG8_WAIT_L(0); PG8_BAR; PG8_MMA(1, 0, At, B0); PG8_MMA(1, 1, At, B1); PG8_BAR; PG8_SCHED;
            PG8_LDB(B0, 1, 0); PG8_LDB(B1, 1, 1); PG8_SCHED; PG8_LDA(At, 1, 0); PG8_STAGE_A2(PG8_SA(0, 1), a2, 1);
            PG8_WAIT_V(8); PG8_WAIT_L(0); PG8_BAR; PG8_MMA(0, 0, At, B0); PG8_MMA(0, 1, At, B1); PG8_BAR; PG8_SCHED;
            PG8_LDA(At, 1, 1); PG8_STAGE(PG8_SB(1, 0), b3, voffB); PG8_STAGE(PG8_SB(1, 1), b3 + hstep, voffB); PG8_STAGE_A2(PG8_SA(1, 0), a3, 0);
            PG8_WAIT_V(8); PG8_WAIT_L(0); PG8_BAR; PG8_MMA(1, 0, At, B0); PG8_MMA(1, 1, At, B1); PG8_BAR; PG8_SCHED;
        }
        if (wr == 0) PG8_BAR;
        E(acc, cur, wr, wc, fr, fq);
        if (!has_next) break;
#pragma unroll
        for (int a = 0; a < 2; ++a)
#pragma unroll
            for (int b = 0; b < 2; ++b)
#pragma unroll
                for (int m = 0; m < 4; ++m)
#pragma unroll
                    for (int n = 0; n < 2; ++n) acc[a][b][m][n] = (f32x4){0.f, 0.f, 0.f, 0.f};
        cur = nxt; cA = nA; cB = nB; ++ui;
        if constexpr (GA) {
#pragma unroll
            for (int h = 0; h < 2; ++h)
#pragma unroll
                for (int i = 0; i < 2; ++i) voA[h][i] = voN[h][i]; }
        if (wr == 1) PG8_BAR;
    }
    PG8_WAIT_V(0);
    PG8_BAR;
#undef PG8_SA
#undef PG8_SB
#undef PG8_STAGE
#undef PG8_STAGE_A
#undef PG8_STAGE_A2
#undef PG8_LDA
#undef PG8_LDB
#undef PG8_MMA
#undef PG8_WAIT_V
#undef PG8_WAIT_L
#undef PG8_BAR
#undef PG8_SCHED
}
}

#define XB_TMO      128
#define XB_XCNT(j)  (256  + 64 * (j))
#define XB_XSUB(j)  (1280 + 64 * (j))
#define XB_XGEN(j)  (2304 + 64 * (j))
#define XB_TOP      3328
#define XB_TOPGEN   3392
#define XCD_BAR_WORDS 3456
#define XB_SPIN_CAP (1u << 18)
__device__ __forceinline__ unsigned xb_ld(unsigned* p)              { return __hip_atomic_load(p, __ATOMIC_RELAXED, __HIP_MEMORY_SCOPE_AGENT); }
__device__ __forceinline__ unsigned xb_add(unsigned* p, unsigned v) { return __hip_atomic_fetch_add(p, v, __ATOMIC_RELAXED, __HIP_MEMORY_SCOPE_AGENT); }
__device__ __forceinline__ unsigned xb_xcc_id() { return (unsigned)__builtin_amdgcn_s_getreg((3 << 11) | 20) & 0xFu; }
#define XB_SPIN(cond, bar) do { unsigned _sp = 0; while (cond) { __builtin_amdgcn_s_sleep(1); \
    if ((++_sp & 255u) == 0u) { if (xb_ld(&(bar)[XB_TMO])) break; if (_sp > XB_SPIN_CAP) { atomicAdd(&(bar)[XB_TMO], 1u); break; } } } } while (0)
struct XcdBarrier { unsigned* bar; unsigned x; volatile LAS unsigned* st; unsigned ng; int wave; };
__device__ __forceinline__ XcdBarrier xcd_barrier_post(unsigned* bar, volatile LAS unsigned* st, unsigned ng) {
    XcdBarrier b; b.bar = bar; b.x = xb_xcc_id(); b.st = st; b.ng = ng; b.wave = __builtin_amdgcn_readfirstlane((int)threadIdx.x >> 6);
    if (threadIdx.x == 0) (void)xb_add(&bar[XB_XCNT(b.x)], 1u);
    return b;
}
__device__ __forceinline__ void xcd_barrier_complete(unsigned* bar, unsigned x, unsigned& nloc, unsigned& nx, const unsigned G) {
    unsigned sum, cnt, mine, sp = 0u;
    for (;;) {
        sum = 0u; cnt = 0u; mine = 0u;
#pragma unroll
        for (unsigned j = 0; j < 16; ++j) { const unsigned c = xb_ld(&bar[XB_XCNT(j)]); sum += c; cnt += (c > 0u) ? 1u : 0u; mine = (j == x) ? c : mine; }
        if (sum == G) break;
        __builtin_amdgcn_s_sleep(1);
        if ((++sp & 255u) == 0u) { if (xb_ld(&bar[XB_TMO])) break; if (sp > XB_SPIN_CAP) { atomicAdd(&bar[XB_TMO], 1u); break; } }
    }
    nloc = mine > 0u ? mine : 1u; nx = cnt > 0u ? cnt : 1u;
}
__device__ __forceinline__ void xcd_barrier(const XcdBarrier& b) {
    asm volatile("s_waitcnt vmcnt(0)" ::: "memory");
    __syncthreads();
    int ln_ = (int)__builtin_amdgcn_mbcnt_hi(~0u, __builtin_amdgcn_mbcnt_lo(~0u, 0u)); asm volatile("" : "+v"(ln_));
    if (b.wave == 0 && ln_ == 0) {
        unsigned* bar = b.bar;
        __builtin_amdgcn_s_waitcnt(0);
        unsigned nloc = b.st[0], nx = b.st[1];
        if (nloc == 0u) { xcd_barrier_complete(bar, b.x, nloc, nx, b.ng); b.st[0] = nloc; b.st[1] = nx; }
        const unsigned old = xb_add(&bar[XB_XSUB(b.x)], 1u);
        const unsigned gen = old / nloc;
        if (old + 1u == (gen + 1u) * nloc) {
            __builtin_amdgcn_fence(__ATOMIC_RELEASE, "agent");
            asm volatile("s_waitcnt vmcnt(0)" ::: "memory");
            const unsigned og = xb_add(&bar[XB_TOP], 1u);
            const unsigned tg = og / nx;
            if (og + 1u == (tg + 1u) * nx) xb_add(&bar[XB_TOPGEN], 1u);
            else XB_SPIN(xb_ld(&bar[XB_TOPGEN]) == tg, bar);
            __builtin_amdgcn_fence(__ATOMIC_ACQUIRE, "agent");
            xb_add(&bar[XB_XGEN(b.x)], 1u);
            asm volatile("s_waitcnt vmcnt(0)" ::: "memory");
        } else {
            XB_SPIN(xb_ld(&bar[XB_XGEN(b.x)]) == gen, bar);
            __builtin_amdgcn_fence(__ATOMIC_ACQUIRE, "agent");
            asm volatile("s_waitcnt vmcnt(0)" ::: "memory");
        }
    }
    __syncthreads();
}


__device__ __forceinline__ void flag_publish(unsigned* flag, int tid) {
    asm volatile("s_waitcnt vmcnt(0)" ::: "memory");
    __syncthreads();
    if (tid == 0) { __builtin_amdgcn_fence(__ATOMIC_RELEASE, "agent"); asm volatile("s_waitcnt vmcnt(0)" ::: "memory"); (void)xb_add(flag, 1u); }
}
__device__ __forceinline__ void flag_wait(unsigned* flag, unsigned want, unsigned* tmo, int tid) {
    if (tid == 0) { unsigned sp = 0;
        while (xb_ld(flag) < want) { __builtin_amdgcn_s_sleep(2); if ((++sp & 255u) == 0u) { if (xb_ld(tmo)) break; if (sp > (1u << 22)) { atomicAdd(tmo, 1u); break; } } }
        __builtin_amdgcn_fence(__ATOMIC_ACQUIRE, "agent"); asm volatile("s_waitcnt vmcnt(0)" ::: "memory"); }
    __syncthreads();
}

struct Args { const float* in[28]; float* out; unsigned char* ws; int ph_lo, ph_hi; };

__device__ __forceinline__ const float* argp(LAS unsigned char* lds, int k) {
    const unsigned long long v = ((const LAS unsigned long long*)(lds + LDS_ARGS))[k];
    const unsigned lo = __builtin_amdgcn_readfirstlane((unsigned)v), hi = __builtin_amdgcn_readfirstlane((unsigned)(v >> 32));
    return (const float*)(GAS const float*)(((unsigned long long)hi << 32) | lo);
}
struct Frame {
    LAS unsigned char* lds; unsigned char* ws; unsigned* ctl;
    int tid, lane, wave, G, bx, sid, row0;
    __device__ __forceinline__ bf16_t* Up() const { return (bf16_t*)(ws + WS_ARENA + (size_t)sid * ARENA) - (size_t)row0 * DINP; }
    __device__ __forceinline__ bf16_t* MIXp() const { return (bf16_t*)(ws + WS_ARENA + (size_t)sid * ARENA + ARENA_MIX) - (size_t)row0 * DM; }
    __device__ __forceinline__ bf16_t* Yp() const { return (bf16_t*)(ws + WS_ARENA + (size_t)sid * ARENA); }
    __device__ __forceinline__ bf16_t* Hp() const { return (bf16_t*)(ws + WS_H + (size_t)sid * HSTREAM); }
    __device__ __forceinline__ Frame fresh() const { Frame f = *this; int ln = (int)__builtin_amdgcn_mbcnt_hi(~0u, __builtin_amdgcn_mbcnt_lo(~0u, 0u)); asm volatile("" : "+v"(ln)); f.lane = ln; f.tid = wave * 64 + ln;
        int b = bx, g = G, s = sid, wv = wave; size_t zo = 0; asm volatile("" : "+s"(b), "+s"(g), "+s"(zo), "+s"(s), "+s"(wv)); unsigned char* w = ws + zo;
        return f; }
};

__device__ __forceinline__ int dmap(int type, int n) {
    if (type == 1) return n < 2048 ? n : (n < 2064 ? n - 2048 + UG_LOW : n - 16);
    if (type == 2) return (n >> 7) * 256 + (n & 127);
    if (type == 3) return (n >> 7) * 256 + 128 + (n & 127);
    return n;
}
__device__ __forceinline__ void transpose_item(const float* W, int ldw, int ncols, int k0, int n0, const float* kscale, bf16_t* WT, int ldt, int type, LAS float* scr, int lane) {
    const int n4 = (lane & 15) * 4, kr = lane >> 4; const bool okc = (n0 + n4) < ncols;
    f32x4 v[16];
#pragma unroll
    for (int i = 0; i < 16; ++i) v[i] = okc ? __builtin_nontemporal_load((const f32x4*)(W + (size_t)(k0 + 4 * i + kr) * ldw + n0 + n4)) : (f32x4){0.f, 0.f, 0.f, 0.f};
    if (kscale) {
#pragma unroll
        for (int i = 0; i < 16; ++i) v[i] = v[i] * kscale[k0 + 4 * i + kr]; }
#pragma unroll
    for (int i = 0; i < 16; ++i) { LAS float* s = scr + (4 * i + kr) * 65 + n4; s[0] = v[i][0]; s[1] = v[i][1]; s[2] = v[i][2]; s[3] = v[i][3]; }
    LDS_WAIT(); asm volatile("" ::: "memory");
    const int c = lane & 7;
#pragma unroll
    for (int j = 0; j < 8; ++j) { const int n = (lane >> 3) + 8 * j; const LAS float* s = scr + (8 * c) * 65 + n;
        u32x4 o; o.x = pk2(s[0 * 65], s[1 * 65]); o.y = pk2(s[2 * 65], s[3 * 65]); o.z = pk2(s[4 * 65], s[5 * 65]); o.w = pk2(s[6 * 65], s[7 * 65]);
        if (n0 + n < ncols) *(u32x4*)(WT + (size_t)dmap(type, n0 + n) * ldt + k0 + 8 * c) = o; }
    LDS_WAIT(); asm volatile("" ::: "memory");
}
__device__ __forceinline__ int t5_bucket(int d) {
    if (d < 16) return d;
    const float v = logf((float)d / 16.0f) / 4.852030263919617f * 16.0f;
    int b = 16 + (int)v; return b < 31 ? b : 31;
}
constexpr int I_IN = 32 * 89, I_OUT = 32 * 32, I_PP = 4 * 32, I_PG = 32 * 32, I_G = 32 * 128, I_U = 32 * 128, I_D = 32 * 128;
constexpr int IO_OUT = I_IN, IO_PP = IO_OUT + I_OUT, IO_PG = IO_PP + I_PP, IO_G = IO_PG + I_PG, IO_U = IO_G + I_G, IO_D = IO_U + I_U, I_L = IO_D + I_D;
__device__ __forceinline__ void conv_items(const Frame& F, const Args& a, const int l, const int lo, const int hi, const int gw, const int NGW) {
    LAS float* scr = (LAS float*)(F.lds + F.wave * 16640);
    bf16_t* WIN = (bf16_t*)(F.ws + WS_WIN); bf16_t* WOUT = (bf16_t*)(F.ws + WS_WOUT); bf16_t* WGU = (bf16_t*)(F.ws + WS_WGU); bf16_t* WD = (bf16_t*)(F.ws + WS_WD);
    bf16_t* WPG = (bf16_t*)(F.ws + WS_WPG); bf16_t* WPP = (bf16_t*)(F.ws + WS_WPP);
    for (int it = lo + gw; it < hi; it += NGW) {
        int r = it;
        if (r < IO_OUT) { const int kb = r / 89, nb = r - kb * 89; transpose_item(argp(F.lds, 2) + (size_t)l * DM * DIN, DIN, DIN, kb * 64, nb * 64, nullptr, WIN + (size_t)l * DINP * DM, DM, 1, scr, F.lane); continue; }
        if (r < IO_PP) { r -= IO_OUT; const int kb = r >> 5, nb = r & 31; transpose_item(argp(F.lds, 12) + (size_t)l * DM * DM, DM, DM, kb * 64, nb * 64, argp(F.lds, 11) + l * DM, WOUT + (size_t)l * DM * DM, DM, 0, scr, F.lane); continue; }
        if (r < IO_PG) { r -= IO_PP; const int kb = r >> 5, nb = r & 31; transpose_item(argp(F.lds, 25) + (size_t)l * PLE * DM, DM, DM, kb * 64, nb * 64, nullptr, WPP + (size_t)l * DM * PLE, PLE, 0, scr, F.lane); continue; }
        if (r < IO_G) { r -= IO_PG; const int kb = r >> 5, nb = r & 31; transpose_item(argp(F.lds, 23) + (size_t)l * DM * DM, DM, DM, kb * 64, nb * 64, nullptr, WPG + (size_t)l * DM * DM, DM, 0, scr, F.lane); continue; }
        if (r < IO_U) { r -= IO_G; const int e = r >> 7, q = r & 127, kb = q >> 2, nb = q & 3; transpose_item(argp(F.lds, 20) + (size_t)(l * NEXP + e) * DM * DEXP, DEXP, DEXP, kb * 64, nb * 64, nullptr, WGU + (size_t)(l * NEXP + e) * 512 * DM, DM, 2, scr, F.lane); continue; }
        if (r < IO_D) { r -= IO_U; const int e = r >> 7, q = r & 127, kb = q >> 2, nb = q & 3; transpose_item(argp(F.lds, 21) + (size_t)(l * NEXP + e) * DM * DEXP, DEXP, DEXP, kb * 64, nb * 64, nullptr, WGU + (size_t)(l * NEXP + e) * 512 * DM, DM, 3, scr, F.lane); continue; }
        { r -= IO_D; const int e = r >> 7, q = r & 127, kb = q >> 5, nb = q & 31; transpose_item(argp(F.lds, 22) + (size_t)(l * NEXP + e) * DEXP * DM, DM, DM, kb * 64, nb * 64, nullptr, WD + (size_t)(l * NEXP + e) * DM * DEXP, DEXP, 0, scr, F.lane); }
    }
}
__device__ __forceinline__ void conv_all(const Frame& F, const Args& a, const int l, const int lo, const int hi) { __syncthreads(); conv_items(F, a, l, lo, hi, F.bx * 8 + F.wave, F.G * 8); __syncthreads(); }
__device__ __forceinline__ void phase_prologue(const Frame& F, const Args& a) {
    bf16_t* WIN = (bf16_t*)(F.ws + WS_WIN);
    conv_all(F, a, 0, 0, IO_PG);
    const size_t gt = (size_t)F.bx * 512 + F.tid, NT = (size_t)F.G * 512;
    for (size_t i = gt; i < (size_t)NL * (DINP - DIN) * DM / 8; i += NT) { const size_t l = i / ((DINP - DIN) * DM / 8), r = i % ((DINP - DIN) * DM / 8);
        *(u32x4*)(WIN + (l * DINP + DIN) * DM + r * 8) = (u32x4){0u, 0u, 0u, 0u}; }
    { const float* x = argp(F.lds, 0); bf16_t* XB = (bf16_t*)(F.ws + WS_XB);
      for (size_t i = gt; i < (size_t)MT * DM / 8; i += NT) { const f32x4 v0 = *(const f32x4*)(x + i * 8), v1 = *(const f32x4*)(x + i * 8 + 4);
          *(u32x4*)(XB + i * 8) = (u32x4){pk2(v0[0], v0[1]), pk2(v0[2], v0[3]), pk2(v1[0], v1[1]), pk2(v1[2], v1[3])}; } }
    { const float* p = argp(F.lds, 1); bf16_t* PB = (bf16_t*)(F.ws + WS_PB);
      for (size_t i = gt; i < (size_t)NL * MT * PLE / 8; i += NT) { const f32x4 v0 = *(const f32x4*)(p + i * 8), v1 = *(const f32x4*)(p + i * 8 + 4);
          *(u32x4*)(PB + i * 8) = (u32x4){pk2(v0[0], v0[1]), pk2(v0[2], v0[3]), pk2(v1[0], v1[1]), pk2(v1[2], v1[3])}; } }
    { float* bt = (float*)(F.ws + WS_BTAB); const float* rb = argp(F.lds, 13);
      for (size_t i = gt; i < 3 * 129 * 8; i += NT) { const int h = (int)(i & 7), j = (int)((i >> 3) % 129), br = (int)((i >> 3) / 129); const int dil = br == 0 ? 1 : (br == 1 ? 4 : 16);
          bt[i] = rb[t5_bucket(j * dil) * 8 + h]; } }
    { bf16_t* wrh = (bf16_t*)(F.ws + WS_WRH); bf16_t* wrl = (bf16_t*)(F.ws + WS_WRL);
      for (size_t i = gt; i < (size_t)NL * 48 * DM; i += NT) { const int k = (int)(i % DM), c = (int)((i / DM) % 48), l = (int)(i / (48 * DM));
          float w = 0.f; if (c < 4) w = argp(F.lds, 16)[((size_t)l * DM + k) * 4 + c]; else if (c < 36) w = argp(F.lds, 18)[((size_t)l * DM + k) * 32 + (c - 4)];
          w *= argp(F.lds, 14)[(size_t)l * DM + k];
          const unsigned h = f2bf(w); const float lo = w - bf2f(h); wrh[i] = (bf16_t)h; wrl[i] = (bf16_t)f2bf(lo); } }
    { float* wrs = (float*)(F.ws + WS_WRS); const int gwv = F.bx * 8 + F.wave;
      if (gwv < NL * 36) { const int l = gwv / 36, c = gwv % 36; float s = 0.f, b = 0.f;
          for (int k = F.lane; k < DM; k += 64) { const float w = c < 4 ? argp(F.lds, 16)[((size_t)l * DM + k) * 4 + c] : argp(F.lds, 18)[((size_t)l * DM + k) * 32 + (c - 4)];
              s += w * argp(F.lds, 14)[(size_t)l * DM + k]; b += w * argp(F.lds, 15)[(size_t)l * DM + k]; }
          s = wave_sum(s); b = wave_sum(b);
          if (F.lane == 0) { wrs[(l * 2 + 0) * 48 + c] = s; wrs[(l * 2 + 1) * 48 + c] = b + (c < 4 ? argp(F.lds, 17)[l * 4 + c] : argp(F.lds, 19)[l * 32 + (c - 4)]); } } }
}

__device__ __forceinline__ void conv_unit(const Frame& F, const Args& a, int l, int unit) {
    const bf16_t* U = F.Up(); bf16_t* MIX = F.MIXp();
    LAS float* hb = (LAS float*)F.lds;
    const int t0 = unit * 32, tl0 = t0 & (SEQ - 1), tb = t0 - tl0;
    const int tid = F.tid;
    __syncthreads();
#pragma unroll 1
    for (int i = 0; i < 8; ++i) { const int id = tid + 512 * i; if (id < 62 * 64) { const int row = id >> 6, ch = (id & 63) * 8; const int tl = tl0 - 30 + row;
        float o[8];
        if (tl >= 0) { const bf16_t* up = U + (size_t)(tb + tl) * DINP; const u32x4 av = *(const u32x4*)(up + UA_VAL + ch), gv = *(const u32x4*)(up + UA_GATE + ch);
            const unsigned aw[4] = {av.x, av.y, av.z, av.w}, gw[4] = {gv.x, gv.y, gv.z, gv.w};
#pragma unroll
            for (int j = 0; j < 4; ++j) { o[2 * j] = bflo(aw[j]) * sigmoidf_(bflo(gw[j])); o[2 * j + 1] = bfhi(aw[j]) * sigmoidf_(bfhi(gw[j])); } }
        else {
#pragma unroll
            for (int j = 0; j < 8; ++j) o[j] = 0.f; }
        *(LAS f32x4*)(hb + row * 512 + ch) = (f32x4){o[0], o[1], o[2], o[3]}; *(LAS f32x4*)(hb + row * 512 + ch + 4) = (f32x4){o[4], o[5], o[6], o[7]}; } }
    __syncthreads();
    float yv[32];
    { const int c = tid; const float* w = argp(F.lds, 3) + (size_t)l * 31 * 512; const float bias = argp(F.lds, 4)[l * 512 + c];
      float wv[31];
#pragma unroll
      for (int j = 0; j < 31; ++j) wv[j] = w[j * 512 + c];
      float hv[62];
#pragma unroll
      for (int r = 0; r < 62; ++r) hv[r] = hb[r * 512 + c];
#pragma unroll
      for (int t = 0; t < 32; ++t) { float s = bias;
#pragma unroll
          for (int j = 0; j < 31; ++j) s += wv[j] * hv[t + j];
          yv[t] = s; } }
    __syncthreads();
#pragma unroll
    for (int t = 0; t < 32; ++t) hb[t * 512 + tid] = yv[t];
    __syncthreads();
    { const float* lg = argp(F.lds, 5) + l * 512; const float* lb = argp(F.lds, 6) + l * 512;
#pragma unroll 1
      for (int i = 0; i < 4; ++i) { const int t = F.wave + 8 * i;
          const f32x4 v0 = *(const LAS f32x4*)(hb + t * 512 + 4 * F.lane), v1 = *(const LAS f32x4*)(hb + t * 512 + 256 + 4 * F.lane);
          const float mean = wave_sum((v0[0] + v0[1]) + (v0[2] + v0[3]) + (v1[0] + v1[1]) + (v1[2] + v1[3])) * (1.f / 512.f);
          const f32x4 d0 = v0 - mean, d1 = v1 - mean;
          const float var = wave_sum((d0[0] * d0[0] + d0[1] * d0[1]) + (d0[2] * d0[2] + d0[3] * d0[3]) + (d1[0] * d1[0] + d1[1] * d1[1]) + (d1[2] * d1[2] + d1[3] * d1[3])) * (1.f / 512.f);
          const float rstd = 1.0f / sqrtf(var + LN_EPS);
          const f32x4 g0 = *(const f32x4*)(lg + 4 * F.lane), g1 = *(const f32x4*)(lg + 256 + 4 * F.lane), b0 = *(const f32x4*)(lb + 4 * F.lane), b1 = *(const f32x4*)(lb + 256 + 4 * F.lane);
          float o0[4], o1[4];
#pragma unroll
          for (int j = 0; j < 4; ++j) { o0[j] = siluf_(d0[j] * rstd * g0[j] + b0[j]); o1[j] = siluf_(d1[j] * rstd * g1[j] + b1[j]); }
          bf16_t* mp = MIX + (size_t)(t0 + t) * DM;
          *(u32x2*)(mp + 4 * F.lane) = (u32x2){pk2(o0[0], o0[1]), pk2(o0[2], o0[3])}; *(u32x2*)(mp + 256 + 4 * F.lane) = (u32x2){pk2(o1[0], o1[1]), pk2(o1[2], o1[3])}; } }
    { const int cg = (tid & 63) * 8; const float* w = argp(F.lds, 10) + (size_t)l * 3 * 512 + cg;
      float wv[3][8];
#pragma unroll
      for (int j = 0; j < 3; ++j) { const f32x4 a0 = *(const f32x4*)(w + j * 512), a1 = *(const f32x4*)(w + j * 512 + 4); wv[j][0] = a0[0]; wv[j][1] = a0[1]; wv[j][2] = a0[2]; wv[j][3] = a0[3]; wv[j][4] = a1[0]; wv[j][5] = a1[1]; wv[j][6] = a1[2]; wv[j][7] = a1[3]; }
#pragma unroll 1
      for (int pass = 0; pass < 2; ++pass) { const int tg = (tid >> 6) + 8 * pass;
      float p[4][8];
#pragma unroll
      for (int rr = 0; rr < 4; ++rr) { const int tl = tl0 + 2 * tg - 2 + rr;
          { const float msk = tl >= 0 ? 1.f : 0.f; const int tlc = tl >= 0 ? tl : 0;
            const bf16_t* up = U + (size_t)(tb + tlc) * DINP; const u32x4 cw = *(const u32x4*)(up + US_C + cg), hw = *(const u32x4*)(up + US_H + cg);
            const unsigned c4[4] = {cw.x, cw.y, cw.z, cw.w}, h4[4] = {hw.x, hw.y, hw.z, hw.w};
#pragma unroll
            for (int j = 0; j < 4; ++j) { p[rr][2 * j] = bflo(c4[j]) * bflo(h4[j]) * msk; p[rr][2 * j + 1] = bfhi(c4[j]) * bfhi(h4[j]) * msk; } } }
#pragma unroll
      for (int tt = 0; tt < 2; ++tt) { const int t = t0 + 2 * tg + tt; const u32x4 bw = *(const u32x4*)(U + (size_t)t * DINP + US_B + cg); const unsigned b4[4] = {bw.x, bw.y, bw.z, bw.w}; unsigned ow[4];
#pragma unroll
          for (int j = 0; j < 4; ++j) { const float y0 = bflo(b4[j]) * (wv[0][2 * j] * p[tt][2 * j] + wv[1][2 * j] * p[tt + 1][2 * j] + wv[2][2 * j] * p[tt + 2][2 * j]);
              const float y1 = bfhi(b4[j]) * (wv[0][2 * j + 1] * p[tt][2 * j + 1] + wv[1][2 * j + 1] * p[tt + 1][2 * j + 1] + wv[2][2 * j + 1] * p[tt + 2][2 * j + 1]); ow[j] = pk2(y0, y1); }
          *(u32x4*)(MIX + (size_t)t * DM + 1536 + cg) = (u32x4){ow[0], ow[1], ow[2], ow[3]}; } } }
}

__device__ __forceinline__ bf16x8 frag_f32(const LAS float* p) { const f32x4 a = *(const LAS f32x4*)p, b = *(const LAS f32x4*)(p + 4);
    const u32x4 w = (u32x4){pk2(a[0], a[1]), pk2(a[2], a[3]), pk2(b[0], b[1]), pk2(b[2], b[3])}; return __builtin_bit_cast(bf16x8, w); }
__device__ __forceinline__ bf16x8 frag_col(const LAS float* p, int stride) {
    const u32x4 w = (u32x4){pk2(p[0], p[stride]), pk2(p[2 * stride], p[3 * stride]), pk2(p[4 * stride], p[5 * stride]), pk2(p[6 * stride], p[7 * stride])}; return __builtin_bit_cast(bf16x8, w); }
__device__ __forceinline__ void gla_a_unit(const Frame& F, const Args& a, int l, int unit) {
    const bf16_t* U = F.Up();
    float* GU = (float*)(F.ws + WS_GU); float* GO = (float*)(F.ws + WS_GO); float* GQ = (float*)(F.ws + WS_GQ); float* GD = (float*)(F.ws + WS_GD);
    const int n = unit & 63, h = (unit >> 6) & 3, b = unit >> 8, bh = b * 4 + h;
    const int t0 = b * SEQ + n * 32, tid = F.tid;
    LAS float* L = (LAS float*)F.lds;
    LAS float* qt = L; LAS float* kr = L + 2048; LAS float* kt = L + 4096; LAS float* kh = L + 6144; LAS float* vv = L + 8192; LAS float* bc = L + 12288; LAS float* gl = L + 14336; LAS float* wg = L + 14848; LAS float* sc = L + 15872;
    const int i = tid >> 4, k4 = (tid & 15) * 4, v8 = (tid & 15) * 8;
    __syncthreads();
    { const bf16_t* up = U + (size_t)(t0 + i) * DINP;
      const u32x2 qw = *(const u32x2*)(up + UG_Q + h * 64 + k4), kw = *(const u32x2*)(up + UG_K + h * 64 + k4); const u32x4 vw = *(const u32x4*)(up + UG_V + h * 128 + v8);
      *(LAS f32x4*)(qt + i * 64 + k4) = (f32x4){bflo(qw.x), bfhi(qw.x), bflo(qw.y), bfhi(qw.y)};
      *(LAS f32x4*)(kr + i * 64 + k4) = (f32x4){bflo(kw.x), bfhi(kw.x), bflo(kw.y), bfhi(kw.y)};
      *(LAS f32x4*)(vv + i * 128 + v8) = (f32x4){bflo(vw.x), bfhi(vw.x), bflo(vw.y), bfhi(vw.y)}; *(LAS f32x4*)(vv + i * 128 + v8 + 4) = (f32x4){bflo(vw.z), bfhi(vw.z), bflo(vw.w), bfhi(vw.w)};
      gl[i * 16 + (tid & 15)] = bf2f(up[UG_LOW + (tid & 15)]);
      const float* w2 = argp(F.lds, 7) + (size_t)l * 16 * 256;
      wg[tid] = w2[(tid >> 6) * 256 + h * 64 + (tid & 63)]; wg[512 + tid] = w2[(8 + (tid >> 6)) * 256 + h * 64 + (tid & 63)]; }
    __syncthreads();
    { const f32x4 bg = *(const f32x4*)(argp(F.lds, 8) + l * 256 + h * 64 + k4); f32x4 z = bg;
#pragma unroll
      for (int r = 0; r < 16; ++r) { const float g = gl[i * 16 + r]; const f32x4 w = *(const LAS f32x4*)(wg + r * 64 + k4); z = z + w * g; }
      f32x4 la;
#pragma unroll
      for (int j = 0; j < 4; ++j) la[j] = (fminf(z[j], 0.f) - __logf(1.0f + __expf(-fabsf(z[j])))) * (1.0f / 16.0f);
      *(LAS f32x4*)(bc + i * 64 + k4) = la; }
    __syncthreads();
    f32x4 bv = {0.f, 0.f, 0.f, 0.f}, bl = bv;
#pragma unroll 8
    for (int r = 0; r < 32; ++r) { const f32x4 x = *(const LAS f32x4*)(bc + r * 64 + k4); bl = bl + x; if (r <= i) bv = bv + x; }
    { const f32x4  q = *(const LAS f32x4*)(qt + i * 64 + k4), k = *(const LAS f32x4*)(kr + i * 64 + k4);
      f32x4 qo, ko, ho;
#pragma unroll
      for (int j = 0; j < 4; ++j) { qo[j] = q[j] * __expf(bv[j]) * 0.125f; ko[j] = k[j] * __expf(-bv[j]); ho[j] = k[j] * __expf(bl[j] - bv[j]); }
      *(LAS f32x4*)(qt + i * 64 + k4) = qo; *(LAS f32x4*)(kt + i * 64 + k4) = ko; *(LAS f32x4*)(kh + i * 64 + k4) = ho;
      *(f32x4*)(GQ + (size_t)(t0 + i) * 256 + h * 64 + k4) = qo;
      if (i == 31) { f32x4 d;
#pragma unroll
          for (int j = 0; j < 4; ++j) d[j] = __expf(bl[j]);
          *(f32x4*)(GD + ((size_t)bh * 64 + n) * 64 + k4) = d; } }
    __syncthreads();
    const int lane = F.lane, w = F.wave, fr = lane & 15, fg = lane >> 4;
    if (w < 4) { const int mi = w >> 1, nj = w & 1; f32x4 d = zero4();
#pragma unroll
        for (int ks = 0; ks < 2; ++ks) d = __builtin_amdgcn_mfma_f32_16x16x32_bf16(frag_f32(qt + (16 * mi + fr) * 64 + 8 * fg + 32 * ks), frag_f32(kt + (16 * nj + fr) * 64 + 8 * fg + 32 * ks), d, 0, 0, 0);
#pragma unroll
        for (int r = 0; r < 4; ++r) { const int ii = 16 * mi + 4 * fg + r, jj = 16 * nj + fr; sc[ii * 36 + jj] = (jj <= ii) ? d[r] : 0.f; } }
    const bf16x8 vfrag = frag_col(vv + (8 * fg) * 128 + 16 * w + fr, 128);
    { float* gp = GU + ((size_t)bh * 64 + n) * 8192 + (size_t)(16 * w + fr) * 64 + 4 * fg;
#pragma unroll
      for (int kt4 = 0; kt4 < 4; ++kt4) { const bf16x8 kfrag = frag_col(kh + (8 * fg) * 64 + 16 * kt4 + fr, 64);
          const f32x4 d = __builtin_amdgcn_mfma_f32_16x16x32_bf16(kfrag, vfrag, zero4(), 0, 0, 0);
          *(f32x4*)(gp + 16 * kt4) = d; } }
    __syncthreads();
#pragma unroll
    for (int it = 0; it < 2; ++it) { const bf16x8 sfrag = frag_f32(sc + (16 * it + fr) * 36 + 8 * fg);
        const f32x4 d = __builtin_amdgcn_mfma_f32_16x16x32_bf16(vfrag, sfrag, zero4(), 0, 0, 0);
        *(f32x4*)(GO + (size_t)(t0 + 16 * it + fr) * 512 + h * 128 + 16 * w + 4 * fg) = d; }
}
__device__ __forceinline__ void gla_scan(const Frame& F) {
    float* GU = (float*)(F.ws + WS_GU); const float* GD = (const float*)(F.ws + WS_GD);
    for (int g = F.sid * 8 * 8192 + F.bx * 512 + F.tid; g < (F.sid + 1) * 8 * 8192; g += F.G * 512) { const int bh = g >> 13, kv = g & 8191, k = kv & 63;
        float* p = GU + (size_t)bh * 64 * 8192 + kv; const float* d = GD + (size_t)bh * 64 * 64 + k; float S = 0.f;
#pragma unroll 1
        for (int n0 = 0; n0 < 64; n0 += 32) { float u[32], dc[32];
#pragma unroll
            for (int j = 0; j < 32; ++j) { u[j] = p[(size_t)(n0 + j) * 8192]; dc[j] = d[(n0 + j) * 64]; }
#pragma unroll
            for (int j = 0; j < 32; ++j) { p[(size_t)(n0 + j) * 8192] = S; S = S * dc[j] + u[j]; } } }
}
struct GlaCIn { f32x4 s[4]; f32x4 q; f32x4 oi[2]; u32x2 rw[2]; };
__device__ __forceinline__ void gla_c_load(const Frame& F, int unit, GlaCIn& in) {
    const bf16_t* U = F.Up(); const float* GU = (const float*)(F.ws + WS_GU); const float* GO = (const float*)(F.ws + WS_GO); const float* GQ = (const float*)(F.ws + WS_GQ);
    const int n = unit & 63, h = (unit >> 6) & 3, b = unit >> 8, bh = b * 4 + h, t0 = b * SEQ + n * 32, tid = F.tid, lane = F.lane, w = F.wave, fr = lane & 15, fg = lane >> 4;
    const float* sp = GU + ((size_t)bh * 64 + n) * 8192;
#pragma unroll
    for (int j = 0; j < 4; ++j) in.s[j] = *(const f32x4*)(sp + (tid + 512 * j) * 4);
    in.q = *(const f32x4*)(GQ + (size_t)(t0 + (tid >> 4)) * 256 + h * 64 + (tid & 15) * 4);
#pragma unroll
    for (int it = 0; it < 2; ++it) { const int row = t0 + 16 * it + fr, col = h * 128 + 16 * w + 4 * fg;
        in.oi[it] = *(const f32x4*)(GO + (size_t)row * 512 + col); in.rw[it] = *(const u32x2*)(U + (size_t)row * DINP + UG_R + col); }
}
__device__ __forceinline__ void gla_c_phase(const Frame& F, const Args& a, int l) {
    bf16_t* MIX = F.MIXp();
    const int tid = F.tid, lane = F.lane, w = F.wave, fr = lane & 15, fg = lane >> 4;
    LAS float* qt = (LAS float*)F.lds; LAS float* SsT = qt + 32 * 68; LAS float* red = SsT + 128 * 68;
    const f32x4 ng = *(const f32x4*)(argp(F.lds, 9) + l * 128 + 16 * w + 4 * fg);
    GlaCIn in; const int ubeg = F.sid * 512 + F.bx, uend = (F.sid + 1) * 512;
    if (ubeg < uend) gla_c_load(F, ubeg, in);
#pragma unroll 1
    for (int unit = ubeg; unit < uend; unit += F.G) {
        const int n = unit & 63, h = (unit >> 6) & 3, b = unit >> 8, t0 = b * SEQ + n * 32;
        __syncthreads();
        *(LAS f32x4*)(qt + (tid >> 4) * 68 + (tid & 15) * 4) = in.q;
#pragma unroll
        for (int j = 0; j < 4; ++j) { const int e = (tid + 512 * j) * 4; *(LAS f32x4*)(SsT + (e >> 6) * 68 + (e & 63)) = in.s[j]; }
        f32x4 o[2] = {in.oi[0], in.oi[1]}; const u32x2 rw0 = in.rw[0], rw1 = in.rw[1];
        __syncthreads();
        if (unit + F.G < uend) gla_c_load(F, unit + F.G, in);
#pragma unroll
        for (int ks = 0; ks < 2; ++ks) { const bf16x8 sf = frag_f32(SsT + (16 * w + fr) * 68 + 8 * fg + 32 * ks);
#pragma unroll
            for (int it = 0; it < 2; ++it) o[it] = __builtin_amdgcn_mfma_f32_16x16x32_bf16(sf, frag_f32(qt + (16 * it + fr) * 68 + 8 * fg + 32 * ks), o[it], 0, 0, 0); }
#pragma unroll
        for (int it = 0; it < 2; ++it) { float ss = (o[it][0] * o[it][0] + o[it][1] * o[it][1]) + (o[it][2] * o[it][2] + o[it][3] * o[it][3]);
            ss += __shfl_xor(ss, 16); ss += __shfl_xor(ss, 32);
            if (fg == 0) red[w * 32 + 16 * it + fr] = ss; }
        __syncthreads();
#pragma unroll
        for (int it = 0; it < 2; ++it) { float tot = 0.f;
#pragma unroll
            for (int ww = 0; ww < 8; ++ww) tot += red[ww * 32 + 16 * it + fr];
            const float rms = 1.0f / sqrtf(tot * (1.f / 128.f) + RMS_EPS);
            const u32x2 rw = it == 0 ? rw0 : rw1;
            const float y0 = o[it][0] * rms * ng[0] * siluf_(bflo(rw.x)), y1 = o[it][1] * rms * ng[1] * siluf_(bfhi(rw.x)), y2 = o[it][2] * rms * ng[2] * siluf_(bflo(rw.y)), y3 = o[it][3] * rms * ng[3] * siluf_(bfhi(rw.y));
            *(u32x2*)(MIX + (size_t)(t0 + 16 * it + fr) * DM + 512 + h * 128 + 16 * w + 4 * fg) = (u32x2){pk2(y0, y1), pk2(y2, y3)}; }
    }
}

typedef short s16x4 __attribute__((ext_vector_type(4)));
__device__ __forceinline__ s16x4 vtr(const LAS unsigned char* p) { return __builtin_bit_cast(s16x4, __builtin_amdgcn_ds_read_tr16_b64_v4i16((LAS s16x4*)p)); }
constexpr int AT_VROW = 160, AT_VBUF = 32 * AT_VROW;
__device__ __forceinline__ void attn_job(const Frame& F, int job, LAS unsigned char* vbuf, const LAS float* bt) {
    const bf16_t* U = F.Up(); bf16_t* AO = (bf16_t*)(F.ws + WS_AO); float* ALSE = (float*)(F.ws + WS_ALSE);
    const int lane = F.lane, qi = lane & 15, g = lane >> 4;
    const int gidx = job & 127, t2 = job >> 7, br = t2 % 3, bh = t2 / 3, h = bh & 7, b = bh >> 3;
    const int dsh = 2 * br, dil = 1 << dsh, gsh = 7 - dsh, r = gidx >> gsh, gi = gidx & ((1 << gsh) - 1);
    const int q0 = gi * 16, tb = b * SEQ;
    const bf16_t* Ub = U + (size_t)(tb + r) * DINP + h * 64;
    const size_t sstep = (size_t)dil * DINP;
    const bf16_t* qrow = Ub + (size_t)(q0 + qi) * sstep + UC_Q + 8 * g;
    const bf16x8 qf0 = *(const bf16x8*)qrow, qf1 = *(const bf16x8*)(qrow + 32);
    const int klo = (q0 >= 128 ? q0 - 128 : 0) & ~31;
    const int nch = ((q0 + 15 - klo) >> 5) + 1;
    const LAS float* bj = bt + (h * 3 + br) * 224;
    float m_run = -1e30f, l_part = 0.f;
    f32x4 o[4];
#pragma unroll
    for (int d = 0; d < 4; ++d) o[d] = (f32x4){0.f, 0.f, 0.f, 0.f};
    bf16x8 ka0, ka1, kb0, kb1; u32x4 vr[4];
#define AT_LOAD(kc) do { const bf16_t* kp = Ub + (size_t)((kc) + qi) * sstep + UC_K + 8 * g; ka0 = *(const bf16x8*)kp; ka1 = *(const bf16x8*)(kp + 32); kp += 16 * sstep; kb0 = *(const bf16x8*)kp; kb1 = *(const bf16x8*)(kp + 32); \
        const bf16_t* vp = Ub + (size_t)((kc) + (lane >> 3)) * sstep + UC_V + (lane & 7) * 8; _Pragma("unroll") for (int it = 0; it < 4; ++it) vr[it] = *(const u32x4*)(vp + (size_t)(8 * it) * sstep); } while (0)
    AT_LOAD(klo);
#pragma unroll 1
    for (int c = 0; c < nch; ++c) {
        const int kc = klo + 32 * c;
        LAS unsigned char* vb = vbuf + (c & 1) * AT_VBUF;
#pragma unroll
        for (int it = 0; it < 4; ++it) *(LAS u32x4*)(vb + (it * 8 + (lane >> 3)) * AT_VROW + (lane & 7) * 16) = vr[it];
        const bf16x8 ca0 = ka0, ca1 = ka1, cb0 = kb0, cb1 = kb1;
        if (c + 1 < nch) AT_LOAD(kc + 32);
        f32x4 sa = (f32x4){0.f, 0.f, 0.f, 0.f}, sb = sa;
        sa = __builtin_amdgcn_mfma_f32_16x16x32_bf16(ca0, qf0, sa, 0, 0, 0); sa = __builtin_amdgcn_mfma_f32_16x16x32_bf16(ca1, qf1, sa, 0, 0, 0);
        sb = __builtin_amdgcn_mfma_f32_16x16x32_bf16(cb0, qf0, sb, 0, 0, 0); sb = __builtin_amdgcn_mfma_f32_16x16x32_bf16(cb1, qf1, sb, 0, 0, 0);
        const int st0 = (q0 + qi) - (kc + 4 * g);
        const LAS float* bp = bj + st0;
        float cmax = -1e30f;
#pragma unroll
        for (int rr = 0; rr < 4; ++rr) { sa[rr] = sa[rr] * 0.125f + bp[48 - rr]; sb[rr] = sb[rr] * 0.125f + bp[32 - rr]; cmax = fmaxf(cmax, fmaxf(sa[rr], sb[rr])); }
        cmax = fmaxf(cmax, __shfl_xor(cmax, 16)); cmax = fmaxf(cmax, __shfl_xor(cmax, 32));
        const float m_new = fmaxf(m_run, cmax), alpha = __expf(m_run - m_new);
        float psum = 0.f;
#pragma unroll
        for (int rr = 0; rr < 4; ++rr) { sa[rr] = __expf(sa[rr] - m_new); sb[rr] = __expf(sb[rr] - m_new); psum += sa[rr] + sb[rr]; }
        l_part = l_part * alpha + psum;
        if (!__all(m_new == m_run)) {
#pragma unroll
            for (int d = 0; d < 4; ++d) o[d] = o[d] * alpha; }
        m_run = m_new;
        const u32x4 pw = (u32x4){pk2(sa[0], sa[1]), pk2(sa[2], sa[3]), pk2(sb[0], sb[1]), pk2(sb[2], sb[3])};
        const bf16x8 pf = __builtin_bit_cast(bf16x8, pw);
        const LAS unsigned char* tp = vb + (4 * g + (qi >> 2)) * AT_VROW + (qi & 3) * 8;
#pragma unroll
        for (int d = 0; d < 4; ++d) { const s16x4 va = vtr(tp + d * 32), vb2 = vtr(tp + 16 * AT_VROW + d * 32);
            const bf16x8 vf = (bf16x8){va[0], va[1], va[2], va[3], vb2[0], vb2[1], vb2[2], vb2[3]};
            o[d] = __builtin_amdgcn_mfma_f32_16x16x32_bf16(vf, pf, o[d], 0, 0, 0); }
    }
#undef AT_LOAD
    float l = l_part; l += __shfl_xor(l, 16); l += __shfl_xor(l, 32);
    const float inv = 1.0f / l;
    const int token = tb + (q0 + qi) * dil + r;
    bf16_t* op = AO + ((size_t)br * MT + token) * 512 + h * 64 + 4 * g;
#pragma unroll
    for (int d = 0; d < 4; ++d) *(u32x2*)(op + d * 16) = (u32x2){pk2(o[d][0] * inv, o[d][1] * inv), pk2(o[d][2] * inv, o[d][3] * inv)};
    if (g == 0) ALSE[((size_t)br * MT + token) * 8 + h] = m_run + logf(l);
}
__device__ __forceinline__ void attn_combine(const Frame& F) {
    const bf16_t* AO = (const bf16_t*)(F.ws + WS_AO); const float* ALSE = (const float*)(F.ws + WS_ALSE); bf16_t* MIX = F.MIXp();
    for (int i = F.row0 * 64 + F.bx * 512 + F.tid; i < (F.row0 + SMT) * 64; i += F.G * 512) { const int token = i >> 6, c8 = (i & 63) * 8, h = c8 >> 6;
        const float l0 = ALSE[(size_t)token * 8 + h], l1 = ALSE[((size_t)MT + token) * 8 + h], l2 = ALSE[((size_t)2 * MT + token) * 8 + h];
        const float m = fmaxf(l0, fmaxf(l1, l2)); float w0 = __expf(l0 - m), w1 = __expf(l1 - m), w2 = __expf(l2 - m); const float inv = 1.0f / (w0 + w1 + w2); w0 *= inv; w1 *= inv; w2 *= inv;
        const u32x4 a = *(const u32x4*)(AO + (size_t)token * 512 + c8), bq = *(const u32x4*)(AO + ((size_t)MT + token) * 512 + c8), cq = *(const u32x4*)(AO + ((size_t)2 * MT + token) * 512 + c8);
        const unsigned aw[4] = {a.x, a.y, a.z, a.w}, bw[4] = {bq.x, bq.y, bq.z, bq.w}, cw[4] = {cq.x, cq.y, cq.z, cq.w}; unsigned ow[4];
#pragma unroll
        for (int j = 0; j < 4; ++j) ow[j] = pk2(w0 * bflo(aw[j]) + w1 * bflo(bw[j]) + w2 * bflo(cw[j]), w0 * bfhi(aw[j]) + w1 * bfhi(bw[j]) + w2 * bfhi(cw[j]));
        *(u32x4*)(MIX + (size_t)token * DM + 1024 + c8) = (u32x4){ow[0], ow[1], ow[2], ow[3]}; }
}

__device__ __forceinline__ void ln1_unit(const Frame& F, const Args& a, int l, int unit, bool commit) {
    const bf16_t* PRE = (const bf16_t*)(F.ws + WS_PRE); bf16_t* XB = (bf16_t*)(F.ws + WS_XB);
    const bf16_t* WRH = (const bf16_t*)(F.ws + WS_WRH) + (size_t)l * 48 * DM; const bf16_t* WRL = (const bf16_t*)(F.ws + WS_WRL) + (size_t)l * 48 * DM; const float* WRS = (const float*)(F.ws + WS_WRS) + l * 96;
    int* ltok = (int*)(F.ws + WS_LTOK) + F.sid * 32 * SMT; float* lgate = (float*)(F.ws + WS_LGATE) + F.sid * 32 * SMT; int* tinfo = (int*)(F.ws + WS_TINFO); unsigned* cnt = F.ctl + CW_CNT + (l * 2 + F.sid) * 32 * 64;
    LAS float* stats = (LAS float*)F.lds;
    LAS float* red = stats + 64;
    LAS float* lg = red + 8 * 2 * 3 * 256;
    const int lane = F.lane, tid = F.tid, w = F.wave, R0 = unit * 32;
    const float* g = argp(F.lds, 14) + (size_t)l * DM; const float* bb = argp(F.lds, 15) + (size_t)l * DM;
    __syncthreads();
#pragma unroll
    for (int rp = 0; rp < 2; ++rp) {
        f32x4 v[2][8]; float s[2] = {0.f, 0.f};
#pragma unroll
        for (int r = 0; r < 2; ++r) { const bf16_t* pr = PRE + (size_t)(R0 + 4 * w + 2 * rp + r) * DM;
#pragma unroll
            for (int j = 0; j < 8; ++j) { const u32x2 x = *(const u32x2*)(pr + 256 * j + 4 * lane); v[r][j] = (f32x4){bflo(x.x), bfhi(x.x), bflo(x.y), bfhi(x.y)}; s[r] += (v[r][j][0] + v[r][j][1]) + (v[r][j][2] + v[r][j][3]); } }
#pragma unroll
        for (int r = 0; r < 2; ++r) { const int row = R0 + 4 * w + 2 * rp + r;
            const float mean = wave_sum(s[r]) * (1.f / DM); float q = 0.f;
#pragma unroll
            for (int j = 0; j < 8; ++j) { v[r][j] = v[r][j] - mean; q += (v[r][j][0] * v[r][j][0] + v[r][j][1] * v[r][j][1]) + (v[r][j][2] * v[r][j][2] + v[r][j][3] * v[r][j][3]); }
            const float rstd = 1.0f / sqrtf(wave_sum(q) * (1.f / DM) + LN_EPS);
            if (lane == 0) { stats[(4 * w + 2 * rp + r) * 2] = mean; stats[(4 * w + 2 * rp + r) * 2 + 1] = rstd; }
#pragma unroll
            for (int j = 0; j < 8; ++j) { const f32x4 gv = *(const f32x4*)(g + 256 * j + 4 * lane), bv = *(const f32x4*)(bb + 256 * j + 4 * lane); const f32x4 y = v[r][j] * rstd * gv + bv;
                *(u32x2*)(XB + (size_t)row * DM + 256 * j + 4 * lane) = (u32x2){pk2(y[0], y[1]), pk2(y[2], y[3])}; } } }
    { const int fr = lane & 15, fg = lane >> 4;
      const bf16_t* ap = PRE + (size_t)(R0 + fr) * DM + w * 256 + 8 * fg;
      const bf16_t* hp = WRH + (size_t)fr * DM + w * 256 + 8 * fg; const bf16_t* lp = WRL + (size_t)fr * DM + w * 256 + 8 * fg;
      f32x4 acc[2][3] = {{zero4(), zero4(), zero4()}, {zero4(), zero4(), zero4()}};
#pragma unroll 4
      for (int s = 0; s < 8; ++s) { const bf16x8 a0 = *(const bf16x8*)(ap + 32 * s), a1 = *(const bf16x8*)(ap + (size_t)16 * DM + 32 * s);
#pragma unroll
          for (int nj = 0; nj < 3; ++nj) { const bf16x8 bh = *(const bf16x8*)(hp + (size_t)(16 * nj) * DM + 32 * s), bl = *(const bf16x8*)(lp + (size_t)(16 * nj) * DM + 32 * s);
              acc[0][nj] = __builtin_amdgcn_mfma_f32_16x16x32_bf16(a0, bh, acc[0][nj], 0, 0, 0); acc[0][nj] = __builtin_amdgcn_mfma_f32_16x16x32_bf16(a0, bl, acc[0][nj], 0, 0, 0);
              acc[1][nj] = __builtin_amdgcn_mfma_f32_16x16x32_bf16(a1, bh, acc[1][nj], 0, 0, 0); acc[1][nj] = __builtin_amdgcn_mfma_f32_16x16x32_bf16(a1, bl, acc[1][nj], 0, 0, 0); } }
#pragma unroll
      for (int mi = 0; mi < 2; ++mi)
#pragma unroll
          for (int nj = 0; nj < 3; ++nj)
#pragma unroll
              for (int r = 0; r < 4; ++r) red[((w * 2 + mi) * 3 + nj) * 256 + (4 * fg + r) * 16 + fr] = acc[mi][nj][r]; }
    __syncthreads();
    for (int idx = tid; idx < 32 * 48; idx += 512) { const int row = idx / 48, c = idx - row * 48, mi = row >> 4, rl = row & 15, nj = c >> 4, cl = c & 15; float sum = 0.f;
#pragma unroll
        for (int kq = 0; kq < 8; ++kq) sum += red[((kq * 2 + mi) * 3 + nj) * 256 + rl * 16 + cl];
        const float mean = stats[row * 2], rstd = stats[row * 2 + 1];
        lg[idx] = (c < 36) ? rstd * (sum - mean * WRS[c]) + WRS[48 + c] : 0.f; }
    __syncthreads();
    if (tid < 32) { const LAS float* lr = lg + tid * 48;
        int gi = 0; float gm = lr[0];
#pragma unroll
        for (int c = 1; c < 4; ++c) { const float x = lr[c]; if (x > gm) { gm = x; gi = c; } }
        float gs = 0.f;
#pragma unroll
        for (int c = 0; c < 4; ++c) gs += expf(lr[c] - gm);
        const float gtop = 1.0f / gs;
        float ev[8];
#pragma unroll
        for (int c = 0; c < 8; ++c) ev[c] = lr[4 + gi * 8 + c];
        int i1 = 0; float m1 = ev[0];
#pragma unroll
        for (int c = 1; c < 8; ++c) if (ev[c] > m1) { m1 = ev[c]; i1 = c; }
        int i2 = -1; float m2 = -INFINITY;
#pragma unroll
        for (int c = 0; c < 8; ++c) if (c != i1 && ev[c] > m2) { m2 = ev[c]; i2 = c; }
        const float p2 = expf(m2 - m1), den = 1.0f + p2;
        const float w1 = gtop / den, w2 = gtop * p2 / den;
        if (commit) { const int tok = R0 + tid; const int e1 = gi * 8 + i1, e2 = gi * 8 + i2;
            const unsigned s1 = __hip_atomic_fetch_add(cnt + e1 * 64, 1u, __ATOMIC_RELAXED, __HIP_MEMORY_SCOPE_AGENT), s2 = __hip_atomic_fetch_add(cnt + e2 * 64, 1u, __ATOMIC_RELAXED, __HIP_MEMORY_SCOPE_AGENT);
            ltok[e1 * SMT + s1] = tok; lgate[e1 * SMT + s1] = w1; ltok[e2 * SMT + s2] = tok; lgate[e2 * SMT + s2] = w2;
            tinfo[tok * 2] = e1 * SMT + (int)s1; tinfo[tok * 2 + 1] = e2 * SMT + (int)s2; } }
}
__device__ __forceinline__ void moe_tables(const Frame& F, int l) {
    LAS int* toff = (LAS int*)(F.lds + LDS_TOFF); const unsigned* cnt = F.ctl + CW_CNT + (l * 2 + F.sid) * 32 * 64;
    __syncthreads();
    if (F.tid < 32) toff[64 + F.tid] = ((int)cnt[F.tid * 64] + 255) >> 8;
    __syncthreads();
    if (F.tid < 33) { int run = 0;
#pragma unroll 1
        for (int k = 0; k < F.tid; ++k) run += toff[64 + k];
        toff[F.tid] = run; }
    __syncthreads();
}
__device__ __forceinline__ void ln2_rows(const Frame& F, const Args& a, int l, float* OUT, bool write_xb) {
    const bf16_t* PRE = (const bf16_t*)(F.ws + WS_PRE); const bf16_t* Y = F.Yp(); bf16_t* XB = (bf16_t*)(F.ws + WS_XB); const int* tinfo = (const int*)(F.ws + WS_TINFO);
    const LAS int* toff = (const LAS int*)(F.lds + LDS_TOFF);
    const float* g = argp(F.lds, 26) + (size_t)l * DM; const float* bb = argp(F.lds, 27) + (size_t)l * DM; const int lane = F.lane;
    for (int row0 = F.row0 + (F.bx * 8 + F.wave) * 2; row0 < F.row0 + SMT; row0 += F.G * 16) {
        f32x4 v[2][8]; float s[2] = {0.f, 0.f};
#pragma unroll
        for (int r = 0; r < 2; ++r) { const int row = row0 + r; const int i0 = tinfo[row * 2], i1 = tinfo[row * 2 + 1];
            const size_t s0 = (size_t)toff[i0 >> 12] * 256 + (i0 & 4095), s1 = (size_t)toff[i1 >> 12] * 256 + (i1 & 4095);
            const bf16_t* pr = PRE + (size_t)row * DM; const bf16_t* y0 = Y + s0 * DM; const bf16_t* y1 = Y + s1 * DM;
#pragma unroll
            for (int j = 0; j < 8; ++j) { const u32x2 pw = *(const u32x2*)(pr + 256 * j + 4 * lane), a0 = *(const u32x2*)(y0 + 256 * j + 4 * lane), a1 = *(const u32x2*)(y1 + 256 * j + 4 * lane);
                v[r][j][0] = bflo(pw.x) + (bflo(a0.x) + bflo(a1.x)); v[r][j][1] = bfhi(pw.x) + (bfhi(a0.x) + bfhi(a1.x)); v[r][j][2] = bflo(pw.y) + (bflo(a0.y) + bflo(a1.y)); v[r][j][3] = bfhi(pw.y) + (bfhi(a0.y) + bfhi(a1.y));
                s[r] += (v[r][j][0] + v[r][j][1]) + (v[r][j][2] + v[r][j][3]); } }
#pragma unroll
        for (int r = 0; r < 2; ++r) { const int row = row0 + r;
            const float mean = wave_sum(s[r]) * (1.f / DM); float q = 0.f;
#pragma unroll
            for (int j = 0; j < 8; ++j) { v[r][j] = v[r][j] - mean; q += (v[r][j][0] * v[r][j][0] + v[r][j][1] * v[r][j][1]) + (v[r][j][2] * v[r][j][2] + v[r][j][3] * v[r][j][3]); }
            const float rstd = 1.0f / sqrtf(wave_sum(q) * (1.f / DM) + LN_EPS);
#pragma unroll
            for (int j = 0; j < 8; ++j) { const f32x4 gv = *(const f32x4*)(g + 256 * j + 4 * lane), bv = *(const f32x4*)(bb + 256 * j + 4 * lane); const f32x4 y = v[r][j] * rstd * gv + bv;
                if (write_xb) *(u32x2*)(XB + (size_t)row * DM + 256 * j + 4 * lane) = (u32x2){pk2(y[0], y[1]), pk2(y[2], y[3])}; else *(f32x4*)(OUT + (size_t)row * DM + 256 * j + 4 * lane) = y; } }
    }
}

constexpr int PH_PER_LAYER = 9, N_PHASES = 1 + NL * PH_PER_LAYER;
__global__ void __launch_bounds__(512, 2) mega(Args args) {
    extern __shared__ __attribute__((aligned(16))) unsigned char lds_raw[];
    const int bxg = blockIdx.x, Gg = gridDim.x;
    Frame F; F.lds = (LAS unsigned char*)lds_raw; F.ws = args.ws; F.ctl = (unsigned*)(args.ws + WS_CTL);
    F.tid = threadIdx.x; F.lane = F.tid & 63; F.wave = __builtin_amdgcn_readfirstlane(F.tid >> 6);
    F.sid = (bxg >> 3) & 1; F.row0 = F.sid * SMT; F.G = Gg >> 1; F.bx = ((bxg >> 4) << 3) | (bxg & 7);
    if (F.tid < 4) ((LAS unsigned*)(F.lds + LDS_BARW))[F.tid] = 0u;
    if (F.tid == 0) { LAS unsigned long long* ap = (LAS unsigned long long*)(F.lds + LDS_ARGS);
#pragma unroll
        for (int k = 0; k < 28; ++k) ap[k] = (unsigned long long)args.in[k];
        ap[28] = (unsigned long long)args.out; }
    __syncthreads();
    XcdBarrier barS = xcd_barrier_post(F.ctl + CW_BAR + F.sid * XCD_BAR_WORDS, (volatile LAS unsigned*)(F.lds + LDS_BARW), (unsigned)(Gg >> 1));
    XcdBarrier barG = xcd_barrier_post(F.ctl + CW_BAR + 2 * XCD_BAR_WORDS, (volatile LAS unsigned*)(F.lds + LDS_BARW + 8), (unsigned)Gg);
#if TPROBE
#define TS_PTR ((volatile LAS unsigned long long*)((LAS unsigned char*)lds_raw + LDS_STAGE + 1280))
    int ts_n = 0;
#define STAMP() do { if (F.wave == 0 && __builtin_amdgcn_mbcnt_hi(~0u, __builtin_amdgcn_mbcnt_lo(~0u, 0u)) == 0u && ts_n < 30) TS_PTR[ts_n] = __builtin_amdgcn_s_memrealtime(); ++ts_n; } while (0)
#else
#define STAMP() do { } while (0)
#endif
    STAMP();
#define SBAR() do { xcd_barrier(barS); STAMP(); } while (0)
#define WSP(T, off) ((T*)(f.ws + (off)))

    { Frame g = F; g.G = Gg; g.bx = bxg; g.sid = 0; const Frame f = g.fresh(); phase_prologue(f, args); }
    xcd_barrier(barG); STAMP();
    { const Frame f = F.fresh(); if (f.sid == 1) { conv_all(f, args, 0, IO_PG, I_L); flag_publish(f.ctl + CW_FLAG + 0 * 64, f.tid); } }
    STAMP();

#pragma unroll 1
    for (int l = 0; l < NL; ++l) {
        { const Frame f = F.fresh(); if (l == 1 && f.sid == 1) flag_wait(f.ctl + CW_FLAG + 1 * 64, (unsigned)f.G, f.ctl + CW_BAR + XB_TMO, f.tid);
            pg8::DenseSched S; S.init(WSP(const bf16_t, WS_XB) + (size_t)f.row0 * DM, WSP(const bf16_t, WS_WIN) + (size_t)l * DINP * DM, DM, DM, SMT, DINP, f.G, f.bx); S.wave = f.wave;
            pg8::EpiBf16 E{f.Up() + (size_t)f.row0 * DINP, DINP}; pg8::gemm_phase(f.lds, DM, S, E); }
        SBAR();
        { { const Frame f = F.fresh(); for (int u = f.bx; u < 128; u += f.G) conv_unit(f, args, l, f.sid * 128 + u); }
          { const Frame f = F.fresh(); for (int u = f.bx; u < 512; u += f.G) gla_a_unit(f, args, l, f.sid * 512 + u); } __syncthreads(); }
        SBAR();
        { { const Frame f = F.fresh(); gla_scan(f); }
            const Frame f = F.fresh();
            LAS float* bt = (LAS float*)(f.lds + 8 * 2 * AT_VBUF);
            __syncthreads();
            for (int i = f.tid; i < 8 * 3 * 224; i += 512) { const int hh = i / 672, rem = i - hh * 672, brr = rem / 224, st = rem - brr * 224 - 48;
                bt[i] = (st >= 0 && st <= 128) ? WSP(const float, WS_BTAB)[(brr * 129 + st) * 8 + hh] : -1e30f; }
            __syncthreads();
            for (int job = f.bx * 8 + f.wave; job < 16 * 3 * 128; job += f.G * 8) attn_job(f, f.sid * 16 * 3 * 128 + job, f.lds + f.wave * 2 * AT_VBUF, bt);
            __syncthreads(); }
        SBAR();
        { { const Frame f = F.fresh(); gla_c_phase(f, args, l); __syncthreads(); } { const Frame f = F.fresh(); attn_combine(f); } }
        SBAR();
        { { const Frame f = F.fresh(); pg8::DenseSched S; S.init(f.MIXp() + (size_t)f.row0 * DM, WSP(const bf16_t, WS_WOUT) + (size_t)l * DM * DM, DM, DM, SMT, DM, f.G, f.bx); S.wave = f.wave;
              pg8::EpiRes E{WSP(bf16_t, WS_PRE) + (size_t)f.row0 * DM, WSP(const bf16_t, WS_XB) + (size_t)f.row0 * DM, DM, DN_ALPHA}; pg8::gemm_phase(f.lds, DM, S, E); }
          { const Frame f = F.fresh(); pg8::DenseSched S; S.init(WSP(const bf16_t, WS_PB) + ((size_t)l * MT + f.row0) * PLE, WSP(const bf16_t, WS_WPP) + (size_t)l * DM * PLE, PLE, PLE, SMT, DM, f.G, f.bx); S.wave = f.wave;
              pg8::EpiBf16 E{WSP(bf16_t, WS_PP) + (size_t)f.row0 * DM, DM}; pg8::gemm_phase(f.lds, PLE, S, E); } }
        SBAR();
        { const Frame f = F.fresh(); for (int u = f.bx; u < SMT / 32; u += f.G) ln1_unit(f, args, l, f.sid * (SMT / 32) + u, true); __syncthreads(); }
        SBAR();
        { { const Frame f = F.fresh(); if (f.sid == l) flag_wait(f.ctl + CW_FLAG + (l == 0 ? 0 : 2) * 64, (unsigned)f.G, f.ctl + CW_BAR + XB_TMO, f.tid);
              pg8::DenseSched S; S.init(WSP(const bf16_t, WS_XB) + (size_t)f.row0 * DM, WSP(const bf16_t, WS_WPG) + (size_t)l * DM * DM, DM, DM, SMT, DM, f.G, f.bx); S.wave = f.wave;
              pg8::EpiPle E{WSP(bf16_t, WS_PRE) + (size_t)f.row0 * DM, WSP(const bf16_t, WS_XB) + (size_t)f.row0 * DM, WSP(const bf16_t, WS_PP) + (size_t)f.row0 * DM, argp(f.lds, 24) + (size_t)l * DM, DM, DN_ALPHA}; pg8::gemm_phase(f.lds, DM, S, E); }
          { const Frame f = F.fresh(); moe_tables(f, l);
              pg8::MoeSched<true> S; S.A = WSP(const bf16_t, WS_XB); S.Bt = WSP(const bf16_t, WS_WGU) + (size_t)l * NEXP * 512 * DM; S.lda = DM; S.ldb = DM; S.nN = 2; S.G = f.G; S.c = f.bx; S.wave = f.wave; S.bexp = (size_t)512 * DM * 2;
              S.toff = (const LAS int*)(f.lds + LDS_TOFF); S.cnt = f.ctl + CW_CNT + (l * 2 + f.sid) * 32 * 64; S.ltok = WSP(const int, WS_LTOK) + f.sid * 32 * SMT;
              pg8::EpiMoe1 E{f.Hp(), WSP(const float, WS_LGATE) + f.sid * 32 * SMT, f.ctl + CW_CNT + (l * 2 + f.sid) * 32 * 64};
              const int total = __builtin_amdgcn_readfirstlane(S.toff[32]) * 2;
#pragma unroll 1
              for (int r0 = 0; r0 * f.G < total; ++r0) { S.round0 = r0; pg8::gemm_phase<pg8::EpiMoe1, pg8::MoeSched<true>, true>(f.lds, DM, S, E); } } }
        SBAR();
        { const Frame f = F.fresh(); moe_tables(f, l);
            pg8::MoeSched<false> S; S.A = f.Hp(); S.Bt = WSP(const bf16_t, WS_WD) + (size_t)l * NEXP * DM * DEXP; S.lda = DEXP; S.ldb = DEXP; S.nN = 8; S.G = f.G; S.c = f.bx; S.wave = f.wave; S.bexp = (size_t)DM * DEXP * 2;
            S.toff = (const LAS int*)(f.lds + LDS_TOFF); S.cnt = f.ctl + CW_CNT + (l * 2 + f.sid) * 32 * 64; S.ltok = WSP(const int, WS_LTOK) + f.sid * 32 * SMT;
            pg8::EpiBf16 E{f.Yp(), DM}; pg8::gemm_phase(f.lds, DEXP, S, E); }
        SBAR();
        { { const Frame f = F.fresh(); moe_tables(f, l); ln2_rows(f, args, l, (float*)argp(f.lds, 28), l + 1 < NL); }
          if (l + 1 < NL) { const Frame f = F.fresh();
              if (f.sid == 0) { conv_all(f, args, l + 1, 0, IO_PG); flag_publish(f.ctl + CW_FLAG + 1 * 64, f.tid); conv_all(f, args, l + 1, IO_PG, I_L); flag_publish(f.ctl + CW_FLAG + 2 * 64, f.tid); } } }
        SBAR();
    }
#undef WSP
#undef SBAR
#if TPROBE
    if (F.sid == TP_SID && F.bx == 0 && F.wave == 0) { asm volatile("s_waitcnt vmcnt(0) lgkmcnt(0)" ::: "memory");
        const unsigned long long d = TS_PTR[TP_K + 1] - TS_PTR[TP_K], t0 = __builtin_amdgcn_s_memrealtime();
        while (__builtin_amdgcn_s_memrealtime() - t0 < d * TP_MULT) __builtin_amdgcn_s_sleep(16); }
#endif
}

extern "C" void kernel_launch(void* const* d_in, const int* in_sizes, int n_in, void* d_out, int out_size, void* d_ws, size_t ws_size, hipStream_t stream) {
    static int grid = 0;
    if (grid == 0) {
        if (n_in != 28 || out_size != MT * DM || ws_size < WS_END) { fprintf(stderr, "kernel_launch: unexpected shapes (n_in %d, out %d, ws %zu); nothing launched\n", n_in, out_size, ws_size); grid = -1; return; }
        int dev = 0, cus = 0, per_cu = 0;
        if (hipGetDevice(&dev) != hipSuccess || hipDeviceGetAttribute(&cus, hipDeviceAttributeMultiprocessorCount, dev) != hipSuccess) { grid = -1; return; }
        if (hipFuncSetAttribute((const void*)mega, hipFuncAttributeMaxDynamicSharedMemorySize, LDS_BYTES) != hipSuccess) { fprintf(stderr, "kernel_launch: hipFuncSetAttribute failed\n"); grid = -1; return; }
        if (hipOccupancyMaxActiveBlocksPerMultiprocessor(&per_cu, (const void*)mega, 512, LDS_BYTES) != hipSuccess || per_cu < 1) { fprintf(stderr, "kernel_launch: occupancy query says %d\n", per_cu); }
        (void)hipGetLastError();
        grid = cus;
    }
    if (grid < 0) return;
    (void)hipMemsetAsync((char*)d_ws + WS_CTL, 0, CTL_ZERO_BYTES, stream);
    Args a{};
    for (int i = 0; i < 28; ++i) a.in[i] = (const float*)d_in[i];
    a.out = (float*)d_out; a.ws = (unsigned char*)d_ws;
    a.ph_lo = 0; a.ph_hi = 0; hipLaunchKernelGGL(mega, dim3(grid), dim3(512), LDS_BYTES, stream, a);
}
```

```cpp
#include <hip/hip_runtime.h>
#include <cstdio>
#include <cstdint>

#ifndef REP_MASK
#define REP_MASK 0
#endif
#define REPS(k) (1 + ((REP_MASK >> (k)) & 1))
#ifndef TPROBE
#define TPROBE 0
#endif
#ifndef TP_SID
#define TP_SID 0
#endif
#ifndef TP_K
#define TP_K 0
#endif
#ifndef TP_K2
#define TP_K2 (TP_K + 1)
#endif
#ifndef TP_MULT
#define TP_MULT 16
#endif
#ifndef LAUNCH_PER_PHASE
#define LAUNCH_PER_PHASE 0
#endif

#define LAS __attribute__((address_space(3)))
#define GAS __attribute__((address_space(1)))
typedef unsigned short bf16_t;
typedef short bf16x8 __attribute__((ext_vector_type(8)));
typedef float f32x4 __attribute__((ext_vector_type(4)));
typedef float f32x2 __attribute__((ext_vector_type(2)));
typedef unsigned u32x4 __attribute__((ext_vector_type(4)));
typedef unsigned u32x2 __attribute__((ext_vector_type(2)));
typedef int i32x4 __attribute__((ext_vector_type(4)));
typedef int i32x8 __attribute__((ext_vector_type(8)));

constexpr int IN8_TILES = 7;
__host__ __device__ constexpr bool in8_tile(int t) { return (t >= 10 && t <= 15) || t == 22; }
__host__ __device__ constexpr int in8_compact(int t) { return t == 22 ? 6 : t - 10; }
constexpr int NL = 2, NBATCH = 4, SEQ = 2048, DM = 2048, MT = NBATCH * SEQ;
constexpr int DIN = 5648, DINP = 5888, PLE = 256, NEXP = 32, DEXP = 256;
constexpr int UA_VAL = 0, UA_GATE = 512, UG_Q = 1024, UG_K = 1280, UG_V = 1536, UG_R = 2048, UC_Q = 2560, UC_K = 3072, UC_V = 3584, US_B = 4096, US_C = 4608, US_H = 5120, UG_LOW = 5632;
constexpr float DN_ALPHA = 1.41421356237309515f, LN_EPS = 1e-5f, RMS_EPS = 1e-6f;
constexpr int NSTREAM = 2, SMT = MT / NSTREAM;
constexpr int MAXSLOT = 16384;

constexpr size_t MiB = 1u << 20;
constexpr size_t WS_CTL = 0, CTL_ZERO_BYTES = 1 * MiB;
constexpr size_t WS_BTAB = 1 * MiB;
constexpr size_t WS_WRT = 1 * MiB + 64 * 1024;
constexpr size_t WS_WRH = 5 * MiB;
constexpr size_t WS_WRL = 5 * MiB + 512 * 1024;
constexpr size_t WS_WRS = 6 * MiB;
constexpr size_t WS_LTOK = 2 * MiB;
constexpr size_t WS_LGATE = 3 * MiB;
constexpr size_t WS_TINFO = 4 * MiB;
constexpr size_t WS_WIN = 8 * MiB;
constexpr size_t WS_WIN8 = 62 * MiB;
constexpr size_t WS_WOUT = 54 * MiB;
constexpr size_t WS_WGU = 70 * MiB;
constexpr size_t WS_WD = 198 * MiB;
constexpr size_t WS_WPG = 262 * MiB;
constexpr size_t WS_WPP = 278 * MiB;
constexpr size_t WS_XB = 280 * MiB;
constexpr size_t WS_PB = 312 * MiB;
constexpr size_t WS_ARENA = 320 * MiB, ARENA = 64 * MiB;
constexpr size_t ARENA_MIX = 46 * MiB;
constexpr size_t WS_PRE = 448 * MiB;
constexpr size_t WS_GU = 448 * MiB;
constexpr size_t WS_GO = 480 * MiB;
constexpr size_t WS_GQ = 496 * MiB;
constexpr size_t WS_GD = 504 * MiB;
constexpr size_t WS_PP = 512 * MiB;
constexpr size_t WS_AO = 560 * MiB;
constexpr size_t WS_ALSE = 584 * MiB;
constexpr size_t WS_H = 544 * MiB, HSTREAM = 8 * MiB;
constexpr size_t WS_XB8 = 585 * MiB;
constexpr size_t WS_END = 601 * MiB;
static_assert((size_t)SMT * DINP * 2 <= ARENA_MIX && ARENA_MIX + (size_t)SMT * DM * 2 <= ARENA && (size_t)MAXSLOT * DM * 2 <= ARENA && WS_ARENA + NSTREAM * ARENA <= 448 * MiB, "ws map");
constexpr int CW_BAR = 4096;
constexpr int CW_FLAG = 14592;
constexpr int CW_CNT = 16384;

constexpr int LDS_STAGE = 135168;
constexpr int LDS_TOFF = LDS_STAGE;
constexpr int LDS_BARW = LDS_STAGE + 512;
constexpr int LDS_ARGS = LDS_STAGE + 1024;
constexpr int LDS_BYTES = LDS_STAGE + 1792;

__device__ __forceinline__ float bf2f(unsigned b) { return __uint_as_float(b << 16); }
__device__ __forceinline__ unsigned f2bf(float f) { unsigned u = __float_as_uint(f); return (u + 0x7fffu + ((u >> 16) & 1u)) >> 16; }
__device__ __forceinline__ unsigned pk2(float lo, float hi) { unsigned r; asm("v_cvt_pk_bf16_f32 %0, %1, %2" : "=v"(r) : "v"(lo), "v"(hi)); return r; }
__device__ __forceinline__ float bflo(unsigned w) { return __uint_as_float(w << 16); }
__device__ __forceinline__ float bfhi(unsigned w) { return __uint_as_float(w & 0xffff0000u); }
#define WS_DPP(x, ctrl) __int_as_float(__builtin_amdgcn_update_dpp(0, __float_as_int(x), ctrl, 0xf, 0xf, true))
__device__ __forceinline__ float wave_sum(float v) {
    v += WS_DPP(v, 0xB1); v += WS_DPP(v, 0x4E); v += WS_DPP(v, 0x141); v += WS_DPP(v, 0x140);
    { const auto r = __builtin_amdgcn_permlane16_swap(__float_as_uint(v), __float_as_uint(v), false, false); v = __uint_as_float(r[0]) + __uint_as_float(r[1]); }
    { const auto r = __builtin_amdgcn_permlane32_swap(__float_as_uint(v), __float_as_uint(v), false, false); v = __uint_as_float(r[0]) + __uint_as_float(r[1]); }
    return v;
}
__device__ __forceinline__ float wave_max(float v) {
#pragma unroll
    for (int o = 1; o < 64; o <<= 1) v = fmaxf(v, __shfl_xor(v, o));
    return v;
}
__device__ __forceinline__ float sigmoidf_(float x) { return __builtin_amdgcn_rcpf(1.0f + __expf(-x)); }
__device__ __forceinline__ float siluf_(float x) { return x * __builtin_amdgcn_rcpf(1.0f + __expf(-x)); }
__device__ __forceinline__ unsigned pk4_fp8(float a, float b, float c, float d) { int w = 0; w = __builtin_amdgcn_cvt_pk_fp8_f32(a, b, w, false); w = __builtin_amdgcn_cvt_pk_fp8_f32(c, d, w, true); return (unsigned)w; }
__device__ __forceinline__ float clamp8(float x) { return __builtin_amdgcn_fmed3f(x, -448.f, 448.f); }
__device__ __forceinline__ unsigned pk4_fp8s(float a, float b, float c, float d) { return pk4_fp8(clamp8(a), clamp8(b), clamp8(c), clamp8(d)); }
constexpr float W8_SCALE = 64.f, W8_INV = 1.f / 64.f;
constexpr float Y8_SCALE = 16.f, Y8_INV = 1.f / 16.f;
#define LDS_WAIT() asm volatile("s_waitcnt lgkmcnt(0)" ::: "memory")
__device__ __forceinline__ f32x4 zero4() { float z = 0.f; asm volatile("" : "+v"(z)); return (f32x4){z, z, z, z}; }

namespace pg8 {
constexpr int BM = 256, BK = 64, HALF = 128, HTB = HALF * BK * 2, STAGE_BYTES = 8 * HTB, NXCD = 8, WGM = 4;
__host__ __device__ __forceinline__ int lds_byte(int r, int c) { const int st = (r >> 4) * 2 + (c >> 5), rr = r & 15, cc = c & 31, ob = rr * 64 + cc * 2; return st * 1024 + (ob ^ (((ob >> 9) & 1) << 5)); }
__host__ __device__ __forceinline__ void stage_rc(int b, int& R, int& C) { const int st = b / 1024, sb = b % 1024, swz = sb ^ (((sb >> 9) & 1) << 5); R = (st >> 1) * 16 + swz / 64; C = (st & 1) * 32 + (swz % 64) / 2; }
__host__ __device__ __forceinline__ int perm32(int rho) { const int n = rho >> 4, i = rho & 15; return 8 * (i >> 2) + 4 * n + (i & 3); }

struct Unit { int pm, pn, e, r; };

struct DenseSched {
    static constexpr bool GATHER = false;
    const bf16_t* A; const bf16_t* Bt; int lda, ldb, nM, nN, nwg, G, c, wave;
    int cut = 1 << 30, add0 = 0, add1 = 0, compactB = 0;
    __device__ void init(const bf16_t* A_, const bf16_t* Bt_, int lda_, int ldb_, int M, int N, int G_, int c_) { A = A_; Bt = Bt_; lda = lda_; ldb = ldb_; nM = M / BM; nN = N / BM; nwg = nM * nN; G = G_; c = c_; }
    __device__ __forceinline__ bool next(int i, Unit& u) const {
        const long L = (long)i * G + c; if (L >= nwg) return false;
        int wgid = (int)L; { const int q = nwg / NXCD, r = nwg % NXCD, xcd = wgid % NXCD, off = wgid / NXCD; wgid = (xcd < r ? xcd * (q + 1) : r * (q + 1) + (xcd - r) * q) + off; }
        const int nig = WGM * nN, gid = wgid / nig, fm = gid * WGM, gsz = (nM - fm) < WGM ? (nM - fm) : WGM;
        u.pm = fm + ((wgid % nig) % gsz); const int t = (wgid % nig) / gsz; u.pn = t + (t < cut ? add0 : add1); u.e = 0; u.r = t; return true;
    }
    __device__ __forceinline__ const char* a_base(const Unit& u) const { return (const char*)A + (size_t)u.pm * BM * lda * 2; }
    __device__ __forceinline__ const char* b_base(const Unit& u) const { return (const char*)Bt + (size_t)(compactB ? u.r : u.pn) * BM * ldb * 2; }
    __device__ __forceinline__ void a_offs(const Unit&, int, unsigned (&vo)[2][2]) const { }
};
template <bool GATHER_> struct MoeSched {
    static constexpr bool GATHER = GATHER_;
    const bf16_t* A; const bf16_t* Bt; int lda, ldb, nN, G, c, wave; size_t bexp;
    const LAS int* toff; const unsigned* cnt; const int* ltok; int round0 = 0;
    __device__ __forceinline__ bool next(int i, Unit& u) const {
        const int cx = GATHER ? c : (c % NXCD) * (G / NXCD) + c / NXCD;
        const int L = (i + round0) * G + cx; const int total = __builtin_amdgcn_readfirstlane(toff[32]) * nN; if (L >= total) return false;
        const int j = L / nN; u.pn = L - j * nN; int e = 0;
#pragma unroll 1
        for (int k = 1; k < 32; ++k) e = (__builtin_amdgcn_readfirstlane(toff[k]) <= j) ? k : e;
        u.e = e; u.r = j - __builtin_amdgcn_readfirstlane(toff[e]); u.pm = j; return true;
    }
    __device__ __forceinline__ const char* a_base(const Unit& u) const { return GATHER ? (const char*)A : (const char*)A + (size_t)u.pm * BM * lda * 2; }
    __device__ __forceinline__ const char* b_base(const Unit& u) const { return (const char*)Bt + (size_t)u.e * bexp + (size_t)u.pn * BM * ldb * 2; }
    __device__ __forceinline__ void a_offs(const Unit& u, int tid, unsigned (&vo)[2][2]) const {
        if constexpr (GATHER) {
        int R[2], C[2]; stage_rc(tid * 16, R[0], C[0]); stage_rc(tid * 16 + 8192, R[1], C[1]);
        const int n = __builtin_amdgcn_readfirstlane((int)cnt[u.e * 64]);
#pragma unroll
        for (int h = 0; h < 2; ++h)
#pragma unroll
            for (int i = 0; i < 2; ++i) {
                const int sr = u.r * BM + h * HALF + R[i]; const int row = (sr < n) ? ltok[u.e * SMT + sr] : 0;
                vo[h][i] = (unsigned)(row * lda + C[i]) * 2u;
            }
        }
    }
};

__device__ __forceinline__ unsigned cvt_pk_bf16(float lo, float hi) { unsigned r; asm volatile("v_cvt_pk_bf16_f32 %0, %1, %2" : "=v"(r) : "v"(lo), "v"(hi)); return r; }

struct EpiBf16 {
    static constexpr bool PERM = true;
    bf16_t* O; int ldc; float sc = 1.f;
    __device__ __forceinline__ void operator()(const f32x4 (&acc)[2][2][4][2], const Unit& u, int wr, int wc, int fr, int fq) const {
        const int row0 = u.pm * BM + wr * 64 + fr, col0 = u.pn * BM + wc * 32 + 8 * fq;
#pragma unroll
        for (int ai = 0; ai < 2; ++ai)
#pragma unroll
            for (int m = 0; m < 4; ++m) { bf16_t* rowp = O + (size_t)(row0 + ai * HALF + m * 16) * ldc + col0;
#pragma unroll
                for (int bj = 0; bj < 2; ++bj) { const f32x4 v0 = acc[ai][bj][m][0] * sc, v1 = acc[ai][bj][m][1] * sc;
                    u32x4 w; w.x = cvt_pk_bf16(v0[0], v0[1]); w.y = cvt_pk_bf16(v0[2], v0[3]); w.z = cvt_pk_bf16(v1[0], v1[1]); w.w = cvt_pk_bf16(v1[2], v1[3]);
                    *(u32x4*)(rowp + bj * HALF) = w; } }
    }
};
struct EpiRes {
    static constexpr bool PERM = true;
    bf16_t* C; const bf16_t* res; int ldc; float alpha, sc;
    __device__ __forceinline__ void operator()(const f32x4 (&acc)[2][2][4][2], const Unit& u, int wr, int wc, int fr, int fq) const {
        const int row0 = u.pm * BM + wr * 64 + fr, col0 = u.pn * BM + wc * 32 + 8 * fq;
        u32x4 rq[2][2];
#pragma unroll
        for (int bj = 0; bj < 2; ++bj) rq[0][bj] = *(const u32x4*)(res + (size_t)row0 * ldc + col0 + bj * HALF);
#pragma unroll
        for (int g = 0; g < 8; ++g) { const int ai = g >> 2, m = g & 3; const size_t off = (size_t)(row0 + ai * HALF + m * 16) * ldc + col0;
            if (g + 1 < 8) { const size_t offn = (size_t)(row0 + ((g + 1) >> 2) * HALF + ((g + 1) & 3) * 16) * ldc + col0;
#pragma unroll
                for (int bj = 0; bj < 2; ++bj) rq[(g + 1) & 1][bj] = *(const u32x4*)(res + offn + bj * HALF); }
#pragma unroll
            for (int bj = 0; bj < 2; ++bj) { const u32x4 rv = rq[g & 1][bj]; const f32x4 v0 = acc[ai][bj][m][0] * sc, v1 = acc[ai][bj][m][1] * sc;
                u32x4 w; w.x = cvt_pk_bf16(bflo(rv.x) * alpha + v0[0], bfhi(rv.x) * alpha + v0[1]); w.y = cvt_pk_bf16(bflo(rv.y) * alpha + v0[2], bfhi(rv.y) * alpha + v0[3]);
                w.z = cvt_pk_bf16(bflo(rv.z) * alpha + v1[0], bfhi(rv.z) * alpha + v1[1]); w.w = cvt_pk_bf16(bflo(rv.w) * alpha + v1[2], bfhi(rv.w) * alpha + v1[3]);
                *(u32x4*)(C + off + bj * HALF) = w; }
            asm volatile("" ::: "memory"); }
    }
};
struct EpiPle {
    static constexpr bool PERM = true;
    bf16_t* C; const bf16_t* x1; const bf16_t* pp; const float* bias; int ldc; float alpha, sc;
    __device__ __forceinline__ void operator()(const f32x4 (&acc)[2][2][4][2], const Unit& u, int wr, int wc, int fr, int fq) const {
        const int row0 = u.pm * BM + wr * 64 + fr, col0 = u.pn * BM + wc * 32 + 8 * fq;
        f32x4 bv[2][2];
#pragma unroll
        for (int bj = 0; bj < 2; ++bj)
#pragma unroll
            for (int n = 0; n < 2; ++n) bv[bj][n] = *(const f32x4*)(bias + col0 + bj * HALF + 4 * n);
        u32x4 xq[2][2], pq[2][2];
#pragma unroll
        for (int bj = 0; bj < 2; ++bj) { const size_t o = (size_t)row0 * ldc + col0 + bj * HALF; xq[0][bj] = *(const u32x4*)(x1 + o); pq[0][bj] = *(const u32x4*)(pp + o); }
#pragma unroll
        for (int g = 0; g < 8; ++g) { const int ai = g >> 2, m = g & 3; const size_t off = (size_t)(row0 + ai * HALF + m * 16) * ldc + col0;
            if (g + 1 < 8) { const size_t offn = (size_t)(row0 + ((g + 1) >> 2) * HALF + ((g + 1) & 3) * 16) * ldc + col0;
#pragma unroll
                for (int bj = 0; bj < 2; ++bj) { xq[(g + 1) & 1][bj] = *(const u32x4*)(x1 + offn + bj * HALF); pq[(g + 1) & 1][bj] = *(const u32x4*)(pp + offn + bj * HALF); } }
#pragma unroll
            for (int bj = 0; bj < 2; ++bj) { const size_t o = off + bj * HALF; const u32x4 xv = xq[g & 1][bj], pw = pq[g & 1][bj];
                const f32x4 a0 = acc[ai][bj][m][0] * sc + bv[bj][0], a1 = acc[ai][bj][m][1] * sc + bv[bj][1];
                u32x4 w;
                w.x = cvt_pk_bf16(bflo(xv.x) * alpha + sigmoidf_(a0[0]) * bflo(pw.x), bfhi(xv.x) * alpha + sigmoidf_(a0[1]) * bfhi(pw.x));
                w.y = cvt_pk_bf16(bflo(xv.y) * alpha + sigmoidf_(a0[2]) * bflo(pw.y), bfhi(xv.y) * alpha + sigmoidf_(a0[3]) * bfhi(pw.y));
                w.z = cvt_pk_bf16(bflo(xv.z) * alpha + sigmoidf_(a1[0]) * bflo(pw.z), bfhi(xv.z) * alpha + sigmoidf_(a1[1]) * bfhi(pw.z));
                w.w = cvt_pk_bf16(bflo(xv.w) * alpha + sigmoidf_(a1[2]) * bflo(pw.w), bfhi(xv.w) * alpha + sigmoidf_(a1[3]) * bfhi(pw.w));
                *(u32x4*)(C + o) = w; }
            asm volatile("" ::: "memory"); }
    }
};
struct EpiMoe1 {
    static constexpr bool PERM = true;
    bf16_t* H; const float* lgate; const unsigned* cnt;
    __device__ __forceinline__ void operator()(const f32x4 (&acc)[2][2][4][2], const Unit& u, int wr, int wc, int fr, int fq) const {
        const int n_e = __builtin_amdgcn_readfirstlane((int)cnt[u.e * 64]);
        const int col0 = u.pn * HALF + wc * 32 + 8 * fq;
#pragma unroll
        for (int ai = 0; ai < 2; ++ai)
#pragma unroll
            for (int m = 0; m < 4; ++m) { const int rt = ai * HALF + wr * 64 + m * 16 + fr; const int sr = u.r * BM + rt;
                const float gw = (sr < n_e) ? lgate[u.e * SMT + sr] : 0.f; const float gu = gw * W8_INV;
                const f32x4 g0 = acc[ai][0][m][0], g1 = acc[ai][0][m][1], u0 = acc[ai][1][m][0], u1 = acc[ai][1][m][1];
                float o[8];
#pragma unroll
                for (int j = 0; j < 4; ++j) { o[j] = siluf_(g0[j] * W8_INV) * u0[j] * gu; o[4 + j] = siluf_(g1[j] * W8_INV) * u1[j] * gu; }
                u32x4 w; w.x = cvt_pk_bf16(o[0], o[1]); w.y = cvt_pk_bf16(o[2], o[3]); w.z = cvt_pk_bf16(o[4], o[5]); w.w = cvt_pk_bf16(o[6], o[7]);
                *(u32x4*)(H + (size_t)(u.pm * BM + rt) * DEXP + col0) = w; }
    }
};

struct EpiY8 {
    static constexpr bool PERM = true;
    unsigned char* Y; const unsigned* cnt;
    __device__ __forceinline__ void operator()(const f32x4 (&acc)[2][2][4][2], const Unit& u, int wr, int wc, int fr, int fq) const {
        const int n_e = __builtin_amdgcn_readfirstlane((int)cnt[u.e * 64]);
        const int col0 = u.pn * BM + wc * 32 + 8 * fq;
#pragma unroll
        for (int ai = 0; ai < 2; ++ai)
#pragma unroll
            for (int m = 0; m < 4; ++m) { const int rt = ai * HALF + wr * 64 + m * 16 + fr;
                if (u.r * BM + rt < n_e) { unsigned char* rowp = Y + (size_t)(u.pm * BM + rt) * DM + col0;
#pragma unroll
                    for (int bj = 0; bj < 2; ++bj) { const f32x4 v0 = acc[ai][bj][m][0] * Y8_SCALE, v1 = acc[ai][bj][m][1] * Y8_SCALE;
                        *(u32x2*)(rowp + bj * HALF) = (u32x2){pk4_fp8s(v0[0], v0[1], v0[2], v0[3]), pk4_fp8s(v1[0], v1[1], v1[2], v1[3])}; } } }
    }
};

template <class Epi, class Sched, bool SINGLE = false, bool F8 = false>
__device__ __forceinline__ void gemm_phase(LAS unsigned char* lds, const int K, const Sched& S, const Epi& E) {
    constexpr bool GA = Sched::GATHER;
    int lane_ = (int)__builtin_amdgcn_mbcnt_hi(~0u, __builtin_amdgcn_mbcnt_lo(~0u, 0u)); asm volatile("" : "+v"(lane_));
    const int wid = S.wave, lane = lane_, tid = wid * 64 + lane_, wr = wid >> 2, wc = wid & 3, fr = lane & 15, fq = lane >> 4;
    const int nt = K / BK, ldb = S.ldb, lda = S.lda;
    unsigned voffB[2], voffA[2];
#pragma unroll
    for (int i = 0; i < 2; ++i) { int R, C; stage_rc(tid * 16 + i * 8192, R, C); const int Rb = Epi::PERM ? ((R & ~31) + perm32(R & 31)) : R; voffB[i] = (unsigned)(Rb * ldb + C) * 2u; voffA[i] = (unsigned)(R * lda + C) * 2u; }
    const size_t kstep = (size_t)(BK * 2);
    const size_t hstep = (size_t)HALF * ldb * 2;
    const size_t ahstep = GA ? 0 : (size_t)HALF * lda * 2;
    const unsigned ldsw = (unsigned)wid * 1024u;
    const int aoff = lds_byte(wr * 64 + fr, fq * 8), boff = lds_byte(wc * 32 + fr, fq * 8);
#define PG8_SA(b, h) (((b) * 2 + (h)) * HTB)
#define PG8_SB(b, h) ((4 + (b) * 2 + (h)) * HTB)
#define PG8_STAGE(bufoff, gbase, voff) do { _Pragma("unroll") for (int _i = 0; _i < 2; ++_i) \
        __builtin_amdgcn_global_load_lds((const unsigned*)((const char*)(gbase) + (voff)[_i]), (LAS unsigned*)(lds + (bufoff) + ldsw + _i * 8192), 16, 0, 0); } while (0)
#define PG8_STAGE_A(bufoff, gbase, h) do { if constexpr (GA) PG8_STAGE(bufoff, gbase, voA[h]); else PG8_STAGE(bufoff, (gbase) + (h) * ahstep, voffA); } while (0)
#define PG8_STAGE_A2(bufoff, gbase, h) do { if constexpr (GA) { unsigned _v[2] = {last ? voN[h][0] : voA[h][0], last ? voN[h][1] : voA[h][1]}; PG8_STAGE(bufoff, gbase, _v); } else PG8_STAGE(bufoff, (gbase) + (h) * ahstep, voffA); } while (0)
#define PG8_LDA(dst, b, h) do { _Pragma("unroll") for (int m = 0; m < 4; ++m) _Pragma("unroll") for (int k = 0; k < 2; ++k) dst[m][k] = *(const LAS bf16x8*)(lds + PG8_SA(b, h) + aoff + m * 2048 + k * 1024); } while (0)
#define PG8_LDB(dst, b, h) do { _Pragma("unroll") for (int n = 0; n < 2; ++n) _Pragma("unroll") for (int k = 0; k < 2; ++k) dst[n][k] = *(const LAS bf16x8*)(lds + PG8_SB(b, h) + boff + n * 2048 + k * 1024); } while (0)
#define PG8_CAT(x0, x1) __builtin_shufflevector(__builtin_bit_cast(i32x4, x0), __builtin_bit_cast(i32x4, x1), 0, 1, 2, 3, 4, 5, 6, 7)
#define PG8_MMA(ai, bj, At, Bt) do { __builtin_amdgcn_s_setprio(1); \
        if constexpr (F8) { _Pragma("unroll") for (int m = 0; m < 4; ++m) _Pragma("unroll") for (int n = 0; n < 2; ++n) \
            { const i32x8 _b8 = PG8_CAT(Bt[n][0], Bt[n][1]), _a8 = PG8_CAT(At[m][0], At[m][1]); asm volatile("v_mfma_f32_16x16x128_f8f6f4 %0, %1, %2, %0" : "+v"(acc[ai][bj][m][n]) : "v"(_b8), "v"(_a8)); } } \
        else { _Pragma("unroll") for (int m = 0; m < 4; ++m) _Pragma("unroll") for (int n = 0; n < 2; ++n) _Pragma("unroll") for (int k = 0; k < 2; ++k) \
            acc[ai][bj][m][n] = __builtin_amdgcn_mfma_f32_16x16x32_bf16(Bt[n][k], At[m][k], acc[ai][bj][m][n], 0, 0, 0); } \
        __builtin_amdgcn_s_setprio(0); } while (0)
#define PG8_WAIT_V(n) asm volatile("s_waitcnt vmcnt(" #n ")" ::: "memory")
#define PG8_WAIT_L(n) asm volatile("s_waitcnt lgkmcnt(" #n ")" ::: "memory")
#define PG8_BAR __builtin_amdgcn_s_barrier()
#define PG8_SCHED __builtin_amdgcn_sched_barrier(0)
    Unit cur, nxt; int ui = 0;
    if (!S.next(0, cur)) return;
    f32x4 acc[2][2][4][2];
#pragma unroll
    for (int a = 0; a < 2; ++a)
#pragma unroll
        for (int b = 0; b < 2; ++b)
#pragma unroll
            for (int m = 0; m < 4; ++m)
#pragma unroll
                for (int n = 0; n < 2; ++n) acc[a][b][m][n] = (f32x4){0.f, 0.f, 0.f, 0.f};
    bf16x8 At[4][2], B0[2][2], B1[2][2];
    const char* cA = S.a_base(cur); const char* cB = S.b_base(cur);
    unsigned voA[2][2], voN[2][2];
    if constexpr (GA) S.a_offs(cur, tid, voA);
    PG8_STAGE(PG8_SB(0, 0), cB, voffB); PG8_STAGE(PG8_SB(0, 1), cB + hstep, voffB); PG8_STAGE_A(PG8_SA(0, 0), cA, 0); PG8_STAGE_A(PG8_SA(0, 1), cA, 1);
    if (wr == 1) PG8_BAR;
    PG8_WAIT_V(2); PG8_BAR;
    PG8_STAGE(PG8_SB(1, 0), cB + kstep, voffB); PG8_STAGE_A(PG8_SA(1, 0), cA + kstep, 0); PG8_STAGE(PG8_SB(1, 1), cB + hstep + kstep, voffB);
    PG8_WAIT_V(6); PG8_BAR;
    for (;;) {
        bool has_next = false; if constexpr (!SINGLE) has_next = S.next(ui + 1, nxt);
        const char* nA = has_next ? S.a_base(nxt) : cA; const char* nB = has_next ? S.b_base(nxt) : cB;
        if constexpr (GA) {
            if (has_next) S.a_offs(nxt, tid, voN);
            else {
#pragma unroll
                for (int h = 0; h < 2; ++h)
#pragma unroll
                    for (int i = 0; i < 2; ++i) voN[h][i] = voA[h][i]; } }
#pragma unroll 1
        for (int t = 0; t < nt; t += 2) {
            const bool last = (t == nt - 2);
            const char* a1 = cA + (size_t)(t + 1) * kstep;
            const char* a2 = last ? nA : cA + (size_t)(t + 2) * kstep; const char* b2 = last ? nB : cB + (size_t)(t + 2) * kstep;
            const char* a3 = a2 + kstep; const char* b3 = b2 + kstep;
            PG8_LDB(B0, 0, 0); PG8_LDB(B1, 0, 1); PG8_SCHED; PG8_LDA(At, 0, 0); PG8_STAGE_A(PG8_SA(1, 1), a1, 1);
            PG8_WAIT_V(8); PG8_WAIT_L(0); PG8_BAR; PG8_MMA(0, 0, At, B0); PG8_MMA(0, 1, At, B1); PG8_BAR; PG8_SCHED;
            PG8_LDA(At, 0, 1); PG8_STAGE(PG8_SB(0, 0), b2, voffB); PG8_STAGE(PG8_SB(0, 1), b2 + hstep, voffB); PG8_STAGE_A2(PG8_SA(0, 0), a2, 0);
            PG8_WAIT_V(8); PG8_WAIT_L(0); PG8_BAR; PG8_MMA(1, 0, At, B0); PG8_MMA(1, 1, At, B1); PG8_BAR; PG8_SCHED;
            PG8_LDB(B0, 1, 0); PG8_LDB(B1, 1, 1); PG8_SCHED; PG8_LDA(At, 1, 0); PG8_STAGE_A2(PG8_SA(0, 1), a2, 1);
            PG8_WAIT_V(8); PG8_WAIT_L(0); PG8_BAR; PG8_MMA(0, 0, At, B0); PG8_MMA(0, 1, At, B1); PG8_BAR; PG8_SCHED;
            PG8_LDA(At, 1, 1); PG8_STAGE(PG8_SB(1, 0), b3, voffB); PG8_STAGE(PG8_SB(1, 1), b3 + hstep, voffB); PG8_STAGE_A2(PG8_SA(1, 0), a3, 0);
            PG8_WAIT_V(8); PG8_WAIT_L(0); PG8_BAR; PG8_MMA(1, 0, At, B0); PG8_MMA(1, 1, At, B1); PG8_BAR; PG8_SCHED;
        }
        if (wr == 0) PG8_BAR;
        if constexpr (F8) asm volatile("s_nop 15\n\ts_nop 3" ::: "memory");
        E(acc, cur, wr, wc, fr, fq);
        if (!has_next) break;
#pragma unroll
        for (int a = 0; a < 2; ++a)
#pragma unroll
            for (int b = 0; b < 2; ++b)
#pragma unroll
                for (int m = 0; m < 4; ++m)
#pragma unroll
                    for (int n = 0; n < 2; ++n) acc[a][b][m][n] = (f32x4){0.f, 0.f, 0.f, 0.f};
        cur = nxt; cA = nA; cB = nB; ++ui;
        if constexpr (GA) {
#pragma unroll
            for (int h = 0; h < 2; ++h)
#pragma unroll
                for (int i = 0; i < 2; ++i) voA[h][i] = voN[h][i]; }
        if (wr == 1) PG8_BAR;
    }
    PG8_WAIT_V(0);
    PG8_BAR;
#undef PG8_SA
#undef PG8_SB
#undef PG8_STAGE
#undef PG8_STAGE_A
#undef PG8_STAGE_A2
#undef PG8_LDA
#undef PG8_LDB
#undef PG8_MMA
#undef PG8_CAT
#undef PG8_WAIT_V
#undef PG8_WAIT_L
#undef PG8_BAR
#undef PG8_SCHED
}
}

#define XB_TMO      128
#define XB_XCNT(j)  (256  + 64 * (j))
#define XB_XSUB(j)  (1280 + 64 * (j))
#define XB_XGEN(j)  (2304 + 64 * (j))
#define XB_TOP      3328
#define XB_TOPGEN   3392
#define XCD_BAR_WORDS 3456
#define XB_SPIN_CAP (1u << 18)
__device__ __forceinline__ unsigned xb_ld(unsigned* p)              { return __hip_atomic_load(p, __ATOMIC_RELAXED, __HIP_MEMORY_SCOPE_AGENT); }
__device__ __forceinline__ unsigned xb_add(unsigned* p, unsigned v) { return __hip_atomic_fetch_add(p, v, __ATOMIC_RELAXED, __HIP_MEMORY_SCOPE_AGENT); }
__device__ __forceinline__ unsigned xb_xcc_id() { return (unsigned)__builtin_amdgcn_s_getreg((3 << 11) | 20) & 0xFu; }
#define XB_SPIN(cond, bar) do { unsigned _sp = 0; while (cond) { __builtin_amdgcn_s_sleep(1); \
    if ((++_sp & 255u) == 0u) { if (xb_ld(&(bar)[XB_TMO])) break; if (_sp > XB_SPIN_CAP) { atomicAdd(&(bar)[XB_TMO], 1u); break; } } } } while (0)
struct XcdBarrier { unsigned* bar; unsigned x; volatile LAS unsigned* st; unsigned ng; int wave; };
__device__ __forceinline__ XcdBarrier xcd_barrier_post(unsigned* bar, volatile LAS unsigned* st, unsigned ng) {
    XcdBarrier b; b.bar = bar; b.x = xb_xcc_id(); b.st = st; b.ng = ng; b.wave = __builtin_amdgcn_readfirstlane((int)threadIdx.x >> 6);
    if (threadIdx.x == 0) (void)xb_add(&bar[XB_XCNT(b.x)], 1u);
    return b;
}
__device__ __forceinline__ void xcd_barrier_complete(unsigned* bar, unsigned x, unsigned& nloc, unsigned& nx, const unsigned G) {
    unsigned sum, cnt, mine, sp = 0u;
    for (;;) {
        sum = 0u; cnt = 0u; mine = 0u;
#pragma unroll
        for (unsigned j = 0; j < 16; ++j) { const unsigned c = xb_ld(&bar[XB_XCNT(j)]); sum += c; cnt += (c > 0u) ? 1u : 0u; mine = (j == x) ? c : mine; }
        if (sum == G) break;
        __builtin_amdgcn_s_sleep(1);
        if ((++sp & 255u) == 0u) { if (xb_ld(&bar[XB_TMO])) break; if (sp > XB_SPIN_CAP) { atomicAdd(&bar[XB_TMO], 1u); break; } }
    }
    nloc = mine > 0u ? mine : 1u; nx = cnt > 0u ? cnt : 1u;
}
__device__ __forceinline__ void xcd_barrier(const XcdBarrier& b) {
    asm volatile("s_waitcnt vmcnt(0)" ::: "memory");
    __syncthreads();
    int ln_ = (int)__builtin_amdgcn_mbcnt_hi(~0u, __builtin_amdgcn_mbcnt_lo(~0u, 0u)); asm volatile("" : "+v"(ln_));
    if (b.wave == 0 && ln_ == 0) {
        unsigned* bar = b.bar;
        __builtin_amdgcn_s_waitcnt(0);
        unsigned nloc = b.st[0], nx = b.st[1];
        if (nloc == 0u) { xcd_barrier_complete(bar, b.x, nloc, nx, b.ng); b.st[0] = nloc; b.st[1] = nx; }
        const unsigned old = xb_add(&bar[XB_XSUB(b.x)], 1u);
        const unsigned gen = old / nloc;
        if (old + 1u == (gen + 1u) * nloc) {
            __builtin_amdgcn_fence(__ATOMIC_RELEASE, "agent");
            asm volatile("s_waitcnt vmcnt(0)" ::: "memory");
            const unsigned og = xb_add(&bar[XB_TOP], 1u);
            const unsigned tg = og / nx;
            if (og + 1u == (tg + 1u) * nx) xb_add(&bar[XB_TOPGEN], 1u);
            else XB_SPIN(xb_ld(&bar[XB_TOPGEN]) == tg, bar);
            __builtin_amdgcn_fence(__ATOMIC_ACQUIRE, "agent");
            asm volatile("s_waitcnt vmcnt(0)" ::: "memory");
        } else {
            XB_SPIN(xb_ld(&bar[XB_TOPGEN]) == gen, bar);
            __builtin_amdgcn_fence(__ATOMIC_ACQUIRE, "agent");
            asm volatile("s_waitcnt vmcnt(0)" ::: "memory");
        }
    }
    __syncthreads();
}


__device__ __forceinline__ void flag_publish(unsigned* flag, int tid) {
    asm volatile("s_waitcnt vmcnt(0)" ::: "memory");
    __syncthreads();
    if (tid == 0) { __builtin_amdgcn_fence(__ATOMIC_RELEASE, "agent"); asm volatile("s_waitcnt vmcnt(0)" ::: "memory"); (void)xb_add(flag, 1u); }
}
__device__ __forceinline__ void flag_wait(unsigned* flag, unsigned want, unsigned* tmo, int tid) {
    if (tid == 0) { unsigned sp = 0;
        while (xb_ld(flag) < want) { __builtin_amdgcn_s_sleep(2); if ((++sp & 255u) == 0u) { if (xb_ld(tmo)) break; if (sp > (1u << 22)) { atomicAdd(tmo, 1u); break; } } }
        __builtin_amdgcn_fence(__ATOMIC_ACQUIRE, "agent"); asm volatile("s_waitcnt vmcnt(0)" ::: "memory"); }
    __syncthreads();
}

struct Args { const float* in[28]; float* out; unsigned char* ws; int ph_lo, ph_hi; };

__device__ __forceinline__ const float* argp(LAS unsigned char* lds, int k) {
    const unsigned long long v = ((const LAS unsigned long long*)(lds + LDS_ARGS))[k];
    const unsigned lo = __builtin_amdgcn_readfirstlane((unsigned)v), hi = __builtin_amdgcn_readfirstlane((unsigned)(v >> 32));
    return (const float*)(GAS const float*)(((unsigned long long)hi << 32) | lo);
}
struct Frame {
    LAS unsigned char* lds; unsigned char* ws; unsigned* ctl;
    int tid, lane, wave, G, bx, sid, row0;
    __device__ __forceinline__ bf16_t* Up() const { return (bf16_t*)(ws + WS_ARENA + (size_t)sid * ARENA) - (size_t)row0 * DINP; }
    __device__ __forceinline__ unsigned char* MIXp() const { return (ws + WS_ARENA + (size_t)sid * ARENA + ARENA_MIX) - (size_t)row0 * DM; }
    __device__ __forceinline__ unsigned char* Yp() const { return ws + WS_ARENA + (size_t)sid * ARENA; }
    __device__ __forceinline__ bf16_t* Hp() const { return (bf16_t*)(ws + WS_H + (size_t)sid * HSTREAM); }
    __device__ __forceinline__ Frame fresh() const { Frame f = *this; int ln = (int)__builtin_amdgcn_mbcnt_hi(~0u, __builtin_amdgcn_mbcnt_lo(~0u, 0u)); asm volatile("" : "+v"(ln)); f.lane = ln; f.tid = wave * 64 + ln;
        int b = bx, g = G, s = sid, wv = wave; size_t zo = 0; asm volatile("" : "+s"(b), "+s"(g), "+s"(zo), "+s"(s), "+s"(wv)); unsigned char* w = ws + zo;
        return f; }
};

__device__ __forceinline__ int dmap(int type, int n) {
    if (type == 1) return n < 2048 ? n : (n < 2064 ? n - 2048 + UG_LOW : n - 16);
    if (type == 2) return (n >> 7) * 256 + (n & 127);
    if (type == 3) return (n >> 7) * 256 + 128 + (n & 127);
    return n;
}
template <bool F8 = false>
__device__ __forceinline__ void transpose_item(const float* W, int ldw, int ncols, int k0, int n0, const float* kscale, bf16_t* WT, int ldt, int type, LAS float* scr, int lane, unsigned char* WT8 = nullptr) {
    const int n4 = (lane & 15) * 4, kr = lane >> 4; const bool okc = (n0 + n4) < ncols;
    f32x4 v[16];
#pragma unroll
    for (int i = 0; i < 16; ++i) v[i] = okc ? __builtin_nontemporal_load((const f32x4*)(W + (size_t)(k0 + 4 * i + kr) * ldw + n0 + n4)) : (f32x4){0.f, 0.f, 0.f, 0.f};
    if (kscale) {
#pragma unroll
        for (int i = 0; i < 16; ++i) v[i] = v[i] * kscale[k0 + 4 * i + kr]; }
#pragma unroll
    for (int i = 0; i < 16; ++i) { LAS float* s = scr + (4 * i + kr) * 65 + n4; s[0] = v[i][0]; s[1] = v[i][1]; s[2] = v[i][2]; s[3] = v[i][3]; }
    LDS_WAIT(); asm volatile("" ::: "memory");
    const int c = lane & 7;
#pragma unroll
    for (int j = 0; j < 8; ++j) { const int n = (lane >> 3) + 8 * j; const LAS float* s = scr + (8 * c) * 65 + n;
        if constexpr (F8) { u32x2 o; o.x = pk4_fp8(s[0 * 65] * W8_SCALE, s[1 * 65] * W8_SCALE, s[2 * 65] * W8_SCALE, s[3 * 65] * W8_SCALE); o.y = pk4_fp8(s[4 * 65] * W8_SCALE, s[5 * 65] * W8_SCALE, s[6 * 65] * W8_SCALE, s[7 * 65] * W8_SCALE);
            if (n0 + n < ncols) *(u32x2*)((unsigned char*)WT + (size_t)dmap(type, n0 + n) * ldt + k0 + 8 * c) = o; }
        else { const int dest = dmap(type, n0 + n);
            if (WT8 != nullptr && in8_tile(dest >> 8)) { u32x2 o; o.x = pk4_fp8(s[0 * 65] * W8_SCALE, s[1 * 65] * W8_SCALE, s[2 * 65] * W8_SCALE, s[3 * 65] * W8_SCALE); o.y = pk4_fp8(s[4 * 65] * W8_SCALE, s[5 * 65] * W8_SCALE, s[6 * 65] * W8_SCALE, s[7 * 65] * W8_SCALE);
                if (n0 + n < ncols) *(u32x2*)(WT8 + (size_t)(in8_compact(dest >> 8) * 256 + (dest & 255)) * DM + k0 + 8 * c) = o; }
            else { u32x4 o; o.x = pk2(s[0 * 65], s[1 * 65]); o.y = pk2(s[2 * 65], s[3 * 65]); o.z = pk2(s[4 * 65], s[5 * 65]); o.w = pk2(s[6 * 65], s[7 * 65]);
                if (n0 + n < ncols) *(u32x4*)(WT + (size_t)dest * ldt + k0 + 8 * c) = o; } } }
    LDS_WAIT(); asm volatile("" ::: "memory");
}
__device__ __forceinline__ int t5_bucket(int d) {
    if (d < 16) return d;
    const float v = logf((float)d / 16.0f) / 4.852030263919617f * 16.0f;
    int b = 16 + (int)v; return b < 31 ? b : 31;
}
constexpr int I_IN = 32 * 89, I_OUT = 32 * 32, I_PP = 4 * 32, I_PG = 32 * 32, I_G = 32 * 128, I_U = 32 * 128, I_D = 32 * 128;
constexpr int IO_OUT = I_IN, IO_PP = IO_OUT + I_OUT, IO_PG = IO_PP + I_PP, IO_G = IO_PG + I_PG, IO_U = IO_G + I_G, IO_D = IO_U + I_U, I_L = IO_D + I_D;
__device__ __forceinline__ void conv_items(const Frame& F, const Args& a, const int l, const int lo, const int hi, const int gw, const int NGW) {
    LAS float* scr = (LAS float*)(F.lds + F.wave * 16640);
    bf16_t* WIN = (bf16_t*)(F.ws + WS_WIN); bf16_t* WOUT = (bf16_t*)(F.ws + WS_WOUT); bf16_t* WGU = (bf16_t*)(F.ws + WS_WGU); bf16_t* WD = (bf16_t*)(F.ws + WS_WD);
    bf16_t* WPG = (bf16_t*)(F.ws + WS_WPG); bf16_t* WPP = (bf16_t*)(F.ws + WS_WPP);
    for (int it = lo + gw; it < hi; it += NGW) {
        int r = it;
        if (r < IO_OUT) { const int kb = r / 89, nb = r - kb * 89; transpose_item(argp(F.lds, 2) + (size_t)l * DM * DIN, DIN, DIN, kb * 64, nb * 64, nullptr, WIN + (size_t)l * DINP * DM, DM, 1, scr, F.lane, F.ws + WS_WIN8 + (size_t)l * IN8_TILES * 256 * DM); continue; }
        if (r < IO_PP) { r -= IO_OUT; const int kb = r >> 5, nb = r & 31; transpose_item<true>(argp(F.lds, 12) + (size_t)l * DM * DM, DM, DM, kb * 64, nb * 64, argp(F.lds, 11) + l * DM, (bf16_t*)((unsigned char*)WOUT + (size_t)l * DM * DM), DM, 0, scr, F.lane); continue; }
        if (r < IO_PG) { r -= IO_PP; const int kb = r >> 5, nb = r & 31; transpose_item(argp(F.lds, 25) + (size_t)l * PLE * DM, DM, DM, kb * 64, nb * 64, nullptr, WPP + (size_t)l * DM * PLE, PLE, 0, scr, F.lane); continue; }
        if (r < IO_G) { r -= IO_PG; const int kb = r >> 5, nb = r & 31; transpose_item<true>(argp(F.lds, 23) + (size_t)l * DM * DM, DM, DM, kb * 64, nb * 64, nullptr, (bf16_t*)((unsigned char*)WPG + (size_t)l * DM * DM), DM, 0, scr, F.lane); continue; }
        if (r < IO_U) { r -= IO_G; const int e = r >> 7, q = r & 127, kb = q >> 2, nb = q & 3; transpose_item<true>(argp(F.lds, 20) + (size_t)(l * NEXP + e) * DM * DEXP, DEXP, DEXP, kb * 64, nb * 64, nullptr, (bf16_t*)((unsigned char*)WGU + (size_t)(l * NEXP + e) * 512 * DM), DM, 2, scr, F.lane); continue; }
        if (r < IO_D) { r -= IO_U; const int e = r >> 7, q = r & 127, kb = q >> 2, nb = q & 3; transpose_item<true>(argp(F.lds, 21) + (size_t)(l * NEXP + e) * DM * DEXP, DEXP, DEXP, kb * 64, nb * 64, nullptr, (bf16_t*)((unsigned char*)WGU + (size_t)(l * NEXP + e) * 512 * DM), DM, 3, scr, F.lane); continue; }
        { r -= IO_D; const int e = r >> 7, q = r & 127, kb = q >> 5, nb = q & 31; transpose_item(argp(F.lds, 22) + (size_t)(l * NEXP + e) * DEXP * DM, DM, DM, kb * 64, nb * 64, nullptr, WD + (size_t)(l * NEXP + e) * DM * DEXP, DEXP, 0, scr, F.lane); }
    }
}
__device__ __forceinline__ void conv_all(const Frame& F, const Args& a, const int l, const int lo, const int hi) { __syncthreads(); conv_items(F, a, l, lo, hi, F.bx * 8 + F.wave, F.G * 8); __syncthreads(); }
__device__ __forceinline__ void phase_prologue(const Frame& F, const Args& a) {
    bf16_t* WIN = (bf16_t*)(F.ws + WS_WIN);
    conv_all(F, a, 0, 0, IO_PG);
    const size_t gt = (size_t)F.bx * 512 + F.tid, NT = (size_t)F.G * 512;
    for (size_t i = gt; i < (size_t)NL * (DINP - DIN) * DM / 8; i += NT) { const size_t l = i / ((DINP - DIN) * DM / 8), r = i % ((DINP - DIN) * DM / 8);
        *(u32x4*)(WIN + (l * DINP + DIN) * DM + r * 8) = (u32x4){0u, 0u, 0u, 0u}; }
    for (size_t i = gt; i < (size_t)NL * 240 * DM / 16; i += NT) { const size_t l = i / (240 * DM / 16), r = i % (240 * DM / 16);
        *(u32x4*)(F.ws + WS_WIN8 + (l * IN8_TILES * 256 + 6 * 256 + 16) * DM + r * 16) = (u32x4){0u, 0u, 0u, 0u}; }
    { const float* x = argp(F.lds, 0); bf16_t* XB = (bf16_t*)(F.ws + WS_XB);
      constexpr size_t N8 = (size_t)MT * DM / 8;
#pragma unroll 1
      for (size_t i = gt; i < N8; i += 4 * NT) { f32x4 v0[4], v1[4];
#pragma unroll
          for (int u = 0; u < 4; ++u) { const size_t ix = i + u * NT; if (ix < N8) { v0[u] = __builtin_nontemporal_load((const f32x4*)(x + ix * 8)); v1[u] = __builtin_nontemporal_load((const f32x4*)(x + ix * 8 + 4)); } }
#pragma unroll
          for (int u = 0; u < 4; ++u) { const size_t ix = i + u * NT; if (ix < N8) { *(u32x4*)(XB + ix * 8) = (u32x4){pk2(v0[u][0], v0[u][1]), pk2(v0[u][2], v0[u][3]), pk2(v1[u][0], v1[u][1]), pk2(v1[u][2], v1[u][3])};
              *(u32x2*)(F.ws + WS_XB8 + ix * 8) = (u32x2){pk4_fp8s(v0[u][0], v0[u][1], v0[u][2], v0[u][3]), pk4_fp8s(v1[u][0], v1[u][1], v1[u][2], v1[u][3])}; } } } }
    { const float* p = argp(F.lds, 1); bf16_t* PB = (bf16_t*)(F.ws + WS_PB);
      constexpr size_t N8 = (size_t)NL * MT * PLE / 8;
#pragma unroll 1
      for (size_t i = gt; i < N8; i += 4 * NT) { f32x4 v0[4], v1[4];
#pragma unroll
          for (int u = 0; u < 4; ++u) { const size_t ix = i + u * NT; if (ix < N8) { v0[u] = __builtin_nontemporal_load((const f32x4*)(p + ix * 8)); v1[u] = __builtin_nontemporal_load((const f32x4*)(p + ix * 8 + 4)); } }
#pragma unroll
          for (int u = 0; u < 4; ++u) { const size_t ix = i + u * NT; if (ix < N8) *(u32x4*)(PB + ix * 8) = (u32x4){pk2(v0[u][0], v0[u][1]), pk2(v0[u][2], v0[u][3]), pk2(v1[u][0], v1[u][1]), pk2(v1[u][2], v1[u][3])}; } } }
    { float* bt = (float*)(F.ws + WS_BTAB); const float* rb = argp(F.lds, 13);
      for (size_t i = gt; i < 3 * 129 * 8; i += NT) { const int h = (int)(i & 7), j = (int)((i >> 3) % 129), br = (int)((i >> 3) / 129); const int dil = br == 0 ? 1 : (br == 1 ? 4 : 16);
          bt[i] = rb[t5_bucket(j * dil) * 8 + h]; } }
    { bf16_t* wrh = (bf16_t*)(F.ws + WS_WRH); bf16_t* wrl = (bf16_t*)(F.ws + WS_WRL);
      for (size_t i = gt; i < (size_t)NL * 48 * DM; i += NT) { const int k = (int)(i % DM), c = (int)((i / DM) % 48), l = (int)(i / (48 * DM));
          float w = 0.f; if (c < 4) w = argp(F.lds, 16)[((size_t)l * DM + k) * 4 + c]; else if (c < 36) w = argp(F.lds, 18)[((size_t)l * DM + k) * 32 + (c - 4)];
          w *= argp(F.lds, 14)[(size_t)l * DM + k];
          const size_t t = (((((size_t)l * 8 + (k >> 8)) * 8 + ((k >> 5) & 7)) * 3 + (c >> 4)) * 64 + (((k >> 3) & 3) * 16 + (c & 15))) * 8 + (k & 7);
          const unsigned h = f2bf(w); const float lo = w - bf2f(h); wrh[t] = (bf16_t)h; wrl[t] = (bf16_t)f2bf(lo); } }
    { float* wrs = (float*)(F.ws + WS_WRS); const int gwv = F.bx * 8 + F.wave;
      if (gwv < NL * 36) { const int l = gwv / 36, c = gwv % 36; float s = 0.f, b = 0.f;
          const float* wp = c < 4 ? argp(F.lds, 16) + (size_t)l * DM * 4 + c : argp(F.lds, 18) + (size_t)l * DM * 32 + (c - 4); const int wst = c < 4 ? 4 : 32;
          const float* gp = argp(F.lds, 14) + (size_t)l * DM; const float* bp = argp(F.lds, 15) + (size_t)l * DM;
          float wv[32], gv[32], bv2[32];
#pragma unroll
          for (int j = 0; j < 32; ++j) { const int k = F.lane + 64 * j; wv[j] = wp[(size_t)k * wst]; gv[j] = gp[k]; bv2[j] = bp[k]; }
#pragma unroll
          for (int j = 0; j < 32; ++j) { s += wv[j] * gv[j]; b += wv[j] * bv2[j]; }
          s = wave_sum(s); b = wave_sum(b);
          if (F.lane == 0) { wrs[(l * 2 + 0) * 48 + c] = s; wrs[(l * 2 + 1) * 48 + c] = b + (c < 4 ? argp(F.lds, 17)[l * 4 + c] : argp(F.lds, 19)[l * 32 + (c - 4)]); } } }
}

__device__ __forceinline__ void conv_unit(const Frame& F, const Args& a, int l, int unit) {
    const bf16_t* U = F.Up(); unsigned char* MIX = F.MIXp();
    LAS float* hb = (LAS float*)F.lds;
    const int t0 = unit * 32, tl0 = t0 & (SEQ - 1), tb = t0 - tl0;
    const int tid = F.tid;
    __syncthreads();
#pragma unroll 1
    for (int i = 0; i < 8; ++i) { const int id = tid + 512 * i; if (id < 62 * 64) { const int row = id >> 6, ch = (id & 63) * 8; const int tl = tl0 - 30 + row;
        float o[8];
        if (tl >= 0) { const bf16_t* up = U + (size_t)(tb + tl) * DINP; const u32x4 av = *(const u32x4*)(up + UA_VAL + ch), gv = *(const u32x4*)(up + UA_GATE + ch);
            const unsigned aw[4] = {av.x, av.y, av.z, av.w}, gw[4] = {gv.x, gv.y, gv.z, gv.w};
#pragma unroll
            for (int j = 0; j < 4; ++j) { o[2 * j] = bflo(aw[j]) * sigmoidf_(bflo(gw[j])); o[2 * j + 1] = bfhi(aw[j]) * sigmoidf_(bfhi(gw[j])); } }
        else {
#pragma unroll
            for (int j = 0; j < 8; ++j) o[j] = 0.f; }
        *(LAS f32x4*)(hb + row * 512 + ch) = (f32x4){o[0], o[1], o[2], o[3]}; *(LAS f32x4*)(hb + row * 512 + ch + 4) = (f32x4){o[4], o[5], o[6], o[7]}; } }
    __syncthreads();
    float yv[32];
    { const int c = tid; const float* w = argp(F.lds, 3) + (size_t)l * 31 * 512; const float bias = argp(F.lds, 4)[l * 512 + c];
      float wv[31];
#pragma unroll
      for (int j = 0; j < 31; ++j) wv[j] = w[j * 512 + c];
      f32x2 pe[31], po[31];
#pragma unroll
      for (int k = 0; k < 31; ++k) { const float h0 = hb[(2 * k) * 512 + c], h1 = hb[(2 * k + 1) * 512 + c]; pe[k] = (f32x2){h0, h1}; if (k > 0) po[k - 1][1] = h0; po[k][0] = h1; }
      po[30][1] = 0.f;
#pragma unroll
      for (int q = 0; q < 16; ++q) { f32x2 s2 = (f32x2){bias, bias};
#pragma unroll
          for (int j = 0; j < 31; ++j) { const int a = 2 * q + j; const f32x2 hh = (a & 1) ? po[a >> 1] : pe[a >> 1]; s2 = s2 + (f32x2){wv[j], wv[j]} * hh; }
          yv[2 * q] = s2[0]; yv[2 * q + 1] = s2[1]; } }
    __syncthreads();
#pragma unroll
    for (int t = 0; t < 32; ++t) hb[t * 512 + tid] = yv[t];
    __syncthreads();
    { const float* lg = argp(F.lds, 5) + l * 512; const float* lb = argp(F.lds, 6) + l * 512;
#pragma unroll 1
      for (int i = 0; i < 4; ++i) { const int t = F.wave + 8 * i;
          const f32x4 v0 = *(const LAS f32x4*)(hb + t * 512 + 4 * F.lane), v1 = *(const LAS f32x4*)(hb + t * 512 + 256 + 4 * F.lane);
          const float mean = wave_sum((v0[0] + v0[1]) + (v0[2] + v0[3]) + (v1[0] + v1[1]) + (v1[2] + v1[3])) * (1.f / 512.f);
          const f32x4 d0 = v0 - mean, d1 = v1 - mean;
          const float var = wave_sum((d0[0] * d0[0] + d0[1] * d0[1]) + (d0[2] * d0[2] + d0[3] * d0[3]) + (d1[0] * d1[0] + d1[1] * d1[1]) + (d1[2] * d1[2] + d1[3] * d1[3])) * (1.f / 512.f);
          const float rstd = 1.0f / sqrtf(var + LN_EPS);
          const f32x4 g0 = *(const f32x4*)(lg + 4 * F.lane), g1 = *(const f32x4*)(lg + 256 + 4 * F.lane), b0 = *(const f32x4*)(lb + 4 * F.lane), b1 = *(const f32x4*)(lb + 256 + 4 * F.lane);
          float o0[4], o1[4];
#pragma unroll
          for (int j = 0; j < 4; ++j) { o0[j] = siluf_(d0[j] * rstd * g0[j] + b0[j]); o1[j] = siluf_(d1[j] * rstd * g1[j] + b1[j]); }
          unsigned char* mp = MIX + (size_t)(t0 + t) * DM;
          *(unsigned*)(mp + 4 * F.lane) = pk4_fp8s(o0[0], o0[1], o0[2], o0[3]); *(unsigned*)(mp + 256 + 4 * F.lane) = pk4_fp8s(o1[0], o1[1], o1[2], o1[3]); } }
    { const int cg = (tid & 63) * 8; const float* w = argp(F.lds, 10) + (size_t)l * 3 * 512 + cg;
      float wv[3][8];
#pragma unroll
      for (int j = 0; j < 3; ++j) { const f32x4 a0 = *(const f32x4*)(w + j * 512), a1 = *(const f32x4*)(w + j * 512 + 4); wv[j][0] = a0[0]; wv[j][1] = a0[1]; wv[j][2] = a0[2]; wv[j][3] = a0[3]; wv[j][4] = a1[0]; wv[j][5] = a1[1]; wv[j][6] = a1[2]; wv[j][7] = a1[3]; }
#pragma unroll 1
      for (int pass = 0; pass < 2; ++pass) { const int tg = (tid >> 6) + 8 * pass;
      float p[4][8];
#pragma unroll
      for (int rr = 0; rr < 4; ++rr) { const int tl = tl0 + 2 * tg - 2 + rr;
          { const float msk = tl >= 0 ? 1.f : 0.f; const int tlc = tl >= 0 ? tl : 0;
            const bf16_t* up = U + (size_t)(tb + tlc) * DINP; const u32x4 cw = *(const u32x4*)(up + US_C + cg), hw = *(const u32x4*)(up + US_H + cg);
            const unsigned c4[4] = {cw.x, cw.y, cw.z, cw.w}, h4[4] = {hw.x, hw.y, hw.z, hw.w};
#pragma unroll
            for (int j = 0; j < 4; ++j) { p[rr][2 * j] = bflo(c4[j]) * bflo(h4[j]) * msk; p[rr][2 * j + 1] = bfhi(c4[j]) * bfhi(h4[j]) * msk; } } }
#pragma unroll
      for (int tt = 0; tt < 2; ++tt) { const int t = t0 + 2 * tg + tt; const u32x4 bw = *(const u32x4*)(U + (size_t)t * DINP + US_B + cg); const unsigned b4[4] = {bw.x, bw.y, bw.z, bw.w}; float yv[8];
#pragma unroll
          for (int j = 0; j < 4; ++j) { const float y0 = bflo(b4[j]) * (wv[0][2 * j] * p[tt][2 * j] + wv[1][2 * j] * p[tt + 1][2 * j] + wv[2][2 * j] * p[tt + 2][2 * j]);
              const float y1 = bfhi(b4[j]) * (wv[0][2 * j + 1] * p[tt][2 * j + 1] + wv[1][2 * j + 1] * p[tt + 1][2 * j + 1] + wv[2][2 * j + 1] * p[tt + 2][2 * j + 1]); yv[2 * j] = y0; yv[2 * j + 1] = y1; }
          *(u32x2*)(MIX + (size_t)t * DM + 1536 + cg) = (u32x2){pk4_fp8s(yv[0], yv[1], yv[2], yv[3]), pk4_fp8s(yv[4], yv[5], yv[6], yv[7])}; } } }
}

__device__ __forceinline__ bf16x8 frag_f32(const LAS float* p) { const f32x4 a = *(const LAS f32x4*)p, b = *(const LAS f32x4*)(p + 4);
    const u32x4 w = (u32x4){pk2(a[0], a[1]), pk2(a[2], a[3]), pk2(b[0], b[1]), pk2(b[2], b[3])}; return __builtin_bit_cast(bf16x8, w); }
__device__ __forceinline__ bf16x8 frag_col(const LAS float* p, int stride) {
    const u32x4 w = (u32x4){pk2(p[0], p[stride]), pk2(p[2 * stride], p[3 * stride]), pk2(p[4 * stride], p[5 * stride]), pk2(p[6 * stride], p[7 * stride])}; return __builtin_bit_cast(bf16x8, w); }
constexpr int GA_LDS = 15872;
static_assert(2 * GA_LDS * 4 <= LDS_STAGE, "gla_a LDS");
__device__ __forceinline__ void gla_a_pair(const Frame& F, const Args& a, int l, int uA, int uB) {
    const bf16_t* U = F.Up();
    float* GU = (float*)(F.ws + WS_GU); float* GO = (float*)(F.ws + WS_GO); float* GQ = (float*)(F.ws + WS_GQ); float* GD = (float*)(F.ws + WS_GD);
    const int tid = F.tid, i = tid >> 4, k4 = (tid & 15) * 4, v8 = (tid & 15) * 8;
    const int lane = F.lane, w = F.wave, fr = lane & 15, fg = lane >> 4;
    LAS float* L0 = (LAS float*)F.lds;
#define GA_UNIT(ub) const int unit = (ub) ? uB : uA; const int n = unit & 63, h = (unit >> 6) & 3, b = unit >> 8, bh = b * 4 + h, t0 = b * SEQ + n * 32; LAS float* L = L0 + (ub) * GA_LDS; \
    LAS float* qt = L; LAS float* kr = L + 2048; LAS float* kt = L + 4096; LAS float* kh = L + 6144; LAS float* vv = L + 8192; LAS float* bc = L + 12288; LAS float* gl = L + 14336; LAS float* wg = L + 14848; LAS float* sc = bc; \
    (void)n; (void)h; (void)b; (void)bh; (void)t0; (void)qt; (void)kr; (void)kt; (void)kh; (void)vv; (void)bc; (void)gl; (void)wg; (void)sc
    __syncthreads();
    f32x4 bgv[2];
    { u32x2 qw[2], kw[2]; u32x4 vw[2]; float glv[2], w0[2], w1[2];
#pragma unroll
      for (int ub = 0; ub < 2; ++ub) { GA_UNIT(ub); const bf16_t* up = U + (size_t)(t0 + i) * DINP;
          qw[ub] = *(const u32x2*)(up + UG_Q + h * 64 + k4); kw[ub] = *(const u32x2*)(up + UG_K + h * 64 + k4); vw[ub] = *(const u32x4*)(up + UG_V + h * 128 + v8);
          glv[ub] = bf2f(up[UG_LOW + (tid & 15)]);
          const float* w2 = argp(F.lds, 7) + (size_t)l * 16 * 256;
          w0[ub] = w2[(tid >> 6) * 256 + h * 64 + (tid & 63)]; w1[ub] = w2[(8 + (tid >> 6)) * 256 + h * 64 + (tid & 63)];
          bgv[ub] = *(const f32x4*)(argp(F.lds, 8) + l * 256 + h * 64 + k4); }
#pragma unroll
      for (int ub = 0; ub < 2; ++ub) { GA_UNIT(ub);
          *(LAS f32x4*)(qt + i * 64 + k4) = (f32x4){bflo(qw[ub].x), bfhi(qw[ub].x), bflo(qw[ub].y), bfhi(qw[ub].y)};
          *(LAS f32x4*)(kr + i * 64 + k4) = (f32x4){bflo(kw[ub].x), bfhi(kw[ub].x), bflo(kw[ub].y), bfhi(kw[ub].y)};
          *(LAS f32x4*)(vv + i * 128 + v8) = (f32x4){bflo(vw[ub].x), bfhi(vw[ub].x), bflo(vw[ub].y), bfhi(vw[ub].y)}; *(LAS f32x4*)(vv + i * 128 + v8 + 4) = (f32x4){bflo(vw[ub].z), bfhi(vw[ub].z), bflo(vw[ub].w), bfhi(vw[ub].w)};
          gl[i * 16 + (tid & 15)] = glv[ub];
          wg[tid] = w0[ub]; wg[512 + tid] = w1[ub]; } }
    __syncthreads();
#pragma unroll
    for (int ub = 0; ub < 2; ++ub) { GA_UNIT(ub); f32x4 z = bgv[ub];
#pragma unroll
      for (int r = 0; r < 16; ++r) { const float g = gl[i * 16 + r]; const f32x4 wv = *(const LAS f32x4*)(wg + r * 64 + k4); z = z + wv * g; }
      f32x4 la;
#pragma unroll
      for (int j = 0; j < 4; ++j) la[j] = (fminf(z[j], 0.f) - __logf(1.0f + __expf(-fabsf(z[j])))) * (1.0f / 16.0f);
      *(LAS f32x4*)(bc + i * 64 + k4) = la; }
    __syncthreads();
#pragma unroll
    for (int ub = 0; ub < 2; ++ub) { GA_UNIT(ub);
      f32x4 bv = {0.f, 0.f, 0.f, 0.f}, bl = bv;
#pragma unroll 8
      for (int r = 0; r < 32; ++r) { const f32x4 x = *(const LAS f32x4*)(bc + r * 64 + k4); bl = bl + x; if (r <= i) bv = bv + x; }
      const f32x4  q = *(const LAS f32x4*)(qt + i * 64 + k4), k = *(const LAS f32x4*)(kr + i * 64 + k4);
      f32x4 qo, ko, ho;
#pragma unroll
      for (int j = 0; j < 4; ++j) { qo[j] = q[j] * __expf(bv[j]) * 0.125f; ko[j] = k[j] * __expf(-bv[j]); ho[j] = k[j] * __expf(bl[j] - bv[j]); }
      *(LAS f32x4*)(qt + i * 64 + k4) = qo; *(LAS f32x4*)(kt + i * 64 + k4) = ko; *(LAS f32x4*)(kh + i * 64 + k4) = ho;
      *(f32x4*)(GQ + (size_t)(t0 + i) * 256 + h * 64 + k4) = qo;
      if (i == 31) { f32x4 d;
#pragma unroll
          for (int j = 0; j < 4; ++j) d[j] = __expf(bl[j]);
          *(f32x4*)(GD + ((size_t)bh * 64 + n) * 64 + k4) = d; } }
    __syncthreads();
    bf16x8 vfr[2];
#pragma unroll
    for (int ub = 0; ub < 2; ++ub) { GA_UNIT(ub);
      if ((w >> 2) == ub) { const int wq = w & 3, mi = wq >> 1, nj = wq & 1; f32x4 d = zero4();
#pragma unroll
          for (int ks = 0; ks < 2; ++ks) d = __builtin_amdgcn_mfma_f32_16x16x32_bf16(frag_f32(qt + (16 * mi + fr) * 64 + 8 * fg + 32 * ks), frag_f32(kt + (16 * nj + fr) * 64 + 8 * fg + 32 * ks), d, 0, 0, 0);
#pragma unroll
          for (int r = 0; r < 4; ++r) { const int ii = 16 * mi + 4 * fg + r, jj = 16 * nj + fr; sc[ii * 36 + jj] = (jj <= ii) ? d[r] : 0.f; } }
      const bf16x8 vfrag = frag_col(vv + (8 * fg) * 128 + 16 * w + fr, 128);
      vfr[ub] = vfrag;
      float* gp = GU + ((size_t)bh * 64 + n) * 8192 + (size_t)(16 * w + fr) * 64 + 4 * fg;
#pragma unroll
      for (int kt4 = 0; kt4 < 4; ++kt4) { const bf16x8 kfrag = frag_col(kh + (8 * fg) * 64 + 16 * kt4 + fr, 64);
          const f32x4 d = __builtin_amdgcn_mfma_f32_16x16x32_bf16(kfrag, vfrag, zero4(), 0, 0, 0);
          *(f32x4*)(gp + 16 * kt4) = d; } }
    __syncthreads();
#pragma unroll
    for (int ub = 0; ub < 2; ++ub) { GA_UNIT(ub);
#pragma unroll
      for (int it = 0; it < 2; ++it) { const bf16x8 sfrag = frag_f32(sc + (16 * it + fr) * 36 + 8 * fg);
          const f32x4 d = __builtin_amdgcn_mfma_f32_16x16x32_bf16(vfr[ub], sfrag, zero4(), 0, 0, 0);
          *(f32x4*)(GO + (size_t)(t0 + 16 * it + fr) * 512 + h * 128 + 16 * w + 4 * fg) = d; } }
#undef GA_UNIT
}
__device__ __forceinline__ void gla_scan(const Frame& F) {
    float* GU = (float*)(F.ws + WS_GU); const float* GD = (const float*)(F.ws + WS_GD);
    for (int g = F.sid * 8 * 8192 + F.bx * 512 + F.tid; g < (F.sid + 1) * 8 * 8192; g += F.G * 512) { const int bh = g >> 13, kv = g & 8191, k = kv & 63;
        float* p = GU + (size_t)bh * 64 * 8192 + kv; const float* d = GD + (size_t)bh * 64 * 64 + k; float S = 0.f;
#pragma unroll 1
        for (int n0 = 0; n0 < 64; n0 += 32) { float u[32], dc[32];
#pragma unroll
            for (int j = 0; j < 32; ++j) { u[j] = p[(size_t)(n0 + j) * 8192]; dc[j] = d[(n0 + j) * 64]; }
#pragma unroll
            for (int j = 0; j < 32; ++j) { p[(size_t)(n0 + j) * 8192] = S; S = S * dc[j] + u[j]; } } }
}
struct GlaCIn { f32x4 s[4]; f32x4 q; f32x4 oi[2]; u32x2 rw[2]; };
__device__ __forceinline__ void gla_c_load(const Frame& F, int unit, GlaCIn& in) {
    const bf16_t* U = F.Up(); const float* GU = (const float*)(F.ws + WS_GU); const float* GO = (const float*)(F.ws + WS_GO); const float* GQ = (const float*)(F.ws + WS_GQ);
    const int n = unit & 63, h = (unit >> 6) & 3, b = unit >> 8, bh = b * 4 + h, t0 = b * SEQ + n * 32, tid = F.tid, lane = F.lane, w = F.wave, fr = lane & 15, fg = lane >> 4;
    const float* sp = GU + ((size_t)bh * 64 + n) * 8192;
#pragma unroll
    for (int j = 0; j < 4; ++j) in.s[j] = *(const f32x4*)(sp + (tid + 512 * j) * 4);
    in.q = *(const f32x4*)(GQ + (size_t)(t0 + (tid >> 4)) * 256 + h * 64 + (tid & 15) * 4);
#pragma unroll
    for (int it = 0; it < 2; ++it) { const int row = t0 + 16 * it + fr, col = h * 128 + 16 * w + 4 * fg;
        in.oi[it] = *(const f32x4*)(GO + (size_t)row * 512 + col); in.rw[it] = *(const u32x2*)(U + (size_t)row * DINP + UG_R + col); }
}
__device__ __forceinline__ void gla_c_phase(const Frame& F, const Args& a, int l) {
    unsigned char* MIX = F.MIXp();
    const int tid = F.tid, lane = F.lane, w = F.wave, fr = lane & 15, fg = lane >> 4;
    LAS float* qt = (LAS float*)F.lds; LAS float* SsT = qt + 32 * 68; LAS float* red = SsT + 128 * 68;
    const f32x4 ng = *(const f32x4*)(argp(F.lds, 9) + l * 128 + 16 * w + 4 * fg);
    GlaCIn in; const int ubeg = F.sid * 512 + F.bx, uend = (F.sid + 1) * 512;
    if (ubeg < uend) gla_c_load(F, ubeg, in);
#pragma unroll 1
    for (int unit = ubeg; unit < uend; unit += F.G) {
        const int n = unit & 63, h = (unit >> 6) & 3, b = unit >> 8, t0 = b * SEQ + n * 32;
        __syncthreads();
        *(LAS f32x4*)(qt + (tid >> 4) * 68 + (tid & 15) * 4) = in.q;
#pragma unroll
        for (int j = 0; j < 4; ++j) { const int e = (tid + 512 * j) * 4; *(LAS f32x4*)(SsT + (e >> 6) * 68 + (e & 63)) = in.s[j]; }
        f32x4 o[2] = {in.oi[0], in.oi[1]}; const u32x2 rw0 = in.rw[0], rw1 = in.rw[1];
        __syncthreads();
        if (unit + F.G < uend) gla_c_load(F, unit + F.G, in);
#pragma unroll
        for (int ks = 0; ks < 2; ++ks) { const bf16x8 sf = frag_f32(SsT + (16 * w + fr) * 68 + 8 * fg + 32 * ks);
#pragma unroll
            for (int it = 0; it < 2; ++it) o[it] = __builtin_amdgcn_mfma_f32_16x16x32_bf16(sf, frag_f32(qt + (16 * it + fr) * 68 + 8 * fg + 32 * ks), o[it], 0, 0, 0); }
#pragma unroll
        for (int it = 0; it < 2; ++it) { float ss = (o[it][0] * o[it][0] + o[it][1] * o[it][1]) + (o[it][2] * o[it][2] + o[it][3] * o[it][3]);
            ss += __shfl_xor(ss, 16); ss += __shfl_xor(ss, 32);
            if (fg == 0) red[w * 32 + 16 * it + fr] = ss; }
        __syncthreads();
#pragma unroll
        for (int it = 0; it < 2; ++it) { float tot = 0.f;
#pragma unroll
            for (int ww = 0; ww < 8; ++ww) tot += red[ww * 32 + 16 * it + fr];
            const float rms = 1.0f / sqrtf(tot * (1.f / 128.f) + RMS_EPS);
            const u32x2 rw = it == 0 ? rw0 : rw1;
            const float y0 = o[it][0] * rms * ng[0] * siluf_(bflo(rw.x)), y1 = o[it][1] * rms * ng[1] * siluf_(bfhi(rw.x)), y2 = o[it][2] * rms * ng[2] * siluf_(bflo(rw.y)), y3 = o[it][3] * rms * ng[3] * siluf_(bfhi(rw.y));
            *(unsigned*)(MIX + (size_t)(t0 + 16 * it + fr) * DM + 512 + h * 128 + 16 * w + 4 * fg) = pk4_fp8s(y0, y1, y2, y3); }
    }
}

typedef short s16x4 __attribute__((ext_vector_type(4)));
__device__ __forceinline__ s16x4 vtr(const LAS unsigned char* p) { return __builtin_bit_cast(s16x4, __builtin_amdgcn_ds_read_tr16_b64_v4i16((LAS s16x4*)p)); }
constexpr int ATK_ROW = 144, AT_VROW = 160, ATK_BYTES = 256 * ATK_ROW, ATV_BYTES = 256 * AT_VROW, AT_BT_OFF = ATK_BYTES + ATV_BYTES, AT_NJOB = 16 * 3 * 16;
static_assert(AT_BT_OFF % 16 == 0 && AT_BT_OFF + 8 * 3 * 224 * 4 <= LDS_STAGE, "attention LDS map");
__device__ __forceinline__ float max_over_groups(float x) {
    { const auto r = __builtin_amdgcn_permlane16_swap(__float_as_uint(x), __float_as_uint(x), false, false); x = fmaxf(__uint_as_float(r[0]), __uint_as_float(r[1])); }
    { const auto r = __builtin_amdgcn_permlane32_swap(__float_as_uint(x), __float_as_uint(x), false, false); x = fmaxf(__uint_as_float(r[0]), __uint_as_float(r[1])); }
    return x;
}
__device__ __forceinline__ float sum_over_groups(float x) {
    { const auto r = __builtin_amdgcn_permlane16_swap(__float_as_uint(x), __float_as_uint(x), false, false); x = __uint_as_float(r[0]) + __uint_as_float(r[1]); }
    { const auto r = __builtin_amdgcn_permlane32_swap(__float_as_uint(x), __float_as_uint(x), false, false); x = __uint_as_float(r[0]) + __uint_as_float(r[1]); }
    return x;
}
struct AttnJob { int tb, h, br, dsh, r, blk; };
__device__ __forceinline__ AttnJob attn_decode(int job) {
    AttnJob j; const int blk16 = job & 15, t2 = job >> 4; j.br = t2 % 3; const int bh = t2 / 3; j.h = bh & 7; j.tb = (bh >> 3) * SEQ; j.dsh = 2 * j.br;
    const int bsh = 4 - j.dsh; j.r = blk16 >> bsh; j.blk = blk16 & ((1 << bsh) - 1); return j;
}
struct AttnTile { u32x4 k[4], v[4]; bf16x8 q0, q1; };
__device__ __forceinline__ void attn_tile_load(const Frame& F, int job, AttnTile& t) {
    const AttnJob j = attn_decode(job); const bf16_t* U = F.Up();
    const int seg = F.tid & 7, rowb = F.tid >> 3, s0 = 128 * j.blk - 128;
    const bf16_t* Ub = U + (size_t)(j.tb + j.r) * DINP + j.h * 64; const size_t sstep = (size_t)DINP << j.dsh;
#pragma unroll
    for (int i = 0; i < 4; ++i) { const int sx = s0 + rowb + 64 * i; const bf16_t* pp = Ub + (size_t)(sx > 0 ? sx : 0) * sstep + seg * 8;
        t.k[i] = *(const u32x4*)(pp + UC_K); t.v[i] = *(const u32x4*)(pp + UC_V); }
    const bf16_t* qrow = Ub + (size_t)(128 * j.blk + 16 * F.wave + (F.lane & 15)) * sstep + UC_Q + 8 * (F.lane >> 4);
    t.q0 = *(const bf16x8*)qrow; t.q1 = *(const bf16x8*)(qrow + 32);
}
__device__ __forceinline__ void attn_tile_store(const Frame& F, const AttnTile& t) {
    const int seg = F.tid & 7, rowb = F.tid >> 3;
#pragma unroll
    for (int i = 0; i < 4; ++i) { *(LAS u32x4*)(F.lds + (rowb + 64 * i) * ATK_ROW + seg * 16) = t.k[i]; *(LAS u32x4*)(F.lds + ATK_BYTES + (rowb + 64 * i) * AT_VROW + seg * 16) = t.v[i]; }
}
__device__ __forceinline__ void attn_block(const Frame& F, int job, const bf16x8 qf0, const bf16x8 qf1, const LAS float* bt) {
    const AttnJob j = attn_decode(job); bf16_t* AO = (bf16_t*)(F.ws + WS_AO); float* ALSE = (float*)(F.ws + WS_ALSE);
    const int lane = F.lane, qi = lane & 15, g = lane >> 4, w = F.wave;
    const int q0 = 128 * j.blk + 16 * w;
    const int klo = (16 * w) & ~31;
    const int c0 = (j.blk == 0) ? (128 - klo) >> 5 : 0;
    const LAS float* bj = bt + (j.h * 3 + j.br) * 224;
    const LAS unsigned char* kt = F.lds + (klo + qi) * ATK_ROW + g * 16; const LAS unsigned char* vt = F.lds + ATK_BYTES + klo * AT_VROW;
    f32x4 sa[5], sb[5]; float cmax = -1e30f;
    bf16x8 kn0, kn1, kn2, kn3;
    { const LAS unsigned char* kp = kt + 32 * c0 * ATK_ROW; kn0 = *(const LAS bf16x8*)kp; kn1 = *(const LAS bf16x8*)(kp + 64); kn2 = *(const LAS bf16x8*)(kp + 16 * ATK_ROW); kn3 = *(const LAS bf16x8*)(kp + 16 * ATK_ROW + 64); }
#pragma unroll
    for (int c = 0; c < 5; ++c) if (c >= c0) {
        const bf16x8 ka0 = kn0, ka1 = kn1, kb0 = kn2, kb1 = kn3;
        if (c < 4) { const LAS unsigned char* kp = kt + 32 * (c + 1) * ATK_ROW; kn0 = *(const LAS bf16x8*)kp; kn1 = *(const LAS bf16x8*)(kp + 64); kn2 = *(const LAS bf16x8*)(kp + 16 * ATK_ROW); kn3 = *(const LAS bf16x8*)(kp + 16 * ATK_ROW + 64); }
        const LAS float* bp = bj + ((128 + 16 * w - klo - 32 * c) + qi - 4 * g);
        float ba[4], bb[4];
#pragma unroll
        for (int rr = 0; rr < 4; ++rr) { ba[rr] = bp[48 - rr]; bb[rr] = bp[32 - rr]; }
        f32x4 xa = __builtin_amdgcn_mfma_f32_16x16x32_bf16(ka0, qf0, (f32x4){0.f, 0.f, 0.f, 0.f}, 0, 0, 0); xa = __builtin_amdgcn_mfma_f32_16x16x32_bf16(ka1, qf1, xa, 0, 0, 0);
        f32x4 xb = __builtin_amdgcn_mfma_f32_16x16x32_bf16(kb0, qf0, (f32x4){0.f, 0.f, 0.f, 0.f}, 0, 0, 0); xb = __builtin_amdgcn_mfma_f32_16x16x32_bf16(kb1, qf1, xb, 0, 0, 0);
#pragma unroll
        for (int rr = 0; rr < 4; ++rr) { xa[rr] = xa[rr] * (0.125f * 1.4426950408889634f) + ba[rr]; xb[rr] = xb[rr] * (0.125f * 1.4426950408889634f) + bb[rr]; cmax = fmaxf(cmax, fmaxf(xa[rr], xb[rr])); }
        sa[c] = xa; sb[c] = xb;
        __builtin_amdgcn_sched_barrier(0); }
    const float m = max_over_groups(cmax);
    float l_part = 0.f;
    f32x4 o[4];
#pragma unroll
    for (int d = 0; d < 4; ++d) o[d] = zero4();
#pragma unroll
    for (int c = 0; c < 5; ++c) if (c >= c0) {
        f32x4 pa, pb;
#pragma unroll
        for (int rr = 0; rr < 4; ++rr) { pa[rr] = __builtin_amdgcn_exp2f(sa[c][rr] - m); pb[rr] = __builtin_amdgcn_exp2f(sb[c][rr] - m); l_part += pa[rr] + pb[rr]; }
        const u32x4 pw = (u32x4){pk2(pa[0], pa[1]), pk2(pa[2], pa[3]), pk2(pb[0], pb[1]), pk2(pb[2], pb[3])};
        const bf16x8 pf = __builtin_bit_cast(bf16x8, pw);
        const LAS unsigned char* tp = vt + (32 * c + 4 * g + (qi >> 2)) * AT_VROW + (qi & 3) * 8;
#pragma unroll
        for (int d = 0; d < 4; ++d) { const s16x4 va = vtr(tp + d * 32), vb2 = vtr(tp + 16 * AT_VROW + d * 32);
            const bf16x8 vf = (bf16x8){va[0], va[1], va[2], va[3], vb2[0], vb2[1], vb2[2], vb2[3]};
            o[d] = __builtin_amdgcn_mfma_f32_16x16x32_bf16(vf, pf, o[d], 0, 0, 0); }
        __builtin_amdgcn_sched_barrier(0); }
    const float l = sum_over_groups(l_part);
    const float inv = 1.0f / l;
    const int token = j.tb + ((q0 + qi) << j.dsh) + j.r;
    bf16_t* op = AO + ((size_t)j.br * MT + token) * 512 + j.h * 64 + 4 * g;
#pragma unroll
    for (int d = 0; d < 4; ++d) *(u32x2*)(op + d * 16) = (u32x2){pk2(o[d][0] * inv, o[d][1] * inv), pk2(o[d][2] * inv, o[d][3] * inv)};
    if (g == 0) ALSE[((size_t)j.br * MT + token) * 8 + j.h] = m * 0.6931471805599453f + logf(l);
}
__device__ __forceinline__ void attn_combine(const Frame& F) {
    const bf16_t* AO = (const bf16_t*)(F.ws + WS_AO); const float* ALSE = (const float*)(F.ws + WS_ALSE); unsigned char* MIX = F.MIXp();
#pragma unroll 4
    for (int i = F.row0 * 64 + F.bx * 512 + F.tid; i < (F.row0 + SMT) * 64; i += F.G * 512) { const int token = i >> 6, c8 = (i & 63) * 8, h = c8 >> 6;
        const float l0 = ALSE[(size_t)token * 8 + h], l1 = ALSE[((size_t)MT + token) * 8 + h], l2 = ALSE[((size_t)2 * MT + token) * 8 + h];
        const float m = fmaxf(l0, fmaxf(l1, l2)); float w0 = __expf(l0 - m), w1 = __expf(l1 - m), w2 = __expf(l2 - m); const float inv = 1.0f / (w0 + w1 + w2); w0 *= inv; w1 *= inv; w2 *= inv;
        const u32x4 a = *(const u32x4*)(AO + (size_t)token * 512 + c8), bq = *(const u32x4*)(AO + ((size_t)MT + token) * 512 + c8), cq = *(const u32x4*)(AO + ((size_t)2 * MT + token) * 512 + c8);
        const unsigned aw[4] = {a.x, a.y, a.z, a.w}, bw[4] = {bq.x, bq.y, bq.z, bq.w}, cw[4] = {cq.x, cq.y, cq.z, cq.w}; float yv[8];
#pragma unroll
        for (int j = 0; j < 4; ++j) { yv[2 * j] = w0 * bflo(aw[j]) + w1 * bflo(bw[j]) + w2 * bflo(cw[j]); yv[2 * j + 1] = w0 * bfhi(aw[j]) + w1 * bfhi(bw[j]) + w2 * bfhi(cw[j]); }
        *(u32x2*)(MIX + (size_t)token * DM + 1024 + c8) = (u32x2){pk4_fp8s(yv[0], yv[1], yv[2], yv[3]), pk4_fp8s(yv[4], yv[5], yv[6], yv[7])}; }
}

__device__ __forceinline__ void ln1_unit(const Frame& F, const Args& a, int l, int unit, bool commit) {
    const bf16_t* PRE = (const bf16_t*)(F.ws + WS_PRE); bf16_t* XB = (bf16_t*)(F.ws + WS_XB); unsigned char* XB8 = F.ws + WS_XB8;
    const bf16_t* WRH = (const bf16_t*)(F.ws + WS_WRH) + (size_t)l * 48 * DM; const bf16_t* WRL = (const bf16_t*)(F.ws + WS_WRL) + (size_t)l * 48 * DM; const float* WRS = (const float*)(F.ws + WS_WRS) + l * 96;
    int* ltok = (int*)(F.ws + WS_LTOK) + F.sid * 32 * SMT; float* lgate = (float*)(F.ws + WS_LGATE) + F.sid * 32 * SMT; int* tinfo = (int*)(F.ws + WS_TINFO); unsigned* cnt = F.ctl + CW_CNT + (l * 2 + F.sid) * 32 * 64;
    LAS float* stats = (LAS float*)F.lds;
    LAS float* red = stats + 64;
    LAS float* lg = red + 8 * 2 * 3 * 256;
    const int lane = F.lane, tid = F.tid, w = F.wave, R0 = unit * 32;
    const float* g = argp(F.lds, 14) + (size_t)l * DM; const float* bb = argp(F.lds, 15) + (size_t)l * DM;
    __syncthreads();
    u32x4 raw[4][4];
#pragma unroll
    for (int r = 0; r < 4; ++r) { const bf16_t* pr = PRE + (size_t)(R0 + 4 * w + r) * DM;
#pragma unroll
        for (int j = 0; j < 4; ++j) raw[r][j] = *(const u32x4*)(pr + 512 * j + 8 * lane); }
#pragma unroll
    for (int rp = 0; rp < 2; ++rp) {
        float v[2][4][8]; float s[2] = {0.f, 0.f};
#pragma unroll
        for (int r = 0; r < 2; ++r) {
#pragma unroll
            for (int j = 0; j < 4; ++j) { const u32x4 x = raw[2 * rp + r][j]; const unsigned xv[4] = {x.x, x.y, x.z, x.w};
#pragma unroll
                for (int q = 0; q < 4; ++q) { v[r][j][2 * q] = bflo(xv[q]); v[r][j][2 * q + 1] = bfhi(xv[q]); s[r] += v[r][j][2 * q] + v[r][j][2 * q + 1]; } } }
#pragma unroll
        for (int r = 0; r < 2; ++r) { const int row = R0 + 4 * w + 2 * rp + r;
            const float mean = wave_sum(s[r]) * (1.f / DM); float q = 0.f;
#pragma unroll
            for (int j = 0; j < 4; ++j)
#pragma unroll
                for (int k = 0; k < 8; ++k) { v[r][j][k] -= mean; q += v[r][j][k] * v[r][j][k]; }
            const float rstd = 1.0f / sqrtf(wave_sum(q) * (1.f / DM) + LN_EPS);
            if (lane == 0) { stats[(4 * w + 2 * rp + r) * 2] = mean; stats[(4 * w + 2 * rp + r) * 2 + 1] = rstd; }
#pragma unroll
            for (int j = 0; j < 4; ++j) { const float* gp = g + 512 * j + 8 * lane; const float* bp = bb + 512 * j + 8 * lane;
                const f32x4 g0 = *(const f32x4*)gp, g1 = *(const f32x4*)(gp + 4), b0 = *(const f32x4*)bp, b1 = *(const f32x4*)(bp + 4);
                const f32x4 y0 = (f32x4){v[r][j][0], v[r][j][1], v[r][j][2], v[r][j][3]} * rstd * g0 + b0, y1 = (f32x4){v[r][j][4], v[r][j][5], v[r][j][6], v[r][j][7]} * rstd * g1 + b1;
                *(u32x4*)(XB + (size_t)row * DM + 512 * j + 8 * lane) = (u32x4){pk2(y0[0], y0[1]), pk2(y0[2], y0[3]), pk2(y1[0], y1[1]), pk2(y1[2], y1[3])};
                *(u32x2*)(XB8 + (size_t)row * DM + 512 * j + 8 * lane) = (u32x2){pk4_fp8(y0[0], y0[1], y0[2], y0[3]), pk4_fp8(y1[0], y1[1], y1[2], y1[3])}; } } }
    { const int fr = lane & 15, fg = lane >> 4;
      const bf16_t* ap = PRE + (size_t)(R0 + fr) * DM + w * 256 + 8 * fg;
      const bf16_t* hp = WRH + ((size_t)w * 8 * 3 * 64 + lane) * 8; const bf16_t* lp = WRL + ((size_t)w * 8 * 3 * 64 + lane) * 8;
      f32x4 acc[2][3] = {{zero4(), zero4(), zero4()}, {zero4(), zero4(), zero4()}};
#pragma unroll 4
      for (int s = 0; s < 8; ++s) { const bf16x8 a0 = *(const bf16x8*)(ap + 32 * s), a1 = *(const bf16x8*)(ap + (size_t)16 * DM + 32 * s);
#pragma unroll
          for (int nj = 0; nj < 3; ++nj) { const bf16x8 bh = *(const bf16x8*)(hp + (size_t)((s * 3 + nj) * 64) * 8), bl = *(const bf16x8*)(lp + (size_t)((s * 3 + nj) * 64) * 8);
              acc[0][nj] = __builtin_amdgcn_mfma_f32_16x16x32_bf16(a0, bh, acc[0][nj], 0, 0, 0); acc[0][nj] = __builtin_amdgcn_mfma_f32_16x16x32_bf16(a0, bl, acc[0][nj], 0, 0, 0);
              acc[1][nj] = __builtin_amdgcn_mfma_f32_16x16x32_bf16(a1, bh, acc[1][nj], 0, 0, 0); acc[1][nj] = __builtin_amdgcn_mfma_f32_16x16x32_bf16(a1, bl, acc[1][nj], 0, 0, 0); } }
#pragma unroll
      for (int mi = 0; mi < 2; ++mi)
#pragma unroll
          for (int nj = 0; nj < 3; ++nj)
#pragma unroll
              for (int r = 0; r < 4; ++r) red[((w * 2 + mi) * 3 + nj) * 256 + (4 * fg + r) * 16 + fr] = acc[mi][nj][r]; }
    __syncthreads();
    for (int idx = tid; idx < 32 * 48; idx += 512) { const int row = idx / 48, c = idx - row * 48, mi = row >> 4, rl = row & 15, nj = c >> 4, cl = c & 15; float sum = 0.f;
#pragma unroll
        for (int kq = 0; kq < 8; ++kq) sum += red[((kq * 2 + mi) * 3 + nj) * 256 + rl * 16 + cl];
        const float mean = stats[row * 2], rstd = stats[row * 2 + 1];
        lg[idx] = (c < 36) ? rstd * (sum - mean * WRS[c]) + WRS[48 + c] : 0.f; }
    __syncthreads();
    if (tid < 32) { const LAS float* lr = lg + tid * 48;
        int gi = 0; float gm = lr[0];
#pragma unroll
        for (int c = 1; c < 4; ++c) { const float x = lr[c]; if (x > gm) { gm = x; gi = c; } }
        float gs = 0.f;
#pragma unroll
        for (int c = 0; c < 4; ++c) gs += expf(lr[c] - gm);
        const float gtop = 1.0f / gs;
        float ev[8];
#pragma unroll
        for (int c = 0; c < 8; ++c) ev[c] = lr[4 + gi * 8 + c];
        int i1 = 0; float m1 = ev[0];
#pragma unroll
        for (int c = 1; c < 8; ++c) if (ev[c] > m1) { m1 = ev[c]; i1 = c; }
        int i2 = -1; float m2 = -INFINITY;
#pragma unroll
        for (int c = 0; c < 8; ++c) if (c != i1 && ev[c] > m2) { m2 = ev[c]; i2 = c; }
        const float p2 = expf(m2 - m1), den = 1.0f + p2;
        const float w1 = gtop / den, w2 = gtop * p2 / den;
        if (commit) { const int tok = R0 + tid; const int e1 = gi * 8 + i1, e2 = gi * 8 + i2;
            const unsigned s1 = __hip_atomic_fetch_add(cnt + e1 * 64, 1u, __ATOMIC_RELAXED, __HIP_MEMORY_SCOPE_AGENT), s2 = __hip_atomic_fetch_add(cnt + e2 * 64, 1u, __ATOMIC_RELAXED, __HIP_MEMORY_SCOPE_AGENT);
            ltok[e1 * SMT + s1] = tok; lgate[e1 * SMT + s1] = w1; ltok[e2 * SMT + s2] = tok; lgate[e2 * SMT + s2] = w2;
            tinfo[tok * 2] = e1 * SMT + (int)s1; tinfo[tok * 2 + 1] = e2 * SMT + (int)s2; } }
}
__device__ __forceinline__ void moe_tables(const Frame& F, int l) {
    LAS int* toff = (LAS int*)(F.lds + LDS_TOFF); const unsigned* cnt = F.ctl + CW_CNT + (l * 2 + F.sid) * 32 * 64;
    __syncthreads();
    if (F.tid < 32) toff[64 + F.tid] = ((int)cnt[F.tid * 64] + 255) >> 8;
    __syncthreads();
    if (F.tid < 33) { int run = 0;
#pragma unroll 1
        for (int k = 0; k < F.tid; ++k) run += toff[64 + k];
        toff[F.tid] = run; }
    __syncthreads();
}
__device__ __forceinline__ void ln2_rows(const Frame& F, const Args& a, int l, float* OUT, bool write_xb) {
    const bf16_t* PRE = (const bf16_t*)(F.ws + WS_PRE); const unsigned char* Y = F.Yp(); bf16_t* XB = (bf16_t*)(F.ws + WS_XB); const int* tinfo = (const int*)(F.ws + WS_TINFO);
    const LAS int* toff = (const LAS int*)(F.lds + LDS_TOFF);
    const float* g = argp(F.lds, 26) + (size_t)l * DM; const float* bb = argp(F.lds, 27) + (size_t)l * DM; const int lane = F.lane;
    for (int row0 = F.row0 + (F.bx * 8 + F.wave) * 2; row0 < F.row0 + SMT; row0 += F.G * 16) {
        float v[2][4][8]; float s[2] = {0.f, 0.f};
#pragma unroll
        for (int r = 0; r < 2; ++r) { const int row = row0 + r; const int i0 = tinfo[row * 2], i1 = tinfo[row * 2 + 1];
            const size_t s0 = (size_t)toff[i0 >> 12] * 256 + (i0 & 4095), s1 = (size_t)toff[i1 >> 12] * 256 + (i1 & 4095);
            const bf16_t* pr = PRE + (size_t)row * DM; const unsigned char* y0 = Y + s0 * DM; const unsigned char* y1 = Y + s1 * DM;
#pragma unroll
            for (int j = 0; j < 4; ++j) { const u32x4 pw = *(const u32x4*)(pr + 512 * j + 8 * lane); const u32x2 a0 = *(const u32x2*)(y0 + 512 * j + 8 * lane), a1 = *(const u32x2*)(y1 + 512 * j + 8 * lane);
                const unsigned pwv[4] = {pw.x, pw.y, pw.z, pw.w}; const unsigned a0v[2] = {a0.x, a0.y}, a1v[2] = {a1.x, a1.y};
#pragma unroll
                for (int q = 0; q < 2; ++q) { const f32x2 e0 = __builtin_amdgcn_cvt_pk_f32_fp8((int)a0v[q], false), e1 = __builtin_amdgcn_cvt_pk_f32_fp8((int)a0v[q], true), f0 = __builtin_amdgcn_cvt_pk_f32_fp8((int)a1v[q], false), f1 = __builtin_amdgcn_cvt_pk_f32_fp8((int)a1v[q], true);
                    v[r][j][4 * q + 0] = bflo(pwv[2 * q]) + (e0[0] + f0[0]) * Y8_INV; v[r][j][4 * q + 1] = bfhi(pwv[2 * q]) + (e0[1] + f0[1]) * Y8_INV;
                    v[r][j][4 * q + 2] = bflo(pwv[2 * q + 1]) + (e1[0] + f1[0]) * Y8_INV; v[r][j][4 * q + 3] = bfhi(pwv[2 * q + 1]) + (e1[1] + f1[1]) * Y8_INV; }
#pragma unroll
                for (int k = 0; k < 8; ++k) s[r] += v[r][j][k]; } }
#pragma unroll
        for (int r = 0; r < 2; ++r) { const int row = row0 + r;
            const float mean = wave_sum(s[r]) * (1.f / DM); float q = 0.f;
#pragma unroll
            for (int j = 0; j < 4; ++j)
#pragma unroll
                for (int k = 0; k < 8; ++k) { v[r][j][k] -= mean; q += v[r][j][k] * v[r][j][k]; }
            const float rstd = 1.0f / sqrtf(wave_sum(q) * (1.f / DM) + LN_EPS);
#pragma unroll
            for (int j = 0; j < 4; ++j) { const float* gp = g + 512 * j + 8 * lane; const float* bp = bb + 512 * j + 8 * lane;
                const f32x4 g0 = *(const f32x4*)gp, g1 = *(const f32x4*)(gp + 4), b0 = *(const f32x4*)bp, b1 = *(const f32x4*)(bp + 4);
                const f32x4 y0 = (f32x4){v[r][j][0], v[r][j][1], v[r][j][2], v[r][j][3]} * rstd * g0 + b0, y1 = (f32x4){v[r][j][4], v[r][j][5], v[r][j][6], v[r][j][7]} * rstd * g1 + b1;
                if (write_xb) { *(u32x4*)(XB + (size_t)row * DM + 512 * j + 8 * lane) = (u32x4){pk2(y0[0], y0[1]), pk2(y0[2], y0[3]), pk2(y1[0], y1[1]), pk2(y1[2], y1[3])};
                    *(u32x2*)(F.ws + WS_XB8 + (size_t)row * DM + 512 * j + 8 * lane) = (u32x2){pk4_fp8s(y0[0], y0[1], y0[2], y0[3]), pk4_fp8s(y1[0], y1[1], y1[2], y1[3])}; }
                else { float* op = OUT + (size_t)row * DM + 512 * j + 8 * lane; __builtin_nontemporal_store(y0, (f32x4*)op); __builtin_nontemporal_store(y1, (f32x4*)(op + 4)); } } }
    }
}

constexpr int PH_PER_LAYER = 9, N_PHASES = 1 + NL * PH_PER_LAYER;
__global__ void __launch_bounds__(512, 2) mega(Args args) {
    extern __shared__ __attribute__((aligned(16))) unsigned char lds_raw[];
    const int bxg = blockIdx.x, Gg = gridDim.x;
    Frame F; F.lds = (LAS unsigned char*)lds_raw; F.ws = args.ws; F.ctl = (unsigned*)(args.ws + WS_CTL);
    F.tid = threadIdx.x; F.lane = F.tid & 63; F.wave = __builtin_amdgcn_readfirstlane(F.tid >> 6);
    F.sid = (bxg >> 3) & 1; F.row0 = F.sid * SMT; F.G = Gg >> 1; F.bx = ((bxg >> 4) << 3) | (bxg & 7);
    if (F.tid < 4) ((LAS unsigned*)(F.lds + LDS_BARW))[F.tid] = 0u;
    if (F.tid == 0) { LAS unsigned long long* ap = (LAS unsigned long long*)(F.lds + LDS_ARGS);
#pragma unroll
        for (int k = 0; k < 28; ++k) ap[k] = (unsigned long long)args.in[k];
        ap[28] = (unsigned long long)args.out; }
    __syncthreads();
    XcdBarrier barS = xcd_barrier_post(F.ctl + CW_BAR + F.sid * XCD_BAR_WORDS, (volatile LAS unsigned*)(F.lds + LDS_BARW), (unsigned)(Gg >> 1));
    XcdBarrier barG = xcd_barrier_post(F.ctl + CW_BAR + 2 * XCD_BAR_WORDS, (volatile LAS unsigned*)(F.lds + LDS_BARW + 8), (unsigned)Gg);
#if TPROBE
#define TS_PTR ((volatile LAS unsigned long long*)((LAS unsigned char*)lds_raw + LDS_STAGE + 1280))
    int ts_n = 0;
#define STAMP() do { if (F.wave == 0 && __builtin_amdgcn_mbcnt_hi(~0u, __builtin_amdgcn_mbcnt_lo(~0u, 0u)) == 0u && ts_n < 30) TS_PTR[ts_n] = __builtin_amdgcn_s_memrealtime(); ++ts_n; } while (0)
#else
#define STAMP() do { } while (0)
#endif
    STAMP();
#define SBAR() do { xcd_barrier(barS); STAMP(); } while (0)
#define WSP(T, off) ((T*)(f.ws + (off)))

    { Frame g = F; g.G = Gg; g.bx = bxg; g.sid = 0; const Frame f = g.fresh(); phase_prologue(f, args); }
    xcd_barrier(barG); STAMP();
    { const Frame f = F.fresh(); if (f.sid == 1) { conv_all(f, args, 0, IO_PG, I_L); flag_publish(f.ctl + CW_FLAG + 0 * 64, f.tid); } }
    STAMP();

#pragma unroll 1
    for (int l = 0; l < NL; ++l) {
        { const Frame f = F.fresh(); if (l == 1 && f.sid == 1) flag_wait(f.ctl + CW_FLAG + 1 * 64, (unsigned)f.G, f.ctl + CW_BAR + XB_TMO, f.tid);
            pg8::DenseSched S; S.init(WSP(const bf16_t, WS_XB) + (size_t)f.row0 * DM, WSP(const bf16_t, WS_WIN) + (size_t)l * DINP * DM, DM, DM, SMT, 16 * 256, f.G, f.bx); S.wave = f.wave; S.cut = 10; S.add0 = 0; S.add1 = 6;
            pg8::EpiBf16 E{f.Up() + (size_t)f.row0 * DINP, DINP}; pg8::gemm_phase(f.lds, DM, S, E); }
        { const Frame f = F.fresh();
            pg8::DenseSched S; S.init(WSP(const bf16_t, WS_XB8) + (size_t)f.row0 * (DM / 2), WSP(const bf16_t, WS_WIN8) + (size_t)l * IN8_TILES * 256 * (DM / 2), DM / 2, DM / 2, SMT, IN8_TILES * 256, f.G, f.bx); S.wave = f.wave; S.cut = 6; S.add0 = 10; S.add1 = 16; S.compactB = 1;
            pg8::EpiBf16 E{f.Up() + (size_t)f.row0 * DINP, DINP, W8_INV};
            const int total = (SMT / 256) * IN8_TILES;
#pragma unroll 1
            for (int r0 = 0; r0 * f.G < total; ++r0) { pg8::DenseSched S2 = S; S2.c = f.bx + r0 * f.G; pg8::gemm_phase<pg8::EpiBf16, pg8::DenseSched, true, true>(f.lds, DM / 2, S2, E); } }
        SBAR();
        { { const Frame f = F.fresh(); const int bxx = (f.G & 7) == 0 ? (f.bx & 7) * (f.G >> 3) + (f.bx >> 3) : f.bx;
            for (int u = bxx; u < 128; u += f.G) conv_unit(f, args, l, f.sid * 128 + u); }
          { const Frame f = F.fresh(); for (int u = f.bx; u < 512; u += 2 * f.G) gla_a_pair(f, args, l, f.sid * 512 + u, f.sid * 512 + (u + f.G < 512 ? u + f.G : u)); } __syncthreads(); }
        SBAR();
        { { const Frame f = F.fresh(); gla_scan(f); }
            const Frame f = F.fresh();
            LAS float* bt = (LAS float*)(f.lds + AT_BT_OFF);
            __syncthreads();
            for (int i = f.tid; i < 8 * 3 * 224; i += 512) { const int hh = i / 672, rem = i - hh * 672, brr = rem / 224, st = rem - brr * 224 - 48;
                bt[i] = (st >= 0 && st <= 128) ? WSP(const float, WS_BTAB)[(brr * 129 + st) * 8 + hh] * 1.4426950408889634f : -1e30f; }
#pragma unroll 1
            for (int jb = f.bx; jb < AT_NJOB; jb += f.G) {
                AttnTile tl; attn_tile_load(f, f.sid * AT_NJOB + jb, tl);
                __syncthreads();
                attn_tile_store(f, tl); const bf16x8 qf0 = tl.q0, qf1 = tl.q1;
                __syncthreads();
                attn_block(f, f.sid * AT_NJOB + jb, qf0, qf1, bt); }
            __syncthreads(); }
        SBAR();
        { { const Frame f = F.fresh(); gla_c_phase(f, args, l); __syncthreads(); } { const Frame f = F.fresh(); attn_combine(f); } }
        SBAR();
        { { const Frame f = F.fresh(); pg8::DenseSched S; S.init((const bf16_t*)(f.MIXp() + (size_t)f.row0 * DM), WSP(const bf16_t, WS_WOUT) + (size_t)l * DM * (DM / 2), DM / 2, DM / 2, SMT, DM, f.G, f.bx); S.wave = f.wave;
              pg8::EpiRes E{WSP(bf16_t, WS_PRE) + (size_t)f.row0 * DM, WSP(const bf16_t, WS_XB) + (size_t)f.row0 * DM, DM, DN_ALPHA, W8_INV}; pg8::gemm_phase<pg8::EpiRes, pg8::DenseSched, true, true>(f.lds, DM / 2, S, E); }
          { const Frame f = F.fresh(); pg8::DenseSched S; S.init(WSP(const bf16_t, WS_PB) + ((size_t)l * MT + f.row0) * PLE, WSP(const bf16_t, WS_WPP) + (size_t)l * DM * PLE, PLE, PLE, SMT, DM, f.G, f.bx); S.wave = f.wave;
              pg8::EpiBf16 E{WSP(bf16_t, WS_PP) + (size_t)f.row0 * DM, DM}; pg8::gemm_phase(f.lds, PLE, S, E); } }
        SBAR();
        { const Frame f = F.fresh(); for (int u = f.bx; u < SMT / 32; u += f.G) ln1_unit(f, args, l, f.sid * (SMT / 32) + u, true); __syncthreads(); }
        SBAR();
        { const Frame f = F.fresh(); moe_tables(f, l); }
        { { const Frame f = F.fresh(); if (f.sid == l) flag_wait(f.ctl + CW_FLAG + (l == 0 ? 0 : 2) * 64, (unsigned)f.G, f.ctl + CW_BAR + XB_TMO, f.tid);
              pg8::DenseSched S; S.init(WSP(const bf16_t, WS_XB8) + (size_t)f.row0 * (DM / 2), WSP(const bf16_t, WS_WPG) + (size_t)l * DM * (DM / 2), DM / 2, DM / 2, SMT, DM, f.G, f.bx); S.wave = f.wave;
              pg8::EpiPle E{WSP(bf16_t, WS_PRE) + (size_t)f.row0 * DM, WSP(const bf16_t, WS_XB) + (size_t)f.row0 * DM, WSP(const bf16_t, WS_PP) + (size_t)f.row0 * DM, argp(f.lds, 24) + (size_t)l * DM, DM, DN_ALPHA, W8_INV}; pg8::gemm_phase<pg8::EpiPle, pg8::DenseSched, true, true>(f.lds, DM / 2, S, E); }
          { const Frame f = F.fresh();
              pg8::MoeSched<true> S; S.A = WSP(const bf16_t, WS_XB8); S.Bt = WSP(const bf16_t, WS_WGU) + (size_t)l * NEXP * 512 * (DM / 2); S.lda = DM / 2; S.ldb = DM / 2; S.nN = 2; S.G = f.G; S.c = f.bx; S.wave = f.wave; S.bexp = (size_t)512 * DM;
              S.toff = (const LAS int*)(f.lds + LDS_TOFF); S.cnt = f.ctl + CW_CNT + (l * 2 + f.sid) * 32 * 64; S.ltok = WSP(const int, WS_LTOK) + f.sid * 32 * SMT;
              pg8::EpiMoe1 E{f.Hp(), WSP(const float, WS_LGATE) + f.sid * 32 * SMT, f.ctl + CW_CNT + (l * 2 + f.sid) * 32 * 64};
              const int total = __builtin_amdgcn_readfirstlane(S.toff[32]) * 2;
#pragma unroll 1
              for (int r0 = 0; r0 * f.G < total; ++r0) { S.round0 = r0; pg8::gemm_phase<pg8::EpiMoe1, pg8::MoeSched<true>, true, true>(f.lds, DM / 2, S, E); } } }
        SBAR();
        { const Frame f = F.fresh();
            pg8::MoeSched<false> S; S.A = f.Hp(); S.Bt = WSP(const bf16_t, WS_WD) + (size_t)l * NEXP * DM * DEXP; S.lda = DEXP; S.ldb = DEXP; S.nN = 8; S.G = f.G; S.c = f.bx; S.wave = f.wave; S.bexp = (size_t)DM * DEXP * 2;
            S.toff = (const LAS int*)(f.lds + LDS_TOFF); S.cnt = f.ctl + CW_CNT + (l * 2 + f.sid) * 32 * 64; S.ltok = WSP(const int, WS_LTOK) + f.sid * 32 * SMT;
            pg8::EpiY8 E{f.Yp(), f.ctl + CW_CNT + (l * 2 + f.sid) * 32 * 64}; pg8::gemm_phase(f.lds, DEXP, S, E); }
        SBAR();
        { { const Frame f = F.fresh(); ln2_rows(f, args, l, (float*)argp(f.lds, 28), l + 1 < NL); }
          if (l + 1 < NL) { const Frame f = F.fresh();
              if (f.sid == 0) { conv_all(f, args, l + 1, 0, IO_PG); flag_publish(f.ctl + CW_FLAG + 1 * 64, f.tid); conv_all(f, args, l + 1, IO_PG, I_L); flag_publish(f.ctl + CW_FLAG + 2 * 64, f.tid); } } }
        if (l + 1 < NL) SBAR(); else STAMP();
    }
#undef WSP
#undef SBAR
#if TPROBE
    if (F.sid == TP_SID && F.bx == 0 && F.wave == 0) { asm volatile("s_waitcnt vmcnt(0) lgkmcnt(0)" ::: "memory");
        const unsigned long long d = TS_PTR[TP_K2] - TS_PTR[TP_K], t0 = __builtin_amdgcn_s_memrealtime();
        while (__builtin_amdgcn_s_memrealtime() - t0 < d * TP_MULT) __builtin_amdgcn_s_sleep(16); }
#endif
}

extern "C" void kernel_launch(void* const* d_in, const int* in_sizes, int n_in, void* d_out, int out_size, void* d_ws, size_t ws_size, hipStream_t stream) {
    static int grid = 0;
    if (grid == 0) {
        if (n_in != 28 || out_size != MT * DM || ws_size < WS_END) { fprintf(stderr, "kernel_launch: unexpected shapes (n_in %d, out %d, ws %zu); nothing launched\n", n_in, out_size, ws_size); grid = -1; return; }
        int dev = 0, cus = 0, per_cu = 0;
        if (hipGetDevice(&dev) != hipSuccess || hipDeviceGetAttribute(&cus, hipDeviceAttributeMultiprocessorCount, dev) != hipSuccess) { grid = -1; return; }
        if (hipFuncSetAttribute((const void*)mega, hipFuncAttributeMaxDynamicSharedMemorySize, LDS_BYTES) != hipSuccess) { fprintf(stderr, "kernel_launch: hipFuncSetAttribute failed\n"); grid = -1; return; }
        if (hipOccupancyMaxActiveBlocksPerMultiprocessor(&per_cu, (const void*)mega, 512, LDS_BYTES) != hipSuccess || per_cu < 1) { fprintf(stderr, "kernel_launch: occupancy query says %d\n", per_cu); }
        (void)hipGetLastError();
        grid = cus;
    }
    if (grid < 0) return;
    (void)hipMemsetAsync((char*)d_ws + WS_CTL, 0, CTL_ZERO_BYTES, stream);
    Args a{};
    for (int i = 0; i < 28; ++i) a.in[i] = (const float*)d_in[i];
    a.out = (float*)d_out; a.ws = (unsigned char*)d_ws;
    a.ph_lo = 0; a.ph_hi = 0; hipLaunchKernelGGL(mega, dim3(grid), dim3(512), LDS_BYTES, stream, a);
}
```
